# Optimizing an MI355X kernel written in HIP

```python
import math
import jax
import jax.numpy as jnp
from jax import lax
import numpy as np

D_MODEL = 2048
BATCH = 2
SEQ = 4096
DEPTH = 4
DEC_BATCH = 32
DEC_SEQ = 8
PAST_LEN = 16384
PAGE_SIZE = 128

MIX_WIDTH = D_MODEL
W_GROUP = MIX_WIDTH // 4
HGRN_WIDTH = W_GROUP
HGRN_HEAD_DIM = 128
HGRN_HEADS = HGRN_WIDTH // HGRN_HEAD_DIM
HGRN_CHUNK = 64
POOL_WIDTH = W_GROUP
POOL_WINDOWS = (2, 4, 8, 16)
POOL_GROUPS = 4
POOL_CH = POOL_WIDTH // POOL_GROUPS
POOL_BUF = 15
SSM_WIDTH = W_GROUP
SSM_HEAD_DIM = 64
SSM_HEADS = SSM_WIDTH // SSM_HEAD_DIM
SSM_STATE = 128
SSM_GROUPS = 2
SSM_CONV = 4
SSM_CONV_DIM = SSM_WIDTH + 2 * SSM_GROUPS * SSM_STATE
SSM_CHUNK = 64
ATTN_WIDTH = MIX_WIDTH - HGRN_WIDTH - POOL_WIDTH - SSM_WIDTH
ATTN_HEAD_DIM = 64
ATTN_HEADS = ATTN_WIDTH // ATTN_HEAD_DIM
ATTN_KV_HEADS = 2
WINDOW = 128
ROPE_THETA = 10000.0
D_FF = 4 * D_MODEL
N_MOD = 6
EPS = 1e-6
IN_SPLITS = (HGRN_WIDTH, HGRN_WIDTH, HGRN_WIDTH, HGRN_WIDTH, POOL_WIDTH, SSM_WIDTH, SSM_WIDTH, SSM_GROUPS * SSM_STATE, SSM_GROUPS * SSM_STATE, SSM_HEADS, ATTN_WIDTH, ATTN_KV_HEADS * ATTN_HEAD_DIM, ATTN_KV_HEADS * ATTN_HEAD_DIM)
IN_WIDTH = sum(IN_SPLITS)

kernel_name = "hymba_hgrn2_pool_ssd_swa_decoder_step"


def rmsnorm(x, g):
    xf = x.astype(jnp.float32)
    y = xf * lax.rsqrt(jnp.mean(xf * xf, axis=-1, keepdims=True) + EPS)
    return (y * g.astype(jnp.float32)).astype(x.dtype)


def to_chunks(a, L):
    b, t = a.shape[0], a.shape[1]
    return jnp.moveaxis(a.reshape((b, t // L, L) + a.shape[2:]), 1, 0)


def from_chunks(a):
    nc, b, L = a.shape[0], a.shape[1], a.shape[2]
    return jnp.moveaxis(a, 0, 1).reshape((b, nc * L) + a.shape[3:])


def causal_decay(cum, mask):
    diff = cum[:, :, None] - cum[:, None, :]
    m = mask.reshape(mask.shape + (1,) * (cum.ndim - 2))
    return jnp.exp(jnp.where(m[None], diff, -jnp.inf))


def hgrn_lower_bounds(lb_logits):
    p = jax.nn.softmax(lb_logits.astype(jnp.float32), axis=0)
    cs = jnp.cumsum(p, axis=0)
    return cs - cs[:1]


def rope(x, pos):
    half = x.shape[-1] // 2
    inv = ROPE_THETA ** (-jnp.arange(half, dtype=jnp.float32) / half)
    ang = pos.astype(jnp.float32)[:, None] * inv[None]
    cos = jnp.cos(ang)[None, :, None]
    sin = jnp.sin(ang)[None, :, None]
    x1, x2 = x[..., :half], x[..., half:]
    return jnp.concatenate([x1 * cos - x2 * sin, x2 * cos + x1 * sin], axis=-1)


def hgrn2_mixer(q_raw, f_raw, i_raw, g_raw, lb, norm_g, state):
    f32 = jnp.float32
    b, t, _ = q_raw.shape
    shp = (b, t, HGRN_HEADS, HGRN_HEAD_DIM)
    q = jax.nn.silu(q_raw.astype(f32)).reshape(shp)
    f = f_raw.astype(f32).reshape(shp)
    lbh = lb.astype(f32).reshape(HGRN_HEADS, HGRN_HEAD_DIM)
    log_f = jnp.logaddexp(jnp.log(lbh), jnp.log1p(-lbh) + jax.nn.log_sigmoid(f))
    k = (1.0 - lbh) * jax.nn.sigmoid(-f)
    v = i_raw.astype(f32).reshape(shp)
    L = math.gcd(t, HGRN_CHUNK)
    mask = jnp.tril(jnp.ones((L, L), dtype=bool))

    def step(S, blk):
        qc, kc, vc, lc = blk
        cum = jnp.cumsum(lc, axis=1)
        decay = causal_decay(cum, mask)
        scores = jnp.einsum('blhd,bshd,blshd->bhls', qc, kc, decay)
        o = jnp.einsum('bhls,bshv->blhv', scores, vc) + jnp.einsum('blhd,bhdv->blhv', qc * jnp.exp(cum), S)
        last = cum[:, -1]
        S = jnp.exp(last)[..., None] * S + jnp.einsum('bshd,bshv->bhdv', kc * jnp.exp(last[:, None] - cum), vc)
        return S, o

    S_fin, o = lax.scan(step, state.astype(f32), (to_chunks(q, L), to_chunks(k, L), to_chunks(v, L), to_chunks(log_f, L)))
    o = rmsnorm(from_chunks(o), norm_g.astype(f32).reshape(HGRN_HEADS, HGRN_HEAD_DIM))
    y = o.reshape(b, t, HGRN_WIDTH) * jax.nn.sigmoid(g_raw.astype(f32))
    return y.astype(q_raw.dtype), S_fin.astype(state.dtype)


def pool_mixer(u, buf, pos0, w_pool, scale):
    f32 = jnp.float32
    b, t, w_all = u.shape
    ext = jnp.concatenate([buf.astype(u.dtype), u], axis=1).astype(f32)
    cs = jnp.concatenate([jnp.zeros((b, 1, w_all), f32), jnp.cumsum(ext, axis=1)], axis=1)
    pos = pos0 + jnp.arange(t)
    outs = []
    for gi, win in enumerate(POOL_WINDOWS):
        sl = slice(gi * POOL_CH, (gi + 1) * POOL_CH)
        s = cs[:, POOL_BUF + 1:POOL_BUF + 1 + t, sl] - cs[:, POOL_BUF + 1 - win:POOL_BUF + 1 - win + t, sl]
        cnt = jnp.minimum(pos + 1, win).astype(f32)
        outs.append(s / cnt[None, :, None] - ext[:, POOL_BUF:, sl])
    pooled = jnp.stack(outs, axis=2)
    y = jnp.einsum('btgc,gcd->btgd', pooled, w_pool.astype(f32)).reshape(b, t, w_all) * scale.astype(f32)
    return y.astype(u.dtype), ext[:, -POOL_BUF:].astype(buf.dtype)


def ssd_mixer(z, xs, bs, cs_, dt_raw, conv_buf, ssm_state, conv_w, conv_b, dt_bias, a_log, d_skip, norm_g):
    f32 = jnp.float32
    b, t, _ = xs.shape
    G, R, P, N = SSM_GROUPS, SSM_HEADS // SSM_GROUPS, SSM_HEAD_DIM, SSM_STATE
    xbc = jnp.concatenate([xs, bs, cs_], axis=-1)
    ext = jnp.concatenate([conv_buf.astype(xbc.dtype), xbc], axis=1)
    acc = ext[:, 0:t].astype(f32) * conv_w[0].astype(f32)
    for j in range(1, SSM_CONV):
        acc = acc + ext[:, j:j + t].astype(f32) * conv_w[j].astype(f32)
    conv = jax.nn.silu(acc + conv_b.astype(f32))
    x, bm, cm = jnp.split(conv, [SSM_WIDTH, SSM_WIDTH + G * N], axis=-1)
    x = x.reshape(b, t, G, R, P)
    bm = bm.reshape(b, t, G, N)
    cm = cm.reshape(b, t, G, N)
    dt = jax.nn.softplus(dt_raw.astype(f32) + dt_bias.astype(f32)).reshape(b, t, G, R)
    a = dt * (-jnp.exp(a_log.astype(f32))).reshape(G, R)
    L = math.gcd(t, SSM_CHUNK)
    mask = jnp.tril(jnp.ones((L, L), dtype=bool))

    def step(S, blk):
        xc, bc, cc, dtc, ac = blk
        cum = jnp.cumsum(ac, axis=1)
        decay = causal_decay(cum, mask)
        cb = jnp.einsum('blgn,bsgn->blsg', cc, bc)
        wts = cb[..., None] * decay * dtc[:, None]
        y = jnp.einsum('blsgr,bsgrp->blgrp', wts, xc)
        y = y + jnp.einsum('blgn,bgrpn->blgrp', cc, S) * jnp.exp(cum)[..., None]
        last = cum[:, -1]
        w_in_state = dtc * jnp.exp(last[:, None] - cum)
        S = jnp.exp(last)[..., None, None] * S + jnp.einsum('bsgr,bsgrp,bsgn->bgrpn', w_in_state, xc, bc)
        return S, y

    S0 = ssm_state.astype(f32).reshape(b, G, R, P, N)
    S_fin, ys = lax.scan(step, S0, (to_chunks(x, L), to_chunks(bm, L), to_chunks(cm, L), to_chunks(dt, L), to_chunks(a, L)))
    y = from_chunks(ys) + x * d_skip.astype(f32).reshape(G, R)[..., None]
    y = y.reshape(b, t, SSM_WIDTH) * jax.nn.silu(z.astype(f32))
    y = rmsnorm(y, norm_g)
    return y.astype(xs.dtype), ext[:, -(SSM_CONV - 1):].astype(conv_buf.dtype), S_fin.reshape(b, SSM_HEADS, P, N).astype(ssm_state.dtype)


def swa_mixer(q_raw, k_raw, v_raw, k_buf, v_buf, pos0, q_norm_g, k_norm_g, sinks):
    f32 = jnp.float32
    b, t, _ = q_raw.shape
    H, KV, Dh = ATTN_HEADS, ATTN_KV_HEADS, ATTN_HEAD_DIM
    R = H // KV
    pos = pos0 + jnp.arange(t)
    q = rope(rmsnorm(q_raw.reshape(b, t, H, Dh), q_norm_g).astype(f32), pos)
    k = rope(rmsnorm(k_raw.reshape(b, t, KV, Dh), k_norm_g).astype(f32), pos).astype(k_buf.dtype)
    v = v_raw.reshape(b, t, KV, Dh).astype(v_buf.dtype)
    k_ext = jnp.concatenate([k_buf, k], axis=1)
    v_ext = jnp.concatenate([v_buf, v], axis=1)
    Lq = math.gcd(t, WINDOW)
    nb = t // Lq
    idx = jnp.arange(nb)[:, None] * Lq + jnp.arange(WINDOW + Lq)[None]
    kb = k_ext[:, idx].astype(f32)
    vb = v_ext[:, idx].astype(f32)
    qb = q.reshape(b, nb, Lq, KV, R, Dh)
    s = jnp.einsum('bnqgrd,bnkgd->bngrqk', qb, kb) * (Dh ** -0.5)
    q_pos = pos0 + jnp.arange(t).reshape(nb, Lq)
    k_pos = pos0 - WINDOW + idx
    kp, qp = k_pos[:, None, :], q_pos[:, :, None]
    mask = (kp >= 0) & (kp <= qp) & (kp > qp - WINDOW)
    s = jnp.where(mask[None, :, None, None], s, -jnp.inf)
    sink = sinks.astype(f32).reshape(1, 1, KV, R, 1, 1)
    m = jnp.maximum(jnp.max(s, axis=-1, keepdims=True), sink)
    p = jnp.exp(s - m)
    den = jnp.sum(p, axis=-1, keepdims=True) + jnp.exp(sink - m)
    o = jnp.einsum('bngrqk,bnkgd->bnqgrd', p / den, vb).reshape(b, t, ATTN_WIDTH)
    return o.astype(q_raw.dtype), k_ext[:, -WINDOW:], v_ext[:, -WINDOW:]


def trunk(x, c, pos0, s_hgrn, s_pool, s_ssm, s_conv, c_k, c_v,
          norm1_g, norm2_g, w_ada, b_ada, w_in, hgrn_lb_logits, hgrn_norm_g, pool_w, pool_scale,
          conv_w, conv_b, dt_bias, a_log, d_skip, ssm_norm_g, q_norm_g, k_norm_g, sinks, w_out, w_up, w_down):
    b = x.shape[0]
    lbs = hgrn_lower_bounds(hgrn_lb_logits)
    offsets = np.cumsum(np.array(IN_SPLITS))[:-1].tolist()
    new_hgrn, new_pool, new_ssm, new_conv, new_k, new_v = [], [], [], [], [], []
    for l in range(DEPTH):
        mod = (jax.nn.silu(c) @ w_ada[l] + b_ada[l]).reshape(b, N_MOD, 1, D_MODEL)
        shift1, scale1, gate1, shift2, scale2, gate2 = (mod[:, i] for i in range(N_MOD))
        h = rmsnorm(x, norm1_g[l]) * (1.0 + scale1) + shift1
        (aq, af, ai, ag, pu, cz, cx, cbm, ccm, cdt, dq, dk, dv) = jnp.split(h @ w_in[l], offsets, axis=-1)
        ya, sa = hgrn2_mixer(aq, af, ai, ag, lbs[l], hgrn_norm_g[l], s_hgrn[l])
        yb, sb = pool_mixer(pu, s_pool[l], pos0, pool_w[l], pool_scale[l])
        yc, sconv, sssm = ssd_mixer(cz, cx, cbm, ccm, cdt, s_conv[l], s_ssm[l], conv_w[l], conv_b[l], dt_bias[l], a_log[l], d_skip[l], ssm_norm_g[l])
        yd, sk, sv = swa_mixer(dq, dk, dv, c_k[l], c_v[l], pos0, q_norm_g[l], k_norm_g[l], sinks[l])
        mixed = jnp.concatenate([ya, yb, yc, yd], axis=-1) @ w_out[l]
        x = x + gate1 * mixed
        h = rmsnorm(x, norm2_g[l]) * (1.0 + scale2) + shift2
        x = x + gate2 * (jnp.square(jax.nn.relu(h @ w_up[l])) @ w_down[l])
        new_hgrn.append(sa)
        new_pool.append(sb)
        new_ssm.append(sssm)
        new_conv.append(sconv)
        new_k.append(sk)
        new_v.append(sv)
    return (x, jnp.stack(new_hgrn), jnp.stack(new_pool), jnp.stack(new_ssm), jnp.stack(new_conv), jnp.stack(new_k), jnp.stack(new_v))


def setup_inputs(seed: int = 0) -> dict:
    key = jax.random.key(seed)
    ks = jax.random.split(key, 40)
    f32 = jnp.float32

    def nrm(k, shape, s=1.0):
        return jax.random.normal(k, shape, f32) * s

    dt0 = jnp.exp(jax.random.uniform(ks[30], (DEPTH, SSM_HEADS), f32) * (math.log(0.1) - math.log(0.001)) + math.log(0.001))
    return {
        "x_prompt": nrm(ks[0], (BATCH, SEQ, D_MODEL)),
        "x_sample": nrm(ks[1], (DEC_BATCH, DEC_SEQ, D_MODEL)),
        "c_prompt": nrm(ks[2], (BATCH, D_MODEL)),
        "c_sample": nrm(ks[3], (DEC_BATCH, D_MODEL)),
        "state_hgrn": nrm(ks[4], (DEPTH, DEC_BATCH, HGRN_HEADS, HGRN_HEAD_DIM, HGRN_HEAD_DIM), 0.5),
        "state_pool": nrm(ks[5], (DEPTH, DEC_BATCH, POOL_BUF, POOL_WIDTH)),
        "state_ssm": nrm(ks[6], (DEPTH, DEC_BATCH, SSM_HEADS, SSM_HEAD_DIM, SSM_STATE), 0.1),
        "state_conv": nrm(ks[7], (DEPTH, DEC_BATCH, SSM_CONV - 1, SSM_CONV_DIM)),
        "cache_k": nrm(ks[8], (DEPTH, DEC_BATCH, WINDOW, ATTN_KV_HEADS, ATTN_HEAD_DIM)),
        "cache_v": nrm(ks[9], (DEPTH, DEC_BATCH, WINDOW, ATTN_KV_HEADS, ATTN_HEAD_DIM)),
        "norm1_g": 1.0 + nrm(ks[10], (DEPTH, D_MODEL), 0.02),
        "norm2_g": 1.0 + nrm(ks[11], (DEPTH, D_MODEL), 0.02),
        "w_ada": nrm(ks[12], (DEPTH, D_MODEL, N_MOD * D_MODEL), 0.5 * D_MODEL ** -0.5),
        "b_ada": nrm(ks[13], (DEPTH, N_MOD * D_MODEL), 0.02),
        "w_in": nrm(ks[14], (DEPTH, D_MODEL, IN_WIDTH), D_MODEL ** -0.5),
        "hgrn_lb_logits": nrm(ks[15], (DEPTH, HGRN_WIDTH), 0.5),
        "hgrn_norm_g": 1.0 + nrm(ks[16], (DEPTH, HGRN_WIDTH), 0.02),
        "pool_w": nrm(ks[17], (DEPTH, POOL_GROUPS, POOL_CH, POOL_CH), POOL_CH ** -0.5),
        "pool_scale": 1.0 + nrm(ks[18], (DEPTH, POOL_WIDTH), 0.02),
        "conv_w": nrm(ks[19], (DEPTH, SSM_CONV, SSM_CONV_DIM), SSM_CONV ** -0.5),
        "conv_b": nrm(ks[20], (DEPTH, SSM_CONV_DIM), 0.02),
        "dt_bias": dt0 + jnp.log(-jnp.expm1(-dt0)),
        "a_log": jnp.log(jax.random.uniform(ks[21], (DEPTH, SSM_HEADS), f32, 1.0, 16.0)),
        "d_skip": 1.0 + nrm(ks[22], (DEPTH, SSM_HEADS), 0.1),
        "ssm_norm_g": 1.0 + nrm(ks[23], (DEPTH, SSM_WIDTH), 0.02),
        "q_norm_g": 1.0 + nrm(ks[24], (DEPTH, ATTN_HEAD_DIM), 0.02),
        "k_norm_g": 1.0 + nrm(ks[25], (DEPTH, ATTN_HEAD_DIM), 0.02),
        "sinks": nrm(ks[26], (DEPTH, ATTN_HEADS)),
        "w_out": nrm(ks[27], (DEPTH, MIX_WIDTH, D_MODEL), MIX_WIDTH ** -0.5),
        "w_up": nrm(ks[28], (DEPTH, D_MODEL, D_FF), D_MODEL ** -0.5),
        "w_down": nrm(ks[29], (DEPTH, D_FF, D_MODEL), D_FF ** -0.5),
    }


def _zeros_like_state(a, b, dtype):
    return jnp.zeros((DEPTH, b) + a.shape[2:], dtype)


def reference(x_prompt, x_sample, c_prompt, c_sample, state_hgrn, state_pool, state_ssm, state_conv, cache_k, cache_v,
              norm1_g, norm2_g, w_ada, b_ada, w_in, hgrn_lb_logits, hgrn_norm_g, pool_w, pool_scale,
              conv_w, conv_b, dt_bias, a_log, d_skip, ssm_norm_g, q_norm_g, k_norm_g, sinks, w_out, w_up, w_down):
    weights = (norm1_g, norm2_g, w_ada, b_ada, w_in, hgrn_lb_logits, hgrn_norm_g, pool_w, pool_scale,
               conv_w, conv_b, dt_bias, a_log, d_skip, ssm_norm_g, q_norm_g, k_norm_g, sinks, w_out, w_up, w_down)
    bp = x_prompt.shape[0]
    dtp = x_prompt.dtype
    (y_prompt, p_hgrn, p_pool, p_ssm, p_conv, p_k, p_v) = trunk(
        x_prompt, c_prompt, 0,
        _zeros_like_state(state_hgrn, bp, dtp), _zeros_like_state(state_pool, bp, dtp),
        _zeros_like_state(state_ssm, bp, dtp), _zeros_like_state(state_conv, bp, dtp),
        _zeros_like_state(cache_k, bp, dtp), _zeros_like_state(cache_v, bp, dtp), *weights)
    (y_sample, s_hgrn, s_pool, s_ssm, s_conv, s_k, s_v) = trunk(
        x_sample, c_sample, PAST_LEN, state_hgrn, state_pool, state_ssm, state_conv, cache_k, cache_v, *weights)
    return (y_prompt, y_sample, p_hgrn, p_pool, p_ssm, p_conv, p_k, p_v, s_hgrn, s_pool, s_ssm, s_conv, s_k, s_v)
```

```cpp
#include <hip/hip_runtime.h>
#include <cstdio>
#include <cstdint>
namespace pg8 {
#define PG8_LAS __attribute__((address_space(3)))
typedef unsigned short bf16_t;
typedef short bf16x8 __attribute__((ext_vector_type(8)));
typedef float f32x4 __attribute__((ext_vector_type(4)));
typedef unsigned u32x4 __attribute__((ext_vector_type(4)));
constexpr int BM = 256, BK = 64, HALF = 128, HTB = HALF * BK * 2  , STAGE_BYTES = 8 * HTB, NXCD = 8, WGM = 8;

__host__ __device__ __forceinline__ int lds_byte(int r, int c) { const int st = (r >> 4) * 2 + (c >> 5), rr = r & 15, cc = c & 31, ob = rr * 64 + cc * 2; return st * 1024 + (ob ^ (((ob >> 9) & 1) << 5)); }
__host__ __device__ __forceinline__ void stage_rc(int b, int& R, int& C) { const int st = b / 1024, sb = b % 1024, swz = sb ^ (((sb >> 9) & 1) << 5); R = (st >> 1) * 16 + swz / 64; C = (st & 1) * 32 + (swz % 64) / 2; }
__host__ __device__ __forceinline__ int perm32(int rho) { const int n = rho >> 4, i = rho & 15; return 8 * (i >> 2) + 4 * n + (i & 3); }

struct Unit { int pm, pn; };
struct Gemm { const bf16_t* A; const bf16_t* Bt; int M, N, K; };

struct StaticOrder {
    int nM, nN, nwg, G, c;
    __host__ __device__ void init(int M, int N, int G_, int c_) { nM = M / BM; nN = N / BM; nwg = nM * nN; G = G_; c = c_; }
    __host__ __device__ bool next(int i, Unit& u) const {
        const long L = (long)i * G + c; if (L >= nwg) return false;
        int wgid = (int)L; { const int q = nwg / NXCD, r = nwg % NXCD, xcd = wgid % NXCD, off = wgid / NXCD; wgid = (xcd < r ? xcd * (q + 1) : r * (q + 1) + (xcd - r) * q) + off; }
        const int nig = WGM * nN, gid = wgid / nig, fm = gid * WGM, gsz = (nM - fm) < WGM ? (nM - fm) : WGM;
        u.pm = fm + ((wgid % nig) % gsz); u.pn = (wgid % nig) / gsz; return true;
    }
    __device__ __forceinline__ void a_ready(const Unit&) const {}
    __device__ __forceinline__ void done(const Unit&) const {}
};

__device__ __forceinline__ unsigned cvt_pk_bf16(float lo, float hi) { unsigned r; asm volatile("v_cvt_pk_bf16_f32 %0, %1, %2" : "=v"(r) : "v"(lo), "v"(hi)); return r; }
typedef float f32x2 __attribute__((ext_vector_type(2)));
struct EpiStoreBf16 {
    static constexpr bool PERM = true, AFTER_DRAIN = false;
    bf16_t* O; int ldc; int act;
    __device__ __forceinline__ void operator()(const f32x4 (&acc)[2][2][4][2], const Unit& u, int wr, int wc, int fr, int fq) const {
        const int row0 = u.pm * BM + wr * 64 + fr; const int col0 = u.pn * BM + wc * 32 + 8 * fq;
#pragma unroll
        for (int ai = 0; ai < 2; ++ai)
#pragma unroll
            for (int m = 0; m < 4; ++m) { bf16_t* rowp = O + (size_t)(row0 + ai * HALF + m * 16) * ldc + col0;
#pragma unroll
                for (int bj = 0; bj < 2; ++bj) { f32x4 v0 = acc[ai][bj][m][0], v1 = acc[ai][bj][m][1];
                    if (act) {
#pragma unroll
                        for (int j = 0; j < 4; ++j) { const float a = v0[j] > 0.f ? v0[j] : 0.f, b = v1[j] > 0.f ? v1[j] : 0.f; v0[j] = a * a; v1[j] = b * b; } }
                    u32x4 w; w.x = cvt_pk_bf16(v0[0], v0[1]); w.y = cvt_pk_bf16(v0[2], v0[3]); w.z = cvt_pk_bf16(v1[0], v1[1]); w.w = cvt_pk_bf16(v1[2], v1[3]);
                    *(u32x4*)(rowp + bj * HALF) = w; } }
    }
};
struct EpiGateRes {
    static constexpr bool PERM = false, AFTER_DRAIN = false;
    float* X; int ldc; const float* gate; int gstride;
    __device__ __forceinline__ void operator()(const f32x4 (&acc)[2][2][4][2], const Unit& u, int wr, int wc, int fr, int fq) const {
        const int row0 = u.pm * BM + wr * 64 + fr, col0 = u.pn * BM + wc * 32 + 4 * fq;
#pragma unroll
        for (int ai = 0; ai < 2; ++ai)
#pragma unroll
            for (int m = 0; m < 4; ++m) { const int row = row0 + ai * HALF + m * 16; const int bb = row < 8192 ? (row >> 12) : 2 + ((row - 8192) >> 3);
                float* rowp = X + (size_t)row * ldc + col0; const float* gp = gate + (size_t)bb * gstride + col0;
#pragma unroll
                for (int bj = 0; bj < 2; ++bj)
#pragma unroll
                    for (int n = 0; n < 2; ++n) { const f32x4 g = *(const f32x4*)(gp + bj * HALF + n * 16); f32x4* xp = (f32x4*)(rowp + bj * HALF + n * 16); *xp = *xp + g * acc[ai][bj][m][n]; } }
    }
};
template <class Epi, class Sched, bool ALIGN_EPI = false, bool SP2 = false>
__device__ __forceinline__ void gemm_phase(PG8_LAS unsigned char* lds, const Gemm g, const Sched& S, const Epi& E) {
    int tid_ = threadIdx.x; asm volatile("" : "+v"(tid_));
    const int tid = tid_, wid = __builtin_amdgcn_readfirstlane(tid >> 6), lane = tid & 63, wr = wid >> 2, wc = wid & 3, fr = lane & 15, fq = lane >> 4;
    const int K = g.K, nt = K / BK;
    unsigned voffA[2], voffB[2];
#pragma unroll
    for (int i = 0; i < 2; ++i) { int R, C; stage_rc(tid * 16 + i * 8192, R, C); const int Rb = Epi::PERM ? ((R & ~31) + perm32(R & 31)) : R;
        voffA[i] = (unsigned)(R * K + C) * 2u; voffB[i] = (unsigned)(Rb * K + C) * 2u; }
    const size_t kstep = (size_t)(BK * 2);
    const size_t hstep = (size_t)HALF * K * 2;
    const size_t tstep = 2 * hstep;
    const unsigned ldsw = (unsigned)wid * 1024u;
    const int aoff = lds_byte(wr * 64 + fr, fq * 8), boff = lds_byte(wc * 32 + fr, fq * 8);
#define PG8_SA(b, h) (((b) * 2 + (h)) * HTB)
#define PG8_SB(b, h) ((4 + (b) * 2 + (h)) * HTB)
#define PG8_STAGE(bufoff, gbase, voff) do { _Pragma("unroll") for (int _i = 0; _i < 2; ++_i) \
        __builtin_amdgcn_global_load_lds((const unsigned*)((const char*)(gbase) + (voff)[_i]), (PG8_LAS unsigned*)(lds + (bufoff) + ldsw + _i * 8192), 16, 0, 0); } while (0)
#define PG8_LDA(dst, b, h) do { _Pragma("unroll") for (int m = 0; m < 4; ++m) _Pragma("unroll") for (int k = 0; k < 2; ++k) dst[m][k] = *(const PG8_LAS bf16x8*)(lds + PG8_SA(b, h) + aoff + m * 2048 + k * 1024); } while (0)
#define PG8_LDB(dst, b, h) do { _Pragma("unroll") for (int n = 0; n < 2; ++n) _Pragma("unroll") for (int k = 0; k < 2; ++k) dst[n][k] = *(const PG8_LAS bf16x8*)(lds + PG8_SB(b, h) + boff + n * 2048 + k * 1024); } while (0)
#define PG8_MMA(ai, bj, At, Bt) do { __builtin_amdgcn_s_setprio(1); _Pragma("unroll") for (int m = 0; m < 4; ++m) _Pragma("unroll") for (int n = 0; n < 2; ++n) _Pragma("unroll") for (int k = 0; k < 2; ++k) \
        acc[ai][bj][m][n] = __builtin_amdgcn_mfma_f32_16x16x32_bf16(Bt[n][k], At[m][k], acc[ai][bj][m][n], 0, 0, 0); __builtin_amdgcn_s_setprio(0); } while (0)
#define PG8_WAIT_V(n) asm volatile("s_waitcnt vmcnt(" #n ")" ::: "memory")
#define PG8_WAIT_L(n) asm volatile("s_waitcnt lgkmcnt(" #n ")" ::: "memory")
#define PG8_BAR __builtin_amdgcn_s_barrier()
#define PG8_SCHED __builtin_amdgcn_sched_barrier(0)
    Unit cur, nxt; int ui = 0;
    if (!S.next(0, cur)) return;
    f32x4 acc[2][2][4][2];
#pragma unroll
    for (int a = 0; a < 2; ++a)
#pragma unroll
        for (int b = 0; b < 2; ++b)
#pragma unroll
            for (int m = 0; m < 4; ++m)
#pragma unroll
                for (int n = 0; n < 2; ++n) acc[a][b][m][n] = (f32x4){0.f, 0.f, 0.f, 0.f};
    bf16x8 At[4][2], B0[2][2], B1[2][2];
    const char* cA = (const char*)g.A + (size_t)cur.pm * tstep; const char* cB = (const char*)g.Bt + (size_t)cur.pn * tstep;
    S.a_ready(cur);
    if constexpr (SP2) {
        PG8_STAGE(PG8_SB(0, 0), cB, voffB); PG8_STAGE(PG8_SB(0, 1), cB + hstep, voffB); PG8_STAGE(PG8_SA(0, 0), cA, voffA); PG8_STAGE(PG8_SA(0, 1), cA + hstep, voffA);
        if (wr == 1) PG8_BAR;
        PG8_WAIT_V(2); PG8_BAR;
        PG8_STAGE(PG8_SB(1, 0), cB + kstep, voffB); PG8_STAGE(PG8_SA(1, 0), cA + kstep, voffA); PG8_STAGE(PG8_SB(1, 1), cB + hstep + kstep, voffB);
        PG8_WAIT_V(6); PG8_BAR;
    } else {
        PG8_STAGE(PG8_SB(0, 0), cB, voffB); PG8_STAGE(PG8_SA(0, 0), cA, voffA); PG8_STAGE(PG8_SB(0, 1), cB + hstep, voffB); PG8_STAGE(PG8_SA(0, 1), cA + hstep, voffA);
        if (wr == 1) PG8_BAR;
        PG8_WAIT_V(4); PG8_BAR;
        PG8_STAGE(PG8_SB(1, 0), cB + kstep, voffB); PG8_STAGE(PG8_SA(1, 0), cA + kstep, voffA); PG8_STAGE(PG8_SB(1, 1), cB + hstep + kstep, voffB);
        PG8_WAIT_V(6); PG8_BAR;
    }
    for (;;) {
        const bool has_next = S.next(ui + 1, nxt);
        const char* nA = has_next ? (const char*)g.A + (size_t)nxt.pm * tstep : cA; const char* nB = has_next ? (const char*)g.Bt + (size_t)nxt.pn * tstep : cB;
        for (int t = 0; t < nt; t += 2) {
            const bool last = (t == nt - 2);
            const char* a1 = cA + (size_t)(t + 1) * kstep;
            const char* a2 = last ? nA : cA + (size_t)(t + 2) * kstep; const char* b2 = last ? nB : cB + (size_t)(t + 2) * kstep;
            const char* a3 = a2 + kstep; const char* b3 = b2 + kstep;
            if (last && has_next) S.a_ready(nxt);
            if constexpr (SP2) {
            PG8_LDB(B0, 0, 0); PG8_LDB(B1, 0, 1); PG8_SCHED; PG8_LDA(At, 0, 0); PG8_STAGE(PG8_SA(1, 1), a1 + hstep, voffA);
            PG8_WAIT_V(8); PG8_WAIT_L(0); PG8_BAR; PG8_MMA(0, 0, At, B0); PG8_MMA(0, 1, At, B1); PG8_BAR; PG8_SCHED;
            PG8_LDA(At, 0, 1); PG8_STAGE(PG8_SB(0, 0), b2, voffB); PG8_STAGE(PG8_SB(0, 1), b2 + hstep, voffB); PG8_STAGE(PG8_SA(0, 0), a2, voffA);
            PG8_WAIT_V(8); PG8_WAIT_L(0); PG8_BAR; PG8_MMA(1, 0, At, B0); PG8_MMA(1, 1, At, B1); PG8_BAR; PG8_SCHED;
            PG8_LDB(B0, 1, 0); PG8_LDB(B1, 1, 1); PG8_SCHED; PG8_LDA(At, 1, 0); PG8_STAGE(PG8_SA(0, 1), a2 + hstep, voffA);
            PG8_WAIT_V(8); PG8_WAIT_L(0); PG8_BAR; PG8_MMA(0, 0, At, B0); PG8_MMA(0, 1, At, B1); PG8_BAR; PG8_SCHED;
            PG8_LDA(At, 1, 1); PG8_STAGE(PG8_SB(1, 0), b3, voffB); PG8_STAGE(PG8_SB(1, 1), b3 + hstep, voffB); PG8_STAGE(PG8_SA(1, 0), a3, voffA);
            PG8_WAIT_V(8); PG8_WAIT_L(0); PG8_BAR; PG8_MMA(1, 0, At, B0); PG8_MMA(1, 1, At, B1); PG8_BAR; PG8_SCHED;
            } else {
            PG8_LDB(B0, 0, 0); PG8_SCHED; PG8_LDA(At, 0, 0); PG8_STAGE(PG8_SA(1, 1), a1 + hstep, voffA);
            PG8_WAIT_L(8); PG8_BAR; PG8_WAIT_L(0); PG8_MMA(0, 0, At, B0); PG8_BAR; PG8_SCHED;
            PG8_LDB(B1, 0, 1); PG8_STAGE(PG8_SB(0, 0), b2, voffB);
            PG8_BAR; PG8_WAIT_L(0); PG8_MMA(0, 1, At, B1); PG8_BAR;
            PG8_LDA(At, 0, 1); PG8_STAGE(PG8_SA(0, 0), a2, voffA);
            PG8_BAR; PG8_WAIT_L(0); PG8_MMA(1, 0, At, B0); PG8_BAR; PG8_SCHED;
            PG8_STAGE(PG8_SB(0, 1), b2 + hstep, voffB);
            PG8_WAIT_V(6); PG8_BAR; PG8_MMA(1, 1, At, B1); PG8_BAR;
            PG8_LDB(B0, 1, 0); PG8_SCHED; PG8_LDA(At, 1, 0); PG8_STAGE(PG8_SA(0, 1), a2 + hstep, voffA);
            PG8_WAIT_L(8); PG8_BAR; PG8_WAIT_L(0); PG8_MMA(0, 0, At, B0); PG8_BAR; PG8_SCHED;
            PG8_LDB(B1, 1, 1); PG8_STAGE(PG8_SB(1, 0), b3, voffB);
            PG8_BAR; PG8_WAIT_L(0); PG8_MMA(0, 1, At, B1); PG8_BAR;
            PG8_LDA(At, 1, 1); PG8_STAGE(PG8_SA(1, 0), a3, voffA);
            PG8_BAR; PG8_WAIT_L(0); PG8_MMA(1, 0, At, B0); PG8_BAR; PG8_SCHED;
            PG8_STAGE(PG8_SB(1, 1), b3 + hstep, voffB);
            PG8_WAIT_V(6); PG8_BAR; PG8_MMA(1, 1, At, B1); PG8_BAR;
            }
        }
        if constexpr (ALIGN_EPI) { if (wr == 0) PG8_BAR; }
        if constexpr (!Epi::AFTER_DRAIN) { E(acc, cur, wr, wc, fr, fq); S.done(cur); }
        if (!has_next) break;
#pragma unroll
        for (int a = 0; a < 2; ++a)
#pragma unroll
            for (int b = 0; b < 2; ++b)
#pragma unroll
                for (int m = 0; m < 4; ++m)
#pragma unroll
                    for (int n = 0; n < 2; ++n) acc[a][b][m][n] = (f32x4){0.f, 0.f, 0.f, 0.f};
        cur = nxt; cA = nA; cB = nB; ++ui;
        if constexpr (ALIGN_EPI) { if (wr == 1) PG8_BAR; }
    }
    PG8_WAIT_V(0);
    if constexpr (!ALIGN_EPI) { if (wr == 0) PG8_BAR; }
    PG8_BAR;
    if constexpr (Epi::AFTER_DRAIN) { E.fused(acc, cur, wr, wc, fr, fq, lds, wid, lane); S.done(cur); }
#undef PG8_SA
#undef PG8_SB
#undef PG8_STAGE
#undef PG8_LDA
#undef PG8_LDB
#undef PG8_MMA
#undef PG8_WAIT_V
#undef PG8_WAIT_L
#undef PG8_BAR
#undef PG8_SCHED
}
}
constexpr int NWAVES = 8, NTHR = 512;
constexpr int D = 2048, DEPTH = 4, BP = 2, TP = 4096, BS = 32, TS = 8;
constexpr int MP = BP * TP, MS = BS * TS, M = MP + MS, NBB = BP + BS;
constexpr int NINW = 4872, NPROJ = 4864, DFF = 8192, NMOD = 6 * D, PAST = 16384;
constexpr int C_AQ = 0, C_AF = 512, C_AI = 1024, C_AG = 1536, C_PU = 2048, C_CZ = 2560, C_CX = 3072, C_DQ = 4096, C_DK = 4608, C_DV = 4736;
constexpr float EPS = 1e-6f;
enum { I_XP = 0, I_XS, I_CP, I_CS, I_SHG, I_SPOOL, I_SSSM, I_SCONV, I_CK, I_CV, I_N1G, I_N2G, I_WADA, I_BADA, I_WIN, I_LBL, I_HNG, I_PW, I_PSC, I_CW, I_CB, I_DTB, I_ALOG, I_DSK, I_SNG, I_QNG, I_KNG, I_SINK, I_WOUT, I_WUP, I_WDN, N_IN };
constexpr size_t O_Y = 0, O_PHG = (size_t)M * D, O_PPOOL = O_PHG + 4 * 2 * 4 * 16384, O_PSSM = O_PPOOL + 4 * 2 * 15 * 512, O_PCONV = O_PSSM + 4 * 2 * 8 * 8192, O_PK = O_PCONV + 4 * 2 * 3 * 1024,
    O_PV = O_PK + 4 * 2 * 128 * 128, O_SHG = O_PV + 4 * 2 * 128 * 128, O_SPOOL = O_SHG + (size_t)4 * 32 * 4 * 16384, O_SSSM = O_SPOOL + 4 * 32 * 15 * 512, O_SCONV = O_SSSM + (size_t)4 * 32 * 8 * 8192,
    O_SK = O_SCONV + 4 * 32 * 3 * 1024, O_SV = O_SK + 4 * 32 * 128 * 128, O_END = O_SV + 4 * 32 * 128 * 128;
static_assert(O_END == 41046016, "output size");
constexpr size_t MiB = 1u << 20;
constexpr size_t WS_CTL = 0, CTL_ZERO_BYTES = 1 * MiB;
constexpr size_t WS_MOD = 1 * MiB, WS_LB = 8 * MiB, WS_ROPE = 8 * MiB + 65536, WS_DT = 10 * MiB;
constexpr size_t WS_WIN = 16 * MiB, WS_WOUT = 92 * MiB, WS_WUP = 124 * MiB, WS_WDN = 252 * MiB;
constexpr size_t WS_H = 380 * MiB, WS_PROJ = 413 * MiB, WS_MIX = 492 * MiB, WS_U = 525 * MiB;
constexpr size_t WS_HGDS = 657 * MiB, WS_HGSS = 689 * MiB, WS_SDDS = 721 * MiB, WS_SDSS = 753 * MiB, WS_HGDEC = 785 * MiB, WS_SDDEC = 785 * MiB + 524288, WS_END = 786 * MiB;
static_assert(WS_WIN + (size_t)4 * NPROJ * D * 2 <= WS_WOUT && WS_PROJ + (size_t)M * NPROJ * 2 <= WS_MIX && WS_U + (size_t)M * DFF * 2 <= WS_HGDS, "ws map");
constexpr int CW_BAR = 4096, CW_Q = 16384;
constexpr int RING_BYTES = 131072, LDSCTL_OFF = RING_BYTES, MISC_OFF = LDSCTL_OFF + 320, PTR_OFF = LDSCTL_OFF + 1024, LDS_BYTES = 147456;
constexpr int PH_PER_LAYER = 9, N_PHASES = 1 + DEPTH * PH_PER_LAYER;
#ifndef MK_ONE_LAUNCH
#define MK_ONE_LAUNCH 0
#endif
#define GAS __attribute__((address_space(1)))
#define LAS __attribute__((address_space(3)))
typedef unsigned short bf16;
typedef unsigned v4u __attribute__((ext_vector_type(4)));
typedef float f32x4 __attribute__((ext_vector_type(4)));
typedef short bf16x8 __attribute__((ext_vector_type(8)));
typedef GAS unsigned gu32;
typedef GAS unsigned long long gu64;
#define RLX_AGENT __ATOMIC_RELAXED, __HIP_MEMORY_SCOPE_AGENT
#define LDS_WAIT() asm volatile("s_waitcnt lgkmcnt(0)" ::: "memory")
#define VM_WAIT() asm volatile("s_waitcnt vmcnt(0)" ::: "memory")
__device__ __forceinline__ unsigned long long rt() { return __builtin_amdgcn_s_memrealtime(); }
__device__ __forceinline__ unsigned f2bf(float f) { unsigned u = __builtin_bit_cast(unsigned, f); return (u + 0x7fffu + ((u >> 16) & 1u)) >> 16; }
__device__ __forceinline__ unsigned pk2(float lo, float hi) { return f2bf(lo) | (f2bf(hi) << 16); }

#define XB_TMO      128
#define XB_XCNT(j)  (256  + 64 * (j))
#define XB_XSUB(j)  (1280 + 64 * (j))
#define XB_XGEN(j)  (2304 + 64 * (j))
#define XB_TOP      3328
#define XB_TOPGEN   3392
#define XCD_BAR_WORDS 3456
#define XB_SPIN_CAP (1u << 18)

__device__ __forceinline__ unsigned xb_ld(unsigned* p)              { return __hip_atomic_load(p, __ATOMIC_RELAXED, __HIP_MEMORY_SCOPE_AGENT); }
__device__ __forceinline__ unsigned xb_add(unsigned* p, unsigned v) { return __hip_atomic_fetch_add(p, v, __ATOMIC_RELAXED, __HIP_MEMORY_SCOPE_AGENT); }
__device__ __forceinline__ unsigned xb_xcc_id() { return (unsigned)__builtin_amdgcn_s_getreg((3 << 11) | 20) & 0xFu; }
#define XB_SPIN(cond, bar) do { unsigned _sp = 0; while (cond) { __builtin_amdgcn_s_sleep(1); \
    if ((++_sp & 255u) == 0u) { if (xb_ld(&(bar)[XB_TMO])) break; if (_sp > XB_SPIN_CAP) { atomicAdd(&(bar)[XB_TMO], 1u); break; } } } } while (0)

struct XcdBarrier {
    unsigned* bar; unsigned x;
    volatile LAS unsigned* st;
};

__device__ __forceinline__ XcdBarrier xcd_barrier_post(unsigned* bar, volatile LAS unsigned* st) {
    XcdBarrier b; b.bar = bar; b.x = xb_xcc_id(); b.st = st;
    if (threadIdx.x == 0) (void)xb_add(&bar[XB_XCNT(b.x)], 1u);
    return b;
}
__device__ __forceinline__ void xcd_barrier_complete(unsigned* bar, unsigned x, unsigned& nloc, unsigned& nx) {
    const unsigned G = gridDim.x * gridDim.y * gridDim.z;
    unsigned sum, cnt, mine, sp = 0u;
    for (;;) {
        sum = 0u; cnt = 0u; mine = 0u;
#pragma unroll
        for (unsigned j = 0; j < 16; ++j) { const unsigned c = xb_ld(&bar[XB_XCNT(j)]); sum += c; cnt += (c > 0u) ? 1u : 0u; mine = (j == x) ? c : mine; }
        if (sum == G) break;
        __builtin_amdgcn_s_sleep(1);
        if ((++sp & 255u) == 0u) { if (xb_ld(&bar[XB_TMO])) break; if (sp > XB_SPIN_CAP) { atomicAdd(&bar[XB_TMO], 1u); break; } }
    }
    nloc = mine > 0u ? mine : 1u; nx = cnt > 0u ? cnt : 1u;
}

__device__ __forceinline__ void xcd_barrier(const XcdBarrier& b) {
    asm volatile("s_waitcnt vmcnt(0)" ::: "memory");
    __syncthreads();
    if (threadIdx.x == 0) {
        unsigned* bar = b.bar;
        __builtin_amdgcn_s_waitcnt(0);
        unsigned nloc = b.st[0], nx = b.st[1];
        if (nloc == 0u) { xcd_barrier_complete(bar, b.x, nloc, nx); b.st[0] = nloc; b.st[1] = nx; }
        const unsigned old = xb_add(&bar[XB_XSUB(b.x)], 1u);
        const unsigned gen = old / nloc;
        if (old + 1u == (gen + 1u) * nloc) {
            __builtin_amdgcn_fence(__ATOMIC_RELEASE, "agent");
            asm volatile("s_waitcnt vmcnt(0)" ::: "memory");
            const unsigned og = xb_add(&bar[XB_TOP], 1u);
            const unsigned tg = og / nx;
            if (og + 1u == (tg + 1u) * nx) xb_add(&bar[XB_TOPGEN], 1u);
            else XB_SPIN(xb_ld(&bar[XB_TOPGEN]) == tg, bar);
            __builtin_amdgcn_fence(__ATOMIC_ACQUIRE, "agent");
            xb_add(&bar[XB_XGEN(b.x)], 1u);
            asm volatile("s_waitcnt vmcnt(0)" ::: "memory");
        } else {
            XB_SPIN(xb_ld(&bar[XB_XGEN(b.x)]) == gen, bar);
            __builtin_amdgcn_fence(__ATOMIC_ACQUIRE, "agent");
            asm volatile("s_waitcnt vmcnt(0)" ::: "memory");
        }
    }
    __syncthreads();
}

struct Frame {
    LAS unsigned char* lds;
    volatile LAS unsigned* MISC;
    gu32* ctl;
    int tid, lane, wave, G, gw, ngw;
    float* out; unsigned char* ws;
};
__device__ __forceinline__ const float* inp(const Frame& F, int i) {
    int off = PTR_OFF + 8 * i; asm volatile("" : "+s"(off));
    const unsigned long long v = *(const LAS unsigned long long*)(F.lds + off);
    const unsigned lo = __builtin_amdgcn_readfirstlane((unsigned)v), hi = __builtin_amdgcn_readfirstlane((unsigned)(v >> 32));
    return (const float*)(((unsigned long long)hi << 32) | lo);
}
__device__ __forceinline__ unsigned char* wsp(const Frame& F, size_t off) { unsigned char* p = F.ws; asm volatile("" : "+s"(p)); return p + off; }
#define INP(i) inp(F, i)
#define WS_LOCALS \
    float* const MOD = (float*)wsp(F, WS_MOD); float* const LBv = (float*)wsp(F, WS_LB); float* const ROPE = (float*)wsp(F, WS_ROPE); float* const DT = (float*)wsp(F, WS_DT); \
    bf16* const Wi = (bf16*)wsp(F, WS_WIN); bf16* const Wo = (bf16*)wsp(F, WS_WOUT); bf16* const Wu = (bf16*)wsp(F, WS_WUP); bf16* const Wd = (bf16*)wsp(F, WS_WDN); \
    bf16* const H = (bf16*)wsp(F, WS_H); bf16* const PROJ = (bf16*)wsp(F, WS_PROJ); bf16* const MIX = (bf16*)wsp(F, WS_MIX); bf16* const U = (bf16*)wsp(F, WS_U); \
    float* const HGDS = (float*)wsp(F, WS_HGDS); float* const HGSS = (float*)wsp(F, WS_HGSS); float* const SDDS = (float*)wsp(F, WS_SDDS); float* const SDSS = (float*)wsp(F, WS_SDSS); \
    float* const HGDEC = (float*)wsp(F, WS_HGDEC); float* const SDDEC = (float*)wsp(F, WS_SDDEC); \
    (void)MOD; (void)LBv; (void)ROPE; (void)DT; (void)Wi; (void)Wo; (void)Wu; (void)Wd; (void)H; (void)PROJ; (void)MIX; (void)U; (void)HGDS; (void)HGSS; (void)SDDS; (void)SDSS; (void)HGDEC; (void)SDDEC;
__device__ __forceinline__ float wave_sum(float v) {
#pragma unroll
    for (int o = 1; o < 64; o <<= 1) v += __shfl_xor(v, o);
    return v;
}
__device__ __forceinline__ float bf2f(bf16 b) { return __builtin_bit_cast(float, (unsigned)b << 16); }
__device__ __forceinline__ float bflo(unsigned w) { return __builtin_bit_cast(float, w << 16); }
__device__ __forceinline__ float bfhi(unsigned w) { return __builtin_bit_cast(float, w & 0xffff0000u); }
__device__ __forceinline__ float sigm(float x) { return 1.f / (1.f + __expf(-x)); }
__device__ __forceinline__ int row_bb(int m) { return m < MP ? (m >> 12) : BP + ((m - MP) >> 3); }
__device__ __forceinline__ int deq(Frame& F, int q) {
    __syncthreads();
    if (F.tid == 0) F.MISC[0] = __hip_atomic_fetch_add(F.ctl + CW_Q + 64 * q, 1u, RLX_AGENT);
    __syncthreads();
    return (int)F.MISC[0];
}

__device__ __forceinline__ void p0_transpose_item(const float* W, int K, int ldw, bf16* WT, int k0, int src_n0, int dst_n0, LAS float* scr, int lane) {
#pragma unroll 8
    for (int i = 0; i < 32; ++i) { const int kk = 2 * i + (lane >> 5); scr[kk * 33 + (lane & 31)] = W[(size_t)(k0 + kk) * ldw + src_n0 + (lane & 31)]; }
    LDS_WAIT(); asm volatile("" ::: "memory");
    const int c = lane & 7;
#pragma unroll
    for (int j = 0; j < 4; ++j) { const int n = (lane >> 3) + 8 * j; const LAS float* s = scr + (8 * c) * 33 + n;
        v4u o; o.x = pk2(s[0 * 33], s[1 * 33]); o.y = pk2(s[2 * 33], s[3 * 33]); o.z = pk2(s[4 * 33], s[5 * 33]); o.w = pk2(s[6 * 33], s[7 * 33]);
        *(GAS v4u*)(WT + (size_t)(dst_n0 + n) * K + k0 + 8 * c) = o; }
    LDS_WAIT(); asm volatile("" ::: "memory");
}
__device__ __forceinline__ void p0_adaln_item(Frame& F, int item) {
    const int l = item / 48, cc = item % 48, tid = F.tid, col = tid & 255, kh = tid >> 8;
    LAS float* cs = (LAS float*)F.lds;
    LAS float* red = (LAS float*)(F.lds + 18432);
    float acc[34];
#pragma unroll
    for (int i = 0; i < 34; ++i) acc[i] = 0.f;
    WS_LOCALS
    const float* W = INP(I_WADA) + (size_t)l * D * NMOD + 256 * cc + col; const float* const cpp = INP(I_CP); const float* const csp = INP(I_CS);
    for (int kt = 0; kt < 16; ++kt) {
        const int kbase = kh * 1024 + kt * 64;
        __syncthreads();
        for (int e = col; e < 64 * 34; e += 256) { const int bb = e >> 6, kk = e & 63;
            const float c = bb < BP ? cpp[bb * D + kbase + kk] : csp[(bb - BP) * D + kbase + kk];
            cs[(kh * 64 + kk) * 36 + bb] = c * sigm(c); }
        __syncthreads();
#pragma unroll 8
        for (int kk = 0; kk < 64; ++kk) {
            const float w = W[(size_t)(kbase + kk) * NMOD];
            const LAS f32x4* c4 = (const LAS f32x4*)(cs + (kh * 64 + kk) * 36);
#pragma unroll
            for (int q = 0; q < 8; ++q) { const f32x4 c = c4[q]; acc[4 * q] += w * c.x; acc[4 * q + 1] += w * c.y; acc[4 * q + 2] += w * c.z; acc[4 * q + 3] += w * c.w; }
            const f32x4 c = c4[8]; acc[32] += w * c.x; acc[33] += w * c.y;
        }
    }
    __syncthreads();
    if (kh == 1) {
#pragma unroll
        for (int i = 0; i < 34; ++i) red[col * 35 + i] = acc[i]; }
    __syncthreads();
    if (kh == 0) { const float bias = INP(I_BADA)[l * NMOD + 256 * cc + col];
#pragma unroll
        for (int i = 0; i < 34; ++i) MOD[((size_t)l * NBB + i) * NMOD + 256 * cc + col] = acc[i] + red[col * 35 + i] + bias; }
    __syncthreads();
}
__device__ __forceinline__ void p0_prologue(Frame& F) {
    WS_LOCALS
    const int gt = blockIdx.x * NTHR + F.tid, NT = F.G * NTHR;
    { const f32x4* s = (const f32x4*)INP(I_XP); f32x4* d = (f32x4*)F.out;
      for (int i = gt; i < MP * D / 4; i += NT) d[i] = s[i];
      s = (const f32x4*)INP(I_XS); d = (f32x4*)(F.out + (size_t)MP * D);
      for (int i = gt; i < MS * D / 4; i += NT) d[i] = s[i]; }
    if (gt < 512) { const float* lg = INP(I_LBL); const float a0 = lg[gt], a1 = lg[512 + gt], a2 = lg[1024 + gt], a3 = lg[1536 + gt];
        const float mx = fmaxf(fmaxf(a0, a1), fmaxf(a2, a3)); const float e0 = expf(a0 - mx), e1 = expf(a1 - mx), e2 = expf(a2 - mx), e3 = expf(a3 - mx); const float inv = 1.f / (e0 + e1 + e2 + e3);
        LBv[gt] = 0.f; LBv[512 + gt] = e1 * inv; LBv[1024 + gt] = (e1 + e2) * inv; LBv[1536 + gt] = (e1 + e2 + e3) * inv; }
    for (int e = gt; e < 4104 * 32; e += NT) { const int r = e >> 5, i = e & 31; const int pos = r < 4096 ? r : PAST + (r - 4096);
        const double inv = exp2(-(double)i * (13.287712379549449 / 32.0)); const double rev = (double)pos * inv * 0.15915494309189535;
        const float fr = (float)(rev - floor(rev));
        ROPE[r * 64 + i] = __builtin_amdgcn_cosf(fr); ROPE[r * 64 + 32 + i] = __builtin_amdgcn_sinf(fr); }
    if ((int)blockIdx.x < 192) p0_adaln_item(F, (int)blockIdx.x);
    if (F.G < 192) for (int it = F.G + (int)blockIdx.x; it < 192; it += F.G) p0_adaln_item(F, it);
    __syncthreads();
    LAS float* scr = (LAS float*)(F.lds + F.wave * 16384);
    constexpr int IT_IN = (D / 64) * (NPROJ / 32), IT_OUT = (D / 64) * (D / 32), IT_UP = (D / 64) * (DFF / 32), IT_DN = (DFF / 64) * (D / 32), IT_L = IT_IN + IT_OUT + IT_UP + IT_DN;
    for (int it = F.gw; it < DEPTH * IT_L; it += F.ngw) {
        const int l = it / IT_L; int r = it % IT_L;
        if (r < IT_IN) { const int nblk = NPROJ / 32, kb = r / nblk, nb = r % nblk, dn0 = 32 * nb, sn0 = dn0 + (dn0 >= 4096 ? 8 : 0);
            p0_transpose_item(INP(I_WIN) + (size_t)l * D * NINW, D, NINW, Wi + (size_t)l * NPROJ * D, 64 * kb, sn0, dn0, scr, F.lane); continue; } r -= IT_IN;
        if (r < IT_OUT) { const int nblk = D / 32, kb = r / nblk, nb = r % nblk;
            p0_transpose_item(INP(I_WOUT) + (size_t)l * D * D, D, D, Wo + (size_t)l * D * D, 64 * kb, 32 * nb, 32 * nb, scr, F.lane); continue; } r -= IT_OUT;
        if (r < IT_UP) { const int nblk = DFF / 32, kb = r / nblk, nb = r % nblk;
            p0_transpose_item(INP(I_WUP) + (size_t)l * D * DFF, D, DFF, Wu + (size_t)l * DFF * D, 64 * kb, 32 * nb, 32 * nb, scr, F.lane); continue; } r -= IT_UP;
        { const int nblk = D / 32, kb = r / nblk, nb = r % nblk;
            p0_transpose_item(INP(I_WDN) + (size_t)l * DFF * D, DFF, D, Wd + (size_t)l * D * DFF, 64 * kb, 32 * nb, 32 * nb, scr, F.lane); }
    }
}

__device__ __forceinline__ void norm_phase(Frame& F, int l, int which) {
    WS_LOCALS
    LAS float* wdt = (LAS float*)F.lds;
    if (which == 0) { const float* wsrc = INP(I_WIN) + (size_t)l * D * NINW + 4096;
        for (int e = F.tid; e < D * 8; e += NTHR) { const int d = e >> 3, j = e & 7; wdt[j * D + d] = wsrc[(size_t)d * NINW + j]; }
        __syncthreads(); }
    const f32x4* g4 = (const f32x4*)(INP(which ? I_N2G : I_N1G) + l * D);
    for (int m = F.gw; m < M; m += F.ngw) {
        const int bb = row_bb(m);
        const f32x4* xr = (const f32x4*)(F.out + (size_t)m * D);
        const float* modp = MOD + ((size_t)l * NBB + bb) * NMOD + (which ? 3 * D : 0);
        const f32x4* sh4 = (const f32x4*)modp; const f32x4* sc4 = (const f32x4*)(modp + D);
        f32x4 v[8]; float ss = 0.f;
#pragma unroll
        for (int j = 0; j < 8; ++j) { v[j] = xr[64 * j + F.lane]; ss += (v[j].x * v[j].x + v[j].y * v[j].y) + (v[j].z * v[j].z + v[j].w * v[j].w); }
        const float r = 1.f / sqrtf(wave_sum(ss) * (1.f / D) + EPS);
        float dta[8];
#pragma unroll
        for (int j = 0; j < 8; ++j) dta[j] = 0.f;
        GAS unsigned long long* o8 = (GAS unsigned long long*)(H + (size_t)m * D);
#pragma unroll
        for (int j = 0; j < 8; ++j) { const int q = 64 * j + F.lane; const f32x4 g = g4[q], sc = sc4[q], sh = sh4[q];
            f32x4 h; h.x = v[j].x * r * g.x * (1.f + sc.x) + sh.x; h.y = v[j].y * r * g.y * (1.f + sc.y) + sh.y; h.z = v[j].z * r * g.z * (1.f + sc.z) + sh.z; h.w = v[j].w * r * g.w * (1.f + sc.w) + sh.w;
            o8[q] = (unsigned long long)pk2(h.x, h.y) | ((unsigned long long)pk2(h.z, h.w) << 32);
            v[j] = h; }
        if (which == 0) {
#pragma unroll
            for (int jj = 0; jj < 8; ++jj) { float a = 0.f;
#pragma unroll
                for (int j = 0; j < 8; ++j) { const f32x4 w = ((const LAS f32x4*)wdt)[jj * (D / 4) + 64 * j + F.lane]; a += (v[j].x * w.x + v[j].y * w.y) + (v[j].z * w.z + v[j].w * w.w); }
                dta[jj] = wave_sum(a); __builtin_amdgcn_sched_barrier(0); }
            if (F.lane == 0) { f32x4* dp = (f32x4*)(DT + (size_t)m * 8); dp[0] = (f32x4){dta[0], dta[1], dta[2], dta[3]}; dp[1] = (f32x4){dta[4], dta[5], dta[6], dta[7]}; } }
    }
}
template <int MODE> __device__ __forceinline__ void hgrn_unit(Frame& F, int l, int u) {
    WS_LOCALS
    const int tid = F.tid, v = tid & 127, dg = tid >> 7;
    const float* const hng = INP(I_HNG);
    int h, m0, L; size_t sidx;
    if (MODE == 2) { const int b = u >> 2; h = u & 3; m0 = MP + b * TS; L = TS; sidx = ((size_t)(l * BS + b) * 4 + h) * 16384; }
    else { const int bh = u >> 6, c = u & 63, b = bh >> 2; h = bh & 3; m0 = b * TP + c * 64; L = 64; sidx = (size_t)u * 16384; }
    LAS float* fL = (LAS float*)F.lds;
    LAS float* kL = fL + 2048; LAS float* qL = kL + 2048; LAS float* vL = qL + 2048;
    LAS float* op = vL + 2048;
    float S[32];
    if (MODE == 0) {
#pragma unroll
        for (int i = 0; i < 32; ++i) S[i] = 0.f;
    } else { const float* src = (MODE == 1 ? HGSS : INP(I_SHG)) + sidx + (size_t)(dg * 32) * 128 + v;
#pragma unroll
        for (int i = 0; i < 32; ++i) S[i] = src[i * 128]; }
    float P = 1.f;
    const int sd = tid & 127; const float lbv = LBv[l * 512 + h * 128 + sd];
    for (int t0 = 0; t0 < L; t0 += 16) {
        const int nst = (L - t0) < 16 ? (L - t0) : 16;
        __syncthreads();
        for (int tt = tid >> 7; tt < nst; tt += 4) { const bf16* row = PROJ + (size_t)(m0 + t0 + tt) * NPROJ + h * 128 + sd;
            const float fr = bf2f(row[C_AF]), qr = bf2f(row[C_AQ]), ir = bf2f(row[C_AI]);
            const float e = __expf(-fr); const float sg = 1.f / (1.f + e), sgn = e / (1.f + e);
            fL[tt * 128 + sd] = lbv + (1.f - lbv) * sg; kL[tt * 128 + sd] = (1.f - lbv) * sgn; qL[tt * 128 + sd] = qr * sigm(qr); vL[tt * 128 + sd] = ir; }
        __syncthreads();
        if (MODE == 0 && tid < 128) for (int tt = 0; tt < nst; ++tt) P *= fL[tt * 128 + tid];
        for (int tt = 0; tt < nst; ++tt) {
            const float vv = vL[tt * 128 + v]; float o = 0.f;
            const LAS f32x4* f4 = (const LAS f32x4*)(fL + tt * 128 + dg * 32); const LAS f32x4* k4 = (const LAS f32x4*)(kL + tt * 128 + dg * 32); const LAS f32x4* q4 = (const LAS f32x4*)(qL + tt * 128 + dg * 32);
#pragma unroll
            for (int j = 0; j < 8; ++j) { const f32x4 f = f4[j], k = k4[j], q = q4[j];
                S[4 * j] = f.x * S[4 * j] + k.x * vv; S[4 * j + 1] = f.y * S[4 * j + 1] + k.y * vv; S[4 * j + 2] = f.z * S[4 * j + 2] + k.z * vv; S[4 * j + 3] = f.w * S[4 * j + 3] + k.w * vv;
                if (MODE != 0) o += (q.x * S[4 * j] + q.y * S[4 * j + 1]) + (q.z * S[4 * j + 2] + q.w * S[4 * j + 3]); }
            if (MODE != 0) op[(tt * 4 + dg) * 128 + v] = o;
        }
        if (MODE != 0) {
            __syncthreads();
            for (int tt = F.wave; tt < nst; tt += 8) {
                const LAS float* p = op + tt * 512;
                const float o0 = (p[F.lane] + p[128 + F.lane]) + (p[256 + F.lane] + p[384 + F.lane]), o1 = (p[64 + F.lane] + p[192 + F.lane]) + (p[320 + F.lane] + p[448 + F.lane]);
                const float r = 1.f / sqrtf(wave_sum(o0 * o0 + o1 * o1) * (1.f / 128.f) + EPS);
                const int m = m0 + t0 + tt; const bf16* grow = PROJ + (size_t)m * NPROJ + C_AG + h * 128; const float* ng = hng + l * 512 + h * 128;
                bf16* orow = MIX + (size_t)m * D + h * 128;
                orow[F.lane] = (bf16)f2bf(o0 * r * ng[F.lane] * sigm(bf2f(grow[F.lane])));
                orow[64 + F.lane] = (bf16)f2bf(o1 * r * ng[64 + F.lane] * sigm(bf2f(grow[64 + F.lane])));
            }
        }
    }
    if (MODE == 0) { float* dst = HGDS + sidx + (size_t)(dg * 32) * 128 + v;
#pragma unroll
        for (int i = 0; i < 32; ++i) dst[i * 128] = S[i];
        if (tid < 128) HGDEC[u * 128 + tid] = P; }
    if (MODE == 2) { float* dst = F.out + O_SHG + sidx + (size_t)(dg * 32) * 128 + v;
#pragma unroll
        for (int i = 0; i < 32; ++i) dst[i * 128] = S[i]; }
}

template <int MODE> __device__ __forceinline__ void ssd_unit(Frame& F, int l, int u) {
    WS_LOCALS
    const int tid = F.tid, hh = F.wave, p = F.lane, g = hh >> 2;
    const float* const cwp = INP(I_CW); const float* const cbp = INP(I_CB); const float* const scv = INP(I_SCONV); const float* const dtbp = INP(I_DTB); const float* const alp = INP(I_ALOG);
    const float ngv = INP(I_SNG)[l * 512 + hh * 64 + p];
    int b, m0, L, tseq0; size_t sidx;
    if (MODE == 2) { b = u; m0 = MP + b * TS; L = TS; tseq0 = 0; sidx = ((size_t)(l * BS + b) * 8 + hh) * 8192 + p * 128; }
    else { b = u >> 6; const int c = u & 63; m0 = b * TP + c * 64; L = 64; tseq0 = c * 64; sidx = ((size_t)u * 8 + hh) * 8192 + p * 128; }
    LAS float* cv = (LAS float*)F.lds;
    LAS float* ygL = cv + 16384;
    LAS float* dtL = ygL + 8192;
    LAS float* dcL = dtL + 128;
    LAS float* red = dcL + 128;
    float S[128];
    if (MODE == 0) {
#pragma unroll
        for (int i = 0; i < 128; ++i) S[i] = 0.f;
    } else { const f32x4* src = (const f32x4*)((MODE == 1 ? SDSS : INP(I_SSSM)) + sidx);
#pragma unroll
        for (int i = 0; i < 32; ++i) { const f32x4 t = src[i]; S[4 * i] = t.x; S[4 * i + 1] = t.y; S[4 * i + 2] = t.z; S[4 * i + 3] = t.w; } }
    float Ptot = 1.f;
    const float dsk = INP(I_DSK)[l * 8 + hh];
    const int ch = 2 * tid;
    float cw[4][2], cb[2];
#pragma unroll
    for (int j = 0; j < 4; ++j) { cw[j][0] = cwp[(l * 4 + j) * 1024 + ch]; cw[j][1] = cwp[(l * 4 + j) * 1024 + ch + 1]; }
    cb[0] = cbp[l * 1024 + ch]; cb[1] = cbp[l * 1024 + ch + 1];
    for (int t0 = 0; t0 < L; t0 += 16) {
        const int nst = (L - t0) < 16 ? (L - t0) : 16;
        __syncthreads();
        {
            float x[3][2];
#pragma unroll
            for (int j = 0; j < 3; ++j) { const int r = t0 - 3 + j; float a0 = 0.f, a1 = 0.f;
                if (MODE == 2) { if (r >= 0) { const unsigned w = *(const unsigned*)(PROJ + (size_t)(m0 + r) * NPROJ + C_CX + ch); a0 = bflo(w); a1 = bfhi(w); }
                                 else { const float* sc = scv + ((size_t)(l * BS + b) * 3 + (3 + r)) * 1024 + ch; a0 = sc[0]; a1 = sc[1]; } }
                else if (tseq0 + r >= 0) { const unsigned w = *(const unsigned*)(PROJ + (size_t)(m0 + r) * NPROJ + C_CX + ch); a0 = bflo(w); a1 = bfhi(w); }
                x[j][0] = a0; x[j][1] = a1; }
            for (int tt = 0; tt < nst; ++tt) {
                const unsigned w = *(const unsigned*)(PROJ + (size_t)(m0 + t0 + tt) * NPROJ + C_CX + ch); const float n0 = bflo(w), n1 = bfhi(w);
                const float c0 = cb[0] + cw[0][0] * x[0][0] + cw[1][0] * x[1][0] + cw[2][0] * x[2][0] + cw[3][0] * n0;
                const float c1 = cb[1] + cw[0][1] * x[0][1] + cw[1][1] * x[1][1] + cw[2][1] * x[2][1] + cw[3][1] * n1;
                cv[tt * 1024 + ch] = c0 * sigm(c0); cv[tt * 1024 + ch + 1] = c1 * sigm(c1);
                x[0][0] = x[1][0]; x[0][1] = x[1][1]; x[1][0] = x[2][0]; x[1][1] = x[2][1]; x[2][0] = n0; x[2][1] = n1; }
        }
        if (tid < nst * 8) { const int tt = tid >> 3, h8 = tid & 7; const float raw = DT[(size_t)(m0 + t0 + tt) * 8 + h8] + dtbp[l * 8 + h8];
            const float dtv = raw > 20.f ? raw : log1pf(__expf(raw)); dtL[tid] = dtv; dcL[tid] = __expf(-dtv * __expf(alp[l * 8 + h8])); }
        __syncthreads();
        for (int tt = 0; tt < nst; ++tt) {
            const float xv = cv[tt * 1024 + hh * 64 + p], dtv = dtL[tt * 8 + hh], dc = dcL[tt * 8 + hh], dx = dtv * xv; Ptot *= dc;
            const LAS f32x4* B4 = (const LAS f32x4*)(cv + tt * 1024 + 512 + g * 128); const LAS f32x4* C4 = (const LAS f32x4*)(cv + tt * 1024 + 768 + g * 128);
            float y = 0.f;
#pragma unroll
            for (int j = 0; j < 32; ++j) { const f32x4 Bv = B4[j];
                S[4 * j] = dc * S[4 * j] + dx * Bv.x; S[4 * j + 1] = dc * S[4 * j + 1] + dx * Bv.y; S[4 * j + 2] = dc * S[4 * j + 2] + dx * Bv.z; S[4 * j + 3] = dc * S[4 * j + 3] + dx * Bv.w;
                if (MODE != 0) { const f32x4 Cv = C4[j]; y += (Cv.x * S[4 * j] + Cv.y * S[4 * j + 1]) + (Cv.z * S[4 * j + 2] + Cv.w * S[4 * j + 3]); } }
            if (MODE != 0) { y += dsk * xv; const float z = bf2f(PROJ[(size_t)(m0 + t0 + tt) * NPROJ + C_CZ + hh * 64 + p]); const float yg = y * z * sigm(z);
                ygL[tt * 512 + hh * 64 + p] = yg; const float ss = wave_sum(yg * yg); if (p == 0) red[tt * 8 + hh] = ss; }
        }
        if (MODE != 0) {
            __syncthreads();
            const float ng = ngv;
            for (int tt = 0; tt < nst; ++tt) { const LAS float* rp = red + tt * 8; const float tot = ((rp[0] + rp[1]) + (rp[2] + rp[3])) + ((rp[4] + rp[5]) + (rp[6] + rp[7]));
                const float r = 1.f / sqrtf(tot * (1.f / 512.f) + EPS);
                MIX[(size_t)(m0 + t0 + tt) * D + 1024 + hh * 64 + p] = (bf16)f2bf(ygL[tt * 512 + hh * 64 + p] * r * ng); }
        }
    }
    if (MODE == 0) { f32x4* dst = (f32x4*)(SDDS + sidx);
#pragma unroll
        for (int i = 0; i < 32; ++i) dst[i] = (f32x4){S[4 * i], S[4 * i + 1], S[4 * i + 2], S[4 * i + 3]};
        if (p == 0) SDDEC[u * 8 + hh] = Ptot;
        if ((u & 63) == 63) for (int e = tid; e < 3 * 1024; e += NTHR) { const int j = e >> 10, c2 = e & 1023;
            F.out[O_PCONV + ((size_t)(l * BP + b) * 3 + j) * 1024 + c2] = bf2f(PROJ[(size_t)(m0 + 61 + j) * NPROJ + C_CX + c2]); } }
    if (MODE == 2) { f32x4* dst = (f32x4*)(F.out + O_SSSM + sidx);
#pragma unroll
        for (int i = 0; i < 32; ++i) dst[i] = (f32x4){S[4 * i], S[4 * i + 1], S[4 * i + 2], S[4 * i + 3]};
        for (int e = tid; e < 3 * 1024; e += NTHR) { const int j = e >> 10, c2 = e & 1023;
            F.out[O_SCONV + ((size_t)(l * BS + b) * 3 + j) * 1024 + c2] = bf2f(PROJ[(size_t)(m0 + 5 + j) * NPROJ + C_CX + c2]); } }
}

__device__ __forceinline__ void scan_phase(Frame& F, int l) {
    WS_LOCALS
    const int gt = blockIdx.x * NTHR + F.tid, NT = F.G * NTHR;
    for (int e = gt; e < 131072; e += NT) { const int bh = e >> 14, dv = e & 16383, d = dv >> 7; float S = 0.f;
#pragma unroll 8
        for (int c = 0; c < 64; ++c) { const size_t u = (size_t)bh * 64 + c; HGSS[u * 16384 + dv] = S; S = HGDEC[u * 128 + d] * S + HGDS[u * 16384 + dv]; }
        F.out[O_PHG + ((size_t)l * 8 + bh) * 16384 + dv] = S; }
    for (int e = gt; e < 131072; e += NT) { const int bhh = e >> 13, b = bhh >> 3, hh = bhh & 7, pn = e & 8191; float S = 0.f;
#pragma unroll 8
        for (int c = 0; c < 64; ++c) { const size_t idx = (size_t)(b * 64 + c) * 8 + hh; SDSS[idx * 8192 + pn] = S; S = SDDEC[idx] * S + SDDS[idx * 8192 + pn]; }
        F.out[O_PSSM + ((size_t)(l * BP + b) * 8 + hh) * 8192 + pn] = S; }
}
template <int SAMPLE> __device__ __forceinline__ void attn_unit(Frame& F, int l, int u) {
    WS_LOCALS
    const int tid = F.tid, lane = F.lane, wave = F.wave;
    const float* const ckp = INP(I_CK); const float* const cvp = INP(I_CV);
    LAS float* Kl = (LAS float*)F.lds; LAS float* Vl = Kl + 12288;
    int b, g, q0, nrows, row_min; size_t mbase;
    if (SAMPLE) { b = u >> 1; g = u & 1; q0 = 0; nrows = 136; row_min = 0; mbase = (size_t)MP + b * TS; }
    else { g = u & 1; const int qt = (u >> 1) & 63; b = u >> 7; q0 = qt * 64; nrows = 192; row_min = q0 >= 127 ? 0 : 127 - q0; mbase = (size_t)b * TP; }
    __syncthreads();
    {   const int j8 = tid & 7; const float* kg = INP(I_KNG) + l * 64 + 8 * j8;
        float kgv[8];
#pragma unroll
        for (int e = 0; e < 8; ++e) kgv[e] = kg[e];
        for (int row = tid >> 3; row < nrows; row += 64) {
            f32x4 k0, k1, v0, v1; bool zero = false;
            if (SAMPLE && row < 128) { const f32x4* kp = (const f32x4*)(ckp + (((size_t)(l * BS + b) * 128 + row) * 2 + g) * 64 + 8 * j8); const f32x4* vp = (const f32x4*)(cvp + (((size_t)(l * BS + b) * 128 + row) * 2 + g) * 64 + 8 * j8);
                k0 = kp[0]; k1 = kp[1]; v0 = vp[0]; v1 = vp[1]; }
            else {
                int t, prow;
                if (SAMPLE) { t = row - 128; prow = 4096 + t; } else { t = q0 - 127 + row; prow = t; if (t < 0 || row == 191) zero = true; }
                if (zero) { k0 = k1 = v0 = v1 = (f32x4){0.f, 0.f, 0.f, 0.f}; }
                else {
                    const bf16* pr = PROJ + (mbase + t) * NPROJ;
                    const v4u kw = *(const v4u*)(pr + C_DK + g * 64 + 8 * j8); const v4u vw = *(const v4u*)(pr + C_DV + g * 64 + 8 * j8);
                    float kr[8] = {bflo(kw.x), bfhi(kw.x), bflo(kw.y), bfhi(kw.y), bflo(kw.z), bfhi(kw.z), bflo(kw.w), bfhi(kw.w)};
                    v0 = (f32x4){bflo(vw.x), bfhi(vw.x), bflo(vw.y), bfhi(vw.y)}; v1 = (f32x4){bflo(vw.z), bfhi(vw.z), bflo(vw.w), bfhi(vw.w)};
                    float ss = 0.f;
#pragma unroll
                    for (int e = 0; e < 8; ++e) ss += kr[e] * kr[e];
                    ss += __shfl_xor(ss, 1); ss += __shfl_xor(ss, 2); ss += __shfl_xor(ss, 4);
                    const float rn = 1.f / sqrtf(ss * (1.f / 64.f) + EPS);
                    const float* rp = ROPE + (size_t)prow * 64 + ((8 * j8) & 31);
                    float ko[8];
#pragma unroll
                    for (int e = 0; e < 8; ++e) { const float kn = kr[e] * rn * kgv[e]; const float other = __shfl_xor(kn, 4); const float c = rp[e], s = rp[32 + e];
                        ko[e] = j8 < 4 ? kn * c - other * s : kn * c + other * s; }
                    k0 = (f32x4){ko[0], ko[1], ko[2], ko[3]}; k1 = (f32x4){ko[4], ko[5], ko[6], ko[7]};
                }
            }
            LAS f32x4* kd = (LAS f32x4*)(Kl + row * 64 + 8 * j8); kd[0] = k0; kd[1] = k1;
            LAS f32x4* vd = (LAS f32x4*)(Vl + row * 64 + 8 * j8); vd[0] = v0; vd[1] = v1;
        }
    }
    __syncthreads();
    if (SAMPLE || q0 == TP - 64) {
        const int roff = SAMPLE ? 8 : 63; const size_t ob = SAMPLE ? ((size_t)(l * BS + b) * 128) : ((size_t)(l * BP + b) * 128);
        float* ok = F.out + (SAMPLE ? O_SK : O_PK); float* ov = F.out + (SAMPLE ? O_SV : O_PV);
        for (int e = tid; e < 128 * 64; e += NTHR) { const int j = e >> 6, dd = e & 63; ok[((ob + j) * 2 + g) * 64 + dd] = Kl[(roff + j) * 64 + dd]; ov[((ob + j) * 2 + g) * 64 + dd] = Vl[(roff + j) * 64 + dd]; }
    }
    if (!SAMPLE || wave == 0) {
        const int dh = lane & 1, qi = (lane >> 1) & 7, r = lane >> 4, head = g * 4 + r;
        const int t = SAMPLE ? qi : q0 + 8 * wave + qi;
        const int qrow = SAMPLE ? 128 + qi : 127 + 8 * wave + qi;
        const int prow = SAMPLE ? 4096 + t : t;
        const int row_lo = SAMPLE ? 0 : 8 * wave;
        float q[32];
        {   const v4u* qp = (const v4u*)(PROJ + (mbase + t) * NPROJ + C_DQ + head * 64 + 32 * dh);
#pragma unroll
            for (int c = 0; c < 4; ++c) { const v4u w = qp[c]; q[8 * c] = bflo(w.x); q[8 * c + 1] = bfhi(w.x); q[8 * c + 2] = bflo(w.y); q[8 * c + 3] = bfhi(w.y); q[8 * c + 4] = bflo(w.z); q[8 * c + 5] = bfhi(w.z); q[8 * c + 6] = bflo(w.w); q[8 * c + 7] = bfhi(w.w); }
            float ss = 0.f;
#pragma unroll
            for (int d = 0; d < 32; ++d) ss += q[d] * q[d];
            ss += __shfl_xor(ss, 1);
            const float rn = 0.125f / sqrtf(ss * (1.f / 64.f) + EPS);
            const float* qg = INP(I_QNG) + l * 64 + 32 * dh; const float* rp = ROPE + (size_t)prow * 64;
#pragma unroll
            for (int i = 0; i < 32; ++i) { const float xn = q[i] * rn * qg[i]; const float other = __shfl_xor(xn, 1); const float c = rp[i], s = rp[32 + i];
                q[i] = dh == 0 ? xn * c - other * s : xn * c + other * s; }
        }
        float mrun = INP(I_SINK)[l * 8 + head], lrun = 1.f;
        float o[32];
#pragma unroll
        for (int d = 0; d < 32; ++d) o[d] = 0.f;
        for (int it = 0; it < 34; ++it) {
            const int rb = row_lo + 4 * it;
            float s[4];
#pragma unroll
            for (int k = 0; k < 4; ++k) { const LAS f32x4* kr = (const LAS f32x4*)(Kl + (rb + k) * 64 + 32 * dh); float a = 0.f;
#pragma unroll
                for (int c = 0; c < 8; ++c) { const f32x4 kv = kr[c]; a += (q[4 * c] * kv.x + q[4 * c + 1] * kv.y) + (q[4 * c + 2] * kv.z + q[4 * c + 3] * kv.w); }
                a += __shfl_xor(a, 1);
                const int row = rb + k; const bool valid = (row <= qrow) && (row > qrow - 128) && (row >= row_min);
                s[k] = valid ? a : -INFINITY; }
            const float mnew = fmaxf(fmaxf(mrun, fmaxf(s[0], s[1])), fmaxf(s[2], s[3]));
            const float al = __expf(mrun - mnew); mrun = mnew;
            float pk[4];
#pragma unroll
            for (int k = 0; k < 4; ++k) pk[k] = __expf(s[k] - mnew);
            lrun = lrun * al + (pk[0] + pk[1]) + (pk[2] + pk[3]);
#pragma unroll
            for (int d = 0; d < 32; ++d) o[d] *= al;
#pragma unroll
            for (int k = 0; k < 4; ++k) { const LAS f32x4* vr = (const LAS f32x4*)(Vl + (rb + k) * 64 + 32 * dh);
#pragma unroll
                for (int c = 0; c < 8; ++c) { const f32x4 vv = vr[c]; o[4 * c] += pk[k] * vv.x; o[4 * c + 1] += pk[k] * vv.y; o[4 * c + 2] += pk[k] * vv.z; o[4 * c + 3] += pk[k] * vv.w; } }
        }
        {   const float inv = 1.f / lrun; v4u* op = (v4u*)(MIX + (mbase + t) * D + 1536 + head * 64 + 32 * dh);
#pragma unroll
            for (int c = 0; c < 4; ++c) { v4u w; w.x = pk2(o[8 * c] * inv, o[8 * c + 1] * inv); w.y = pk2(o[8 * c + 2] * inv, o[8 * c + 3] * inv); w.z = pk2(o[8 * c + 4] * inv, o[8 * c + 5] * inv); w.w = pk2(o[8 * c + 6] * inv, o[8 * c + 7] * inv); op[c] = w; }
        }
    }
}
__device__ __forceinline__ void pool_unit(Frame& F, int l, int u) {
    WS_LOCALS
    const int tid = F.tid, c = tid & 127, tq = tid >> 7;
    const float* const pwp = INP(I_PW); const float* const spp = INP(I_SPOOL);
    LAS float* pl = (LAS float*)F.lds; LAS float* wl = pl + 8192;
    const bool samp = u >= 128; const int b = samp ? 0 : (u >> 6), t0 = samp ? 0 : (u & 63) * 64; const int s8 = samp ? (u - 128) * 8 : 0;
    const size_t m0 = samp ? (size_t)MP + (size_t)s8 * TS : (size_t)b * TP + t0;
    for (int gi = 0; gi < 4; ++gi) {
        const int win = 2 << gi, chn = gi * 128 + c;
        __syncthreads();
        for (int e = tid; e < 128 * 128 / 4; e += NTHR) ((LAS f32x4*)wl)[e] = ((const f32x4*)(pwp + (size_t)(l * 4 + gi) * 16384))[e];
        for (int i = 0; i < 16; ++i) { const int tt = tq * 16 + i; float s = 0.f, self, cnt;
            if (!samp) { const int t = t0 + tt; const bf16* base = PROJ + ((size_t)b * TP) * NPROJ + C_PU + chn;
                for (int j = 0; j < win; ++j) if (t - j >= 0) s += bf2f(base[(size_t)(t - j) * NPROJ]);
                self = bf2f(base[(size_t)t * NPROJ]); cnt = (float)((t + 1) < win ? (t + 1) : win); }
            else { const int bs = s8 + (tt >> 3), ts = tt & 7; const bf16* base = PROJ + ((size_t)MP + (size_t)bs * TS) * NPROJ + C_PU + chn; const float* buf = spp + ((size_t)(l * BS + bs) * 15) * 512 + chn;
                for (int j = 0; j < win; ++j) { const int e2 = 15 + ts - j; s += e2 >= 15 ? bf2f(base[(size_t)(e2 - 15) * NPROJ]) : buf[(size_t)e2 * 512]; }
                self = bf2f(base[(size_t)ts * NPROJ]); cnt = (float)win; }
            pl[tt * 128 + c] = s / cnt - self; }
        __syncthreads();
        float acc[16];
#pragma unroll
        for (int i = 0; i < 16; ++i) acc[i] = 0.f;
        for (int k4 = 0; k4 < 32; ++k4) { const float w0 = wl[(4 * k4) * 128 + c], w1 = wl[(4 * k4 + 1) * 128 + c], w2 = wl[(4 * k4 + 2) * 128 + c], w3 = wl[(4 * k4 + 3) * 128 + c];
#pragma unroll
            for (int i = 0; i < 16; ++i) { const f32x4 pv = ((const LAS f32x4*)(pl + (tq * 16 + i) * 128))[k4]; acc[i] += (pv.x * w0 + pv.y * w1) + (pv.z * w2 + pv.w * w3); } }
        const float sc = INP(I_PSC)[l * 512 + chn];
#pragma unroll
        for (int i = 0; i < 16; ++i) MIX[(m0 + tq * 16 + i) * D + 512 + chn] = (bf16)f2bf(acc[i] * sc);
    }
    if (!samp && t0 == TP - 64) for (int e = tid; e < 15 * 512; e += NTHR) { const int j = e >> 9, ch = e & 511;
        F.out[O_PPOOL + ((size_t)(l * BP + b) * 15 + j) * 512 + ch] = bf2f(PROJ[((size_t)b * TP + TP - 15 + j) * NPROJ + C_PU + ch]); }
    if (samp) for (int e = tid; e < 8 * 15 * 512; e += NTHR) { const int bs = s8 + e / (15 * 512), j = (e / 512) % 15, ch = e & 511;
        F.out[O_SPOOL + ((size_t)(l * BS + bs) * 15 + j) * 512 + ch] = j < 7 ? spp[((size_t)(l * BS + bs) * 15 + 8 + j) * 512 + ch] : bf2f(PROJ[((size_t)MP + (size_t)bs * TS + (j - 7)) * NPROJ + C_PU + ch]); }
}
#ifdef PH_SEL
#define PSEL(k, stmt) do { if ((k) == PH_SEL) { stmt; } } while (0)
#else
#define PSEL(k, stmt) do { stmt; } while (0)
#endif
struct Args { const float* in[N_IN]; float* out; unsigned char* ws; int ph_lo, ph_hi; };
static_assert(sizeof(Args) == (N_IN + 2) * 8 + 8, "Args has no padding");
__global__ void __launch_bounds__(NTHR, 2) hymba_fwd(Args args) {
    extern __shared__ __attribute__((aligned(16))) unsigned char lds[];
    Frame F;
    F.lds = (LAS unsigned char*)lds;
    F.MISC = (volatile LAS unsigned*)(F.lds + MISC_OFF);
    F.tid = threadIdx.x; F.lane = F.tid & 63; F.wave = __builtin_amdgcn_readfirstlane(F.tid >> 6);
    F.G = gridDim.x; F.gw = (int)blockIdx.x * NWAVES + F.wave; F.ngw = F.G * NWAVES;
    unsigned char* ws = args.ws; F.ws = ws; F.out = args.out;
    F.ctl = (gu32*)(ws + WS_CTL);
    for (int u = F.tid; u < (LDS_BYTES - LDSCTL_OFF) / 4; u += NTHR) ((LAS unsigned*)(F.lds + LDSCTL_OFF))[u] = 0u;
    __syncthreads();
    if (F.tid < N_IN) ((LAS unsigned long long*)(F.lds + PTR_OFF))[F.tid] = (unsigned long long)args.in[F.tid];
    __syncthreads();
    const int lo = args.ph_lo, hi = args.ph_hi;
    XcdBarrier bar; bar.bar = (unsigned*)(F.ctl + CW_BAR); bar.x = 0; bar.st = nullptr;
    if (hi - lo > 1) bar = xcd_barrier_post((unsigned*)(F.ctl + CW_BAR), F.MISC + 8);
#define IN(k) (lo <= (k) && (k) < hi)
#define LAUNDER(P) asm volatile("" : "+v"(P.tid), "+v"(P.lane), "+s"(P.wave), "+s"(P.gw))
#define PHASE_LOCALS Frame P = F; LAUNDER(P); WS_LOCALS
#define SEAM(k) do { if (IN(k) && IN((k) + 1)) xcd_barrier(bar); } while (0)
    if (IN(0)) { PSEL(0, p0_prologue(F)); } SEAM(0);
    for (int l = 0; l < DEPTH; ++l) {
        const int pb = 1 + l * PH_PER_LAYER;

        if (IN(pb + 0)) { PHASE_LOCALS  PSEL(1, norm_phase(P, l, 0)); } SEAM(pb + 0);
        if (IN(pb + 1)) { PHASE_LOCALS
            pg8::Gemm g{H, Wi + (size_t)l * NPROJ * D, M, NPROJ, D}; pg8::StaticOrder S; S.init(M, NPROJ, F.G, (int)blockIdx.x);
            pg8::EpiStoreBf16 E{PROJ, NPROJ, 0};
            PSEL(2, (pg8::gemm_phase<pg8::EpiStoreBf16, pg8::StaticOrder, true, true>(P.lds, g, S, E)));
        } SEAM(pb + 1);
        if (IN(pb + 2)) { PHASE_LOCALS
            int u;
            { Frame Q = F; LAUNDER(Q); while ((u = deq(Q, l * 16 + 0)) < 128) PSEL(3, ssd_unit<0>(Q, l, u)); }
            { Frame Q = F; LAUNDER(Q); while ((u = deq(Q, l * 16 + 1)) < 256) PSEL(4, attn_unit<0>(Q, l, u)); }
            { Frame Q = F; LAUNDER(Q); while ((u = deq(Q, l * 16 + 2)) < 512) PSEL(5, hgrn_unit<0>(Q, l, u)); }
            { Frame Q = F; LAUNDER(Q); while ((u = deq(Q, l * 16 + 3)) < 132) PSEL(6, pool_unit(Q, l, u)); }
            { Frame Q = F; LAUNDER(Q); while ((u = deq(Q, l * 16 + 4)) < 32) PSEL(7, ssd_unit<2>(Q, l, u)); }
            { Frame Q = F; LAUNDER(Q); while ((u = deq(Q, l * 16 + 5)) < 64) PSEL(8, attn_unit<1>(Q, l, u)); }
            { Frame Q = F; LAUNDER(Q); while ((u = deq(Q, l * 16 + 6)) < 128) PSEL(9, hgrn_unit<2>(Q, l, u)); }
        } SEAM(pb + 2);
        if (IN(pb + 3)) { PHASE_LOCALS  PSEL(10, scan_phase(P, l)); } SEAM(pb + 3);
        if (IN(pb + 4)) { PHASE_LOCALS
            int u;
            { Frame Q = F; LAUNDER(Q); while ((u = deq(Q, l * 16 + 7)) < 128) PSEL(11, ssd_unit<1>(Q, l, u)); }
            { Frame Q = F; LAUNDER(Q); while ((u = deq(Q, l * 16 + 8)) < 512) PSEL(12, hgrn_unit<1>(Q, l, u)); }
        } SEAM(pb + 4);
        if (IN(pb + 5)) { PHASE_LOCALS
            pg8::Gemm g{MIX, Wo + (size_t)l * D * D, M, D, D}; pg8::StaticOrder S; S.init(M, D, F.G, (int)blockIdx.x);
            pg8::EpiGateRes E{F.out, D, MOD + (size_t)l * NBB * NMOD + 2 * D, NMOD};
            PSEL(13, (pg8::gemm_phase<pg8::EpiGateRes, pg8::StaticOrder, true, true>(P.lds, g, S, E)));
        } SEAM(pb + 5);
        if (IN(pb + 6)) { PHASE_LOCALS  PSEL(14, norm_phase(P, l, 1)); } SEAM(pb + 6);
        if (IN(pb + 7)) { PHASE_LOCALS
            pg8::Gemm g{H, Wu + (size_t)l * DFF * D, M, DFF, D}; pg8::StaticOrder S; S.init(M, DFF, F.G, (int)blockIdx.x);
            pg8::EpiStoreBf16 E{U, DFF, 1};
            PSEL(15, (pg8::gemm_phase<pg8::EpiStoreBf16, pg8::StaticOrder, true, true>(P.lds, g, S, E)));
        } SEAM(pb + 7);
        if (IN(pb + 8)) { PHASE_LOCALS
            pg8::Gemm g{U, Wd + (size_t)l * D * DFF, M, D, DFF}; pg8::StaticOrder S; S.init(M, D, F.G, (int)blockIdx.x);
            pg8::EpiGateRes E{F.out, D, MOD + (size_t)l * NBB * NMOD + 5 * D, NMOD};
            PSEL(16, (pg8::gemm_phase<pg8::EpiGateRes, pg8::StaticOrder, true, true>(P.lds, g, S, E)));
        } SEAM(pb + 8);
    }
#undef IN
#undef SEAM
}

extern "C" void kernel_launch(void* const* d_in, const int* in_sizes, int n_in, void* d_out, int out_size, void* d_ws, size_t ws_size, hipStream_t stream) {
    static int grid = 0;
    if (grid == 0) {
        if (n_in != N_IN || (size_t)out_size != O_END || ws_size < WS_END) { fprintf(stderr, "kernel_launch: unexpected shapes (n_in %d, out %d, ws %zu); nothing launched\n", n_in, out_size, ws_size); grid = -1; return; }
        int dev = 0, cus = 0, per_cu = 0;
        if (hipGetDevice(&dev) != hipSuccess || hipDeviceGetAttribute(&cus, hipDeviceAttributeMultiprocessorCount, dev) != hipSuccess) { grid = -1; return; }
        if (hipFuncSetAttribute((const void*)hymba_fwd, hipFuncAttributeMaxDynamicSharedMemorySize, LDS_BYTES) != hipSuccess) { fprintf(stderr, "kernel_launch: hipFuncSetAttribute failed\n"); grid = -1; return; }
        if (hipOccupancyMaxActiveBlocksPerMultiprocessor(&per_cu, (const void*)hymba_fwd, NTHR, LDS_BYTES) != hipSuccess || per_cu < 1) { fprintf(stderr, "kernel_launch: occupancy query says %d\n", per_cu); }
        (void)hipGetLastError();
        grid = cus;
    }
    if (grid < 0) return;
    if (hipMemsetAsync((char*)d_ws + WS_CTL, 0, CTL_ZERO_BYTES, stream) != hipSuccess) return;
    Args a{};
    for (int i = 0; i < N_IN; ++i) a.in[i] = (const float*)d_in[i];
    a.out = (float*)d_out; a.ws = (unsigned char*)d_ws;
#if MK_ONE_LAUNCH
    a.ph_lo = 0; a.ph_hi = N_PHASES;
    hipLaunchKernelGGL(hymba_fwd, dim3(grid), dim3(NTHR), LDS_BYTES, stream, a);
#else
    for (int k = 0; k < N_PHASES; ++k) { a.ph_lo = k; a.ph_hi = k + 1; hipLaunchKernelGGL(hymba_fwd, dim3(grid), dim3(NTHR), LDS_BYTES, stream, a); }
#endif
}
```

```cpp
#include <hip/hip_runtime.h>
#include <cstdio>
#include <cstdint>
namespace pg8 {
#define PG8_LAS __attribute__((address_space(3)))
typedef unsigned short bf16_t;
typedef short bf16x8 __attribute__((ext_vector_type(8)));
typedef float f32x4 __attribute__((ext_vector_type(4)));
typedef unsigned u32x4 __attribute__((ext_vector_type(4)));
constexpr int BM = 256, BK = 64, HALF = 128, HTB = HALF * BK * 2  , STAGE_BYTES = 8 * HTB, NXCD = 8, WGM = 8;

__host__ __device__ __forceinline__ int lds_byte(int r, int c) { const int st = (r >> 4) * 2 + (c >> 5), rr = r & 15, cc = c & 31, ob = rr * 64 + cc * 2; return st * 1024 + (ob ^ (((ob >> 9) & 1) << 5)); }
__host__ __device__ __forceinline__ void stage_rc(int b, int& R, int& C) { const int st = b / 1024, sb = b % 1024, swz = sb ^ (((sb >> 9) & 1) << 5); R = (st >> 1) * 16 + swz / 64; C = (st & 1) * 32 + (swz % 64) / 2; }
__host__ __device__ __forceinline__ int perm32(int rho) { const int n = rho >> 4, i = rho & 15; return 8 * (i >> 2) + 4 * n + (i & 3); }

struct Unit { int pm, pn; };
struct Gemm { const bf16_t* A; const bf16_t* Bt; int M, N, K; };

struct StaticOrder {
    int nM, nN, nwg, G, c;
    __host__ __device__ void init(int M, int N, int G_, int c_) { nM = M / BM; nN = N / BM; nwg = nM * nN; G = G_; c = c_; }
    __host__ __device__ bool next(int i, Unit& u) const {
        const long L = (long)i * G + c; if (L >= nwg) return false;
        int wgid = (int)L; { const int q = nwg / NXCD, r = nwg % NXCD, xcd = wgid % NXCD, off = wgid / NXCD; wgid = (xcd < r ? xcd * (q + 1) : r * (q + 1) + (xcd - r) * q) + off; }
        const int nig = WGM * nN, gid = wgid / nig, fm = gid * WGM, gsz = (nM - fm) < WGM ? (nM - fm) : WGM;
        u.pm = fm + ((wgid % nig) % gsz); u.pn = (wgid % nig) / gsz; return true;
    }
    __device__ __forceinline__ void a_ready(const Unit&) const {}
    __device__ __forceinline__ void done(const Unit&) const {}
};

__device__ __forceinline__ unsigned cvt_pk_bf16(float lo, float hi) { unsigned r; asm volatile("v_cvt_pk_bf16_f32 %0, %1, %2" : "=v"(r) : "v"(lo), "v"(hi)); return r; }
typedef float f32x2 __attribute__((ext_vector_type(2)));
struct EpiStoreBf16 {
    static constexpr bool PERM = true, AFTER_DRAIN = false;
    bf16_t* O; int ldc; int act;
    __device__ __forceinline__ void operator()(const f32x4 (&acc)[2][2][4][2], const Unit& u, int wr, int wc, int fr, int fq) const {
        const int row0 = u.pm * BM + wr * 64 + fr; const int col0 = u.pn * BM + wc * 32 + 8 * fq;
#pragma unroll
        for (int ai = 0; ai < 2; ++ai)
#pragma unroll
            for (int m = 0; m < 4; ++m) { bf16_t* rowp = O + (size_t)(row0 + ai * HALF + m * 16) * ldc + col0;
#pragma unroll
                for (int bj = 0; bj < 2; ++bj) { f32x4 v0 = acc[ai][bj][m][0], v1 = acc[ai][bj][m][1];
                    if (act) {
#pragma unroll
                        for (int j = 0; j < 4; ++j) { const float a = v0[j] > 0.f ? v0[j] : 0.f, b = v1[j] > 0.f ? v1[j] : 0.f; v0[j] = a * a; v1[j] = b * b; } }
                    u32x4 w; w.x = cvt_pk_bf16(v0[0], v0[1]); w.y = cvt_pk_bf16(v0[2], v0[3]); w.z = cvt_pk_bf16(v1[0], v1[1]); w.w = cvt_pk_bf16(v1[2], v1[3]);
                    *(u32x4*)(rowp + bj * HALF) = w; } }
    }
};
struct EpiGateRes {
    static constexpr bool PERM = false, AFTER_DRAIN = false;
    float* X; int ldc; const float* gate; int gstride;
    __device__ __forceinline__ void operator()(const f32x4 (&acc)[2][2][4][2], const Unit& u, int wr, int wc, int fr, int fq) const {
        const int row0 = u.pm * BM + wr * 64 + fr, col0 = u.pn * BM + wc * 32 + 4 * fq;
#pragma unroll
        for (int ai = 0; ai < 2; ++ai)
#pragma unroll
            for (int m = 0; m < 4; ++m) { const int row = row0 + ai * HALF + m * 16; const int bb = row < 8192 ? (row >> 12) : 2 + ((row - 8192) >> 3);
                float* rowp = X + (size_t)row * ldc + col0; const float* gp = gate + (size_t)bb * gstride + col0;
#pragma unroll
                for (int bj = 0; bj < 2; ++bj)
#pragma unroll
                    for (int n = 0; n < 2; ++n) { const f32x4 g = *(const f32x4*)(gp + bj * HALF + n * 16); f32x4* xp = (f32x4*)(rowp + bj * HALF + n * 16); *xp = *xp + g * acc[ai][bj][m][n]; } }
    }
};
template <class Epi, class Sched, bool ALIGN_EPI = false, bool SP2 = false>
__device__ __forceinline__ void gemm_phase(PG8_LAS unsigned char* lds, const Gemm g, const Sched& S, const Epi& E) {
    int tid_ = threadIdx.x; asm volatile("" : "+v"(tid_));
    const int tid = tid_, wid = __builtin_amdgcn_readfirstlane(tid >> 6), lane = tid & 63, wr = wid >> 2, wc = wid & 3, fr = lane & 15, fq = lane >> 4;
    const int K = g.K, nt = K / BK;
    unsigned voffA[2], voffB[2];
#pragma unroll
    for (int i = 0; i < 2; ++i) { int R, C; stage_rc(tid * 16 + i * 8192, R, C); const int Rb = Epi::PERM ? ((R & ~31) + perm32(R & 31)) : R;
        voffA[i] = (unsigned)(R * K + C) * 2u; voffB[i] = (unsigned)(Rb * K + C) * 2u; }
    const size_t kstep = (size_t)(BK * 2);
    const size_t hstep = (size_t)HALF * K * 2;
    const size_t tstep = 2 * hstep;
    const unsigned ldsw = (unsigned)wid * 1024u;
    const int aoff = lds_byte(wr * 64 + fr, fq * 8), boff = lds_byte(wc * 32 + fr, fq * 8);
#define PG8_SA(b, h) (((b) * 2 + (h)) * HTB)
#define PG8_SB(b, h) ((4 + (b) * 2 + (h)) * HTB)
#define PG8_STAGE(bufoff, gbase, voff) do { _Pragma("unroll") for (int _i = 0; _i < 2; ++_i) \
        __builtin_amdgcn_global_load_lds((const unsigned*)((const char*)(gbase) + (voff)[_i]), (PG8_LAS unsigned*)(lds + (bufoff) + ldsw + _i * 8192), 16, 0, 0); } while (0)
#define PG8_LDA(dst, b, h) do { _Pragma("unroll") for (int m = 0; m < 4; ++m) _Pragma("unroll") for (int k = 0; k < 2; ++k) dst[m][k] = *(const PG8_LAS bf16x8*)(lds + PG8_SA(b, h) + aoff + m * 2048 + k * 1024); } while (0)
#define PG8_LDB(dst, b, h) do { _Pragma("unroll") for (int n = 0; n < 2; ++n) _Pragma("unroll") for (int k = 0; k < 2; ++k) dst[n][k] = *(const PG8_LAS bf16x8*)(lds + PG8_SB(b, h) + boff + n * 2048 + k * 1024); } while (0)
#define PG8_MMA(ai, bj, At, Bt) do { __builtin_amdgcn_s_setprio(1); _Pragma("unroll") for (int m = 0; m < 4; ++m) _Pragma("unroll") for (int n = 0; n < 2; ++n) _Pragma("unroll") for (int k = 0; k < 2; ++k) \
        acc[ai][bj][m][n] = __builtin_amdgcn_mfma_f32_16x16x32_bf16(Bt[n][k], At[m][k], acc[ai][bj][m][n], 0, 0, 0); __builtin_amdgcn_s_setprio(0); } while (0)
#define PG8_WAIT_V(n) asm volatile("s_waitcnt vmcnt(" #n ")" ::: "memory")
#define PG8_WAIT_L(n) asm volatile("s_waitcnt lgkmcnt(" #n ")" ::: "memory")
#define PG8_BAR __builtin_amdgcn_s_barrier()
#define PG8_SCHED __builtin_amdgcn_sched_barrier(0)
    Unit cur, nxt; int ui = 0;
    if (!S.next(0, cur)) return;
    f32x4 acc[2][2][4][2];
#pragma unroll
    for (int a = 0; a < 2; ++a)
#pragma unroll
        for (int b = 0; b < 2; ++b)
#pragma unroll
            for (int m = 0; m < 4; ++m)
#pragma unroll
                for (int n = 0; n < 2; ++n) acc[a][b][m][n] = (f32x4){0.f, 0.f, 0.f, 0.f};
    bf16x8 At[4][2], B0[2][2], B1[2][2];
    const char* cA = (const char*)g.A + (size_t)cur.pm * tstep; const char* cB = (const char*)g.Bt + (size_t)cur.pn * tstep;
    S.a_ready(cur);
    if constexpr (SP2) {
        PG8_STAGE(PG8_SB(0, 0), cB, voffB); PG8_STAGE(PG8_SB(0, 1), cB + hstep, voffB); PG8_STAGE(PG8_SA(0, 0), cA, voffA); PG8_STAGE(PG8_SA(0, 1), cA + hstep, voffA);
        if (wr == 1) PG8_BAR;
        PG8_WAIT_V(2); PG8_BAR;
        PG8_STAGE(PG8_SB(1, 0), cB + kstep, voffB); PG8_STAGE(PG8_SA(1, 0), cA + kstep, voffA); PG8_STAGE(PG8_SB(1, 1), cB + hstep + kstep, voffB);
        PG8_WAIT_V(6); PG8_BAR;
    } else {
        PG8_STAGE(PG8_SB(0, 0), cB, voffB); PG8_STAGE(PG8_SA(0, 0), cA, voffA); PG8_STAGE(PG8_SB(0, 1), cB + hstep, voffB); PG8_STAGE(PG8_SA(0, 1), cA + hstep, voffA);
        if (wr == 1) PG8_BAR;
        PG8_WAIT_V(4); PG8_BAR;
        PG8_STAGE(PG8_SB(1, 0), cB + kstep, voffB); PG8_STAGE(PG8_SA(1, 0), cA + kstep, voffA); PG8_STAGE(PG8_SB(1, 1), cB + hstep + kstep, voffB);
        PG8_WAIT_V(6); PG8_BAR;
    }
    for (;;) {
        const bool has_next = S.next(ui + 1, nxt);
        const char* nA = has_next ? (const char*)g.A + (size_t)nxt.pm * tstep : cA; const char* nB = has_next ? (const char*)g.Bt + (size_t)nxt.pn * tstep : cB;
        for (int t = 0; t < nt; t += 2) {
            const bool last = (t == nt - 2);
            const char* a1 = cA + (size_t)(t + 1) * kstep;
            const char* a2 = last ? nA : cA + (size_t)(t + 2) * kstep; const char* b2 = last ? nB : cB + (size_t)(t + 2) * kstep;
            const char* a3 = a2 + kstep; const char* b3 = b2 + kstep;
            if (last && has_next) S.a_ready(nxt);
            if constexpr (SP2) {
            PG8_LDB(B0, 0, 0); PG8_LDB(B1, 0, 1); PG8_SCHED; PG8_LDA(At, 0, 0); PG8_STAGE(PG8_SA(1, 1), a1 + hstep, voffA);
            PG8_WAIT_V(8); PG8_WAIT_L(0); PG8_BAR; PG8_MMA(0, 0, At, B0); PG8_MMA(0, 1, At, B1); PG8_BAR; PG8_SCHED;
            PG8_LDA(At, 0, 1); PG8_STAGE(PG8_SB(0, 0), b2, voffB); PG8_STAGE(PG8_SB(0, 1), b2 + hstep, voffB); PG8_STAGE(PG8_SA(0, 0), a2, voffA);
            PG8_WAIT_V(8); PG8_WAIT_L(0); PG8_BAR; PG8_MMA(1, 0, At, B0); PG8_MMA(1, 1, At, B1); PG8_BAR; PG8_SCHED;
            PG8_LDB(B0, 1, 0); PG8_LDB(B1, 1, 1); PG8_SCHED; PG8_LDA(At, 1, 0); PG8_STAGE(PG8_SA(0, 1), a2 + hstep, voffA);
            PG8_WAIT_V(8); PG8_WAIT_L(0); PG8_BAR; PG8_MMA(0, 0, At, B0); PG8_MMA(0, 1, At, B1); PG8_BAR; PG8_SCHED;
            PG8_LDA(At, 1, 1); PG8_STAGE(PG8_SB(1, 0), b3, voffB); PG8_STAGE(PG8_SB(1, 1), b3 + hstep, voffB); PG8_STAGE(PG8_SA(1, 0), a3, voffA);
            PG8_WAIT_V(8); PG8_WAIT_L(0); PG8_BAR; PG8_MMA(1, 0, At, B0); PG8_MMA(1, 1, At, B1); PG8_BAR; PG8_SCHED;
            } else {
            PG8_LDB(B0, 0, 0); PG8_SCHED; PG8_LDA(At, 0, 0); PG8_STAGE(PG8_SA(1, 1), a1 + hstep, voffA);
            PG8_WAIT_L(8); PG8_BAR; PG8_WAIT_L(0); PG8_MMA(0, 0, At, B0); PG8_BAR; PG8_SCHED;
            PG8_LDB(B1, 0, 1); PG8_STAGE(PG8_SB(0, 0), b2, voffB);
            PG8_BAR; PG8_WAIT_L(0); PG8_MMA(0, 1, At, B1); PG8_BAR;
            PG8_LDA(At, 0, 1); PG8_STAGE(PG8_SA(0, 0), a2, voffA);
            PG8_BAR; PG8_WAIT_L(0); PG8_MMA(1, 0, At, B0); PG8_BAR; PG8_SCHED;
            PG8_STAGE(PG8_SB(0, 1), b2 + hstep, voffB);
            PG8_WAIT_V(6); PG8_BAR; PG8_MMA(1, 1, At, B1); PG8_BAR;
            PG8_LDB(B0, 1, 0); PG8_SCHED; PG8_LDA(At, 1, 0); PG8_STAGE(PG8_SA(0, 1), a2 + hstep, voffA);
            PG8_WAIT_L(8); PG8_BAR; PG8_WAIT_L(0); PG8_MMA(0, 0, At, B0); PG8_BAR; PG8_SCHED;
            PG8_LDB(B1, 1, 1); PG8_STAGE(PG8_SB(1, 0), b3, voffB);
            PG8_BAR; PG8_WAIT_L(0); PG8_MMA(0, 1, At, B1); PG8_BAR;
            PG8_LDA(At, 1, 1); PG8_STAGE(PG8_SA(1, 0), a3, voffA);
            PG8_BAR; PG8_WAIT_L(0); PG8_MMA(1, 0, At, B0); PG8_BAR; PG8_SCHED;
            PG8_STAGE(PG8_SB(1, 1), b3 + hstep, voffB);
            PG8_WAIT_V(6); PG8_BAR; PG8_MMA(1, 1, At, B1); PG8_BAR;
            }
        }
        if constexpr (ALIGN_EPI) { if (wr == 0) PG8_BAR; }
        if constexpr (!Epi::AFTER_DRAIN) { E(acc, cur, wr, wc, fr, fq); S.done(cur); }
        if (!has_next) break;
#pragma unroll
        for (int a = 0; a < 2; ++a)
#pragma unroll
            for (int b = 0; b < 2; ++b)
#pragma unroll
                for (int m = 0; m < 4; ++m)
#pragma unroll
                    for (int n = 0; n < 2; ++n) acc[a][b][m][n] = (f32x4){0.f, 0.f, 0.f, 0.f};
        cur = nxt; cA = nA; cB = nB; ++ui;
        if constexpr (ALIGN_EPI) { if (wr == 1) PG8_BAR; }
    }
    PG8_WAIT_V(0);
    if constexpr (!ALIGN_EPI) { if (wr == 0) PG8_BAR; }
    PG8_BAR;
    if constexpr (Epi::AFTER_DRAIN) { E.fused(acc, cur, wr, wc, fr, fq, lds, wid, lane); S.done(cur); }
#undef PG8_SA
#undef PG8_SB
#undef PG8_STAGE
#undef PG8_LDA
#undef PG8_LDB
#undef PG8_MMA
#undef PG8_WAIT_V
#undef PG8_WAIT_L
#undef PG8_BAR
#undef PG8_SCHED
}
}
constexpr int NWAVES = 8, NTHR = 512;
constexpr int D = 2048, DEPTH = 4, BP = 2, TP = 4096, BS = 32, TS = 8;
constexpr int MP = BP * TP, MS = BS * TS, M = MP + MS, NBB = BP + BS;
constexpr int NINW = 4872, NPROJ = 4864, DFF = 8192, NMOD = 6 * D, PAST = 16384;
constexpr int C_AQ = 0, C_AF = 512, C_AI = 1024, C_AG = 1536, C_PU = 2048, C_CZ = 2560, C_CX = 3072, C_DQ = 4096, C_DK = 4608, C_DV = 4736;
constexpr float EPS = 1e-6f;
enum { I_XP = 0, I_XS, I_CP, I_CS, I_SHG, I_SPOOL, I_SSSM, I_SCONV, I_CK, I_CV, I_N1G, I_N2G, I_WADA, I_BADA, I_WIN, I_LBL, I_HNG, I_PW, I_PSC, I_CW, I_CB, I_DTB, I_ALOG, I_DSK, I_SNG, I_QNG, I_KNG, I_SINK, I_WOUT, I_WUP, I_WDN, N_IN };
constexpr size_t O_Y = 0, O_PHG = (size_t)M * D, O_PPOOL = O_PHG + 4 * 2 * 4 * 16384, O_PSSM = O_PPOOL + 4 * 2 * 15 * 512, O_PCONV = O_PSSM + 4 * 2 * 8 * 8192, O_PK = O_PCONV + 4 * 2 * 3 * 1024,
    O_PV = O_PK + 4 * 2 * 128 * 128, O_SHG = O_PV + 4 * 2 * 128 * 128, O_SPOOL = O_SHG + (size_t)4 * 32 * 4 * 16384, O_SSSM = O_SPOOL + 4 * 32 * 15 * 512, O_SCONV = O_SSSM + (size_t)4 * 32 * 8 * 8192,
    O_SK = O_SCONV + 4 * 32 * 3 * 1024, O_SV = O_SK + 4 * 32 * 128 * 128, O_END = O_SV + 4 * 32 * 128 * 128;
static_assert(O_END == 41046016, "output size");
constexpr size_t MiB = 1u << 20;
constexpr size_t WS_CTL = 0, CTL_ZERO_BYTES = 1 * MiB;
constexpr size_t WS_MOD = 1 * MiB, WS_LB = 8 * MiB, WS_ROPE = 8 * MiB + 65536, WS_DT = 10 * MiB;
constexpr size_t WS_WIN = 16 * MiB, WS_WOUT = 92 * MiB, WS_WUP = 124 * MiB, WS_WDN = 252 * MiB;
constexpr size_t WS_H = 380 * MiB, WS_PROJ = 413 * MiB, WS_MIX = 492 * MiB, WS_U = 525 * MiB;
constexpr size_t WS_HGDS = 657 * MiB, WS_HGSS = 689 * MiB, WS_SDDS = 721 * MiB, WS_SDSS = 753 * MiB, WS_HGDEC = 785 * MiB, WS_SDDEC = 785 * MiB + 524288, WS_END = 786 * MiB;
static_assert(WS_WIN + (size_t)4 * NPROJ * D * 2 <= WS_WOUT && WS_PROJ + (size_t)M * NPROJ * 2 <= WS_MIX && WS_U + (size_t)M * DFF * 2 <= WS_HGDS, "ws map");
constexpr int CW_BAR = 4096, CW_Q = 16384;
constexpr int RING_BYTES = 131072, LDSCTL_OFF = RING_BYTES, MISC_OFF = LDSCTL_OFF + 320, PTR_OFF = LDSCTL_OFF + 1024, LDS_BYTES = 147456;
constexpr int PH_PER_LAYER = 9, N_PHASES = 1 + DEPTH * PH_PER_LAYER;
#ifndef MK_ONE_LAUNCH
#define MK_ONE_LAUNCH 1
#endif
#define GAS __attribute__((address_space(1)))
#define LAS __attribute__((address_space(3)))
typedef unsigned short bf16;
typedef unsigned v4u __attribute__((ext_vector_type(4)));
typedef float f32x4 __attribute__((ext_vector_type(4)));
typedef short bf16x8 __attribute__((ext_vector_type(8)));
typedef GAS unsigned gu32;
typedef GAS unsigned long long gu64;
#define RLX_AGENT __ATOMIC_RELAXED, __HIP_MEMORY_SCOPE_AGENT
#define LDS_WAIT() asm volatile("s_waitcnt lgkmcnt(0)" ::: "memory")
#define VM_WAIT() asm volatile("s_waitcnt vmcnt(0)" ::: "memory")
__device__ __forceinline__ unsigned long long rt() { return __builtin_amdgcn_s_memrealtime(); }
__device__ __forceinline__ unsigned f2bf(float f) { unsigned u = __builtin_bit_cast(unsigned, f); return (u + 0x7fffu + ((u >> 16) & 1u)) >> 16; }
__device__ __forceinline__ unsigned pk2(float lo, float hi) { return f2bf(lo) | (f2bf(hi) << 16); }

#define XB_TMO      128
#define XB_XCNT(j)  (256  + 64 * (j))
#define XB_XSUB(j)  (1280 + 64 * (j))
#define XB_XGEN(j)  (2304 + 64 * (j))
#define XB_TOP      3328
#define XB_TOPGEN   3392
#define XCD_BAR_WORDS 3456
#define XB_SPIN_CAP (1u << 18)

__device__ __forceinline__ unsigned xb_ld(unsigned* p)              { return __hip_atomic_load(p, __ATOMIC_RELAXED, __HIP_MEMORY_SCOPE_AGENT); }
__device__ __forceinline__ unsigned xb_add(unsigned* p, unsigned v) { return __hip_atomic_fetch_add(p, v, __ATOMIC_RELAXED, __HIP_MEMORY_SCOPE_AGENT); }
__device__ __forceinline__ unsigned xb_xcc_id() { return (unsigned)__builtin_amdgcn_s_getreg((3 << 11) | 20) & 0xFu; }
#define XB_SPIN(cond, bar) do { unsigned _sp = 0; while (cond) { __builtin_amdgcn_s_sleep(1); \
    if ((++_sp & 255u) == 0u) { if (xb_ld(&(bar)[XB_TMO])) break; if (_sp > XB_SPIN_CAP) { atomicAdd(&(bar)[XB_TMO], 1u); break; } } } } while (0)

struct XcdBarrier {
    unsigned* bar; unsigned x;
    volatile LAS unsigned* st;
};

__device__ __forceinline__ XcdBarrier xcd_barrier_post(unsigned* bar, volatile LAS unsigned* st) {
    XcdBarrier b; b.bar = bar; b.x = xb_xcc_id(); b.st = st;
    if (threadIdx.x == 0) (void)xb_add(&bar[XB_XCNT(b.x)], 1u);
    return b;
}
__device__ __forceinline__ void xcd_barrier_complete(unsigned* bar, unsigned x, unsigned& nloc, unsigned& nx) {
    const unsigned G = gridDim.x * gridDim.y * gridDim.z;
    unsigned sum, cnt, mine, sp = 0u;
    for (;;) {
        sum = 0u; cnt = 0u; mine = 0u;
#pragma unroll
        for (unsigned j = 0; j < 16; ++j) { const unsigned c = xb_ld(&bar[XB_XCNT(j)]); sum += c; cnt += (c > 0u) ? 1u : 0u; mine = (j == x) ? c : mine; }
        if (sum == G) break;
        __builtin_amdgcn_s_sleep(1);
        if ((++sp & 255u) == 0u) { if (xb_ld(&bar[XB_TMO])) break; if (sp > XB_SPIN_CAP) { atomicAdd(&bar[XB_TMO], 1u); break; } }
    }
    nloc = mine > 0u ? mine : 1u; nx = cnt > 0u ? cnt : 1u;
}

__device__ __forceinline__ void xcd_barrier(const XcdBarrier& b) {
    asm volatile("s_waitcnt vmcnt(0)" ::: "memory");
    __syncthreads();
    if (threadIdx.x == 0) {
        unsigned* bar = b.bar;
        __builtin_amdgcn_s_waitcnt(0);
        unsigned nloc = b.st[0], nx = b.st[1];
        if (nloc == 0u) { xcd_barrier_complete(bar, b.x, nloc, nx); b.st[0] = nloc; b.st[1] = nx; }
        const unsigned old = xb_add(&bar[XB_XSUB(b.x)], 1u);
        const unsigned gen = old / nloc;
        if (old + 1u == (gen + 1u) * nloc) {
            __builtin_amdgcn_fence(__ATOMIC_RELEASE, "agent");
            asm volatile("s_waitcnt vmcnt(0)" ::: "memory");
            const unsigned og = xb_add(&bar[XB_TOP], 1u);
            const unsigned tg = og / nx;
            if (og + 1u == (tg + 1u) * nx) xb_add(&bar[XB_TOPGEN], 1u);
            else XB_SPIN(xb_ld(&bar[XB_TOPGEN]) == tg, bar);
            __builtin_amdgcn_fence(__ATOMIC_ACQUIRE, "agent");
            xb_add(&bar[XB_XGEN(b.x)], 1u);
            asm volatile("s_waitcnt vmcnt(0)" ::: "memory");
        } else {
            XB_SPIN(xb_ld(&bar[XB_XGEN(b.x)]) == gen, bar);
            __builtin_amdgcn_fence(__ATOMIC_ACQUIRE, "agent");
            asm volatile("s_waitcnt vmcnt(0)" ::: "memory");
        }
    }
    __syncthreads();
}

struct Frame {
    LAS unsigned char* lds;
    volatile LAS unsigned* MISC;
    gu32* ctl;
    int tid, lane, wave, G, gw, ngw;
    float* out; unsigned char* ws;
};
__device__ __forceinline__ const float* inp(const Frame& F, int i) {
    int off = PTR_OFF + 8 * i; asm volatile("" : "+s"(off));
    const unsigned long long v = *(const LAS unsigned long long*)(F.lds + off);
    const unsigned lo = __builtin_amdgcn_readfirstlane((unsigned)v), hi = __builtin_amdgcn_readfirstlane((unsigned)(v >> 32));
    return (const float*)(((unsigned long long)hi << 32) | lo);
}
__device__ __forceinline__ unsigned char* wsp(const Frame& F, size_t off) { unsigned char* p = F.ws; asm volatile("" : "+s"(p)); return p + off; }
#define INP(i) inp(F, i)
#define WS_LOCALS \
    float* const MOD = (float*)wsp(F, WS_MOD); float* const LBv = (float*)wsp(F, WS_LB); float* const ROPE = (float*)wsp(F, WS_ROPE); float* const DT = (float*)wsp(F, WS_DT); \
    bf16* const Wi = (bf16*)wsp(F, WS_WIN); bf16* const Wo = (bf16*)wsp(F, WS_WOUT); bf16* const Wu = (bf16*)wsp(F, WS_WUP); bf16* const Wd = (bf16*)wsp(F, WS_WDN); \
    bf16* const H = (bf16*)wsp(F, WS_H); bf16* const PROJ = (bf16*)wsp(F, WS_PROJ); bf16* const MIX = (bf16*)wsp(F, WS_MIX); bf16* const U = (bf16*)wsp(F, WS_U); \
    float* const HGDS = (float*)wsp(F, WS_HGDS); float* const HGSS = (float*)wsp(F, WS_HGSS); float* const SDDS = (float*)wsp(F, WS_SDDS); float* const SDSS = (float*)wsp(F, WS_SDSS); \
    float* const HGDEC = (float*)wsp(F, WS_HGDEC); float* const SDDEC = (float*)wsp(F, WS_SDDEC); \
    (void)MOD; (void)LBv; (void)ROPE; (void)DT; (void)Wi; (void)Wo; (void)Wu; (void)Wd; (void)H; (void)PROJ; (void)MIX; (void)U; (void)HGDS; (void)HGSS; (void)SDDS; (void)SDSS; (void)HGDEC; (void)SDDEC;
__device__ __forceinline__ float wave_sum(float v) {
#pragma unroll
    for (int o = 1; o < 64; o <<= 1) v += __shfl_xor(v, o);
    return v;
}
__device__ __forceinline__ float bf2f(bf16 b) { return __builtin_bit_cast(float, (unsigned)b << 16); }
__device__ __forceinline__ float bflo(unsigned w) { return __builtin_bit_cast(float, w << 16); }
__device__ __forceinline__ float bfhi(unsigned w) { return __builtin_bit_cast(float, w & 0xffff0000u); }
__device__ __forceinline__ float sigm(float x) { return 1.f / (1.f + __expf(-x)); }
__device__ __forceinline__ int row_bb(int m) { return m < MP ? (m >> 12) : BP + ((m - MP) >> 3); }
__device__ __forceinline__ int deq(Frame& F, int q) {
    __syncthreads();
    if (F.tid == 0) F.MISC[0] = __hip_atomic_fetch_add(F.ctl + CW_Q + 64 * q, 1u, RLX_AGENT);
    __syncthreads();
    return (int)F.MISC[0];
}

__device__ __forceinline__ void p0_transpose_item(const float* W, int K, int ldw, bf16* WT, int k0, int src_n0, int dst_n0, LAS float* scr, int lane) {
#pragma unroll 8
    for (int i = 0; i < 32; ++i) { const int kk = 2 * i + (lane >> 5); scr[kk * 33 + (lane & 31)] = W[(size_t)(k0 + kk) * ldw + src_n0 + (lane & 31)]; }
    LDS_WAIT(); asm volatile("" ::: "memory");
    const int c = lane & 7;
#pragma unroll
    for (int j = 0; j < 4; ++j) { const int n = (lane >> 3) + 8 * j; const LAS float* s = scr + (8 * c) * 33 + n;
        v4u o; o.x = pk2(s[0 * 33], s[1 * 33]); o.y = pk2(s[2 * 33], s[3 * 33]); o.z = pk2(s[4 * 33], s[5 * 33]); o.w = pk2(s[6 * 33], s[7 * 33]);
        *(GAS v4u*)(WT + (size_t)(dst_n0 + n) * K + k0 + 8 * c) = o; }
    LDS_WAIT(); asm volatile("" ::: "memory");
}
__device__ __forceinline__ void p0_adaln_item(Frame& F, int item) {
    const int l = item / 48, cc = item % 48, tid = F.tid, col = tid & 255, kh = tid >> 8;
    LAS float* cs = (LAS float*)F.lds;
    LAS float* red = (LAS float*)(F.lds + 18432);
    float acc[34];
#pragma unroll
    for (int i = 0; i < 34; ++i) acc[i] = 0.f;
    WS_LOCALS
    const float* W = INP(I_WADA) + (size_t)l * D * NMOD + 256 * cc + col; const float* const cpp = INP(I_CP); const float* const csp = INP(I_CS);
    for (int kt = 0; kt < 16; ++kt) {
        const int kbase = kh * 1024 + kt * 64;
        __syncthreads();
        for (int e = col; e < 64 * 34; e += 256) { const int bb = e >> 6, kk = e & 63;
            const float c = bb < BP ? cpp[bb * D + kbase + kk] : csp[(bb - BP) * D + kbase + kk];
            cs[(kh * 64 + kk) * 36 + bb] = c * sigm(c); }
        __syncthreads();
#pragma unroll 8
        for (int kk = 0; kk < 64; ++kk) {
            const float w = W[(size_t)(kbase + kk) * NMOD];
            const LAS f32x4* c4 = (const LAS f32x4*)(cs + (kh * 64 + kk) * 36);
#pragma unroll
            for (int q = 0; q < 8; ++q) { const f32x4 c = c4[q]; acc[4 * q] += w * c.x; acc[4 * q + 1] += w * c.y; acc[4 * q + 2] += w * c.z; acc[4 * q + 3] += w * c.w; }
            const f32x4 c = c4[8]; acc[32] += w * c.x; acc[33] += w * c.y;
        }
    }
    __syncthreads();
    if (kh == 1) {
#pragma unroll
        for (int i = 0; i < 34; ++i) red[col * 35 + i] = acc[i]; }
    __syncthreads();
    if (kh == 0) { const float bias = INP(I_BADA)[l * NMOD + 256 * cc + col];
#pragma unroll
        for (int i = 0; i < 34; ++i) MOD[((size_t)l * NBB + i) * NMOD + 256 * cc + col] = acc[i] + red[col * 35 + i] + bias; }
    __syncthreads();
}
__device__ __forceinline__ void p0_prologue(Frame& F) {
    WS_LOCALS
    const int gt = blockIdx.x * NTHR + F.tid, NT = F.G * NTHR;
    { const f32x4* s = (const f32x4*)INP(I_XP); f32x4* d = (f32x4*)F.out;
      for (int i = gt; i < MP * D / 4; i += NT) d[i] = s[i];
      s = (const f32x4*)INP(I_XS); d = (f32x4*)(F.out + (size_t)MP * D);
      for (int i = gt; i < MS * D / 4; i += NT) d[i] = s[i]; }
    if (gt < 512) { const float* lg = INP(I_LBL); const float a0 = lg[gt], a1 = lg[512 + gt], a2 = lg[1024 + gt], a3 = lg[1536 + gt];
        const float mx = fmaxf(fmaxf(a0, a1), fmaxf(a2, a3)); const float e0 = expf(a0 - mx), e1 = expf(a1 - mx), e2 = expf(a2 - mx), e3 = expf(a3 - mx); const float inv = 1.f / (e0 + e1 + e2 + e3);
        LBv[gt] = 0.f; LBv[512 + gt] = e1 * inv; LBv[1024 + gt] = (e1 + e2) * inv; LBv[1536 + gt] = (e1 + e2 + e3) * inv; }
    for (int e = gt; e < 4104 * 32; e += NT) { const int r = e >> 5, i = e & 31; const int pos = r < 4096 ? r : PAST + (r - 4096);
        const double inv = exp2(-(double)i * (13.287712379549449 / 32.0)); const double rev = (double)pos * inv * 0.15915494309189535;
        const float fr = (float)(rev - floor(rev));
        ROPE[r * 64 + i] = __builtin_amdgcn_cosf(fr); ROPE[r * 64 + 32 + i] = __builtin_amdgcn_sinf(fr); }
    if ((int)blockIdx.x < 192) p0_adaln_item(F, (int)blockIdx.x);
    if (F.G < 192) for (int it = F.G + (int)blockIdx.x; it < 192; it += F.G) p0_adaln_item(F, it);
    __syncthreads();
    LAS float* scr = (LAS float*)(F.lds + F.wave * 16384);
    constexpr int IT_IN = (D / 64) * (NPROJ / 32), IT_OUT = (D / 64) * (D / 32), IT_UP = (D / 64) * (DFF / 32), IT_DN = (DFF / 64) * (D / 32), IT_L = IT_IN + IT_OUT + IT_UP + IT_DN;
    for (int it = F.gw; it < DEPTH * IT_L; it += F.ngw) {
        const int l = it / IT_L; int r = it % IT_L;
        if (r < IT_IN) { const int nblk = NPROJ / 32, kb = r / nblk, nb = r % nblk, dn0 = 32 * nb, sn0 = dn0 + (dn0 >= 4096 ? 8 : 0);
            p0_transpose_item(INP(I_WIN) + (size_t)l * D * NINW, D, NINW, Wi + (size_t)l * NPROJ * D, 64 * kb, sn0, dn0, scr, F.lane); continue; } r -= IT_IN;
        if (r < IT_OUT) { const int nblk = D / 32, kb = r / nblk, nb = r % nblk;
            p0_transpose_item(INP(I_WOUT) + (size_t)l * D * D, D, D, Wo + (size_t)l * D * D, 64 * kb, 32 * nb, 32 * nb, scr, F.lane); continue; } r -= IT_OUT;
        if (r < IT_UP) { const int nblk = DFF / 32, kb = r / nblk, nb = r % nblk;
            p0_transpose_item(INP(I_WUP) + (size_t)l * D * DFF, D, DFF, Wu + (size_t)l * DFF * D, 64 * kb, 32 * nb, 32 * nb, scr, F.lane); continue; } r -= IT_UP;
        { const int nblk = D / 32, kb = r / nblk, nb = r % nblk;
            p0_transpose_item(INP(I_WDN) + (size_t)l * DFF * D, DFF, D, Wd + (size_t)l * D * DFF, 64 * kb, 32 * nb, 32 * nb, scr, F.lane); }
    }
}

__device__ __forceinline__ void norm_phase(Frame& F, int l, int which) {
    WS_LOCALS
    LAS float* wdt = (LAS float*)F.lds;
    if (which == 0) { const float* wsrc = INP(I_WIN) + (size_t)l * D * NINW + 4096;
        for (int e = F.tid; e < D * 8; e += NTHR) { const int d = e >> 3, j = e & 7; wdt[j * D + d] = wsrc[(size_t)d * NINW + j]; }
        __syncthreads(); }
    const f32x4* g4 = (const f32x4*)(INP(which ? I_N2G : I_N1G) + l * D);
    for (int m = F.gw; m < M; m += F.ngw) {
        const int bb = row_bb(m);
        const f32x4* xr = (const f32x4*)(F.out + (size_t)m * D);
        const float* modp = MOD + ((size_t)l * NBB + bb) * NMOD + (which ? 3 * D : 0);
        const f32x4* sh4 = (const f32x4*)modp; const f32x4* sc4 = (const f32x4*)(modp + D);
        f32x4 v[8]; float ss = 0.f;
#pragma unroll
        for (int j = 0; j < 8; ++j) { v[j] = xr[64 * j + F.lane]; ss += (v[j].x * v[j].x + v[j].y * v[j].y) + (v[j].z * v[j].z + v[j].w * v[j].w); }
        const float r = 1.f / sqrtf(wave_sum(ss) * (1.f / D) + EPS);
        float dta[8];
#pragma unroll
        for (int j = 0; j < 8; ++j) dta[j] = 0.f;
        GAS unsigned long long* o8 = (GAS unsigned long long*)(H + (size_t)m * D);
#pragma unroll
        for (int j = 0; j < 8; ++j) { const int q = 64 * j + F.lane; const f32x4 g = g4[q], sc = sc4[q], sh = sh4[q];
            f32x4 h; h.x = v[j].x * r * g.x * (1.f + sc.x) + sh.x; h.y = v[j].y * r * g.y * (1.f + sc.y) + sh.y; h.z = v[j].z * r * g.z * (1.f + sc.z) + sh.z; h.w = v[j].w * r * g.w * (1.f + sc.w) + sh.w;
            o8[q] = (unsigned long long)pk2(h.x, h.y) | ((unsigned long long)pk2(h.z, h.w) << 32);
            v[j] = h; }
        if (which == 0) {
#pragma unroll
            for (int jj = 0; jj < 8; ++jj) { float a = 0.f;
#pragma unroll
                for (int j = 0; j < 8; ++j) { const f32x4 w = ((const LAS f32x4*)wdt)[jj * (D / 4) + 64 * j + F.lane]; a += (v[j].x * w.x + v[j].y * w.y) + (v[j].z * w.z + v[j].w * w.w); }
                dta[jj] = wave_sum(a); __builtin_amdgcn_sched_barrier(0); }
            if (F.lane == 0) { f32x4* dp = (f32x4*)(DT + (size_t)m * 8); dp[0] = (f32x4){dta[0], dta[1], dta[2], dta[3]}; dp[1] = (f32x4){dta[4], dta[5], dta[6], dta[7]}; } }
    }
}
template <int MODE> __device__ __forceinline__ void hgrn_unit(Frame& F, int l, int u) {
    WS_LOCALS
    const int tid = F.tid, v = tid & 127, dg = tid >> 7;
    const float* const hng = INP(I_HNG);
    int h, m0, L; size_t sidx;
    if (MODE == 2) { const int b = u >> 2; h = u & 3; m0 = MP + b * TS; L = TS; sidx = ((size_t)(l * BS + b) * 4 + h) * 16384; }
    else { const int bh = u >> 6, c = u & 63, b = bh >> 2; h = bh & 3; m0 = b * TP + c * 64; L = 64; sidx = (size_t)u * 16384; }
    LAS float* fL = (LAS float*)F.lds;
    LAS float* kL = fL + 2048; LAS float* qL = kL + 2048; LAS float* vL = qL + 2048;
    LAS float* op = vL + 2048;
    float S[32];
    if (MODE == 0) {
#pragma unroll
        for (int i = 0; i < 32; ++i) S[i] = 0.f;
    } else { const float* src = (MODE == 1 ? HGSS : INP(I_SHG)) + sidx + (size_t)(dg * 32) * 128 + v;
#pragma unroll
        for (int i = 0; i < 32; ++i) S[i] = src[i * 128]; }
    float P = 1.f;
    const int sd = tid & 127; const float lbv = LBv[l * 512 + h * 128 + sd];
    for (int t0 = 0; t0 < L; t0 += 16) {
        const int nst = (L - t0) < 16 ? (L - t0) : 16;
        __syncthreads();
        for (int tt = tid >> 7; tt < nst; tt += 4) { const bf16* row = PROJ + (size_t)(m0 + t0 + tt) * NPROJ + h * 128 + sd;
            const float fr = bf2f(row[C_AF]), qr = bf2f(row[C_AQ]), ir = bf2f(row[C_AI]);
            const float e = __expf(-fr); const float sg = 1.f / (1.f + e), sgn = e / (1.f + e);
            fL[tt * 128 + sd] = lbv + (1.f - lbv) * sg; kL[tt * 128 + sd] = (1.f - lbv) * sgn; qL[tt * 128 + sd] = qr * sigm(qr); vL[tt * 128 + sd] = ir; }
        __syncthreads();
        if (MODE == 0 && tid < 128) for (int tt = 0; tt < nst; ++tt) P *= fL[tt * 128 + tid];
        for (int tt = 0; tt < nst; ++tt) {
            const float vv = vL[tt * 128 + v]; float o = 0.f;
            const LAS f32x4* f4 = (const LAS f32x4*)(fL + tt * 128 + dg * 32); const LAS f32x4* k4 = (const LAS f32x4*)(kL + tt * 128 + dg * 32); const LAS f32x4* q4 = (const LAS f32x4*)(qL + tt * 128 + dg * 32);
#pragma unroll
            for (int j = 0; j < 8; ++j) { const f32x4 f = f4[j], k = k4[j], q = q4[j];
                S[4 * j] = f.x * S[4 * j] + k.x * vv; S[4 * j + 1] = f.y * S[4 * j + 1] + k.y * vv; S[4 * j + 2] = f.z * S[4 * j + 2] + k.z * vv; S[4 * j + 3] = f.w * S[4 * j + 3] + k.w * vv;
                if (MODE != 0) o += (q.x * S[4 * j] + q.y * S[4 * j + 1]) + (q.z * S[4 * j + 2] + q.w * S[4 * j + 3]); }
            if (MODE != 0) op[(tt * 4 + dg) * 128 + v] = o;
        }
        if (MODE != 0) {
            __syncthreads();
            for (int tt = F.wave; tt < nst; tt += 8) {
                const LAS float* p = op + tt * 512;
                const float o0 = (p[F.lane] + p[128 + F.lane]) + (p[256 + F.lane] + p[384 + F.lane]), o1 = (p[64 + F.lane] + p[192 + F.lane]) + (p[320 + F.lane] + p[448 + F.lane]);
                const float r = 1.f / sqrtf(wave_sum(o0 * o0 + o1 * o1) * (1.f / 128.f) + EPS);
                const int m = m0 + t0 + tt; const bf16* grow = PROJ + (size_t)m * NPROJ + C_AG + h * 128; const float* ng = hng + l * 512 + h * 128;
                bf16* orow = MIX + (size_t)m * D + h * 128;
                orow[F.lane] = (bf16)f2bf(o0 * r * ng[F.lane] * sigm(bf2f(grow[F.lane])));
                orow[64 + F.lane] = (bf16)f2bf(o1 * r * ng[64 + F.lane] * sigm(bf2f(grow[64 + F.lane])));
            }
        }
    }
    if (MODE == 0) { float* dst = HGDS + sidx + (size_t)(dg * 32) * 128 + v;
#pragma unroll
        for (int i = 0; i < 32; ++i) dst[i * 128] = S[i];
        if (tid < 128) HGDEC[u * 128 + tid] = P; }
    if (MODE == 2) { float* dst = F.out + O_SHG + sidx + (size_t)(dg * 32) * 128 + v;
#pragma unroll
        for (int i = 0; i < 32; ++i) dst[i * 128] = S[i]; }
}

template <int MODE> __device__ __forceinline__ void ssd_unit(Frame& F, int l, int u) {
    WS_LOCALS
    const int tid = F.tid, hh = F.wave, p = F.lane, g = hh >> 2;
    const float* const cwp = INP(I_CW); const float* const cbp = INP(I_CB); const float* const scv = INP(I_SCONV); const float* const dtbp = INP(I_DTB); const float* const alp = INP(I_ALOG);
    const float ngv = INP(I_SNG)[l * 512 + hh * 64 + p];
    int b, m0, L, tseq0; size_t sidx;
    if (MODE == 2) { b = u; m0 = MP + b * TS; L = TS; tseq0 = 0; sidx = ((size_t)(l * BS + b) * 8 + hh) * 8192 + p * 128; }
    else { b = u >> 6; const int c = u & 63; m0 = b * TP + c * 64; L = 64; tseq0 = c * 64; sidx = ((size_t)u * 8 + hh) * 8192 + p * 128; }
    LAS float* cv = (LAS float*)F.lds;
    LAS float* ygL = cv + 16384;
    LAS float* dtL = ygL + 8192;
    LAS float* dcL = dtL + 128;
    LAS float* red = dcL + 128;
    float S[128];
    if (MODE == 0) {
#pragma unroll
        for (int i = 0; i < 128; ++i) S[i] = 0.f;
    } else { const f32x4* src = (const f32x4*)((MODE == 1 ? SDSS : INP(I_SSSM)) + sidx);
#pragma unroll
        for (int i = 0; i < 32; ++i) { const f32x4 t = src[i]; S[4 * i] = t.x; S[4 * i + 1] = t.y; S[4 * i + 2] = t.z; S[4 * i + 3] = t.w; } }
    float Ptot = 1.f;
    const float dsk = INP(I_DSK)[l * 8 + hh];
    const int ch = 2 * tid;
    float cw[4][2], cb[2];
#pragma unroll
    for (int j = 0; j < 4; ++j) { cw[j][0] = cwp[(l * 4 + j) * 1024 + ch]; cw[j][1] = cwp[(l * 4 + j) * 1024 + ch + 1]; }
    cb[0] = cbp[l * 1024 + ch]; cb[1] = cbp[l * 1024 + ch + 1];
    for (int t0 = 0; t0 < L; t0 += 16) {
        const int nst = (L - t0) < 16 ? (L - t0) : 16;
        __syncthreads();
        {
            float x[3][2];
#pragma unroll
            for (int j = 0; j < 3; ++j) { const int r = t0 - 3 + j; float a0 = 0.f, a1 = 0.f;
                if (MODE == 2) { if (r >= 0) { const unsigned w = *(const unsigned*)(PROJ + (size_t)(m0 + r) * NPROJ + C_CX + ch); a0 = bflo(w); a1 = bfhi(w); }
                                 else { const float* sc = scv + ((size_t)(l * BS + b) * 3 + (3 + r)) * 1024 + ch; a0 = sc[0]; a1 = sc[1]; } }
                else if (tseq0 + r >= 0) { const unsigned w = *(const unsigned*)(PROJ + (size_t)(m0 + r) * NPROJ + C_CX + ch); a0 = bflo(w); a1 = bfhi(w); }
                x[j][0] = a0; x[j][1] = a1; }
            for (int tt = 0; tt < nst; ++tt) {
                const unsigned w = *(const unsigned*)(PROJ + (size_t)(m0 + t0 + tt) * NPROJ + C_CX + ch); const float n0 = bflo(w), n1 = bfhi(w);
                const float c0 = cb[0] + cw[0][0] * x[0][0] + cw[1][0] * x[1][0] + cw[2][0] * x[2][0] + cw[3][0] * n0;
                const float c1 = cb[1] + cw[0][1] * x[0][1] + cw[1][1] * x[1][1] + cw[2][1] * x[2][1] + cw[3][1] * n1;
                cv[tt * 1024 + ch] = c0 * sigm(c0); cv[tt * 1024 + ch + 1] = c1 * sigm(c1);
                x[0][0] = x[1][0]; x[0][1] = x[1][1]; x[1][0] = x[2][0]; x[1][1] = x[2][1]; x[2][0] = n0; x[2][1] = n1; }
        }
        if (tid < nst * 8) { const int tt = tid >> 3, h8 = tid & 7; const float raw = DT[(size_t)(m0 + t0 + tt) * 8 + h8] + dtbp[l * 8 + h8];
            const float dtv = raw > 20.f ? raw : log1pf(__expf(raw)); dtL[tid] = dtv; dcL[tid] = __expf(-dtv * __expf(alp[l * 8 + h8])); }
        __syncthreads();
        for (int tt = 0; tt < nst; ++tt) {
            const float xv = cv[tt * 1024 + hh * 64 + p], dtv = dtL[tt * 8 + hh], dc = dcL[tt * 8 + hh], dx = dtv * xv; Ptot *= dc;
            const LAS f32x4* B4 = (const LAS f32x4*)(cv + tt * 1024 + 512 + g * 128); const LAS f32x4* C4 = (const LAS f32x4*)(cv + tt * 1024 + 768 + g * 128);
            float y = 0.f;
#pragma unroll
            for (int j = 0; j < 32; ++j) { const f32x4 Bv = B4[j];
                S[4 * j] = dc * S[4 * j] + dx * Bv.x; S[4 * j + 1] = dc * S[4 * j + 1] + dx * Bv.y; S[4 * j + 2] = dc * S[4 * j + 2] + dx * Bv.z; S[4 * j + 3] = dc * S[4 * j + 3] + dx * Bv.w;
                if (MODE != 0) { const f32x4 Cv = C4[j]; y += (Cv.x * S[4 * j] + Cv.y * S[4 * j + 1]) + (Cv.z * S[4 * j + 2] + Cv.w * S[4 * j + 3]); } }
            if (MODE != 0) { y += dsk * xv; const float z = bf2f(PROJ[(size_t)(m0 + t0 + tt) * NPROJ + C_CZ + hh * 64 + p]); const float yg = y * z * sigm(z);
                ygL[tt * 512 + hh * 64 + p] = yg; const float ss = wave_sum(yg * yg); if (p == 0) red[tt * 8 + hh] = ss; }
        }
        if (MODE != 0) {
            __syncthreads();
            const float ng = ngv;
            for (int tt = 0; tt < nst; ++tt) { const LAS float* rp = red + tt * 8; const float tot = ((rp[0] + rp[1]) + (rp[2] + rp[3])) + ((rp[4] + rp[5]) + (rp[6] + rp[7]));
                const float r = 1.f / sqrtf(tot * (1.f / 512.f) + EPS);
                MIX[(size_t)(m0 + t0 + tt) * D + 1024 + hh * 64 + p] = (bf16)f2bf(ygL[tt * 512 + hh * 64 + p] * r * ng); }
        }
    }
    if (MODE == 0) { f32x4* dst = (f32x4*)(SDDS + sidx);
#pragma unroll
        for (int i = 0; i < 32; ++i) dst[i] = (f32x4){S[4 * i], S[4 * i + 1], S[4 * i + 2], S[4 * i + 3]};
        if (p == 0) SDDEC[u * 8 + hh] = Ptot;
        if ((u & 63) == 63) for (int e = tid; e < 3 * 1024; e += NTHR) { const int j = e >> 10, c2 = e & 1023;
            F.out[O_PCONV + ((size_t)(l * BP + b) * 3 + j) * 1024 + c2] = bf2f(PROJ[(size_t)(m0 + 61 + j) * NPROJ + C_CX + c2]); } }
    if (MODE == 2) { f32x4* dst = (f32x4*)(F.out + O_SSSM + sidx);
#pragma unroll
        for (int i = 0; i < 32; ++i) dst[i] = (f32x4){S[4 * i], S[4 * i + 1], S[4 * i + 2], S[4 * i + 3]};
        for (int e = tid; e < 3 * 1024; e += NTHR) { const int j = e >> 10, c2 = e & 1023;
            F.out[O_SCONV + ((size_t)(l * BS + b) * 3 + j) * 1024 + c2] = bf2f(PROJ[(size_t)(m0 + 5 + j) * NPROJ + C_CX + c2]); } }
}

__device__ __forceinline__ void scan_phase(Frame& F, int l) {
    WS_LOCALS
    const int gt = blockIdx.x * NTHR + F.tid, NT = F.G * NTHR;
    for (int e = gt; e < 131072; e += NT) { const int bh = e >> 14, dv = e & 16383, d = dv >> 7; float S = 0.f;
#pragma unroll 8
        for (int c = 0; c < 64; ++c) { const size_t u = (size_t)bh * 64 + c; HGSS[u * 16384 + dv] = S; S = HGDEC[u * 128 + d] * S + HGDS[u * 16384 + dv]; }
        F.out[O_PHG + ((size_t)l * 8 + bh) * 16384 + dv] = S; }
    for (int e = gt; e < 131072; e += NT) { const int bhh = e >> 13, b = bhh >> 3, hh = bhh & 7, pn = e & 8191; float S = 0.f;
#pragma unroll 8
        for (int c = 0; c < 64; ++c) { const size_t idx = (size_t)(b * 64 + c) * 8 + hh; SDSS[idx * 8192 + pn] = S; S = SDDEC[idx] * S + SDDS[idx * 8192 + pn]; }
        F.out[O_PSSM + ((size_t)(l * BP + b) * 8 + hh) * 8192 + pn] = S; }
}
template <int SAMPLE> __device__ __forceinline__ void attn_unit(Frame& F, int l, int u) {
    WS_LOCALS
    const int tid = F.tid, lane = F.lane, wave = F.wave;
    const float* const ckp = INP(I_CK); const float* const cvp = INP(I_CV);
    LAS float* Kl = (LAS float*)F.lds; LAS float* Vl = Kl + 12288;
    int b, g, q0, nrows, row_min; size_t mbase;
    if (SAMPLE) { b = u >> 1; g = u & 1; q0 = 0; nrows = 136; row_min = 0; mbase = (size_t)MP + b * TS; }
    else { g = u & 1; const int qt = (u >> 1) & 63; b = u >> 7; q0 = qt * 64; nrows = 192; row_min = q0 >= 127 ? 0 : 127 - q0; mbase = (size_t)b * TP; }
    __syncthreads();
    {   const int j8 = tid & 7; const float* kg = INP(I_KNG) + l * 64 + 8 * j8;
        float kgv[8];
#pragma unroll
        for (int e = 0; e < 8; ++e) kgv[e] = kg[e];
        for (int row = tid >> 3; row < nrows; row += 64) {
            f32x4 k0, k1, v0, v1; bool zero = false;
            if (SAMPLE && row < 128) { const f32x4* kp = (const f32x4*)(ckp + (((size_t)(l * BS + b) * 128 + row) * 2 + g) * 64 + 8 * j8); const f32x4* vp = (const f32x4*)(cvp + (((size_t)(l * BS + b) * 128 + row) * 2 + g) * 64 + 8 * j8);
                k0 = kp[0]; k1 = kp[1]; v0 = vp[0]; v1 = vp[1]; }
            else {
                int t, prow;
                if (SAMPLE) { t = row - 128; prow = 4096 + t; } else { t = q0 - 127 + row; prow = t; if (t < 0 || row == 191) zero = true; }
                if (zero) { k0 = k1 = v0 = v1 = (f32x4){0.f, 0.f, 0.f, 0.f}; }
                else {
                    const bf16* pr = PROJ + (mbase + t) * NPROJ;
                    const v4u kw = *(const v4u*)(pr + C_DK + g * 64 + 8 * j8); const v4u vw = *(const v4u*)(pr + C_DV + g * 64 + 8 * j8);
                    float kr[8] = {bflo(kw.x), bfhi(kw.x), bflo(kw.y), bfhi(kw.y), bflo(kw.z), bfhi(kw.z), bflo(kw.w), bfhi(kw.w)};
                    v0 = (f32x4){bflo(vw.x), bfhi(vw.x), bflo(vw.y), bfhi(vw.y)}; v1 = (f32x4){bflo(vw.z), bfhi(vw.z), bflo(vw.w), bfhi(vw.w)};
                    float ss = 0.f;
#pragma unroll
                    for (int e = 0; e < 8; ++e) ss += kr[e] * kr[e];
                    ss += __shfl_xor(ss, 1); ss += __shfl_xor(ss, 2); ss += __shfl_xor(ss, 4);
                    const float rn = 1.f / sqrtf(ss * (1.f / 64.f) + EPS);
                    const float* rp = ROPE + (size_t)prow * 64 + ((8 * j8) & 31);
                    float ko[8];
#pragma unroll
                    for (int e = 0; e < 8; ++e) { const float kn = kr[e] * rn * kgv[e]; const float other = __shfl_xor(kn, 4); const float c = rp[e], s = rp[32 + e];
                        ko[e] = j8 < 4 ? kn * c - other * s : kn * c + other * s; }
                    k0 = (f32x4){ko[0], ko[1], ko[2], ko[3]}; k1 = (f32x4){ko[4], ko[5], ko[6], ko[7]};
                }
            }
            LAS f32x4* kd = (LAS f32x4*)(Kl + row * 64 + 8 * j8); kd[0] = k0; kd[1] = k1;
            LAS f32x4* vd = (LAS f32x4*)(Vl + row * 64 + 8 * j8); vd[0] = v0; vd[1] = v1;
        }
    }
    __syncthreads();
    if (SAMPLE || q0 == TP - 64) {
        const int roff = SAMPLE ? 8 : 63; const size_t ob = SAMPLE ? ((size_t)(l * BS + b) * 128) : ((size_t)(l * BP + b) * 128);
        float* ok = F.out + (SAMPLE ? O_SK : O_PK); float* ov = F.out + (SAMPLE ? O_SV : O_PV);
        for (int e = tid; e < 128 * 64; e += NTHR) { const int j = e >> 6, dd = e & 63; ok[((ob + j) * 2 + g) * 64 + dd] = Kl[(roff + j) * 64 + dd]; ov[((ob + j) * 2 + g) * 64 + dd] = Vl[(roff + j) * 64 + dd]; }
    }
    if (!SAMPLE || wave == 0) {
        const int dh = lane & 1, qi = (lane >> 1) & 7, r = lane >> 4, head = g * 4 + r;
        const int t = SAMPLE ? qi : q0 + 8 * wave + qi;
        const int qrow = SAMPLE ? 128 + qi : 127 + 8 * wave + qi;
        const int prow = SAMPLE ? 4096 + t : t;
        const int row_lo = SAMPLE ? 0 : 8 * wave;
        float q[32];
        {   const v4u* qp = (const v4u*)(PROJ + (mbase + t) * NPROJ + C_DQ + head * 64 + 32 * dh);
#pragma unroll
            for (int c = 0; c < 4; ++c) { const v4u w = qp[c]; q[8 * c] = bflo(w.x); q[8 * c + 1] = bfhi(w.x); q[8 * c + 2] = bflo(w.y); q[8 * c + 3] = bfhi(w.y); q[8 * c + 4] = bflo(w.z); q[8 * c + 5] = bfhi(w.z); q[8 * c + 6] = bflo(w.w); q[8 * c + 7] = bfhi(w.w); }
            float ss = 0.f;
#pragma unroll
            for (int d = 0; d < 32; ++d) ss += q[d] * q[d];
            ss += __shfl_xor(ss, 1);
            const float rn = 0.125f / sqrtf(ss * (1.f / 64.f) + EPS);
            const float* qg = INP(I_QNG) + l * 64 + 32 * dh; const float* rp = ROPE + (size_t)prow * 64;
#pragma unroll
            for (int i = 0; i < 32; ++i) { const float xn = q[i] * rn * qg[i]; const float other = __shfl_xor(xn, 1); const float c = rp[i], s = rp[32 + i];
                q[i] = dh == 0 ? xn * c - other * s : xn * c + other * s; }
        }
        float mrun = INP(I_SINK)[l * 8 + head], lrun = 1.f;
        float o[32];
#pragma unroll
        for (int d = 0; d < 32; ++d) o[d] = 0.f;
        for (int it = 0; it < 34; ++it) {
            const int rb = row_lo + 4 * it;
            float s[4];
#pragma unroll
            for (int k = 0; k < 4; ++k) { const LAS f32x4* kr = (const LAS f32x4*)(Kl + (rb + k) * 64 + 32 * dh); float a = 0.f;
#pragma unroll
                for (int c = 0; c < 8; ++c) { const f32x4 kv = kr[c]; a += (q[4 * c] * kv.x + q[4 * c + 1] * kv.y) + (q[4 * c + 2] * kv.z + q[4 * c + 3] * kv.w); }
                a += __shfl_xor(a, 1);
                const int row = rb + k; const bool valid = (row <= qrow) && (row > qrow - 128) && (row >= row_min);
                s[k] = valid ? a : -INFINITY; }
            const float mnew = fmaxf(fmaxf(mrun, fmaxf(s[0], s[1])), fmaxf(s[2], s[3]));
            const float al = __expf(mrun - mnew); mrun = mnew;
            float pk[4];
#pragma unroll
            for (int k = 0; k < 4; ++k) pk[k] = __expf(s[k] - mnew);
            lrun = lrun * al + (pk[0] + pk[1]) + (pk[2] + pk[3]);
#pragma unroll
            for (int d = 0; d < 32; ++d) o[d] *= al;
#pragma unroll
            for (int k = 0; k < 4; ++k) { const LAS f32x4* vr = (const LAS f32x4*)(Vl + (rb + k) * 64 + 32 * dh);
#pragma unroll
                for (int c = 0; c < 8; ++c) { const f32x4 vv = vr[c]; o[4 * c] += pk[k] * vv.x; o[4 * c + 1] += pk[k] * vv.y; o[4 * c + 2] += pk[k] * vv.z; o[4 * c + 3] += pk[k] * vv.w; } }
        }
        {   const float inv = 1.f / lrun; v4u* op = (v4u*)(MIX + (mbase + t) * D + 1536 + head * 64 + 32 * dh);
#pragma unroll
            for (int c = 0; c < 4; ++c) { v4u w; w.x = pk2(o[8 * c] * inv, o[8 * c + 1] * inv); w.y = pk2(o[8 * c + 2] * inv, o[8 * c + 3] * inv); w.z = pk2(o[8 * c + 4] * inv, o[8 * c + 5] * inv); w.w = pk2(o[8 * c + 6] * inv, o[8 * c + 7] * inv); op[c] = w; }
        }
    }
}
__device__ __forceinline__ void pool_unit(Frame& F, int l, int u) {
    WS_LOCALS
    const int tid = F.tid, c = tid & 127, tq = tid >> 7;
    const float* const pwp = INP(I_PW); const float* const spp = INP(I_SPOOL);
    LAS float* pl = (LAS float*)F.lds; LAS float* wl = pl + 8192;
    const bool samp = u >= 128; const int b = samp ? 0 : (u >> 6), t0 = samp ? 0 : (u & 63) * 64; const int s8 = samp ? (u - 128) * 8 : 0;
    const size_t m0 = samp ? (size_t)MP + (size_t)s8 * TS : (size_t)b * TP + t0;
    for (int gi = 0; gi < 4; ++gi) {
        const int win = 2 << gi, chn = gi * 128 + c;
        __syncthreads();
        for (int e = tid; e < 128 * 128 / 4; e += NTHR) ((LAS f32x4*)wl)[e] = ((const f32x4*)(pwp + (size_t)(l * 4 + gi) * 16384))[e];
        for (int i = 0; i < 16; ++i) { const int tt = tq * 16 + i; float s = 0.f, self, cnt;
            if (!samp) { const int t = t0 + tt; const bf16* base = PROJ + ((size_t)b * TP) * NPROJ + C_PU + chn;
                for (int j = 0; j < win; ++j) if (t - j >= 0) s += bf2f(base[(size_t)(t - j) * NPROJ]);
                self = bf2f(base[(size_t)t * NPROJ]); cnt = (float)((t + 1) < win ? (t + 1) : win); }
            else { const int bs = s8 + (tt >> 3), ts = tt & 7; const bf16* base = PROJ + ((size_t)MP + (size_t)bs * TS) * NPROJ + C_PU + chn; const float* buf = spp + ((size_t)(l * BS + bs) * 15) * 512 + chn;
                for (int j = 0; j < win; ++j) { const int e2 = 15 + ts - j; s += e2 >= 15 ? bf2f(base[(size_t)(e2 - 15) * NPROJ]) : buf[(size_t)e2 * 512]; }
                self = bf2f(base[(size_t)ts * NPROJ]); cnt = (float)win; }
            pl[tt * 128 + c] = s / cnt - self; }
        __syncthreads();
        float acc[16];
#pragma unroll
        for (int i = 0; i < 16; ++i) acc[i] = 0.f;
        for (int k4 = 0; k4 < 32; ++k4) { const float w0 = wl[(4 * k4) * 128 + c], w1 = wl[(4 * k4 + 1) * 128 + c], w2 = wl[(4 * k4 + 2) * 128 + c], w3 = wl[(4 * k4 + 3) * 128 + c];
#pragma unroll
            for (int i = 0; i < 16; ++i) { const f32x4 pv = ((const LAS f32x4*)(pl + (tq * 16 + i) * 128))[k4]; acc[i] += (pv.x * w0 + pv.y * w1) + (pv.z * w2 + pv.w * w3); } }
        const float sc = INP(I_PSC)[l * 512 + chn];
#pragma unroll
        for (int i = 0; i < 16; ++i) MIX[(m0 + tq * 16 + i) * D + 512 + chn] = (bf16)f2bf(acc[i] * sc);
    }
    if (!samp && t0 == TP - 64) for (int e = tid; e < 15 * 512; e += NTHR) { const int j = e >> 9, ch = e & 511;
        F.out[O_PPOOL + ((size_t)(l * BP + b) * 15 + j) * 512 + ch] = bf2f(PROJ[((size_t)b * TP + TP - 15 + j) * NPROJ + C_PU + ch]); }
    if (samp) for (int e = tid; e < 8 * 15 * 512; e += NTHR) { const int bs = s8 + e / (15 * 512), j = (e / 512) % 15, ch = e & 511;
        F.out[O_SPOOL + ((size_t)(l * BS + bs) * 15 + j) * 512 + ch] = j < 7 ? spp[((size_t)(l * BS + bs) * 15 + 8 + j) * 512 + ch] : bf2f(PROJ[((size_t)MP + (size_t)bs * TS + (j - 7)) * NPROJ + C_PU + ch]); }
}
#ifdef PH_SEL
#define PSEL(k, stmt) do { if ((k) == PH_SEL) { stmt; } } while (0)
#else
#define PSEL(k, stmt) do { stmt; } while (0)
#endif
struct Args { const float* in[N_IN]; float* out; unsigned char* ws; int ph_lo, ph_hi; };
static_assert(sizeof(Args) == (N_IN + 2) * 8 + 8, "Args has no padding");
__global__ void __launch_bounds__(NTHR, 2) hymba_fwd(Args args) {
    extern __shared__ __attribute__((aligned(16))) unsigned char lds[];
    Frame F;
    F.lds = (LAS unsigned char*)lds;
    F.MISC = (volatile LAS unsigned*)(F.lds + MISC_OFF);
    F.tid = threadIdx.x; F.lane = F.tid & 63; F.wave = __builtin_amdgcn_readfirstlane(F.tid >> 6);
    F.G = gridDim.x; F.gw = (int)blockIdx.x * NWAVES + F.wave; F.ngw = F.G * NWAVES;
    unsigned char* ws = args.ws; F.ws = ws; F.out = args.out;
    F.ctl = (gu32*)(ws + WS_CTL);
    for (int u = F.tid; u < (LDS_BYTES - LDSCTL_OFF) / 4; u += NTHR) ((LAS unsigned*)(F.lds + LDSCTL_OFF))[u] = 0u;
    __syncthreads();
    if (F.tid < N_IN) ((LAS unsigned long long*)(F.lds + PTR_OFF))[F.tid] = (unsigned long long)args.in[F.tid];
    __syncthreads();
    const int lo = args.ph_lo, hi = args.ph_hi;
    XcdBarrier bar; bar.bar = (unsigned*)(F.ctl + CW_BAR); bar.x = 0; bar.st = nullptr;
    if (hi - lo > 1) bar = xcd_barrier_post((unsigned*)(F.ctl + CW_BAR), F.MISC + 8);
#define IN(k) (lo <= (k) && (k) < hi)
#define LAUNDER(P) asm volatile("" : "+v"(P.tid), "+v"(P.lane), "+s"(P.wave), "+s"(P.gw))
#define PHASE_LOCALS Frame P = F; LAUNDER(P); WS_LOCALS
#define SEAM(k) do { if (IN(k) && IN((k) + 1)) xcd_barrier(bar); } while (0)
    if (IN(0)) { PSEL(0, p0_prologue(F)); } SEAM(0);
    for (int l = 0; l < DEPTH; ++l) {
        const int pb = 1 + l * PH_PER_LAYER;

        if (IN(pb + 0)) { PHASE_LOCALS  PSEL(1, norm_phase(P, l, 0)); } SEAM(pb + 0);
        if (IN(pb + 1)) { PHASE_LOCALS
            pg8::Gemm g{H, Wi + (size_t)l * NPROJ * D, M, NPROJ, D}; pg8::StaticOrder S; S.init(M, NPROJ, F.G, (int)blockIdx.x);
            pg8::EpiStoreBf16 E{PROJ, NPROJ, 0};
            PSEL(2, (pg8::gemm_phase<pg8::EpiStoreBf16, pg8::StaticOrder, true, true>(P.lds, g, S, E)));
        } SEAM(pb + 1);
        if (IN(pb + 2)) { PHASE_LOCALS
            int u;
            { Frame Q = F; LAUNDER(Q); while ((u = deq(Q, l * 16 + 0)) < 128) PSEL(3, ssd_unit<0>(Q, l, u)); }
            { Frame Q = F; LAUNDER(Q); while ((u = deq(Q, l * 16 + 1)) < 256) PSEL(4, attn_unit<0>(Q, l, u)); }
            { Frame Q = F; LAUNDER(Q); while ((u = deq(Q, l * 16 + 2)) < 512) PSEL(5, hgrn_unit<0>(Q, l, u)); }
            { Frame Q = F; LAUNDER(Q); while ((u = deq(Q, l * 16 + 3)) < 132) PSEL(6, pool_unit(Q, l, u)); }
            { Frame Q = F; LAUNDER(Q); while ((u = deq(Q, l * 16 + 4)) < 32) PSEL(7, ssd_unit<2>(Q, l, u)); }
            { Frame Q = F; LAUNDER(Q); while ((u = deq(Q, l * 16 + 5)) < 64) PSEL(8, attn_unit<1>(Q, l, u)); }
            { Frame Q = F; LAUNDER(Q); while ((u = deq(Q, l * 16 + 6)) < 128) PSEL(9, hgrn_unit<2>(Q, l, u)); }
        } SEAM(pb + 2);
        if (IN(pb + 3)) { PHASE_LOCALS  PSEL(10, scan_phase(P, l)); } SEAM(pb + 3);
        if (IN(pb + 4)) { PHASE_LOCALS
            int u;
            { Frame Q = F; LAUNDER(Q); while ((u = deq(Q, l * 16 + 7)) < 128) PSEL(11, ssd_unit<1>(Q, l, u)); }
            { Frame Q = F; LAUNDER(Q); while ((u = deq(Q, l * 16 + 8)) < 512) PSEL(12, hgrn_unit<1>(Q, l, u)); }
        } SEAM(pb + 4);
        if (IN(pb + 5)) { PHASE_LOCALS
            pg8::Gemm g{MIX, Wo + (size_t)l * D * D, M, D, D}; pg8::StaticOrder S; S.init(M, D, F.G, (int)blockIdx.x);
            pg8::EpiGateRes E{F.out, D, MOD + (size_t)l * NBB * NMOD + 2 * D, NMOD};
            PSEL(13, (pg8::gemm_phase<pg8::EpiGateRes, pg8::StaticOrder, true, true>(P.lds, g, S, E)));
        } SEAM(pb + 5);
        if (IN(pb + 6)) { PHASE_LOCALS  PSEL(14, norm_phase(P, l, 1)); } SEAM(pb + 6);
        if (IN(pb + 7)) { PHASE_LOCALS
            pg8::Gemm g{H, Wu + (size_t)l * DFF * D, M, DFF, D}; pg8::StaticOrder S; S.init(M, DFF, F.G, (int)blockIdx.x);
            pg8::EpiStoreBf16 E{U, DFF, 1};
            PSEL(15, (pg8::gemm_phase<pg8::EpiStoreBf16, pg8::StaticOrder, true, true>(P.lds, g, S, E)));
        } SEAM(pb + 7);
        if (IN(pb + 8)) { PHASE_LOCALS
            pg8::Gemm g{U, Wd + (size_t)l * D * DFF, M, D, DFF}; pg8::StaticOrder S; S.init(M, D, F.G, (int)blockIdx.x);
            pg8::EpiGateRes E{F.out, D, MOD + (size_t)l * NBB * NMOD + 5 * D, NMOD};
            PSEL(16, (pg8::gemm_phase<pg8::EpiGateRes, pg8::StaticOrder, true, true>(P.lds, g, S, E)));
        } SEAM(pb + 8);
    }
#undef IN
#undef SEAM
}

extern "C" void kernel_launch(void* const* d_in, const int* in_sizes, int n_in, void* d_out, int out_size, void* d_ws, size_t ws_size, hipStream_t stream) {
    static int grid = 0;
    if (grid == 0) {
        if (n_in != N_IN || (size_t)out_size != O_END || ws_size < WS_END) { fprintf(stderr, "kernel_launch: unexpected shapes (n_in %d, out %d, ws %zu); nothing launched\n", n_in, out_size, ws_size); grid = -1; return; }
        int dev = 0, cus = 0, per_cu = 0;
        if (hipGetDevice(&dev) != hipSuccess || hipDeviceGetAttribute(&cus, hipDeviceAttributeMultiprocessorCount, dev) != hipSuccess) { grid = -1; return; }
        if (hipFuncSetAttribute((const void*)hymba_fwd, hipFuncAttributeMaxDynamicSharedMemorySize, LDS_BYTES) != hipSuccess) { fprintf(stderr, "kernel_launch: hipFuncSetAttribute failed\n"); grid = -1; return; }
        if (hipOccupancyMaxActiveBlocksPerMultiprocessor(&per_cu, (const void*)hymba_fwd, NTHR, LDS_BYTES) != hipSuccess || per_cu < 1) { fprintf(stderr, "kernel_launch: occupancy query says %d\n", per_cu); }
        (void)hipGetLastError();
        grid = cus;
    }
    if (grid < 0) return;
    if (hipMemsetAsync((char*)d_ws + WS_CTL, 0, CTL_ZERO_BYTES, stream) != hipSuccess) return;
    Args a{};
    for (int i = 0; i < N_IN; ++i) a.in[i] = (const float*)d_in[i];
    a.out = (float*)d_out; a.ws = (unsigned char*)d_ws;
#if MK_ONE_LAUNCH
    a.ph_lo = 0; a.ph_hi = N_PHASES;
    hipLaunchKernelGGL(hymba_fwd, dim3(grid), dim3(NTHR), LDS_BYTES, stream, a);
#else
    for (int k = 0; k < N_PHASES; ++k) { a.ph_lo = k; a.ph_hi = k + 1; hipLaunchKernelGGL(hymba_fwd, dim3(grid), dim3(NTHR), LDS_BYTES, stream, a); }
#endif
}
```

```cpp
#include <hip/hip_runtime.h>
#include <cstdio>
#include <cstdint>
namespace pg8 {
#define PG8_LAS __attribute__((address_space(3)))
typedef unsigned short bf16_t;
typedef short bf16x8 __attribute__((ext_vector_type(8)));
typedef float f32x4 __attribute__((ext_vector_type(4)));
typedef unsigned u32x4 __attribute__((ext_vector_type(4)));
constexpr int BM = 256, BK = 64, HALF = 128, HTB = HALF * BK * 2  , STAGE_BYTES = 8 * HTB, NXCD = 8, WGM = 8;

__host__ __device__ __forceinline__ int lds_byte(int r, int c) { const int st = (r >> 4) * 2 + (c >> 5), rr = r & 15, cc = c & 31, ob = rr * 64 + cc * 2; return st * 1024 + (ob ^ (((ob >> 9) & 1) << 5)); }
__host__ __device__ __forceinline__ void stage_rc(int b, int& R, int& C) { const int st = b / 1024, sb = b % 1024, swz = sb ^ (((sb >> 9) & 1) << 5); R = (st >> 1) * 16 + swz / 64; C = (st & 1) * 32 + (swz % 64) / 2; }
__host__ __device__ __forceinline__ int perm32(int rho) { const int n = rho >> 4, i = rho & 15; return 8 * (i >> 2) + 4 * n + (i & 3); }

struct Unit { int pm, pn, k0, nt, at; };
struct Gemm { const bf16_t* A; const bf16_t* Bt; int M, N, K; };

struct StaticOrder {
    int nM, nN, nwg, G, c, ntK;
    __host__ __device__ void init(int M, int N, int K, int G_, int c_) { nM = M / BM; nN = N / BM; nwg = nM * nN; G = G_; c = c_; ntK = K / BK; }
    __host__ __device__ bool next(int i, Unit& u) const {
        const long L = (long)i * G + c; if (L >= nwg) return false;
        int wgid = (int)L; { const int q = nwg / NXCD, r = nwg % NXCD, xcd = wgid % NXCD, off = wgid / NXCD; wgid = (xcd < r ? xcd * (q + 1) : r * (q + 1) + (xcd - r) * q) + off; }
        const int nig = WGM * nN, gid = wgid / nig, fm = gid * WGM, gsz = (nM - fm) < WGM ? (nM - fm) : WGM;
        u.pm = fm + ((wgid % nig) % gsz); u.pn = (wgid % nig) / gsz; u.k0 = 0; u.nt = ntK; u.at = 0; return true;
    }
    __device__ __forceinline__ void a_ready(const Unit&) const {}
    __device__ __forceinline__ void done(const Unit&) const {}
};

struct SplitOrder {
    StaticOrder so; int nfull, ntot, pmS, nN, ntS;
    __host__ __device__ void init(int Mfull, int N, int K, int nslice, int G_, int c_) { so.init(Mfull, N, K, G_, c_); nfull = so.nwg; pmS = Mfull / BM; nN = N / BM; ntS = K / BK / nslice; ntot = nfull + nN * nslice; }
    __host__ __device__ bool next(int i, Unit& u) const {
        const long L = (long)i * so.G + so.c; if (L >= ntot) return false;
        if (L < nfull) return so.next(i, u);
        const int j = (int)L - nfull; u.pm = pmS; u.pn = j % nN; u.k0 = (j / nN) * ntS * BK; u.nt = ntS; u.at = 1; return true;
    }
    __device__ __forceinline__ void a_ready(const Unit&) const {}
    __device__ __forceinline__ void done(const Unit&) const {}
};

__device__ __forceinline__ unsigned cvt_pk_bf16(float lo, float hi) { unsigned r; asm volatile("v_cvt_pk_bf16_f32 %0, %1, %2" : "=v"(r) : "v"(lo), "v"(hi)); return r; }
typedef float f32x2 __attribute__((ext_vector_type(2)));
struct EpiStoreBf16 {
    static constexpr bool PERM = true, AFTER_DRAIN = false;
    bf16_t* O; int ldc; int act;
    __device__ __forceinline__ void operator()(const f32x4 (&acc)[2][2][4][2], const Unit& u, int wr, int wc, int fr, int fq) const {
        const int row0 = u.pm * BM + wr * 64 + fr; const int col0 = u.pn * BM + wc * 32 + 8 * fq;
#pragma unroll
        for (int ai = 0; ai < 2; ++ai)
#pragma unroll
            for (int m = 0; m < 4; ++m) { bf16_t* rowp = O + (size_t)(row0 + ai * HALF + m * 16) * ldc + col0;
#pragma unroll
                for (int bj = 0; bj < 2; ++bj) { f32x4 v0 = acc[ai][bj][m][0], v1 = acc[ai][bj][m][1];
                    if (act) {
#pragma unroll
                        for (int j = 0; j < 4; ++j) { const float a = v0[j] > 0.f ? v0[j] : 0.f, b = v1[j] > 0.f ? v1[j] : 0.f; v0[j] = a * a; v1[j] = b * b; } }
                    u32x4 w; w.x = cvt_pk_bf16(v0[0], v0[1]); w.y = cvt_pk_bf16(v0[2], v0[3]); w.z = cvt_pk_bf16(v1[0], v1[1]); w.w = cvt_pk_bf16(v1[2], v1[3]);
                    *(u32x4*)(rowp + bj * HALF) = w; } }
    }
};
struct EpiGateRes {
    static constexpr bool PERM = false, AFTER_DRAIN = false;
    float* X; int ldc; const float* gate; int gstride; float* part;
    __device__ __forceinline__ void operator()(const f32x4 (&acc)[2][2][4][2], const Unit& u, int wr, int wc, int fr, int fq) const {
        const int row0 = u.pm * BM + wr * 64 + fr, col0 = u.pn * BM + wc * 32 + 4 * fq;
#pragma unroll
        for (int ai = 0; ai < 2; ++ai)
#pragma unroll
            for (int m = 0; m < 4; ++m) { const int row = row0 + ai * HALF + m * 16; const int bb = row < 8192 ? (row >> 12) : 2 + ((row - 8192) >> 3);
                float* rowp = X + (size_t)row * ldc + col0; const float* gp = gate + (size_t)bb * gstride + col0;
#pragma unroll
                for (int bj = 0; bj < 2; ++bj)
#pragma unroll
                    for (int n = 0; n < 2; ++n) { const f32x4 g = *(const f32x4*)(gp + bj * HALF + n * 16); const f32x4 v = g * acc[ai][bj][m][n]; float* xs = rowp + bj * HALF + n * 16;
                        if (u.at) { const int sl = u.k0 / (u.nt * BK); *(f32x4*)(part + ((size_t)(sl * BM + (row - 8192)) * ldc + col0 + bj * HALF + n * 16)) = v; }
                        else { f32x4* xp = (f32x4*)xs; *xp = *xp + v; } } }
    }
};
template <class Epi, class Sched, bool ALIGN_EPI = false, bool SP2 = false>
__device__ __forceinline__ void gemm_phase(PG8_LAS unsigned char* lds, const Gemm g, const Sched& S, const Epi& E) {
    int tid_ = threadIdx.x; asm volatile("" : "+v"(tid_));
    const int tid = tid_, wid = __builtin_amdgcn_readfirstlane(tid >> 6), lane = tid & 63, wr = wid >> 2, wc = wid & 3, fr = lane & 15, fq = lane >> 4;
    const int K = g.K;
    unsigned voffA[2], voffB[2];
#pragma unroll
    for (int i = 0; i < 2; ++i) { int R, C; stage_rc(tid * 16 + i * 8192, R, C); const int Rb = Epi::PERM ? ((R & ~31) + perm32(R & 31)) : R;
        voffA[i] = (unsigned)(R * K + C) * 2u; voffB[i] = (unsigned)(Rb * K + C) * 2u; }
    const size_t kstep = (size_t)(BK * 2);
    const size_t hstep = (size_t)HALF * K * 2;
    const size_t tstep = 2 * hstep;
    const unsigned ldsw = (unsigned)wid * 1024u;
    const int aoff = lds_byte(wr * 64 + fr, fq * 8), boff = lds_byte(wc * 32 + fr, fq * 8);
#define PG8_SA(b, h) (((b) * 2 + (h)) * HTB)
#define PG8_SB(b, h) ((4 + (b) * 2 + (h)) * HTB)
#define PG8_STAGE(bufoff, gbase, voff) do { _Pragma("unroll") for (int _i = 0; _i < 2; ++_i) \
        __builtin_amdgcn_global_load_lds((const unsigned*)((const char*)(gbase) + (voff)[_i]), (PG8_LAS unsigned*)(lds + (bufoff) + ldsw + _i * 8192), 16, 0, 0); } while (0)
#define PG8_LDA(dst, b, h) do { _Pragma("unroll") for (int m = 0; m < 4; ++m) _Pragma("unroll") for (int k = 0; k < 2; ++k) dst[m][k] = *(const PG8_LAS bf16x8*)(lds + PG8_SA(b, h) + aoff + m * 2048 + k * 1024); } while (0)
#define PG8_LDB(dst, b, h) do { _Pragma("unroll") for (int n = 0; n < 2; ++n) _Pragma("unroll") for (int k = 0; k < 2; ++k) dst[n][k] = *(const PG8_LAS bf16x8*)(lds + PG8_SB(b, h) + boff + n * 2048 + k * 1024); } while (0)
#define PG8_MMA(ai, bj, At, Bt) do { __builtin_amdgcn_s_setprio(1); _Pragma("unroll") for (int m = 0; m < 4; ++m) _Pragma("unroll") for (int n = 0; n < 2; ++n) _Pragma("unroll") for (int k = 0; k < 2; ++k) \
        acc[ai][bj][m][n] = __builtin_amdgcn_mfma_f32_16x16x32_bf16(Bt[n][k], At[m][k], acc[ai][bj][m][n], 0, 0, 0); __builtin_amdgcn_s_setprio(0); } while (0)
#define PG8_WAIT_V(n) asm volatile("s_waitcnt vmcnt(" #n ")" ::: "memory")
#define PG8_WAIT_L(n) asm volatile("s_waitcnt lgkmcnt(" #n ")" ::: "memory")
#define PG8_BAR __builtin_amdgcn_s_barrier()
#define PG8_SCHED __builtin_amdgcn_sched_barrier(0)
    Unit cur, nxt; int ui = 0;
    if (!S.next(0, cur)) return;
    f32x4 acc[2][2][4][2];
#pragma unroll
    for (int a = 0; a < 2; ++a)
#pragma unroll
        for (int b = 0; b < 2; ++b)
#pragma unroll
            for (int m = 0; m < 4; ++m)
#pragma unroll
                for (int n = 0; n < 2; ++n) acc[a][b][m][n] = (f32x4){0.f, 0.f, 0.f, 0.f};
    bf16x8 At[4][2], B0[2][2], B1[2][2];
    const char* cA = (const char*)g.A + (size_t)cur.pm * tstep + (size_t)cur.k0 * 2; const char* cB = (const char*)g.Bt + (size_t)cur.pn * tstep + (size_t)cur.k0 * 2;
    S.a_ready(cur);
    if constexpr (SP2) {
        PG8_STAGE(PG8_SB(0, 0), cB, voffB); PG8_STAGE(PG8_SB(0, 1), cB + hstep, voffB); PG8_STAGE(PG8_SA(0, 0), cA, voffA); PG8_STAGE(PG8_SA(0, 1), cA + hstep, voffA);
        if (wr == 1) PG8_BAR;
        PG8_WAIT_V(2); PG8_BAR;
        PG8_STAGE(PG8_SB(1, 0), cB + kstep, voffB); PG8_STAGE(PG8_SA(1, 0), cA + kstep, voffA); PG8_STAGE(PG8_SB(1, 1), cB + hstep + kstep, voffB);
        PG8_WAIT_V(6); PG8_BAR;
    } else {
        PG8_STAGE(PG8_SB(0, 0), cB, voffB); PG8_STAGE(PG8_SA(0, 0), cA, voffA); PG8_STAGE(PG8_SB(0, 1), cB + hstep, voffB); PG8_STAGE(PG8_SA(0, 1), cA + hstep, voffA);
        if (wr == 1) PG8_BAR;
        PG8_WAIT_V(4); PG8_BAR;
        PG8_STAGE(PG8_SB(1, 0), cB + kstep, voffB); PG8_STAGE(PG8_SA(1, 0), cA + kstep, voffA); PG8_STAGE(PG8_SB(1, 1), cB + hstep + kstep, voffB);
        PG8_WAIT_V(6); PG8_BAR;
    }
    for (;;) {
        const bool has_next = S.next(ui + 1, nxt);
        const char* nA = has_next ? (const char*)g.A + (size_t)nxt.pm * tstep + (size_t)nxt.k0 * 2 : cA; const char* nB = has_next ? (const char*)g.Bt + (size_t)nxt.pn * tstep + (size_t)nxt.k0 * 2 : cB;
        const int nt = cur.nt;
        for (int t = 0; t < nt; t += 2) {
            const bool last = (t == nt - 2);
            const char* a1 = cA + (size_t)(t + 1) * kstep;
            const char* a2 = last ? nA : cA + (size_t)(t + 2) * kstep; const char* b2 = last ? nB : cB + (size_t)(t + 2) * kstep;
            const char* a3 = a2 + kstep; const char* b3 = b2 + kstep;
            if (last && has_next) S.a_ready(nxt);
            if constexpr (SP2) {
            PG8_LDB(B0, 0, 0); PG8_LDB(B1, 0, 1); PG8_SCHED; PG8_LDA(At, 0, 0); PG8_STAGE(PG8_SA(1, 1), a1 + hstep, voffA);
            PG8_WAIT_V(8); PG8_WAIT_L(0); PG8_BAR; PG8_MMA(0, 0, At, B0); PG8_MMA(0, 1, At, B1); PG8_BAR; PG8_SCHED;
            PG8_LDA(At, 0, 1); PG8_STAGE(PG8_SB(0, 0), b2, voffB); PG8_STAGE(PG8_SB(0, 1), b2 + hstep, voffB); PG8_STAGE(PG8_SA(0, 0), a2, voffA);
            PG8_WAIT_V(8); PG8_WAIT_L(0); PG8_BAR; PG8_MMA(1, 0, At, B0); PG8_MMA(1, 1, At, B1); PG8_BAR; PG8_SCHED;
            PG8_LDB(B0, 1, 0); PG8_LDB(B1, 1, 1); PG8_SCHED; PG8_LDA(At, 1, 0); PG8_STAGE(PG8_SA(0, 1), a2 + hstep, voffA);
            PG8_WAIT_V(8); PG8_WAIT_L(0); PG8_BAR; PG8_MMA(0, 0, At, B0); PG8_MMA(0, 1, At, B1); PG8_BAR; PG8_SCHED;
            PG8_LDA(At, 1, 1); PG8_STAGE(PG8_SB(1, 0), b3, voffB); PG8_STAGE(PG8_SB(1, 1), b3 + hstep, voffB); PG8_STAGE(PG8_SA(1, 0), a3, voffA);
            PG8_WAIT_V(8); PG8_WAIT_L(0); PG8_BAR; PG8_MMA(1, 0, At, B0); PG8_MMA(1, 1, At, B1); PG8_BAR; PG8_SCHED;
            } else {
            PG8_LDB(B0, 0, 0); PG8_SCHED; PG8_LDA(At, 0, 0); PG8_STAGE(PG8_SA(1, 1), a1 + hstep, voffA);
            PG8_WAIT_L(8); PG8_BAR; PG8_WAIT_L(0); PG8_MMA(0, 0, At, B0); PG8_BAR; PG8_SCHED;
            PG8_LDB(B1, 0, 1); PG8_STAGE(PG8_SB(0, 0), b2, voffB);
            PG8_BAR; PG8_WAIT_L(0); PG8_MMA(0, 1, At, B1); PG8_BAR;
            PG8_LDA(At, 0, 1); PG8_STAGE(PG8_SA(0, 0), a2, voffA);
            PG8_BAR; PG8_WAIT_L(0); PG8_MMA(1, 0, At, B0); PG8_BAR; PG8_SCHED;
            PG8_STAGE(PG8_SB(0, 1), b2 + hstep, voffB);
            PG8_WAIT_V(6); PG8_BAR; PG8_MMA(1, 1, At, B1); PG8_BAR;
            PG8_LDB(B0, 1, 0); PG8_SCHED; PG8_LDA(At, 1, 0); PG8_STAGE(PG8_SA(0, 1), a2 + hstep, voffA);
            PG8_WAIT_L(8); PG8_BAR; PG8_WAIT_L(0); PG8_MMA(0, 0, At, B0); PG8_BAR; PG8_SCHED;
            PG8_LDB(B1, 1, 1); PG8_STAGE(PG8_SB(1, 0), b3, voffB);
            PG8_BAR; PG8_WAIT_L(0); PG8_MMA(0, 1, At, B1); PG8_BAR;
            PG8_LDA(At, 1, 1); PG8_STAGE(PG8_SA(1, 0), a3, voffA);
            PG8_BAR; PG8_WAIT_L(0); PG8_MMA(1, 0, At, B0); PG8_BAR; PG8_SCHED;
            PG8_STAGE(PG8_SB(1, 1), b3 + hstep, voffB);
            PG8_WAIT_V(6); PG8_BAR; PG8_MMA(1, 1, At, B1); PG8_BAR;
            }
        }
        if constexpr (ALIGN_EPI) { if (wr == 0) PG8_BAR; }
        if constexpr (!Epi::AFTER_DRAIN) { E(acc, cur, wr, wc, fr, fq); S.done(cur); }
        if (!has_next) break;
#pragma unroll
        for (int a = 0; a < 2; ++a)
#pragma unroll
            for (int b = 0; b < 2; ++b)
#pragma unroll
                for (int m = 0; m < 4; ++m)
#pragma unroll
                    for (int n = 0; n < 2; ++n) acc[a][b][m][n] = (f32x4){0.f, 0.f, 0.f, 0.f};
        cur = nxt; cA = nA; cB = nB; ++ui;
        if constexpr (ALIGN_EPI) { if (wr == 1) PG8_BAR; }
    }
    PG8_WAIT_V(0);
    if constexpr (!ALIGN_EPI) { if (wr == 0) PG8_BAR; }
    PG8_BAR;
    if constexpr (Epi::AFTER_DRAIN) { E.fused(acc, cur, wr, wc, fr, fq, lds, wid, lane); S.done(cur); }
#undef PG8_SA
#undef PG8_SB
#undef PG8_STAGE
#undef PG8_LDA
#undef PG8_LDB
#undef PG8_MMA
#undef PG8_WAIT_V
#undef PG8_WAIT_L
#undef PG8_BAR
#undef PG8_SCHED
}
}
constexpr int NWAVES = 8, NTHR = 512;
constexpr int D = 2048, DEPTH = 4, BP = 2, TP = 4096, BS = 32, TS = 8;
constexpr int MP = BP * TP, MS = BS * TS, M = MP + MS, NBB = BP + BS;
constexpr int NINW = 4872, NPROJ = 4864, DFF = 8192, NMOD = 6 * D, PAST = 16384;
constexpr int C_AQ = 0, C_AF = 512, C_AI = 1024, C_AG = 1536, C_PU = 2048, C_CZ = 2560, C_CX = 3072, C_DQ = 4096, C_DK = 4608, C_DV = 4736;
constexpr float EPS = 1e-6f;
enum { I_XP = 0, I_XS, I_CP, I_CS, I_SHG, I_SPOOL, I_SSSM, I_SCONV, I_CK, I_CV, I_N1G, I_N2G, I_WADA, I_BADA, I_WIN, I_LBL, I_HNG, I_PW, I_PSC, I_CW, I_CB, I_DTB, I_ALOG, I_DSK, I_SNG, I_QNG, I_KNG, I_SINK, I_WOUT, I_WUP, I_WDN, N_IN };
constexpr size_t O_Y = 0, O_PHG = (size_t)M * D, O_PPOOL = O_PHG + 4 * 2 * 4 * 16384, O_PSSM = O_PPOOL + 4 * 2 * 15 * 512, O_PCONV = O_PSSM + 4 * 2 * 8 * 8192, O_PK = O_PCONV + 4 * 2 * 3 * 1024,
    O_PV = O_PK + 4 * 2 * 128 * 128, O_SHG = O_PV + 4 * 2 * 128 * 128, O_SPOOL = O_SHG + (size_t)4 * 32 * 4 * 16384, O_SSSM = O_SPOOL + 4 * 32 * 15 * 512, O_SCONV = O_SSSM + (size_t)4 * 32 * 8 * 8192,
    O_SK = O_SCONV + 4 * 32 * 3 * 1024, O_SV = O_SK + 4 * 32 * 128 * 128, O_END = O_SV + 4 * 32 * 128 * 128;
static_assert(O_END == 41046016, "output size");
constexpr size_t MiB = 1u << 20;
constexpr size_t WS_CTL = 0, CTL_ZERO_BYTES = 1 * MiB;
constexpr size_t WS_MOD = 1 * MiB, WS_LB = 8 * MiB, WS_ROPE = 8 * MiB + 65536, WS_DT = 10 * MiB;
constexpr size_t WS_WIN = 16 * MiB, WS_WOUT = 92 * MiB, WS_WUP = 124 * MiB, WS_WDN = 252 * MiB;
constexpr size_t WS_H = 380 * MiB, WS_PROJ = 413 * MiB, WS_MIX = 492 * MiB, WS_U = 525 * MiB;
constexpr size_t WS_HGDS = 657 * MiB, WS_HGSS = 689 * MiB, WS_SDDS = 721 * MiB, WS_SDSS = 753 * MiB, WS_HGDEC = 785 * MiB, WS_SDDEC = 785 * MiB + 524288, WS_PART = 786 * MiB, WS_END = 818 * MiB;
static_assert(WS_WIN + (size_t)4 * NPROJ * D * 2 <= WS_WOUT && WS_PROJ + (size_t)M * NPROJ * 2 <= WS_MIX && WS_U + (size_t)M * DFF * 2 <= WS_HGDS, "ws map");
constexpr int CW_BAR = 4096, CW_Q = 16384;
constexpr int RING_BYTES = 131072, LDSCTL_OFF = RING_BYTES, MISC_OFF = LDSCTL_OFF + 320, PTR_OFF = LDSCTL_OFF + 1024, LDS_BYTES = 147456;
constexpr int PH_PER_LAYER = 9, N_PHASES = 2 + DEPTH * PH_PER_LAYER;
constexpr int NSL_OUT = 8, NSL_DN = 16;
#ifndef MK_ONE_LAUNCH
#define MK_ONE_LAUNCH 1
#endif
#define GAS __attribute__((address_space(1)))
#define LAS __attribute__((address_space(3)))
typedef unsigned short bf16;
typedef unsigned v4u __attribute__((ext_vector_type(4)));
typedef float f32x4 __attribute__((ext_vector_type(4)));
typedef short bf16x8 __attribute__((ext_vector_type(8)));
typedef GAS unsigned gu32;
typedef GAS unsigned long long gu64;
#define RLX_AGENT __ATOMIC_RELAXED, __HIP_MEMORY_SCOPE_AGENT
#define LDS_WAIT() asm volatile("s_waitcnt lgkmcnt(0)" ::: "memory")
#define VM_WAIT() asm volatile("s_waitcnt vmcnt(0)" ::: "memory")
__device__ __forceinline__ unsigned long long rt() { return __builtin_amdgcn_s_memrealtime(); }
__device__ __forceinline__ unsigned f2bf(float f) { unsigned u = __builtin_bit_cast(unsigned, f); return (u + 0x7fffu + ((u >> 16) & 1u)) >> 16; }
__device__ __forceinline__ unsigned pk2(float lo, float hi) { return f2bf(lo) | (f2bf(hi) << 16); }

#define XB_TMO      128
#define XB_XCNT(j)  (256  + 64 * (j))
#define XB_XSUB(j)  (1280 + 64 * (j))
#define XB_XGEN(j)  (2304 + 64 * (j))
#define XB_TOP      3328
#define XB_TOPGEN   3392
#define XCD_BAR_WORDS 3456
#define XB_SPIN_CAP (1u << 18)

__device__ __forceinline__ unsigned xb_ld(unsigned* p)              { return __hip_atomic_load(p, __ATOMIC_RELAXED, __HIP_MEMORY_SCOPE_AGENT); }
__device__ __forceinline__ unsigned xb_add(unsigned* p, unsigned v) { return __hip_atomic_fetch_add(p, v, __ATOMIC_RELAXED, __HIP_MEMORY_SCOPE_AGENT); }
__device__ __forceinline__ unsigned xb_xcc_id() { return (unsigned)__builtin_amdgcn_s_getreg((3 << 11) | 20) & 0xFu; }
#define XB_SPIN(cond, bar) do { unsigned _sp = 0; while (cond) { __builtin_amdgcn_s_sleep(1); \
    if ((++_sp & 255u) == 0u) { if (xb_ld(&(bar)[XB_TMO])) break; if (_sp > XB_SPIN_CAP) { atomicAdd(&(bar)[XB_TMO], 1u); break; } } } } while (0)

struct XcdBarrier {
    unsigned* bar; unsigned x;
    volatile LAS unsigned* st;
};

__device__ __forceinline__ XcdBarrier xcd_barrier_post(unsigned* bar, volatile LAS unsigned* st) {
    XcdBarrier b; b.bar = bar; b.x = xb_xcc_id(); b.st = st;
    if (threadIdx.x == 0) (void)xb_add(&bar[XB_XCNT(b.x)], 1u);
    return b;
}
__device__ __forceinline__ void xcd_barrier_complete(unsigned* bar, unsigned x, unsigned& nloc, unsigned& nx) {
    const unsigned G = gridDim.x * gridDim.y * gridDim.z;
    unsigned sum, cnt, mine, sp = 0u;
    for (;;) {
        sum = 0u; cnt = 0u; mine = 0u;
#pragma unroll
        for (unsigned j = 0; j < 16; ++j) { const unsigned c = xb_ld(&bar[XB_XCNT(j)]); sum += c; cnt += (c > 0u) ? 1u : 0u; mine = (j == x) ? c : mine; }
        if (sum == G) break;
        __builtin_amdgcn_s_sleep(1);
        if ((++sp & 255u) == 0u) { if (xb_ld(&bar[XB_TMO])) break; if (sp > XB_SPIN_CAP) { atomicAdd(&bar[XB_TMO], 1u); break; } }
    }
    nloc = mine > 0u ? mine : 1u; nx = cnt > 0u ? cnt : 1u;
}

__device__ __forceinline__ void xcd_barrier(const XcdBarrier& b) {
    asm volatile("s_waitcnt vmcnt(0)" ::: "memory");
    __syncthreads();
    if (threadIdx.x == 0) {
        unsigned* bar = b.bar;
        __builtin_amdgcn_s_waitcnt(0);
        unsigned nloc = b.st[0], nx = b.st[1];
        if (nloc == 0u) { xcd_barrier_complete(bar, b.x, nloc, nx); b.st[0] = nloc; b.st[1] = nx; }
        const unsigned old = xb_add(&bar[XB_XSUB(b.x)], 1u);
        const unsigned gen = old / nloc;
        if (old + 1u == (gen + 1u) * nloc) {
            __builtin_amdgcn_fence(__ATOMIC_RELEASE, "agent");
            asm volatile("s_waitcnt vmcnt(0)" ::: "memory");
            const unsigned og = xb_add(&bar[XB_TOP], 1u);
            const unsigned tg = og / nx;
            if (og + 1u == (tg + 1u) * nx) xb_add(&bar[XB_TOPGEN], 1u);
            else XB_SPIN(xb_ld(&bar[XB_TOPGEN]) == tg, bar);
            __builtin_amdgcn_fence(__ATOMIC_ACQUIRE, "agent");
            xb_add(&bar[XB_XGEN(b.x)], 1u);
            asm volatile("s_waitcnt vmcnt(0)" ::: "memory");
        } else {
            XB_SPIN(xb_ld(&bar[XB_XGEN(b.x)]) == gen, bar);
            __builtin_amdgcn_fence(__ATOMIC_ACQUIRE, "agent");
            asm volatile("s_waitcnt vmcnt(0)" ::: "memory");
        }
    }
    __syncthreads();
}

struct Frame {
    LAS unsigned char* lds;
    volatile LAS unsigned* MISC;
    gu32* ctl;
    int tid, lane, wave, G, gw, ngw;
    float* out; unsigned char* ws;
};
__device__ __forceinline__ const float* inp(const Frame& F, int i) {
    int off = PTR_OFF + 8 * i; asm volatile("" : "+s"(off));
    const unsigned long long v = *(const LAS unsigned long long*)(F.lds + off);
    const unsigned lo = __builtin_amdgcn_readfirstlane((unsigned)v), hi = __builtin_amdgcn_readfirstlane((unsigned)(v >> 32));
    return (const float*)(((unsigned long long)hi << 32) | lo);
}
__device__ __forceinline__ unsigned char* wsp(const Frame& F, size_t off) { unsigned char* p = F.ws; asm volatile("" : "+s"(p)); return p + off; }
#define INP(i) inp(F, i)
#define WS_LOCALS \
    float* const MOD = (float*)wsp(F, WS_MOD); float* const LBv = (float*)wsp(F, WS_LB); float* const ROPE = (float*)wsp(F, WS_ROPE); float* const DT = (float*)wsp(F, WS_DT); \
    bf16* const Wi = (bf16*)wsp(F, WS_WIN); bf16* const Wo = (bf16*)wsp(F, WS_WOUT); bf16* const Wu = (bf16*)wsp(F, WS_WUP); bf16* const Wd = (bf16*)wsp(F, WS_WDN); \
    bf16* const H = (bf16*)wsp(F, WS_H); bf16* const PROJ = (bf16*)wsp(F, WS_PROJ); bf16* const MIX = (bf16*)wsp(F, WS_MIX); bf16* const U = (bf16*)wsp(F, WS_U); \
    float* const HGDS = (float*)wsp(F, WS_HGDS); float* const HGSS = (float*)wsp(F, WS_HGSS); float* const SDDS = (float*)wsp(F, WS_SDDS); float* const SDSS = (float*)wsp(F, WS_SDSS); \
    float* const HGDEC = (float*)wsp(F, WS_HGDEC); float* const SDDEC = (float*)wsp(F, WS_SDDEC); \
    (void)MOD; (void)LBv; (void)ROPE; (void)DT; (void)Wi; (void)Wo; (void)Wu; (void)Wd; (void)H; (void)PROJ; (void)MIX; (void)U; (void)HGDS; (void)HGSS; (void)SDDS; (void)SDSS; (void)HGDEC; (void)SDDEC;
__device__ __forceinline__ float wave_sum(float v) {
#pragma unroll
    for (int o = 1; o < 64; o <<= 1) v += __shfl_xor(v, o);
    return v;
}
__device__ __forceinline__ float bf2f(bf16 b) { return __builtin_bit_cast(float, (unsigned)b << 16); }
__device__ __forceinline__ float bflo(unsigned w) { return __builtin_bit_cast(float, w << 16); }
__device__ __forceinline__ float bfhi(unsigned w) { return __builtin_bit_cast(float, w & 0xffff0000u); }
__device__ __forceinline__ float sigm(float x) { return 1.f / (1.f + __expf(-x)); }
__device__ __forceinline__ int row_bb(int m) { return m < MP ? (m >> 12) : BP + ((m - MP) >> 3); }
__device__ __forceinline__ int deq(Frame& F, int q) {
    __syncthreads();
    if (F.tid == 0) F.MISC[0] = __hip_atomic_fetch_add(F.ctl + CW_Q + 64 * q, 1u, RLX_AGENT);
    __syncthreads();
    return (int)F.MISC[0];
}

__device__ __forceinline__ void p0_transpose_item(const float* W, int K, int ldw, bf16* WT, int k0, int src_n0, int dst_n0, LAS float* scr, int lane) {
    float tv[32];
#pragma unroll
    for (int i = 0; i < 32; ++i) { const int kk = 2 * i + (lane >> 5); tv[i] = W[(size_t)(k0 + kk) * ldw + src_n0 + (lane & 31)]; }
#pragma unroll
    for (int i = 0; i < 32; ++i) { const int kk = 2 * i + (lane >> 5); scr[kk * 33 + (lane & 31)] = tv[i]; }
    LDS_WAIT(); asm volatile("" ::: "memory");
    const int c = lane & 7;
#pragma unroll
    for (int j = 0; j < 4; ++j) { const int n = (lane >> 3) + 8 * j; const LAS float* s = scr + (8 * c) * 33 + n;
        v4u o; o.x = pk2(s[0 * 33], s[1 * 33]); o.y = pk2(s[2 * 33], s[3 * 33]); o.z = pk2(s[4 * 33], s[5 * 33]); o.w = pk2(s[6 * 33], s[7 * 33]);
        *(GAS v4u*)(WT + (size_t)(dst_n0 + n) * K + k0 + 8 * c) = o; }
    LDS_WAIT(); asm volatile("" ::: "memory");
}
__device__ __forceinline__ void p0_adaln_item(Frame& F, int item) {
    const int l = item / 48, cc = item % 48, tid = F.tid, col = tid & 255, kh = tid >> 8;
    LAS float* cs = (LAS float*)F.lds;
    LAS float* red = (LAS float*)(F.lds + 18432);
    float acc[34];
#pragma unroll
    for (int i = 0; i < 34; ++i) acc[i] = 0.f;
    WS_LOCALS
    const float* W = INP(I_WADA) + (size_t)l * D * NMOD + 256 * cc + col; const float* const cpp = INP(I_CP); const float* const csp = INP(I_CS);
    for (int kt = 0; kt < 16; ++kt) {
        const int kbase = kh * 1024 + kt * 64;
        __syncthreads();
        for (int e = col; e < 64 * 34; e += 256) { const int bb = e >> 6, kk = e & 63;
            const float c = bb < BP ? cpp[bb * D + kbase + kk] : csp[(bb - BP) * D + kbase + kk];
            cs[(kh * 64 + kk) * 36 + bb] = c * sigm(c); }
        __syncthreads();
#pragma unroll 8
        for (int kk = 0; kk < 64; ++kk) {
            const float w = W[(size_t)(kbase + kk) * NMOD];
            const LAS f32x4* c4 = (const LAS f32x4*)(cs + (kh * 64 + kk) * 36);
#pragma unroll
            for (int q = 0; q < 8; ++q) { const f32x4 c = c4[q]; acc[4 * q] += w * c.x; acc[4 * q + 1] += w * c.y; acc[4 * q + 2] += w * c.z; acc[4 * q + 3] += w * c.w; }
            const f32x4 c = c4[8]; acc[32] += w * c.x; acc[33] += w * c.y;
        }
    }
    __syncthreads();
    if (kh == 1) {
#pragma unroll
        for (int i = 0; i < 34; ++i) red[col * 35 + i] = acc[i]; }
    __syncthreads();
    if (kh == 0) { const float bias = INP(I_BADA)[l * NMOD + 256 * cc + col];
#pragma unroll
        for (int i = 0; i < 34; ++i) MOD[((size_t)l * NBB + i) * NMOD + 256 * cc + col] = acc[i] + red[col * 35 + i] + bias; }
    __syncthreads();
}
__device__ __forceinline__ void p0_prologue(Frame& F) {
    WS_LOCALS
    const int gt = blockIdx.x * NTHR + F.tid, NT = F.G * NTHR;
    { const f32x4* s = (const f32x4*)INP(I_XP); f32x4* d = (f32x4*)F.out;
      for (int i = gt; i < MP * D / 4; i += NT) d[i] = s[i];
      s = (const f32x4*)INP(I_XS); d = (f32x4*)(F.out + (size_t)MP * D);
      for (int i = gt; i < MS * D / 4; i += NT) d[i] = s[i]; }
    if (gt < 512) { const float* lg = INP(I_LBL); const float a0 = lg[gt], a1 = lg[512 + gt], a2 = lg[1024 + gt], a3 = lg[1536 + gt];
        const float mx = fmaxf(fmaxf(a0, a1), fmaxf(a2, a3)); const float e0 = expf(a0 - mx), e1 = expf(a1 - mx), e2 = expf(a2 - mx), e3 = expf(a3 - mx); const float inv = 1.f / (e0 + e1 + e2 + e3);
        LBv[gt] = 0.f; LBv[512 + gt] = e1 * inv; LBv[1024 + gt] = (e1 + e2) * inv; LBv[1536 + gt] = (e1 + e2 + e3) * inv; }
    for (int e = gt; e < 4104 * 32; e += NT) { const int r = e >> 5, i = e & 31; const int pos = r < 4096 ? r : PAST + (r - 4096);
        const double inv = exp2(-(double)i * (13.287712379549449 / 32.0)); const double rev = (double)pos * inv * 0.15915494309189535;
        const float fr = (float)(rev - floor(rev));
        ROPE[r * 64 + i] = __builtin_amdgcn_cosf(fr); ROPE[r * 64 + 32 + i] = __builtin_amdgcn_sinf(fr); }
    if ((int)blockIdx.x < 192) p0_adaln_item(F, (int)blockIdx.x);
    if (F.G < 192) for (int it = F.G + (int)blockIdx.x; it < 192; it += F.G) p0_adaln_item(F, it);
    __syncthreads();
    LAS float* scr = (LAS float*)(F.lds + F.wave * 16384);
    constexpr int IT_IN = (D / 64) * (NPROJ / 32), IT_OUT = (D / 64) * (D / 32), IT_UP = (D / 64) * (DFF / 32), IT_DN = (DFF / 64) * (D / 32), IT_L = IT_IN + IT_OUT + IT_UP + IT_DN;
    for (int it = F.gw; it < DEPTH * IT_L; it += F.ngw) {
        const int l = it / IT_L; int r = it % IT_L;
        if (r < IT_IN) { const int nblk = NPROJ / 32, kb = r / nblk, nb = r % nblk, dn0 = 32 * nb, sn0 = dn0 + (dn0 >= 4096 ? 8 : 0);
            p0_transpose_item(INP(I_WIN) + (size_t)l * D * NINW, D, NINW, Wi + (size_t)l * NPROJ * D, 64 * kb, sn0, dn0, scr, F.lane); continue; } r -= IT_IN;
        if (r < IT_OUT) { const int nblk = D / 32, kb = r / nblk, nb = r % nblk;
            p0_transpose_item(INP(I_WOUT) + (size_t)l * D * D, D, D, Wo + (size_t)l * D * D, 64 * kb, 32 * nb, 32 * nb, scr, F.lane); continue; } r -= IT_OUT;
        if (r < IT_UP) { const int nblk = DFF / 32, kb = r / nblk, nb = r % nblk;
            p0_transpose_item(INP(I_WUP) + (size_t)l * D * DFF, D, DFF, Wu + (size_t)l * DFF * D, 64 * kb, 32 * nb, 32 * nb, scr, F.lane); continue; } r -= IT_UP;
        { const int nblk = D / 32, kb = r / nblk, nb = r % nblk;
            p0_transpose_item(INP(I_WDN) + (size_t)l * DFF * D, DFF, D, Wd + (size_t)l * D * DFF, 64 * kb, 32 * nb, 32 * nb, scr, F.lane); }
    }
}

__device__ __forceinline__ void norm_phase(Frame& F, int l, int which, int nsl) {
    WS_LOCALS
    LAS float* wdt = (LAS float*)F.lds;
    if (which == 0) { const float* wsrc = INP(I_WIN) + (size_t)l * D * NINW + 4096;
        for (int e = F.tid; e < D * 8; e += NTHR) { const int d = e >> 3, j = e & 7; wdt[j * D + d] = wsrc[(size_t)d * NINW + j]; }
        __syncthreads(); }
    const f32x4* g4 = (const f32x4*)(INP(which ? I_N2G : I_N1G) + l * D);
    for (int m = F.gw; m < M; m += F.ngw) {
        const int bb = row_bb(m);
        const f32x4* xr = (const f32x4*)(F.out + (size_t)m * D);
        const float* modp = MOD + ((size_t)l * NBB + bb) * NMOD + (which ? 3 * D : 0);
        const f32x4* sh4 = (const f32x4*)modp; const f32x4* sc4 = (const f32x4*)(modp + D);
        f32x4 v[8]; float ss = 0.f;
#pragma unroll
        for (int j = 0; j < 8; ++j) v[j] = xr[64 * j + F.lane];
        if (m >= MP && nsl > 0) { const f32x4* pp = (const f32x4*)wsp(F, WS_PART) + (size_t)(m - MP) * (D / 4);
#pragma unroll 1
            for (int s = 0; s < nsl; ++s) {
#pragma unroll
                for (int j = 0; j < 8; ++j) v[j] = v[j] + pp[(size_t)s * (MS * D / 4) + 64 * j + F.lane]; }
            f32x4* xw = (f32x4*)(F.out + (size_t)m * D);
#pragma unroll
            for (int j = 0; j < 8; ++j) xw[64 * j + F.lane] = v[j]; }
#pragma unroll
        for (int j = 0; j < 8; ++j) ss += (v[j].x * v[j].x + v[j].y * v[j].y) + (v[j].z * v[j].z + v[j].w * v[j].w);
        const float r = 1.f / sqrtf(wave_sum(ss) * (1.f / D) + EPS);
        float dta[8];
#pragma unroll
        for (int j = 0; j < 8; ++j) dta[j] = 0.f;
        GAS unsigned long long* o8 = (GAS unsigned long long*)(H + (size_t)m * D);
#pragma unroll
        for (int j = 0; j < 8; ++j) { const int q = 64 * j + F.lane; const f32x4 g = g4[q], sc = sc4[q], sh = sh4[q];
            f32x4 h; h.x = v[j].x * r * g.x * (1.f + sc.x) + sh.x; h.y = v[j].y * r * g.y * (1.f + sc.y) + sh.y; h.z = v[j].z * r * g.z * (1.f + sc.z) + sh.z; h.w = v[j].w * r * g.w * (1.f + sc.w) + sh.w;
            o8[q] = (unsigned long long)pk2(h.x, h.y) | ((unsigned long long)pk2(h.z, h.w) << 32);
            v[j] = h; }
        if (which == 0) {
#pragma unroll
            for (int jj = 0; jj < 8; ++jj) { float a = 0.f;
#pragma unroll
                for (int j = 0; j < 8; ++j) { const f32x4 w = ((const LAS f32x4*)wdt)[jj * (D / 4) + 64 * j + F.lane]; a += (v[j].x * w.x + v[j].y * w.y) + (v[j].z * w.z + v[j].w * w.w); }
                dta[jj] = wave_sum(a); __builtin_amdgcn_sched_barrier(0); }
            if (F.lane == 0) { f32x4* dp = (f32x4*)(DT + (size_t)m * 8); dp[0] = (f32x4){dta[0], dta[1], dta[2], dta[3]}; dp[1] = (f32x4){dta[4], dta[5], dta[6], dta[7]}; } }
    }
}

__device__ __forceinline__ void final_fix_phase(Frame& F, int nsl) {
    for (int m = MP + F.gw; m < M; m += F.ngw) {
        f32x4* xw = (f32x4*)(F.out + (size_t)m * D); const f32x4* pp = (const f32x4*)wsp(F, WS_PART) + (size_t)(m - MP) * (D / 4);
        f32x4 v[8];
#pragma unroll
        for (int j = 0; j < 8; ++j) v[j] = xw[64 * j + F.lane];
#pragma unroll 1
        for (int s = 0; s < nsl; ++s) {
#pragma unroll
            for (int j = 0; j < 8; ++j) v[j] = v[j] + pp[(size_t)s * (MS * D / 4) + 64 * j + F.lane]; }
#pragma unroll
        for (int j = 0; j < 8; ++j) xw[64 * j + F.lane] = v[j];
    }
}
template <int MODE> __device__ __forceinline__ void hgrn_unit(Frame& F, int l, int u) {
    WS_LOCALS
    const int tid = F.tid, v = tid & 127, dg = tid >> 7;
    const float* const hng = INP(I_HNG);
    int h, m0, L; size_t sidx;
    if (MODE == 2) { const int b = u >> 2; h = u & 3; m0 = MP + b * TS; L = TS; sidx = ((size_t)(l * BS + b) * 4 + h) * 16384; }
    else { const int bh = u >> 6, c = u & 63, b = bh >> 2; h = bh & 3; m0 = b * TP + c * 64; L = 64; sidx = (size_t)u * 16384; }
    LAS float* fL = (LAS float*)F.lds;
    LAS float* kL = fL + 2048; LAS float* qL = kL + 2048; LAS float* vL = qL + 2048;
    LAS float* op = vL + 2048;
    float S[32];
    if (MODE == 0) {
#pragma unroll
        for (int i = 0; i < 32; ++i) S[i] = 0.f;
    } else { const float* src = (MODE == 1 ? HGSS : INP(I_SHG)) + sidx + (size_t)(dg * 32) * 128 + v;
#pragma unroll
        for (int i = 0; i < 32; ++i) S[i] = src[i * 128]; }
    float P = 1.f;
    const int sd = tid & 127; const float lbv = LBv[l * 512 + h * 128 + sd];
    for (int t0 = 0; t0 < L; t0 += 16) {
        const int nst = (L - t0) < 16 ? (L - t0) : 16;
        __syncthreads();
        for (int tt = tid >> 7; tt < nst; tt += 4) { const bf16* row = PROJ + (size_t)(m0 + t0 + tt) * NPROJ + h * 128 + sd;
            const float fr = bf2f(row[C_AF]), qr = bf2f(row[C_AQ]), ir = bf2f(row[C_AI]);
            const float e = __expf(-fr); const float sg = 1.f / (1.f + e), sgn = e / (1.f + e);
            fL[tt * 128 + sd] = lbv + (1.f - lbv) * sg; kL[tt * 128 + sd] = (1.f - lbv) * sgn; qL[tt * 128 + sd] = qr * sigm(qr); vL[tt * 128 + sd] = ir; }
        __syncthreads();
        if (MODE == 0 && tid < 128) for (int tt = 0; tt < nst; ++tt) P *= fL[tt * 128 + tid];
        for (int tt = 0; tt < nst; ++tt) {
            const float vv = vL[tt * 128 + v]; float o = 0.f;
            const LAS f32x4* f4 = (const LAS f32x4*)(fL + tt * 128 + dg * 32); const LAS f32x4* k4 = (const LAS f32x4*)(kL + tt * 128 + dg * 32); const LAS f32x4* q4 = (const LAS f32x4*)(qL + tt * 128 + dg * 32);
#pragma unroll
            for (int j = 0; j < 8; ++j) { const f32x4 f = f4[j], k = k4[j], q = q4[j];
                S[4 * j] = f.x * S[4 * j] + k.x * vv; S[4 * j + 1] = f.y * S[4 * j + 1] + k.y * vv; S[4 * j + 2] = f.z * S[4 * j + 2] + k.z * vv; S[4 * j + 3] = f.w * S[4 * j + 3] + k.w * vv;
                if (MODE != 0) o += (q.x * S[4 * j] + q.y * S[4 * j + 1]) + (q.z * S[4 * j + 2] + q.w * S[4 * j + 3]); }
            if (MODE != 0) op[(tt * 4 + dg) * 128 + v] = o;
        }
        if (MODE != 0) {
            __syncthreads();
            for (int tt = F.wave; tt < nst; tt += 8) {
                const LAS float* p = op + tt * 512;
                const float o0 = (p[F.lane] + p[128 + F.lane]) + (p[256 + F.lane] + p[384 + F.lane]), o1 = (p[64 + F.lane] + p[192 + F.lane]) + (p[320 + F.lane] + p[448 + F.lane]);
                const float r = 1.f / sqrtf(wave_sum(o0 * o0 + o1 * o1) * (1.f / 128.f) + EPS);
                const int m = m0 + t0 + tt; const bf16* grow = PROJ + (size_t)m * NPROJ + C_AG + h * 128; const float* ng = hng + l * 512 + h * 128;
                bf16* orow = MIX + (size_t)m * D + h * 128;
                orow[F.lane] = (bf16)f2bf(o0 * r * ng[F.lane] * sigm(bf2f(grow[F.lane])));
                orow[64 + F.lane] = (bf16)f2bf(o1 * r * ng[64 + F.lane] * sigm(bf2f(grow[64 + F.lane])));
            }
        }
    }
    if (MODE == 0) { float* dst = HGDS + sidx + (size_t)(dg * 32) * 128 + v;
#pragma unroll
        for (int i = 0; i < 32; ++i) dst[i * 128] = S[i];
        if (tid < 128) HGDEC[u * 128 + tid] = P; }
    if (MODE == 2) { float* dst = F.out + O_SHG + sidx + (size_t)(dg * 32) * 128 + v;
#pragma unroll
        for (int i = 0; i < 32; ++i) dst[i * 128] = S[i]; }
}

template <int MODE> __device__ __forceinline__ void ssd_unit(Frame& F, int l, int u) {
    WS_LOCALS
    const int tid = F.tid, hh = F.wave, p = F.lane, g = hh >> 2;
    const float* const cwp = INP(I_CW); const float* const cbp = INP(I_CB); const float* const scv = INP(I_SCONV); const float* const dtbp = INP(I_DTB); const float* const alp = INP(I_ALOG);
    const float ngv = INP(I_SNG)[l * 512 + hh * 64 + p];
    int b, m0, L, tseq0; size_t sidx;
    if (MODE == 2) { b = u; m0 = MP + b * TS; L = TS; tseq0 = 0; sidx = ((size_t)(l * BS + b) * 8 + hh) * 8192 + p * 128; }
    else { b = u >> 6; const int c = u & 63; m0 = b * TP + c * 64; L = 64; tseq0 = c * 64; sidx = ((size_t)u * 8 + hh) * 8192 + p * 128; }
    LAS float* cv = (LAS float*)F.lds;
    LAS float* ygL = cv + 16384;
    LAS float* dtL = ygL + 8192;
    LAS float* dcL = dtL + 128;
    LAS float* red = dcL + 128;
    float S[128];
    if (MODE == 0) {
#pragma unroll
        for (int i = 0; i < 128; ++i) S[i] = 0.f;
    } else { const f32x4* src = (const f32x4*)((MODE == 1 ? SDSS : INP(I_SSSM)) + sidx);
#pragma unroll
        for (int i = 0; i < 32; ++i) { const f32x4 t = src[i]; S[4 * i] = t.x; S[4 * i + 1] = t.y; S[4 * i + 2] = t.z; S[4 * i + 3] = t.w; } }
    float Ptot = 1.f;
    const float dsk = INP(I_DSK)[l * 8 + hh];
    const int ch = 2 * tid;
    float cw[4][2], cb[2];
#pragma unroll
    for (int j = 0; j < 4; ++j) { cw[j][0] = cwp[(l * 4 + j) * 1024 + ch]; cw[j][1] = cwp[(l * 4 + j) * 1024 + ch + 1]; }
    cb[0] = cbp[l * 1024 + ch]; cb[1] = cbp[l * 1024 + ch + 1];
    for (int t0 = 0; t0 < L; t0 += 16) {
        const int nst = (L - t0) < 16 ? (L - t0) : 16;
        __syncthreads();
        {
            float x[3][2];
#pragma unroll
            for (int j = 0; j < 3; ++j) { const int r = t0 - 3 + j; float a0 = 0.f, a1 = 0.f;
                if (MODE == 2) { if (r >= 0) { const unsigned w = *(const unsigned*)(PROJ + (size_t)(m0 + r) * NPROJ + C_CX + ch); a0 = bflo(w); a1 = bfhi(w); }
                                 else { const float* sc = scv + ((size_t)(l * BS + b) * 3 + (3 + r)) * 1024 + ch; a0 = sc[0]; a1 = sc[1]; } }
                else if (tseq0 + r >= 0) { const unsigned w = *(const unsigned*)(PROJ + (size_t)(m0 + r) * NPROJ + C_CX + ch); a0 = bflo(w); a1 = bfhi(w); }
                x[j][0] = a0; x[j][1] = a1; }
            for (int tt = 0; tt < nst; ++tt) {
                const unsigned w = *(const unsigned*)(PROJ + (size_t)(m0 + t0 + tt) * NPROJ + C_CX + ch); const float n0 = bflo(w), n1 = bfhi(w);
                const float c0 = cb[0] + cw[0][0] * x[0][0] + cw[1][0] * x[1][0] + cw[2][0] * x[2][0] + cw[3][0] * n0;
                const float c1 = cb[1] + cw[0][1] * x[0][1] + cw[1][1] * x[1][1] + cw[2][1] * x[2][1] + cw[3][1] * n1;
                cv[tt * 1024 + ch] = c0 * sigm(c0); cv[tt * 1024 + ch + 1] = c1 * sigm(c1);
                x[0][0] = x[1][0]; x[0][1] = x[1][1]; x[1][0] = x[2][0]; x[1][1] = x[2][1]; x[2][0] = n0; x[2][1] = n1; }
        }
        if (tid < nst * 8) { const int tt = tid >> 3, h8 = tid & 7; const float raw = DT[(size_t)(m0 + t0 + tt) * 8 + h8] + dtbp[l * 8 + h8];
            const float dtv = raw > 20.f ? raw : log1pf(__expf(raw)); dtL[tid] = dtv; dcL[tid] = __expf(-dtv * __expf(alp[l * 8 + h8])); }
        __syncthreads();
        for (int tt = 0; tt < nst; ++tt) {
            const float xv = cv[tt * 1024 + hh * 64 + p], dtv = dtL[tt * 8 + hh], dc = dcL[tt * 8 + hh], dx = dtv * xv; Ptot *= dc;
            const LAS f32x4* B4 = (const LAS f32x4*)(cv + tt * 1024 + 512 + g * 128); const LAS f32x4* C4 = (const LAS f32x4*)(cv + tt * 1024 + 768 + g * 128);
            float y = 0.f;
#pragma unroll
            for (int j = 0; j < 32; ++j) { const f32x4 Bv = B4[j];
                S[4 * j] = dc * S[4 * j] + dx * Bv.x; S[4 * j + 1] = dc * S[4 * j + 1] + dx * Bv.y; S[4 * j + 2] = dc * S[4 * j + 2] + dx * Bv.z; S[4 * j + 3] = dc * S[4 * j + 3] + dx * Bv.w;
                if (MODE != 0) { const f32x4 Cv = C4[j]; y += (Cv.x * S[4 * j] + Cv.y * S[4 * j + 1]) + (Cv.z * S[4 * j + 2] + Cv.w * S[4 * j + 3]); } }
            if (MODE != 0) { y += dsk * xv; const float z = bf2f(PROJ[(size_t)(m0 + t0 + tt) * NPROJ + C_CZ + hh * 64 + p]); const float yg = y * z * sigm(z);
                ygL[tt * 512 + hh * 64 + p] = yg; const float ss = wave_sum(yg * yg); if (p == 0) red[tt * 8 + hh] = ss; }
        }
        if (MODE != 0) {
            __syncthreads();
            const float ng = ngv;
            for (int tt = 0; tt < nst; ++tt) { const LAS float* rp = red + tt * 8; const float tot = ((rp[0] + rp[1]) + (rp[2] + rp[3])) + ((rp[4] + rp[5]) + (rp[6] + rp[7]));
                const float r = 1.f / sqrtf(tot * (1.f / 512.f) + EPS);
                MIX[(size_t)(m0 + t0 + tt) * D + 1024 + hh * 64 + p] = (bf16)f2bf(ygL[tt * 512 + hh * 64 + p] * r * ng); }
        }
    }
    if (MODE == 0) { f32x4* dst = (f32x4*)(SDDS + sidx);
#pragma unroll
        for (int i = 0; i < 32; ++i) dst[i] = (f32x4){S[4 * i], S[4 * i + 1], S[4 * i + 2], S[4 * i + 3]};
        if (p == 0) SDDEC[u * 8 + hh] = Ptot;
        if ((u & 63) == 63) for (int e = tid; e < 3 * 1024; e += NTHR) { const int j = e >> 10, c2 = e & 1023;
            F.out[O_PCONV + ((size_t)(l * BP + b) * 3 + j) * 1024 + c2] = bf2f(PROJ[(size_t)(m0 + 61 + j) * NPROJ + C_CX + c2]); } }
    if (MODE == 2) { f32x4* dst = (f32x4*)(F.out + O_SSSM + sidx);
#pragma unroll
        for (int i = 0; i < 32; ++i) dst[i] = (f32x4){S[4 * i], S[4 * i + 1], S[4 * i + 2], S[4 * i + 3]};
        for (int e = tid; e < 3 * 1024; e += NTHR) { const int j = e >> 10, c2 = e & 1023;
            F.out[O_SCONV + ((size_t)(l * BS + b) * 3 + j) * 1024 + c2] = bf2f(PROJ[(size_t)(m0 + 5 + j) * NPROJ + C_CX + c2]); } }
}

__device__ __forceinline__ void scan_phase(Frame& F, int l) {
    WS_LOCALS
    const int gt = blockIdx.x * NTHR + F.tid, NT = F.G * NTHR;
    for (int e = gt; e < 131072; e += NT) { const int bh = e >> 14, dv = e & 16383, d = dv >> 7; float S = 0.f;
#pragma unroll 8
        for (int c = 0; c < 64; ++c) { const size_t u = (size_t)bh * 64 + c; HGSS[u * 16384 + dv] = S; S = HGDEC[u * 128 + d] * S + HGDS[u * 16384 + dv]; }
        F.out[O_PHG + ((size_t)l * 8 + bh) * 16384 + dv] = S; }
    for (int e = gt; e < 131072; e += NT) { const int bhh = e >> 13, b = bhh >> 3, hh = bhh & 7, pn = e & 8191; float S = 0.f;
#pragma unroll 8
        for (int c = 0; c < 64; ++c) { const size_t idx = (size_t)(b * 64 + c) * 8 + hh; SDSS[idx * 8192 + pn] = S; S = SDDEC[idx] * S + SDDS[idx * 8192 + pn]; }
        F.out[O_PSSM + ((size_t)(l * BP + b) * 8 + hh) * 8192 + pn] = S; }
}
template <int SAMPLE> __device__ __forceinline__ void attn_unit(Frame& F, int l, int u) {
    WS_LOCALS
    const int tid = F.tid, lane = F.lane, wave = F.wave;
    const float* const ckp = INP(I_CK); const float* const cvp = INP(I_CV);
    LAS float* Kl = (LAS float*)F.lds; LAS float* Vl = Kl + 12288;
    int b, g, q0, nrows, row_min; size_t mbase;
    if (SAMPLE) { b = u >> 1; g = u & 1; q0 = 0; nrows = 136; row_min = 0; mbase = (size_t)MP + b * TS; }
    else { g = u & 1; const int qt = (u >> 1) & 63; b = u >> 7; q0 = qt * 64; nrows = 192; row_min = q0 >= 127 ? 0 : 127 - q0; mbase = (size_t)b * TP; }
    __syncthreads();
    {   const int j8 = tid & 7; const float* kg = INP(I_KNG) + l * 64 + 8 * j8;
        float kgv[8];
#pragma unroll
        for (int e = 0; e < 8; ++e) kgv[e] = kg[e];
        for (int row = tid >> 3; row < nrows; row += 64) {
            f32x4 k0, k1, v0, v1; bool zero = false;
            if (SAMPLE && row < 128) { const f32x4* kp = (const f32x4*)(ckp + (((size_t)(l * BS + b) * 128 + row) * 2 + g) * 64 + 8 * j8); const f32x4* vp = (const f32x4*)(cvp + (((size_t)(l * BS + b) * 128 + row) * 2 + g) * 64 + 8 * j8);
                k0 = kp[0]; k1 = kp[1]; v0 = vp[0]; v1 = vp[1]; }
            else {
                int t, prow;
                if (SAMPLE) { t = row - 128; prow = 4096 + t; } else { t = q0 - 127 + row; prow = t; if (t < 0 || row == 191) zero = true; }
                if (zero) { k0 = k1 = v0 = v1 = (f32x4){0.f, 0.f, 0.f, 0.f}; }
                else {
                    const bf16* pr = PROJ + (mbase + t) * NPROJ;
                    const v4u kw = *(const v4u*)(pr + C_DK + g * 64 + 8 * j8); const v4u vw = *(const v4u*)(pr + C_DV + g * 64 + 8 * j8);
                    float kr[8] = {bflo(kw.x), bfhi(kw.x), bflo(kw.y), bfhi(kw.y), bflo(kw.z), bfhi(kw.z), bflo(kw.w), bfhi(kw.w)};
                    v0 = (f32x4){bflo(vw.x), bfhi(vw.x), bflo(vw.y), bfhi(vw.y)}; v1 = (f32x4){bflo(vw.z), bfhi(vw.z), bflo(vw.w), bfhi(vw.w)};
                    float ss = 0.f;
#pragma unroll
                    for (int e = 0; e < 8; ++e) ss += kr[e] * kr[e];
                    ss += __shfl_xor(ss, 1); ss += __shfl_xor(ss, 2); ss += __shfl_xor(ss, 4);
                    const float rn = 1.f / sqrtf(ss * (1.f / 64.f) + EPS);
                    const float* rp = ROPE + (size_t)prow * 64 + ((8 * j8) & 31);
                    float ko[8];
#pragma unroll
                    for (int e = 0; e < 8; ++e) { const float kn = kr[e] * rn * kgv[e]; const float other = __shfl_xor(kn, 4); const float c = rp[e], s = rp[32 + e];
                        ko[e] = j8 < 4 ? kn * c - other * s : kn * c + other * s; }
                    k0 = (f32x4){ko[0], ko[1], ko[2], ko[3]}; k1 = (f32x4){ko[4], ko[5], ko[6], ko[7]};
                }
            }
            LAS f32x4* kd = (LAS f32x4*)(Kl + row * 64 + 8 * j8); kd[0] = k0; kd[1] = k1;
            LAS f32x4* vd = (LAS f32x4*)(Vl + row * 64 + 8 * j8); vd[0] = v0; vd[1] = v1;
        }
    }
    __syncthreads();
    if (SAMPLE || q0 == TP - 64) {
        const int roff = SAMPLE ? 8 : 63; const size_t ob = SAMPLE ? ((size_t)(l * BS + b) * 128) : ((size_t)(l * BP + b) * 128);
        float* ok = F.out + (SAMPLE ? O_SK : O_PK); float* ov = F.out + (SAMPLE ? O_SV : O_PV);
        for (int e = tid; e < 128 * 64; e += NTHR) { const int j = e >> 6, dd = e & 63; ok[((ob + j) * 2 + g) * 64 + dd] = Kl[(roff + j) * 64 + dd]; ov[((ob + j) * 2 + g) * 64 + dd] = Vl[(roff + j) * 64 + dd]; }
    }
    if (!SAMPLE || wave == 0) {
        const int dh = lane & 1, qi = (lane >> 1) & 7, r = lane >> 4, head = g * 4 + r;
        const int t = SAMPLE ? qi : q0 + 8 * wave + qi;
        const int qrow = SAMPLE ? 128 + qi : 127 + 8 * wave + qi;
        const int prow = SAMPLE ? 4096 + t : t;
        const int row_lo = SAMPLE ? 0 : 8 * wave;
        float q[32];
        {   const v4u* qp = (const v4u*)(PROJ + (mbase + t) * NPROJ + C_DQ + head * 64 + 32 * dh);
#pragma unroll
            for (int c = 0; c < 4; ++c) { const v4u w = qp[c]; q[8 * c] = bflo(w.x); q[8 * c + 1] = bfhi(w.x); q[8 * c + 2] = bflo(w.y); q[8 * c + 3] = bfhi(w.y); q[8 * c + 4] = bflo(w.z); q[8 * c + 5] = bfhi(w.z); q[8 * c + 6] = bflo(w.w); q[8 * c + 7] = bfhi(w.w); }
            float ss = 0.f;
#pragma unroll
            for (int d = 0; d < 32; ++d) ss += q[d] * q[d];
            ss += __shfl_xor(ss, 1);
            const float rn = 0.125f / sqrtf(ss * (1.f / 64.f) + EPS);
            const float* qg = INP(I_QNG) + l * 64 + 32 * dh; const float* rp = ROPE + (size_t)prow * 64;
#pragma unroll
            for (int i = 0; i < 32; ++i) { const float xn = q[i] * rn * qg[i]; const float other = __shfl_xor(xn, 1); const float c = rp[i], s = rp[32 + i];
                q[i] = dh == 0 ? xn * c - other * s : xn * c + other * s; }
        }
        float mrun = INP(I_SINK)[l * 8 + head], lrun = 1.f;
        float o[32];
#pragma unroll
        for (int d = 0; d < 32; ++d) o[d] = 0.f;
        for (int it = 0; it < 34; ++it) {
            const int rb = row_lo + 4 * it;
            float s[4];
#pragma unroll
            for (int k = 0; k < 4; ++k) { const LAS f32x4* kr = (const LAS f32x4*)(Kl + (rb + k) * 64 + 32 * dh); float a = 0.f;
#pragma unroll
                for (int c = 0; c < 8; ++c) { const f32x4 kv = kr[c]; a += (q[4 * c] * kv.x + q[4 * c + 1] * kv.y) + (q[4 * c + 2] * kv.z + q[4 * c + 3] * kv.w); }
                a += __shfl_xor(a, 1);
                const int row = rb + k; const bool valid = (row <= qrow) && (row > qrow - 128) && (row >= row_min);
                s[k] = valid ? a : -INFINITY; }
            const float mnew = fmaxf(fmaxf(mrun, fmaxf(s[0], s[1])), fmaxf(s[2], s[3]));
            const float al = __expf(mrun - mnew); mrun = mnew;
            float pk[4];
#pragma unroll
            for (int k = 0; k < 4; ++k) pk[k] = __expf(s[k] - mnew);
            lrun = lrun * al + (pk[0] + pk[1]) + (pk[2] + pk[3]);
#pragma unroll
            for (int d = 0; d < 32; ++d) o[d] *= al;
#pragma unroll
            for (int k = 0; k < 4; ++k) { const LAS f32x4* vr = (const LAS f32x4*)(Vl + (rb + k) * 64 + 32 * dh);
#pragma unroll
                for (int c = 0; c < 8; ++c) { const f32x4 vv = vr[c]; o[4 * c] += pk[k] * vv.x; o[4 * c + 1] += pk[k] * vv.y; o[4 * c + 2] += pk[k] * vv.z; o[4 * c + 3] += pk[k] * vv.w; } }
        }
        {   const float inv = 1.f / lrun; v4u* op = (v4u*)(MIX + (mbase + t) * D + 1536 + head * 64 + 32 * dh);
#pragma unroll
            for (int c = 0; c < 4; ++c) { v4u w; w.x = pk2(o[8 * c] * inv, o[8 * c + 1] * inv); w.y = pk2(o[8 * c + 2] * inv, o[8 * c + 3] * inv); w.z = pk2(o[8 * c + 4] * inv, o[8 * c + 5] * inv); w.w = pk2(o[8 * c + 6] * inv, o[8 * c + 7] * inv); op[c] = w; }
        }
    }
}
__device__ __forceinline__ void pool_unit(Frame& F, int l, int u) {
    WS_LOCALS
    const int tid = F.tid, c = tid & 127, tq = tid >> 7;
    const float* const pwp = INP(I_PW); const float* const spp = INP(I_SPOOL);
    LAS float* pl = (LAS float*)F.lds; LAS float* wl = pl + 8192;
    const bool samp = u >= 128; const int b = samp ? 0 : (u >> 6), t0 = samp ? 0 : (u & 63) * 64; const int s8 = samp ? (u - 128) * 8 : 0;
    const size_t m0 = samp ? (size_t)MP + (size_t)s8 * TS : (size_t)b * TP + t0;
    for (int gi = 0; gi < 4; ++gi) {
        const int win = 2 << gi, chn = gi * 128 + c;
        __syncthreads();
        for (int e = tid; e < 128 * 128 / 4; e += NTHR) ((LAS f32x4*)wl)[e] = ((const f32x4*)(pwp + (size_t)(l * 4 + gi) * 16384))[e];
        for (int i = 0; i < 16; ++i) { const int tt = tq * 16 + i; float s = 0.f, self, cnt;
            if (!samp) { const int t = t0 + tt; const bf16* base = PROJ + ((size_t)b * TP) * NPROJ + C_PU + chn;
                for (int j = 0; j < win; ++j) if (t - j >= 0) s += bf2f(base[(size_t)(t - j) * NPROJ]);
                self = bf2f(base[(size_t)t * NPROJ]); cnt = (float)((t + 1) < win ? (t + 1) : win); }
            else { const int bs = s8 + (tt >> 3), ts = tt & 7; const bf16* base = PROJ + ((size_t)MP + (size_t)bs * TS) * NPROJ + C_PU + chn; const float* buf = spp + ((size_t)(l * BS + bs) * 15) * 512 + chn;
                for (int j = 0; j < win; ++j) { const int e2 = 15 + ts - j; s += e2 >= 15 ? bf2f(base[(size_t)(e2 - 15) * NPROJ]) : buf[(size_t)e2 * 512]; }
                self = bf2f(base[(size_t)ts * NPROJ]); cnt = (float)win; }
            pl[tt * 128 + c] = s / cnt - self; }
        __syncthreads();
        float acc[16];
#pragma unroll
        for (int i = 0; i < 16; ++i) acc[i] = 0.f;
        for (int k4 = 0; k4 < 32; ++k4) { const float w0 = wl[(4 * k4) * 128 + c], w1 = wl[(4 * k4 + 1) * 128 + c], w2 = wl[(4 * k4 + 2) * 128 + c], w3 = wl[(4 * k4 + 3) * 128 + c];
#pragma unroll
            for (int i = 0; i < 16; ++i) { const f32x4 pv = ((const LAS f32x4*)(pl + (tq * 16 + i) * 128))[k4]; acc[i] += (pv.x * w0 + pv.y * w1) + (pv.z * w2 + pv.w * w3); } }
        const float sc = INP(I_PSC)[l * 512 + chn];
#pragma unroll
        for (int i = 0; i < 16; ++i) MIX[(m0 + tq * 16 + i) * D + 512 + chn] = (bf16)f2bf(acc[i] * sc);
    }
    if (!samp && t0 == TP - 64) for (int e = tid; e < 15 * 512; e += NTHR) { const int j = e >> 9, ch = e & 511;
        F.out[O_PPOOL + ((size_t)(l * BP + b) * 15 + j) * 512 + ch] = bf2f(PROJ[((size_t)b * TP + TP - 15 + j) * NPROJ + C_PU + ch]); }
    if (samp) for (int e = tid; e < 8 * 15 * 512; e += NTHR) { const int bs = s8 + e / (15 * 512), j = (e / 512) % 15, ch = e & 511;
        F.out[O_SPOOL + ((size_t)(l * BS + bs) * 15 + j) * 512 + ch] = j < 7 ? spp[((size_t)(l * BS + bs) * 15 + 8 + j) * 512 + ch] : bf2f(PROJ[((size_t)MP + (size_t)bs * TS + (j - 7)) * NPROJ + C_PU + ch]); }
}
#ifndef PROBE_DUP
#define PROBE_DUP 0
#endif
#ifdef PH_SEL
#define PSEL(k, stmt) do { if ((k) == PH_SEL) { stmt; } } while (0)
#else
#define PSEL(k, stmt) do { stmt; } while (0)
#endif
struct Args { const float* in[N_IN]; float* out; unsigned char* ws; int ph_lo, ph_hi; };
static_assert(sizeof(Args) == (N_IN + 2) * 8 + 8, "Args has no padding");
__global__ void __launch_bounds__(NTHR, 2) hymba_fwd(Args args) {
    extern __shared__ __attribute__((aligned(16))) unsigned char lds[];
    Frame F;
    F.lds = (LAS unsigned char*)lds;
    F.MISC = (volatile LAS unsigned*)(F.lds + MISC_OFF);
    F.tid = threadIdx.x; F.lane = F.tid & 63; F.wave = __builtin_amdgcn_readfirstlane(F.tid >> 6);
    F.G = gridDim.x; F.gw = (int)blockIdx.x * NWAVES + F.wave; F.ngw = F.G * NWAVES;
    unsigned char* ws = args.ws; F.ws = ws; F.out = args.out;
    F.ctl = (gu32*)(ws + WS_CTL);
    for (int u = F.tid; u < (LDS_BYTES - LDSCTL_OFF) / 4; u += NTHR) ((LAS unsigned*)(F.lds + LDSCTL_OFF))[u] = 0u;
    __syncthreads();
    if (F.tid < N_IN) ((LAS unsigned long long*)(F.lds + PTR_OFF))[F.tid] = (unsigned long long)args.in[F.tid];
    __syncthreads();
    const int lo = args.ph_lo, hi = args.ph_hi;
    XcdBarrier bar; bar.bar = (unsigned*)(F.ctl + CW_BAR); bar.x = 0; bar.st = nullptr;
    if (hi - lo > 1) bar = xcd_barrier_post((unsigned*)(F.ctl + CW_BAR), F.MISC + 8);
#define IN(k) (lo <= (k) && (k) < hi)
#define LAUNDER(P) asm volatile("" : "+v"(P.tid), "+v"(P.lane), "+s"(P.wave), "+s"(P.gw))
#define PHASE_LOCALS Frame P = F; LAUNDER(P); WS_LOCALS
#define SEAM(k) do { if (IN(k) && IN((k) + 1)) xcd_barrier(bar); } while (0)
    int rp_pro = (PROBE_DUP == 1) ? 2 : 1, rp_mix = (PROBE_DUP == 2) ? 2 : 1, rp_up = (PROBE_DUP == 3) ? 2 : 1; asm volatile("" : "+s"(rp_pro), "+s"(rp_mix), "+s"(rp_up));
    for (int rp = 0; rp < rp_pro; ++rp) { if (IN(0)) { PSEL(0, p0_prologue(F)); } SEAM(0); }
    for (int l = 0; l < DEPTH; ++l) {
        const int pb = 1 + l * PH_PER_LAYER;

        if (IN(pb + 0)) { PHASE_LOCALS  PSEL(1, norm_phase(P, l, 0, l > 0 ? NSL_DN : 0)); } SEAM(pb + 0);
        if (IN(pb + 1)) { PHASE_LOCALS
            pg8::Gemm g{H, Wi + (size_t)l * NPROJ * D, M, NPROJ, D}; pg8::StaticOrder S; S.init(M, NPROJ, D, F.G, (int)blockIdx.x);
            pg8::EpiStoreBf16 E{PROJ, NPROJ, 0};
            PSEL(2, (pg8::gemm_phase<pg8::EpiStoreBf16, pg8::StaticOrder, true, true>(P.lds, g, S, E)));
        } SEAM(pb + 1);
        for (int rp = 0; rp < rp_mix; ++rp) {
        if (IN(pb + 2)) { PHASE_LOCALS
            int u;
            { Frame Q = F; LAUNDER(Q); while ((u = deq(Q, l * 32 + 16 * rp + 0)) < 128) PSEL(3, ssd_unit<0>(Q, l, u)); }
            { Frame Q = F; LAUNDER(Q); while ((u = deq(Q, l * 32 + 16 * rp + 1)) < 256) PSEL(4, attn_unit<0>(Q, l, u)); }
            { Frame Q = F; LAUNDER(Q); while ((u = deq(Q, l * 32 + 16 * rp + 2)) < 512) PSEL(5, hgrn_unit<0>(Q, l, u)); }
            { Frame Q = F; LAUNDER(Q); while ((u = deq(Q, l * 32 + 16 * rp + 3)) < 132) PSEL(6, pool_unit(Q, l, u)); }
            { Frame Q = F; LAUNDER(Q); while ((u = deq(Q, l * 32 + 16 * rp + 4)) < 32) PSEL(7, ssd_unit<2>(Q, l, u)); }
            { Frame Q = F; LAUNDER(Q); while ((u = deq(Q, l * 32 + 16 * rp + 5)) < 64) PSEL(8, attn_unit<1>(Q, l, u)); }
            { Frame Q = F; LAUNDER(Q); while ((u = deq(Q, l * 32 + 16 * rp + 6)) < 128) PSEL(9, hgrn_unit<2>(Q, l, u)); }
        } SEAM(pb + 2);
        if (IN(pb + 3)) { PHASE_LOCALS  PSEL(10, scan_phase(P, l)); } SEAM(pb + 3);
        if (IN(pb + 4)) { PHASE_LOCALS
            int u;
            { Frame Q = F; LAUNDER(Q); while ((u = deq(Q, l * 32 + 16 * rp + 7)) < 128) PSEL(11, ssd_unit<1>(Q, l, u)); }
            { Frame Q = F; LAUNDER(Q); while ((u = deq(Q, l * 32 + 16 * rp + 8)) < 512) PSEL(12, hgrn_unit<1>(Q, l, u)); }
        } SEAM(pb + 4);
        }
        if (IN(pb + 5)) { PHASE_LOCALS
            pg8::Gemm g{MIX, Wo + (size_t)l * D * D, M, D, D}; pg8::SplitOrder S; S.init(MP, D, D, NSL_OUT, F.G, (int)blockIdx.x);
            pg8::EpiGateRes E{F.out, D, MOD + (size_t)l * NBB * NMOD + 2 * D, NMOD, (float*)wsp(F, WS_PART)};
            PSEL(13, (pg8::gemm_phase<pg8::EpiGateRes, pg8::SplitOrder, true, true>(P.lds, g, S, E)));
        } SEAM(pb + 5);
        if (IN(pb + 6)) { PHASE_LOCALS  PSEL(14, norm_phase(P, l, 1, NSL_OUT)); } SEAM(pb + 6);
        for (int rp = 0; rp < rp_up; ++rp) {
        if (IN(pb + 7)) { PHASE_LOCALS
            pg8::Gemm g{H, Wu + (size_t)l * DFF * D, M, DFF, D}; pg8::StaticOrder S; S.init(M, DFF, D, F.G, (int)blockIdx.x);
            pg8::EpiStoreBf16 E{U, DFF, 1};
            PSEL(15, (pg8::gemm_phase<pg8::EpiStoreBf16, pg8::StaticOrder, true, true>(P.lds, g, S, E)));
        } SEAM(pb + 7);
        }
        if (IN(pb + 8)) { PHASE_LOCALS
            pg8::Gemm g{U, Wd + (size_t)l * D * DFF, M, D, DFF}; pg8::SplitOrder S; S.init(MP, D, DFF, NSL_DN, F.G, (int)blockIdx.x);
            pg8::EpiGateRes E{F.out, D, MOD + (size_t)l * NBB * NMOD + 5 * D, NMOD, (float*)wsp(F, WS_PART)};
            PSEL(16, (pg8::gemm_phase<pg8::EpiGateRes, pg8::SplitOrder, true, true>(P.lds, g, S, E)));
        } SEAM(pb + 8);
    }
    if (IN(N_PHASES - 1)) { Frame P = F; LAUNDER(P); final_fix_phase(P, NSL_DN); }
#undef IN
#undef SEAM
}

extern "C" void kernel_launch(void* const* d_in, const int* in_sizes, int n_in, void* d_out, int out_size, void* d_ws, size_t ws_size, hipStream_t stream) {
    static int grid = 0;
    if (grid == 0) {
        if (n_in != N_IN || (size_t)out_size != O_END || ws_size < WS_END) { fprintf(stderr, "kernel_launch: unexpected shapes (n_in %d, out %d, ws %zu); nothing launched\n", n_in, out_size, ws_size); grid = -1; return; }
        int dev = 0, cus = 0, per_cu = 0;
        if (hipGetDevice(&dev) != hipSuccess || hipDeviceGetAttribute(&cus, hipDeviceAttributeMultiprocessorCount, dev) != hipSuccess) { grid = -1; return; }
        if (hipFuncSetAttribute((const void*)hymba_fwd, hipFuncAttributeMaxDynamicSharedMemorySize, LDS_BYTES) != hipSuccess) { fprintf(stderr, "kernel_launch: hipFuncSetAttribute failed\n"); grid = -1; return; }
        if (hipOccupancyMaxActiveBlocksPerMultiprocessor(&per_cu, (const void*)hymba_fwd, NTHR, LDS_BYTES) != hipSuccess || per_cu < 1) { fprintf(stderr, "kernel_launch: occupancy query says %d\n", per_cu); }
        (void)hipGetLastError();
        grid = cus;
    }
    if (grid < 0) return;
    if (hipMemsetAsync((char*)d_ws + WS_CTL, 0, CTL_ZERO_BYTES, stream) != hipSuccess) return;
    Args a{};
    for (int i = 0; i < N_IN; ++i) a.in[i] = (const float*)d_in[i];
    a.out = (float*)d_out; a.ws = (unsigned char*)d_ws;
#if MK_ONE_LAUNCH
    a.ph_lo = 0; a.ph_hi = N_PHASES;
    hipLaunchKernelGGL(hymba_fwd, dim3(grid), dim3(NTHR), LDS_BYTES, stream, a);
#else
    for (int k = 0; k < N_PHASES; ++k) { a.ph_lo = k; a.ph_hi = k + 1; hipLaunchKernelGGL(hymba_fwd, dim3(grid), dim3(NTHR), LDS_BYTES, stream, a); }
#endif
}
```

```cpp
#include <hip/hip_runtime.h>
#include <cstdio>
#include <cstdint>
namespace pg8 {
#define PG8_LAS __attribute__((address_space(3)))
typedef unsigned short bf16_t;
typedef short bf16x8 __attribute__((ext_vector_type(8)));
typedef float f32x4 __attribute__((ext_vector_type(4)));
typedef unsigned u32x4 __attribute__((ext_vector_type(4)));
constexpr int BM = 256, BK = 64, HALF = 128, HTB = HALF * BK * 2  , STAGE_BYTES = 8 * HTB, NXCD = 8, WGM = 8;

__host__ __device__ __forceinline__ int lds_byte(int r, int c) { const int st = (r >> 4) * 2 + (c >> 5), rr = r & 15, cc = c & 31, ob = rr * 64 + cc * 2; return st * 1024 + (ob ^ (((ob >> 9) & 1) << 5)); }
__host__ __device__ __forceinline__ void stage_rc(int b, int& R, int& C) { const int st = b / 1024, sb = b % 1024, swz = sb ^ (((sb >> 9) & 1) << 5); R = (st >> 1) * 16 + swz / 64; C = (st & 1) * 32 + (swz % 64) / 2; }
__host__ __device__ __forceinline__ int perm32(int rho) { const int n = rho >> 4, i = rho & 15; return 8 * (i >> 2) + 4 * n + (i & 3); }

struct Unit { int pm, pn, k0, nt, at; };
struct Gemm { const bf16_t* A; const bf16_t* Bt; int M, N, K; };

struct StaticOrder {
    int nM, nN, nwg, G, c, ntK;
    __host__ __device__ void init(int M, int N, int K, int G_, int c_) { nM = M / BM; nN = N / BM; nwg = nM * nN; G = G_; c = c_; ntK = K / BK; }
    __host__ __device__ bool next(int i, Unit& u) const {
        const long L = (long)i * G + c; if (L >= nwg) return false;
        int wgid = (int)L; { const int q = nwg / NXCD, r = nwg % NXCD, xcd = wgid % NXCD, off = wgid / NXCD; wgid = (xcd < r ? xcd * (q + 1) : r * (q + 1) + (xcd - r) * q) + off; }
        const int nig = WGM * nN, gid = wgid / nig, fm = gid * WGM, gsz = (nM - fm) < WGM ? (nM - fm) : WGM;
        u.pm = fm + ((wgid % nig) % gsz); u.pn = (wgid % nig) / gsz; u.k0 = 0; u.nt = ntK; u.at = 0; return true;
    }
    __device__ __forceinline__ void a_ready(const Unit&) const {}
    __device__ __forceinline__ void done(const Unit&) const {}
};

struct SplitOrder {
    StaticOrder so; int nfull, ntot, pmS, nN, ntS;
    __host__ __device__ void init(int Mfull, int N, int K, int nslice, int G_, int c_) { so.init(Mfull, N, K, G_, c_); nfull = so.nwg; pmS = Mfull / BM; nN = N / BM; ntS = K / BK / nslice; ntot = nfull + nN * nslice; }
    __host__ __device__ bool next(int i, Unit& u) const {
        const long L = (long)i * so.G + so.c; if (L >= ntot) return false;
        if (L < nfull) return so.next(i, u);
        const int j = (int)L - nfull; u.pm = pmS; u.pn = j % nN; u.k0 = (j / nN) * ntS * BK; u.nt = ntS; u.at = 1; return true;
    }
    __device__ __forceinline__ void a_ready(const Unit&) const {}
    __device__ __forceinline__ void done(const Unit&) const {}
};

__device__ __forceinline__ unsigned cvt_pk_bf16(float lo, float hi) { unsigned r; asm volatile("v_cvt_pk_bf16_f32 %0, %1, %2" : "=v"(r) : "v"(lo), "v"(hi)); return r; }
typedef float f32x2 __attribute__((ext_vector_type(2)));
struct EpiStoreBf16 {
    static constexpr bool PERM = true, AFTER_DRAIN = false;
    bf16_t* O; int ldc; int act;
    __device__ __forceinline__ void operator()(const f32x4 (&acc)[2][2][4][2], const Unit& u, int wr, int wc, int fr, int fq) const {
        const int row0 = u.pm * BM + wr * 64 + fr; const int col0 = u.pn * BM + wc * 32 + 8 * fq;
#pragma unroll
        for (int ai = 0; ai < 2; ++ai)
#pragma unroll
            for (int m = 0; m < 4; ++m) { bf16_t* rowp = O + (size_t)(row0 + ai * HALF + m * 16) * ldc + col0;
#pragma unroll
                for (int bj = 0; bj < 2; ++bj) { f32x4 v0 = acc[ai][bj][m][0], v1 = acc[ai][bj][m][1];
                    if (act) {
#pragma unroll
                        for (int j = 0; j < 4; ++j) { const float a = v0[j] > 0.f ? v0[j] : 0.f, b = v1[j] > 0.f ? v1[j] : 0.f; v0[j] = a * a; v1[j] = b * b; } }
                    u32x4 w; w.x = cvt_pk_bf16(v0[0], v0[1]); w.y = cvt_pk_bf16(v0[2], v0[3]); w.z = cvt_pk_bf16(v1[0], v1[1]); w.w = cvt_pk_bf16(v1[2], v1[3]);
                    *(u32x4*)(rowp + bj * HALF) = w; } }
    }
};
struct EpiGateRes {
    static constexpr bool PERM = false, AFTER_DRAIN = false;
    float* X; int ldc; const float* gate; int gstride; float* part;
    __device__ __forceinline__ void operator()(const f32x4 (&acc)[2][2][4][2], const Unit& u, int wr, int wc, int fr, int fq) const {
        const int row0 = u.pm * BM + wr * 64 + fr, col0 = u.pn * BM + wc * 32 + 4 * fq;
#pragma unroll
        for (int ai = 0; ai < 2; ++ai)
#pragma unroll
            for (int m = 0; m < 4; ++m) { const int row = row0 + ai * HALF + m * 16; const int bb = row < 8192 ? (row >> 12) : 2 + ((row - 8192) >> 3);
                float* rowp = X + (size_t)row * ldc + col0; const float* gp = gate + (size_t)bb * gstride + col0;
#pragma unroll
                for (int bj = 0; bj < 2; ++bj)
#pragma unroll
                    for (int n = 0; n < 2; ++n) { const f32x4 g = *(const f32x4*)(gp + bj * HALF + n * 16); const f32x4 v = g * acc[ai][bj][m][n]; float* xs = rowp + bj * HALF + n * 16;
                        if (u.at) { const int sl = u.k0 / (u.nt * BK); *(f32x4*)(part + ((size_t)(sl * BM + (row - 8192)) * ldc + col0 + bj * HALF + n * 16)) = v; }
                        else { f32x4* xp = (f32x4*)xs; *xp = *xp + v; } } }
    }
};
template <class Epi, class Sched, bool ALIGN_EPI = false, bool SP2 = false>
__device__ __forceinline__ void gemm_phase(PG8_LAS unsigned char* lds, const Gemm g, const Sched& S, const Epi& E) {
    int tid_ = threadIdx.x; asm volatile("" : "+v"(tid_));
    const int tid = tid_, wid = __builtin_amdgcn_readfirstlane(tid >> 6), lane = tid & 63, wr = wid >> 2, wc = wid & 3, fr = lane & 15, fq = lane >> 4;
    const int K = g.K;
    unsigned voffA[2], voffB[2];
#pragma unroll
    for (int i = 0; i < 2; ++i) { int R, C; stage_rc(tid * 16 + i * 8192, R, C); const int Rb = Epi::PERM ? ((R & ~31) + perm32(R & 31)) : R;
        voffA[i] = (unsigned)(R * K + C) * 2u; voffB[i] = (unsigned)(Rb * K + C) * 2u; }
    const size_t kstep = (size_t)(BK * 2);
    const size_t hstep = (size_t)HALF * K * 2;
    const size_t tstep = 2 * hstep;
    const unsigned ldsw = (unsigned)wid * 1024u;
    const int aoff = lds_byte(wr * 64 + fr, fq * 8), boff = lds_byte(wc * 32 + fr, fq * 8);
#define PG8_SA(b, h) (((b) * 2 + (h)) * HTB)
#define PG8_SB(b, h) ((4 + (b) * 2 + (h)) * HTB)
#define PG8_STAGE(bufoff, gbase, voff) do { _Pragma("unroll") for (int _i = 0; _i < 2; ++_i) \
        __builtin_amdgcn_global_load_lds((const unsigned*)((const char*)(gbase) + (voff)[_i]), (PG8_LAS unsigned*)(lds + (bufoff) + ldsw + _i * 8192), 16, 0, 0); } while (0)
#define PG8_LDA(dst, b, h) do { _Pragma("unroll") for (int m = 0; m < 4; ++m) _Pragma("unroll") for (int k = 0; k < 2; ++k) dst[m][k] = *(const PG8_LAS bf16x8*)(lds + PG8_SA(b, h) + aoff + m * 2048 + k * 1024); } while (0)
#define PG8_LDB(dst, b, h) do { _Pragma("unroll") for (int n = 0; n < 2; ++n) _Pragma("unroll") for (int k = 0; k < 2; ++k) dst[n][k] = *(const PG8_LAS bf16x8*)(lds + PG8_SB(b, h) + boff + n * 2048 + k * 1024); } while (0)
#define PG8_MMA(ai, bj, At, Bt) do { __builtin_amdgcn_s_setprio(1); _Pragma("unroll") for (int m = 0; m < 4; ++m) _Pragma("unroll") for (int n = 0; n < 2; ++n) _Pragma("unroll") for (int k = 0; k < 2; ++k) \
        acc[ai][bj][m][n] = __builtin_amdgcn_mfma_f32_16x16x32_bf16(Bt[n][k], At[m][k], acc[ai][bj][m][n], 0, 0, 0); __builtin_amdgcn_s_setprio(0); } while (0)
#define PG8_WAIT_V(n) asm volatile("s_waitcnt vmcnt(" #n ")" ::: "memory")
#define PG8_WAIT_L(n) asm volatile("s_waitcnt lgkmcnt(" #n ")" ::: "memory")
#define PG8_BAR __builtin_amdgcn_s_barrier()
#define PG8_SCHED __builtin_amdgcn_sched_barrier(0)
    Unit cur, nxt; int ui = 0;
    if (!S.next(0, cur)) return;
    f32x4 acc[2][2][4][2];
#pragma unroll
    for (int a = 0; a < 2; ++a)
#pragma unroll
        for (int b = 0; b < 2; ++b)
#pragma unroll
            for (int m = 0; m < 4; ++m)
#pragma unroll
                for (int n = 0; n < 2; ++n) acc[a][b][m][n] = (f32x4){0.f, 0.f, 0.f, 0.f};
    bf16x8 At[4][2], B0[2][2], B1[2][2];
    const char* cA = (const char*)g.A + (size_t)cur.pm * tstep + (size_t)cur.k0 * 2; const char* cB = (const char*)g.Bt + (size_t)cur.pn * tstep + (size_t)cur.k0 * 2;
    S.a_ready(cur);
    if constexpr (SP2) {
        PG8_STAGE(PG8_SB(0, 0), cB, voffB); PG8_STAGE(PG8_SB(0, 1), cB + hstep, voffB); PG8_STAGE(PG8_SA(0, 0), cA, voffA); PG8_STAGE(PG8_SA(0, 1), cA + hstep, voffA);
        if (wr == 1) PG8_BAR;
        PG8_WAIT_V(2); PG8_BAR;
        PG8_STAGE(PG8_SB(1, 0), cB + kstep, voffB); PG8_STAGE(PG8_SA(1, 0), cA + kstep, voffA); PG8_STAGE(PG8_SB(1, 1), cB + hstep + kstep, voffB);
        PG8_WAIT_V(6); PG8_BAR;
    } else {
        PG8_STAGE(PG8_SB(0, 0), cB, voffB); PG8_STAGE(PG8_SA(0, 0), cA, voffA); PG8_STAGE(PG8_SB(0, 1), cB + hstep, voffB); PG8_STAGE(PG8_SA(0, 1), cA + hstep, voffA);
        if (wr == 1) PG8_BAR;
        PG8_WAIT_V(4); PG8_BAR;
        PG8_STAGE(PG8_SB(1, 0), cB + kstep, voffB); PG8_STAGE(PG8_SA(1, 0), cA + kstep, voffA); PG8_STAGE(PG8_SB(1, 1), cB + hstep + kstep, voffB);
        PG8_WAIT_V(6); PG8_BAR;
    }
    for (;;) {
        const bool has_next = S.next(ui + 1, nxt);
        const char* nA = has_next ? (const char*)g.A + (size_t)nxt.pm * tstep + (size_t)nxt.k0 * 2 : cA; const char* nB = has_next ? (const char*)g.Bt + (size_t)nxt.pn * tstep + (size_t)nxt.k0 * 2 : cB;
        const int nt = cur.nt;
        for (int t = 0; t < nt; t += 2) {
            const bool last = (t == nt - 2);
            const char* a1 = cA + (size_t)(t + 1) * kstep;
            const char* a2 = last ? nA : cA + (size_t)(t + 2) * kstep; const char* b2 = last ? nB : cB + (size_t)(t + 2) * kstep;
            const char* a3 = a2 + kstep; const char* b3 = b2 + kstep;
            if (last && has_next) S.a_ready(nxt);
            if constexpr (SP2) {
            PG8_LDB(B0, 0, 0); PG8_LDB(B1, 0, 1); PG8_SCHED; PG8_LDA(At, 0, 0); PG8_STAGE(PG8_SA(1, 1), a1 + hstep, voffA);
            PG8_WAIT_V(8); PG8_WAIT_L(0); PG8_BAR; PG8_MMA(0, 0, At, B0); PG8_MMA(0, 1, At, B1); PG8_BAR; PG8_SCHED;
            PG8_LDA(At, 0, 1); PG8_STAGE(PG8_SB(0, 0), b2, voffB); PG8_STAGE(PG8_SB(0, 1), b2 + hstep, voffB); PG8_STAGE(PG8_SA(0, 0), a2, voffA);
            PG8_WAIT_V(8); PG8_WAIT_L(0); PG8_BAR; PG8_MMA(1, 0, At, B0); PG8_MMA(1, 1, At, B1); PG8_BAR; PG8_SCHED;
            PG8_LDB(B0, 1, 0); PG8_LDB(B1, 1, 1); PG8_SCHED; PG8_LDA(At, 1, 0); PG8_STAGE(PG8_SA(0, 1), a2 + hstep, voffA);
            PG8_WAIT_V(8); PG8_WAIT_L(0); PG8_BAR; PG8_MMA(0, 0, At, B0); PG8_MMA(0, 1, At, B1); PG8_BAR; PG8_SCHED;
            PG8_LDA(At, 1, 1); PG8_STAGE(PG8_SB(1, 0), b3, voffB); PG8_STAGE(PG8_SB(1, 1), b3 + hstep, voffB); PG8_STAGE(PG8_SA(1, 0), a3, voffA);
            PG8_WAIT_V(8); PG8_WAIT_L(0); PG8_BAR; PG8_MMA(1, 0, At, B0); PG8_MMA(1, 1, At, B1); PG8_BAR; PG8_SCHED;
            } else {
            PG8_LDB(B0, 0, 0); PG8_SCHED; PG8_LDA(At, 0, 0); PG8_STAGE(PG8_SA(1, 1), a1 + hstep, voffA);
            PG8_WAIT_L(8); PG8_BAR; PG8_WAIT_L(0); PG8_MMA(0, 0, At, B0); PG8_BAR; PG8_SCHED;
            PG8_LDB(B1, 0, 1); PG8_STAGE(PG8_SB(0, 0), b2, voffB);
            PG8_BAR; PG8_WAIT_L(0); PG8_MMA(0, 1, At, B1); PG8_BAR;
            PG8_LDA(At, 0, 1); PG8_STAGE(PG8_SA(0, 0), a2, voffA);
            PG8_BAR; PG8_WAIT_L(0); PG8_MMA(1, 0, At, B0); PG8_BAR; PG8_SCHED;
            PG8_STAGE(PG8_SB(0, 1), b2 + hstep, voffB);
            PG8_WAIT_V(6); PG8_BAR; PG8_MMA(1, 1, At, B1); PG8_BAR;
            PG8_LDB(B0, 1, 0); PG8_SCHED; PG8_LDA(At, 1, 0); PG8_STAGE(PG8_SA(0, 1), a2 + hstep, voffA);
            PG8_WAIT_L(8); PG8_BAR; PG8_WAIT_L(0); PG8_MMA(0, 0, At, B0); PG8_BAR; PG8_SCHED;
            PG8_LDB(B1, 1, 1); PG8_STAGE(PG8_SB(1, 0), b3, voffB);
            PG8_BAR; PG8_WAIT_L(0); PG8_MMA(0, 1, At, B1); PG8_BAR;
            PG8_LDA(At, 1, 1); PG8_STAGE(PG8_SA(1, 0), a3, voffA);
            PG8_BAR; PG8_WAIT_L(0); PG8_MMA(1, 0, At, B0); PG8_BAR; PG8_SCHED;
            PG8_STAGE(PG8_SB(1, 1), b3 + hstep, voffB);
            PG8_WAIT_V(6); PG8_BAR; PG8_MMA(1, 1, At, B1); PG8_BAR;
            }
        }
        if constexpr (ALIGN_EPI) { if (wr == 0) PG8_BAR; }
        if constexpr (!Epi::AFTER_DRAIN) { E(acc, cur, wr, wc, fr, fq); S.done(cur); }
        if (!has_next) break;
#pragma unroll
        for (int a = 0; a < 2; ++a)
#pragma unroll
            for (int b = 0; b < 2; ++b)
#pragma unroll
                for (int m = 0; m < 4; ++m)
#pragma unroll
                    for (int n = 0; n < 2; ++n) acc[a][b][m][n] = (f32x4){0.f, 0.f, 0.f, 0.f};
        cur = nxt; cA = nA; cB = nB; ++ui;
        if constexpr (ALIGN_EPI) { if (wr == 1) PG8_BAR; }
    }
    PG8_WAIT_V(0);
    if constexpr (!ALIGN_EPI) { if (wr == 0) PG8_BAR; }
    PG8_BAR;
    if constexpr (Epi::AFTER_DRAIN) { E.fused(acc, cur, wr, wc, fr, fq, lds, wid, lane); S.done(cur); }
#undef PG8_SA
#undef PG8_SB
#undef PG8_STAGE
#undef PG8_LDA
#undef PG8_LDB
#undef PG8_MMA
#undef PG8_WAIT_V
#undef PG8_WAIT_L
#undef PG8_BAR
#undef PG8_SCHED
}
}
constexpr int NWAVES = 8, NTHR = 512;
constexpr int D = 2048, DEPTH = 4, BP = 2, TP = 4096, BS = 32, TS = 8;
constexpr int MP = BP * TP, MS = BS * TS, M = MP + MS, NBB = BP + BS;
constexpr int NINW = 4872, NPROJ = 4864, DFF = 8192, NMOD = 6 * D, PAST = 16384;
constexpr int C_AQ = 0, C_AF = 512, C_AI = 1024, C_AG = 1536, C_PU = 2048, C_CZ = 2560, C_CX = 3072, C_DQ = 4096, C_DK = 4608, C_DV = 4736;
constexpr float EPS = 1e-6f;
enum { I_XP = 0, I_XS, I_CP, I_CS, I_SHG, I_SPOOL, I_SSSM, I_SCONV, I_CK, I_CV, I_N1G, I_N2G, I_WADA, I_BADA, I_WIN, I_LBL, I_HNG, I_PW, I_PSC, I_CW, I_CB, I_DTB, I_ALOG, I_DSK, I_SNG, I_QNG, I_KNG, I_SINK, I_WOUT, I_WUP, I_WDN, N_IN };
constexpr size_t O_Y = 0, O_PHG = (size_t)M * D, O_PPOOL = O_PHG + 4 * 2 * 4 * 16384, O_PSSM = O_PPOOL + 4 * 2 * 15 * 512, O_PCONV = O_PSSM + 4 * 2 * 8 * 8192, O_PK = O_PCONV + 4 * 2 * 3 * 1024,
    O_PV = O_PK + 4 * 2 * 128 * 128, O_SHG = O_PV + 4 * 2 * 128 * 128, O_SPOOL = O_SHG + (size_t)4 * 32 * 4 * 16384, O_SSSM = O_SPOOL + 4 * 32 * 15 * 512, O_SCONV = O_SSSM + (size_t)4 * 32 * 8 * 8192,
    O_SK = O_SCONV + 4 * 32 * 3 * 1024, O_SV = O_SK + 4 * 32 * 128 * 128, O_END = O_SV + 4 * 32 * 128 * 128;
static_assert(O_END == 41046016, "output size");
constexpr size_t MiB = 1u << 20;
constexpr size_t WS_CTL = 0, CTL_ZERO_BYTES = 1 * MiB;
constexpr size_t WS_MOD = 1 * MiB, WS_LB = 8 * MiB, WS_ROPE = 8 * MiB + 65536, WS_DT = 10 * MiB;
constexpr size_t WS_WIN = 16 * MiB, WS_WOUT = 92 * MiB, WS_WUP = 124 * MiB, WS_WDN = 252 * MiB;
constexpr size_t WS_H = 380 * MiB, WS_PROJ = 413 * MiB, WS_MIX = 492 * MiB, WS_U = 525 * MiB;
constexpr size_t WS_HGDS = 657 * MiB, WS_HGSS = 689 * MiB, WS_SDDS = 721 * MiB, WS_SDSS = 753 * MiB, WS_HGDEC = 785 * MiB, WS_SDDEC = 785 * MiB + 524288, WS_PART = 786 * MiB, WS_YTMP = 818 * MiB, WS_WPT = 850 * MiB, WS_END = 851 * MiB;
static_assert(WS_WIN + (size_t)4 * NPROJ * D * 2 <= WS_WOUT && WS_PROJ + (size_t)M * NPROJ * 2 <= WS_MIX && WS_U + (size_t)M * DFF * 2 <= WS_HGDS, "ws map");
constexpr int CW_BAR = 4096, CW_Q = 16384, CQ_CONV = 160;
constexpr int RING_BYTES = 131072, LDSCTL_OFF = RING_BYTES, MISC_OFF = LDSCTL_OFF + 320, PTR_OFF = LDSCTL_OFF + 1024, LDS_BYTES = 147456;
constexpr int PH_PER_LAYER = 9, N_PHASES = 2 + DEPTH * PH_PER_LAYER;
constexpr int NSL_OUT = 8, NSL_DN = 16;
#ifndef MK_ONE_LAUNCH
#define MK_ONE_LAUNCH 1
#endif
#define GAS __attribute__((address_space(1)))
#define LAS __attribute__((address_space(3)))
typedef unsigned short bf16;
typedef unsigned v4u __attribute__((ext_vector_type(4)));
typedef float f32x4 __attribute__((ext_vector_type(4)));
typedef short bf16x8 __attribute__((ext_vector_type(8)));
typedef GAS unsigned gu32;
typedef GAS unsigned long long gu64;
#define RLX_AGENT __ATOMIC_RELAXED, __HIP_MEMORY_SCOPE_AGENT
#define LDS_WAIT() asm volatile("s_waitcnt lgkmcnt(0)" ::: "memory")
#define VM_WAIT() asm volatile("s_waitcnt vmcnt(0)" ::: "memory")
__device__ __forceinline__ unsigned long long rt() { return __builtin_amdgcn_s_memrealtime(); }
__device__ __forceinline__ unsigned f2bf(float f) { unsigned u = __builtin_bit_cast(unsigned, f); return (u + 0x7fffu + ((u >> 16) & 1u)) >> 16; }
__device__ __forceinline__ unsigned pk2(float lo, float hi) { return f2bf(lo) | (f2bf(hi) << 16); }

#define XB_TMO      128
#define XB_XCNT(j)  (256  + 64 * (j))
#define XB_XSUB(j)  (1280 + 64 * (j))
#define XB_XGEN(j)  (2304 + 64 * (j))
#define XB_TOP      3328
#define XB_TOPGEN   3392
#define XCD_BAR_WORDS 3456
#define XB_SPIN_CAP (1u << 18)

__device__ __forceinline__ unsigned xb_ld(unsigned* p)              { return __hip_atomic_load(p, __ATOMIC_RELAXED, __HIP_MEMORY_SCOPE_AGENT); }
__device__ __forceinline__ unsigned xb_add(unsigned* p, unsigned v) { return __hip_atomic_fetch_add(p, v, __ATOMIC_RELAXED, __HIP_MEMORY_SCOPE_AGENT); }
__device__ __forceinline__ unsigned xb_xcc_id() { return (unsigned)__builtin_amdgcn_s_getreg((3 << 11) | 20) & 0xFu; }
#define XB_SPIN(cond, bar) do { unsigned _sp = 0; while (cond) { __builtin_amdgcn_s_sleep(1); \
    if ((++_sp & 255u) == 0u) { if (xb_ld(&(bar)[XB_TMO])) break; if (_sp > XB_SPIN_CAP) { atomicAdd(&(bar)[XB_TMO], 1u); break; } } } } while (0)

struct XcdBarrier {
    unsigned* bar; unsigned x;
    volatile LAS unsigned* st;
};

__device__ __forceinline__ XcdBarrier xcd_barrier_post(unsigned* bar, volatile LAS unsigned* st) {
    XcdBarrier b; b.bar = bar; b.x = xb_xcc_id(); b.st = st;
    if (threadIdx.x == 0) (void)xb_add(&bar[XB_XCNT(b.x)], 1u);
    return b;
}
__device__ __forceinline__ void xcd_barrier_complete(unsigned* bar, unsigned x, unsigned& nloc, unsigned& nx) {
    const unsigned G = gridDim.x * gridDim.y * gridDim.z;
    unsigned sum, cnt, mine, sp = 0u;
    for (;;) {
        sum = 0u; cnt = 0u; mine = 0u;
#pragma unroll
        for (unsigned j = 0; j < 16; ++j) { const unsigned c = xb_ld(&bar[XB_XCNT(j)]); sum += c; cnt += (c > 0u) ? 1u : 0u; mine = (j == x) ? c : mine; }
        if (sum == G) break;
        __builtin_amdgcn_s_sleep(1);
        if ((++sp & 255u) == 0u) { if (xb_ld(&bar[XB_TMO])) break; if (sp > XB_SPIN_CAP) { atomicAdd(&bar[XB_TMO], 1u); break; } }
    }
    nloc = mine > 0u ? mine : 1u; nx = cnt > 0u ? cnt : 1u;
}

__device__ __forceinline__ void xcd_barrier(const XcdBarrier& b) {
    asm volatile("s_waitcnt vmcnt(0)" ::: "memory");
    __syncthreads();
    if (threadIdx.x == 0) {
        unsigned* bar = b.bar;
        __builtin_amdgcn_s_waitcnt(0);
        unsigned nloc = b.st[0], nx = b.st[1];
        if (nloc == 0u) { xcd_barrier_complete(bar, b.x, nloc, nx); b.st[0] = nloc; b.st[1] = nx; }
        const unsigned old = xb_add(&bar[XB_XSUB(b.x)], 1u);
        const unsigned gen = old / nloc;
        if (old + 1u == (gen + 1u) * nloc) {
            __builtin_amdgcn_fence(__ATOMIC_RELEASE, "agent");
            asm volatile("s_waitcnt vmcnt(0)" ::: "memory");
            const unsigned og = xb_add(&bar[XB_TOP], 1u);
            const unsigned tg = og / nx;
            if (og + 1u == (tg + 1u) * nx) xb_add(&bar[XB_TOPGEN], 1u);
            else XB_SPIN(xb_ld(&bar[XB_TOPGEN]) == tg, bar);
            __builtin_amdgcn_fence(__ATOMIC_ACQUIRE, "agent");
            xb_add(&bar[XB_XGEN(b.x)], 1u);
            asm volatile("s_waitcnt vmcnt(0)" ::: "memory");
        } else {
            XB_SPIN(xb_ld(&bar[XB_XGEN(b.x)]) == gen, bar);
            __builtin_amdgcn_fence(__ATOMIC_ACQUIRE, "agent");
            asm volatile("s_waitcnt vmcnt(0)" ::: "memory");
        }
    }
    __syncthreads();
}

struct Frame {
    LAS unsigned char* lds;
    volatile LAS unsigned* MISC;
    gu32* ctl;
    int tid, lane, wave, G, gw, ngw;
    float* out; unsigned char* ws;
};
__device__ __forceinline__ const float* inp(const Frame& F, int i) {
    int off = PTR_OFF + 8 * i; asm volatile("" : "+s"(off));
    const unsigned long long v = *(const LAS unsigned long long*)(F.lds + off);
    const unsigned lo = __builtin_amdgcn_readfirstlane((unsigned)v), hi = __builtin_amdgcn_readfirstlane((unsigned)(v >> 32));
    return (const float*)(((unsigned long long)hi << 32) | lo);
}
__device__ __forceinline__ unsigned char* wsp(const Frame& F, size_t off) { unsigned char* p = F.ws; asm volatile("" : "+s"(p)); return p + off; }
#define INP(i) inp(F, i)
#define WS_LOCALS \
    float* const MOD = (float*)wsp(F, WS_MOD); float* const LBv = (float*)wsp(F, WS_LB); float* const ROPE = (float*)wsp(F, WS_ROPE); float* const DT = (float*)wsp(F, WS_DT); \
    bf16* const Wi = (bf16*)wsp(F, WS_WIN); bf16* const Wo = (bf16*)wsp(F, WS_WOUT); bf16* const Wu = (bf16*)wsp(F, WS_WUP); bf16* const Wd = (bf16*)wsp(F, WS_WDN); \
    bf16* const H = (bf16*)wsp(F, WS_H); bf16* const PROJ = (bf16*)wsp(F, WS_PROJ); bf16* const MIX = (bf16*)wsp(F, WS_MIX); bf16* const U = (bf16*)wsp(F, WS_U); \
    float* const HGDS = (float*)wsp(F, WS_HGDS); float* const HGSS = (float*)wsp(F, WS_HGSS); float* const SDDS = (float*)wsp(F, WS_SDDS); float* const SDSS = (float*)wsp(F, WS_SDSS); \
    float* const HGDEC = (float*)wsp(F, WS_HGDEC); float* const SDDEC = (float*)wsp(F, WS_SDDEC); \
    (void)MOD; (void)LBv; (void)ROPE; (void)DT; (void)Wi; (void)Wo; (void)Wu; (void)Wd; (void)H; (void)PROJ; (void)MIX; (void)U; (void)HGDS; (void)HGSS; (void)SDDS; (void)SDSS; (void)HGDEC; (void)SDDEC;
__device__ __forceinline__ float wave_sum(float v) {
#pragma unroll
    for (int o = 1; o < 64; o <<= 1) v += __shfl_xor(v, o);
    return v;
}
__device__ __forceinline__ float bf2f(bf16 b) { return __builtin_bit_cast(float, (unsigned)b << 16); }
__device__ __forceinline__ float bflo(unsigned w) { return __builtin_bit_cast(float, w << 16); }
__device__ __forceinline__ float bfhi(unsigned w) { return __builtin_bit_cast(float, w & 0xffff0000u); }
__device__ __forceinline__ float sigm(float x) { return 1.f / (1.f + __expf(-x)); }
__device__ __forceinline__ int row_bb(int m) { return m < MP ? (m >> 12) : BP + ((m - MP) >> 3); }
typedef short bf16x8v __attribute__((ext_vector_type(8)));
__device__ __forceinline__ f32x4 mma16(const LAS bf16* A, int lda, const LAS bf16* B, int ldb, int K, f32x4 acc, int lane) {
    const LAS bf16* ap = A + (lane & 15) * lda + 8 * (lane >> 4); const LAS bf16* bp = B + (lane & 15) * ldb + 8 * (lane >> 4);
    for (int k = 0; k < K; k += 32) { const bf16x8v a = *(const LAS bf16x8v*)(ap + k); const bf16x8v b = *(const LAS bf16x8v*)(bp + k); acc = __builtin_amdgcn_mfma_f32_16x16x32_bf16(a, b, acc, 0, 0, 0); }
    return acc;
}
__device__ __forceinline__ bf16 tobf(float f) { return (bf16)f2bf(f); }

__device__ __forceinline__ int deq(Frame& F, int q) {
    __syncthreads();
    if (F.tid == 0) F.MISC[0] = __hip_atomic_fetch_add(F.ctl + CW_Q + 64 * q, 1u, RLX_AGENT);
    __syncthreads();
    return (int)F.MISC[0];
}

__device__ __forceinline__ void p0_transpose_item(const float* W, int K, int ldw, bf16* WT, int k0, int src_n0, int dst_n0, LAS float* scr, int lane) {
    float tv[32];
#pragma unroll
    for (int i = 0; i < 32; ++i) { const int kk = 2 * i + (lane >> 5); tv[i] = W[(size_t)(k0 + kk) * ldw + src_n0 + (lane & 31)]; }
#pragma unroll
    for (int i = 0; i < 32; ++i) { const int kk = 2 * i + (lane >> 5); scr[kk * 33 + (lane & 31)] = tv[i]; }
    LDS_WAIT(); asm volatile("" ::: "memory");
    const int c = lane & 7;
#pragma unroll
    for (int j = 0; j < 4; ++j) { const int n = (lane >> 3) + 8 * j; const LAS float* s = scr + (8 * c) * 33 + n;
        v4u o; o.x = pk2(s[0 * 33], s[1 * 33]); o.y = pk2(s[2 * 33], s[3 * 33]); o.z = pk2(s[4 * 33], s[5 * 33]); o.w = pk2(s[6 * 33], s[7 * 33]);
        *(GAS v4u*)(WT + (size_t)(dst_n0 + n) * K + k0 + 8 * c) = o; }
    LDS_WAIT(); asm volatile("" ::: "memory");
}
__device__ __forceinline__ void p0_adaln(Frame& F) {
    WS_LOCALS
    constexpr int LDC = 520, NITEM = DEPTH * NMOD / 32;
    LAS bf16* cs = (LAS bf16*)F.lds;
    const float* const cpp = INP(I_CP); const float* const csp = INP(I_CS); const float* const wada = INP(I_WADA); const float* const bada = INP(I_BADA);
    const int lane = F.lane, item = (int)blockIdx.x + F.G * F.wave; const bool act = item < NITEM;
    const int l = act ? item / (NMOD / 32) : 0, n0 = act ? (item % (NMOD / 32)) * 32 : 0;
    f32x4 acc[2][3];
#pragma unroll
    for (int a = 0; a < 2; ++a)
#pragma unroll
        for (int r = 0; r < 3; ++r) acc[a][r] = (f32x4){0.f, 0.f, 0.f, 0.f};
    const float* wl = wada + (size_t)l * D * NMOD + n0 + (lane & 15);
    for (int kc = 0; kc < 4; ++kc) {
        __syncthreads();
        for (int e = F.tid; e < 48 * 512; e += NTHR) { const int bb = e >> 9, kk = e & 511; float v = 0.f;
            if (bb < NBB) { const float c = bb < BP ? cpp[bb * D + kc * 512 + kk] : csp[(bb - BP) * D + kc * 512 + kk]; v = c * sigm(c); }
            cs[bb * LDC + kk] = tobf(v); }
        __syncthreads();
        if (act) {
#pragma unroll 2
            for (int ks = 0; ks < 16; ++ks) { const int kg = kc * 512 + ks * 32 + 8 * (lane >> 4);
                float w0[8], w1[8];
#pragma unroll
                for (int j = 0; j < 8; ++j) { w0[j] = wl[(size_t)(kg + j) * NMOD]; w1[j] = wl[(size_t)(kg + j) * NMOD + 16]; }
                v4u b0, b1; b0.x = pg8::cvt_pk_bf16(w0[0], w0[1]); b0.y = pg8::cvt_pk_bf16(w0[2], w0[3]); b0.z = pg8::cvt_pk_bf16(w0[4], w0[5]); b0.w = pg8::cvt_pk_bf16(w0[6], w0[7]);
                b1.x = pg8::cvt_pk_bf16(w1[0], w1[1]); b1.y = pg8::cvt_pk_bf16(w1[2], w1[3]); b1.z = pg8::cvt_pk_bf16(w1[4], w1[5]); b1.w = pg8::cvt_pk_bf16(w1[6], w1[7]);
                const bf16x8v bf0 = __builtin_bit_cast(bf16x8v, b0), bf1 = __builtin_bit_cast(bf16x8v, b1);
#pragma unroll
                for (int r = 0; r < 3; ++r) { const bf16x8v a = *(const LAS bf16x8v*)(cs + (16 * r + (lane & 15)) * LDC + ks * 32 + 8 * (lane >> 4));
                    acc[0][r] = __builtin_amdgcn_mfma_f32_16x16x32_bf16(a, bf0, acc[0][r], 0, 0, 0); acc[1][r] = __builtin_amdgcn_mfma_f32_16x16x32_bf16(a, bf1, acc[1][r], 0, 0, 0); } }
        }
    }
    if (act) {
#pragma unroll
        for (int a = 0; a < 2; ++a) { const int n = n0 + 16 * a + (lane & 15); const float bias = bada[l * NMOD + n];
#pragma unroll
            for (int r = 0; r < 3; ++r)
#pragma unroll
                for (int i = 0; i < 4; ++i) { const int bb = 16 * r + 4 * (lane >> 4) + i; if (bb < NBB) MOD[((size_t)l * NBB + bb) * NMOD + n] = acc[a][r][i] + bias; } }
    }
    __syncthreads();
}
__device__ __forceinline__ void convert_layer(Frame& F, int l, int qid) {
    WS_LOCALS
    LAS float* scr = (LAS float*)(F.lds + F.wave * 16384);
    constexpr int IT_IN = (D / 64) * (NPROJ / 32), IT_OUT = (D / 64) * (D / 32), IT_UP = (D / 64) * (DFF / 32), IT_DN = (DFF / 64) * (D / 32), IT_L = IT_IN + IT_OUT + IT_UP + IT_DN, NBATCH = (IT_L + 15) / 16;
    const float* const win = INP(I_WIN) + (size_t)l * D * NINW; const float* const wout = INP(I_WOUT) + (size_t)l * D * D; const float* const wup = INP(I_WUP) + (size_t)l * D * DFF; const float* const wdn = INP(I_WDN) + (size_t)l * DFF * D;
    int bt;
    while ((bt = deq(F, qid)) < NBATCH) {
#pragma unroll 1
        for (int s = 0; s < 2; ++s) { int r = bt * 16 + s * 8 + F.wave; if (r >= IT_L) continue;
            if (r < IT_IN) { const int nblk = NPROJ / 32, kb = r / nblk, nb = r % nblk, dn0 = 32 * nb, sn0 = dn0 + (dn0 >= 4096 ? 8 : 0);
                p0_transpose_item(win, D, NINW, Wi + (size_t)l * NPROJ * D, 64 * kb, sn0, dn0, scr, F.lane); continue; } r -= IT_IN;
            if (r < IT_OUT) { const int nblk = D / 32, kb = r / nblk, nb = r % nblk;
                p0_transpose_item(wout, D, D, Wo + (size_t)l * D * D, 64 * kb, 32 * nb, 32 * nb, scr, F.lane); continue; } r -= IT_OUT;
            if (r < IT_UP) { const int nblk = DFF / 32, kb = r / nblk, nb = r % nblk;
                p0_transpose_item(wup, D, DFF, Wu + (size_t)l * DFF * D, 64 * kb, 32 * nb, 32 * nb, scr, F.lane); continue; } r -= IT_UP;
            { const int nblk = D / 32, kb = r / nblk, nb = r % nblk;
                p0_transpose_item(wdn, DFF, D, Wd + (size_t)l * D * DFF, 64 * kb, 32 * nb, 32 * nb, scr, F.lane); } }
    }
}
__device__ __forceinline__ void p0_prologue(Frame& F) {
    WS_LOCALS
    const int gt = blockIdx.x * NTHR + F.tid, NT = F.G * NTHR;
    { const f32x4* s = (const f32x4*)INP(I_XP); f32x4* d = (f32x4*)F.out;
      for (int i = gt; i < MP * D / 4; i += NT) d[i] = s[i];
      s = (const f32x4*)INP(I_XS); d = (f32x4*)(F.out + (size_t)MP * D);
      for (int i = gt; i < MS * D / 4; i += NT) d[i] = s[i]; }
    if (gt < 512) { const float* lg = INP(I_LBL); const float a0 = lg[gt], a1 = lg[512 + gt], a2 = lg[1024 + gt], a3 = lg[1536 + gt];
        const float mx = fmaxf(fmaxf(a0, a1), fmaxf(a2, a3)); const float e0 = expf(a0 - mx), e1 = expf(a1 - mx), e2 = expf(a2 - mx), e3 = expf(a3 - mx); const float inv = 1.f / (e0 + e1 + e2 + e3);
        LBv[gt] = 0.f; LBv[512 + gt] = e1 * inv; LBv[1024 + gt] = (e1 + e2) * inv; LBv[1536 + gt] = (e1 + e2 + e3) * inv; }
    for (int e = gt; e < 4104 * 32; e += NT) { const int r = e >> 5, i = e & 31; const int pos = r < 4096 ? r : PAST + (r - 4096);
        const double inv = exp2(-(double)i * (13.287712379549449 / 32.0)); const double rev = (double)pos * inv * 0.15915494309189535;
        const float fr = (float)(rev - floor(rev));
        ROPE[r * 64 + i] = __builtin_amdgcn_cosf(fr); ROPE[r * 64 + 32 + i] = __builtin_amdgcn_sinf(fr); }
    { const float* pw = INP(I_PW); bf16* wpt = (bf16*)wsp(F, WS_WPT);
      for (int e = gt; e < 16 * 16384; e += NT) { const int lg = e >> 14, dd = (e >> 7) & 127, c = e & 127; wpt[e] = (bf16)f2bf(pw[(size_t)lg * 16384 + c * 128 + dd]); } }
    p0_adaln(F);
    convert_layer(F, 0, CQ_CONV);
}

__device__ __forceinline__ void norm_phase(Frame& F, int l, int which, int nsl) {
    WS_LOCALS
    LAS float* wdt = (LAS float*)F.lds;
    if (which == 0) { const float* wsrc = INP(I_WIN) + (size_t)l * D * NINW + 4096;
        for (int e = F.tid; e < D * 8; e += NTHR) { const int d = e >> 3, j = e & 7; wdt[j * D + d] = wsrc[(size_t)d * NINW + j]; }
        __syncthreads(); }
    const f32x4* g4 = (const f32x4*)(INP(which ? I_N2G : I_N1G) + l * D);
    for (int m = F.gw; m < M; m += F.ngw) {
        const int bb = row_bb(m);
        const f32x4* xr = (const f32x4*)(F.out + (size_t)m * D);
        const float* modp = MOD + ((size_t)l * NBB + bb) * NMOD + (which ? 3 * D : 0);
        const f32x4* sh4 = (const f32x4*)modp; const f32x4* sc4 = (const f32x4*)(modp + D);
        f32x4 v[8]; float ss = 0.f;
#pragma unroll
        for (int j = 0; j < 8; ++j) v[j] = xr[64 * j + F.lane];
        if (m >= MP && nsl > 0) { const f32x4* pp = (const f32x4*)wsp(F, WS_PART) + (size_t)(m - MP) * (D / 4);
#pragma unroll 1
            for (int s = 0; s < nsl; ++s) {
#pragma unroll
                for (int j = 0; j < 8; ++j) v[j] = v[j] + pp[(size_t)s * (MS * D / 4) + 64 * j + F.lane]; }
            f32x4* xw = (f32x4*)(F.out + (size_t)m * D);
#pragma unroll
            for (int j = 0; j < 8; ++j) xw[64 * j + F.lane] = v[j]; }
#pragma unroll
        for (int j = 0; j < 8; ++j) ss += (v[j].x * v[j].x + v[j].y * v[j].y) + (v[j].z * v[j].z + v[j].w * v[j].w);
        const float r = 1.f / sqrtf(wave_sum(ss) * (1.f / D) + EPS);
        float dta[8];
#pragma unroll
        for (int j = 0; j < 8; ++j) dta[j] = 0.f;
        GAS unsigned long long* o8 = (GAS unsigned long long*)(H + (size_t)m * D);
#pragma unroll
        for (int j = 0; j < 8; ++j) { const int q = 64 * j + F.lane; const f32x4 g = g4[q], sc = sc4[q], sh = sh4[q];
            f32x4 h; h.x = v[j].x * r * g.x * (1.f + sc.x) + sh.x; h.y = v[j].y * r * g.y * (1.f + sc.y) + sh.y; h.z = v[j].z * r * g.z * (1.f + sc.z) + sh.z; h.w = v[j].w * r * g.w * (1.f + sc.w) + sh.w;
            o8[q] = (unsigned long long)pk2(h.x, h.y) | ((unsigned long long)pk2(h.z, h.w) << 32);
            v[j] = h; }
        if (which == 0) {
#pragma unroll
            for (int jj = 0; jj < 8; ++jj) { float a = 0.f;
#pragma unroll
                for (int j = 0; j < 8; ++j) { const f32x4 w = ((const LAS f32x4*)wdt)[jj * (D / 4) + 64 * j + F.lane]; a += (v[j].x * w.x + v[j].y * w.y) + (v[j].z * w.z + v[j].w * w.w); }
                dta[jj] = wave_sum(a); __builtin_amdgcn_sched_barrier(0); }
            if (F.lane == 0) { f32x4* dp = (f32x4*)(DT + (size_t)m * 8); dp[0] = (f32x4){dta[0], dta[1], dta[2], dta[3]}; dp[1] = (f32x4){dta[4], dta[5], dta[6], dta[7]}; } }
    }
}

__device__ __forceinline__ void final_fix_phase(Frame& F, int nsl) {
    for (int m = MP + F.gw; m < M; m += F.ngw) {
        f32x4* xw = (f32x4*)(F.out + (size_t)m * D); const f32x4* pp = (const f32x4*)wsp(F, WS_PART) + (size_t)(m - MP) * (D / 4);
        f32x4 v[8];
#pragma unroll
        for (int j = 0; j < 8; ++j) v[j] = xw[64 * j + F.lane];
#pragma unroll 1
        for (int s = 0; s < nsl; ++s) {
#pragma unroll
            for (int j = 0; j < 8; ++j) v[j] = v[j] + pp[(size_t)s * (MS * D / 4) + 64 * j + F.lane]; }
#pragma unroll
        for (int j = 0; j < 8; ++j) xw[64 * j + F.lane] = v[j];
    }
}
template <int MODE> __device__ __forceinline__ void ssd_raw(const bf16* PROJ, const float* scv, int l, int b, int m0, int tseq0, int r, int ch, float& a0, float& a1) {
    a0 = 0.f; a1 = 0.f;
    if (MODE == 2) { if (r >= 0) { const unsigned w = *(const unsigned*)(PROJ + (size_t)(m0 + r) * NPROJ + C_CX + ch); a0 = bflo(w); a1 = bfhi(w); }
                     else { const float* sc = scv + ((size_t)(l * BS + b) * 3 + (3 + r)) * 1024 + ch; a0 = sc[0]; a1 = sc[1]; } }
    else if (tseq0 + r >= 0) { const unsigned w = *(const unsigned*)(PROJ + (size_t)(m0 + r) * NPROJ + C_CX + ch); a0 = bflo(w); a1 = bfhi(w); }
}
template <int MODE> __device__ __forceinline__ void ssd_unit(Frame& F, int l, int u) {
    WS_LOCALS
    constexpr int T = (MODE == 2) ? 16 : 64, SK = (MODE == 2) ? 32 : 64, L = (MODE == 2) ? 8 : 64, LDN = 136, LDS_ = SK + 8;
    constexpr int NT_CB = (T / 16) * (SK / 16), NT_Y = (T / 16) * 4;
    const int tid = F.tid, lane = F.lane, wave = F.wave;
    const float* const cwp = INP(I_CW); const float* const cbp = INP(I_CB); const float* const scv = INP(I_SCONV);
    int b, m0, tseq0;
    if (MODE == 2) { b = u; m0 = MP + b * TS; tseq0 = 0; } else { b = u >> 6; m0 = b * TP + (u & 63) * 64; tseq0 = (u & 63) * 64; }
    LAS bf16* Cg = (LAS bf16*)F.lds;
    LAS bf16* Bg = Cg + 64 * LDN;
    LAS bf16* BgT = Bg + 64 * LDN;
    LAS bf16* xT = BgT + 128 * 72;
    LAS bf16* xwT = xT + 64 * 72;
    LAS bf16* Wl = xwT + 64 * 72;
    LAS bf16* Sl = Wl + 64 * 72;
    LAS float* cumL = (LAS float*)(Sl + 64 * LDN);
    LAS float* dtL = cumL + 256;
    LAS float* rowss = dtL + 256;
    float* const ytmp = (float*)wsp(F, WS_YTMP) + (size_t)blockIdx.x * (64 * 512);
    float ssum[4] = {0.f, 0.f, 0.f, 0.f};
    if (tid < 64) rowss[tid] = 0.f;
#pragma unroll 1
    for (int g = 0; g < 2; ++g) {
        __syncthreads();
        {   const int pr = tid & 127, rq = tid >> 7;
            const int isC = pr >> 6, n0 = 2 * (pr & 63), ch = 512 + isC * 256 + g * 128 + n0;
            float w[4][2], bia[2];
#pragma unroll
            for (int j = 0; j < 4; ++j) { w[j][0] = cwp[(l * 4 + j) * 1024 + ch]; w[j][1] = cwp[(l * 4 + j) * 1024 + ch + 1]; }
            bia[0] = cbp[l * 1024 + ch]; bia[1] = cbp[l * 1024 + ch + 1];
            constexpr int RQ = T / 4; const int r0 = rq * RQ;
            float x0[2], x1[2], x2[2];
            ssd_raw<MODE>(PROJ, scv, l, b, m0, tseq0, r0 - 3, ch, x0[0], x0[1]); ssd_raw<MODE>(PROJ, scv, l, b, m0, tseq0, r0 - 2, ch, x1[0], x1[1]); ssd_raw<MODE>(PROJ, scv, l, b, m0, tseq0, r0 - 1, ch, x2[0], x2[1]);
#pragma unroll 2
            for (int i = 0; i < RQ; ++i) { const int r = r0 + i; float n0v = 0.f, n1v = 0.f, c0 = 0.f, c1 = 0.f;
                if (r < L) { ssd_raw<MODE>(PROJ, scv, l, b, m0, tseq0, r, ch, n0v, n1v);
                    c0 = bia[0] + w[0][0] * x0[0] + w[1][0] * x1[0] + w[2][0] * x2[0] + w[3][0] * n0v; c1 = bia[1] + w[0][1] * x0[1] + w[1][1] * x1[1] + w[2][1] * x2[1] + w[3][1] * n1v;
                    c0 = c0 * sigm(c0); c1 = c1 * sigm(c1); }
                x0[0] = x1[0]; x0[1] = x1[1]; x1[0] = x2[0]; x1[1] = x2[1]; x2[0] = n0v; x2[1] = n1v;
                if (isC) { if (MODE != 0) *(LAS unsigned*)(Cg + r * LDN + n0) = pk2(c0, c1); }
                else { if (MODE != 0) *(LAS unsigned*)(Bg + r * LDN + n0) = pk2(c0, c1);
                       if (MODE != 1) { BgT[n0 * LDS_ + r] = tobf(c0); BgT[(n0 + 1) * LDS_ + r] = tobf(c1); } } }
            if (MODE == 2 && !isC) { for (int r = T + rq * 4; r < T + rq * 4 + 4; ++r) { BgT[n0 * LDS_ + r] = 0; BgT[(n0 + 1) * LDS_ + r] = 0; } }
        }
        if (wave < 4) { const int hh = g * 4 + wave; float dtv = 0.f, a = 0.f;
            if (lane < L) { const float raw = DT[(size_t)(m0 + lane) * 8 + hh] + INP(I_DTB)[l * 8 + hh]; dtv = raw > 20.f ? raw : log1pf(__expf(raw)); a = -dtv * __expf(INP(I_ALOG)[l * 8 + hh]); }
#pragma unroll
            for (int o = 1; o < 64; o <<= 1) { const float y = __shfl_up(a, o); if (lane >= o) a += y; }
            cumL[lane * 4 + wave] = a; dtL[lane * 4 + wave] = dtv; }
        __syncthreads();
        f32x4 cb[2]; int cbt[2], cbs[2];
#pragma unroll
        for (int j = 0; j < 2; ++j) { const int id = 2 * wave + j; cbt[j] = id / (SK / 16); cbs[j] = id % (SK / 16); cb[j] = (f32x4){0.f, 0.f, 0.f, 0.f};
            if (MODE != 0 && id < NT_CB) { if (MODE == 2 && cbs[j] > 0) {} else cb[j] = mma16(Cg + cbt[j] * 16 * LDN, LDN, Bg + cbs[j] * 16 * LDN, LDN, 128, cb[j], lane); } }
#pragma unroll 1
        for (int r = 0; r < 4; ++r) {
            const int hh = g * 4 + r;
            __syncthreads();
            {   const int pr = tid & 31, rg = tid >> 5; const int ch = hh * 64 + 2 * pr;
                float w[4][2], bia[2];
#pragma unroll
                for (int j = 0; j < 4; ++j) { w[j][0] = cwp[(l * 4 + j) * 1024 + ch]; w[j][1] = cwp[(l * 4 + j) * 1024 + ch + 1]; }
                bia[0] = cbp[l * 1024 + ch]; bia[1] = cbp[l * 1024 + ch + 1];
                constexpr int RG = SK / 16; const int r0 = rg * RG;
                const float cl = cumL[(L - 1) * 4 + r];
                float x0[2], x1[2], x2[2];
                ssd_raw<MODE>(PROJ, scv, l, b, m0, tseq0, r0 - 3, ch, x0[0], x0[1]); ssd_raw<MODE>(PROJ, scv, l, b, m0, tseq0, r0 - 2, ch, x1[0], x1[1]); ssd_raw<MODE>(PROJ, scv, l, b, m0, tseq0, r0 - 1, ch, x2[0], x2[1]);
#pragma unroll 2
                for (int i = 0; i < RG; ++i) { const int s = r0 + i; float n0v = 0.f, n1v = 0.f, c0 = 0.f, c1 = 0.f, ws = 0.f;
                    if (s < L) { ssd_raw<MODE>(PROJ, scv, l, b, m0, tseq0, s, ch, n0v, n1v);
                        c0 = bia[0] + w[0][0] * x0[0] + w[1][0] * x1[0] + w[2][0] * x2[0] + w[3][0] * n0v; c1 = bia[1] + w[0][1] * x0[1] + w[1][1] * x1[1] + w[2][1] * x2[1] + w[3][1] * n1v;
                        c0 = c0 * sigm(c0); c1 = c1 * sigm(c1); ws = dtL[s * 4 + r] * __expf(cl - cumL[s * 4 + r]); }
                    x0[0] = x1[0]; x0[1] = x1[1]; x1[0] = x2[0]; x1[1] = x2[1]; x2[0] = n0v; x2[1] = n1v;
                    xT[(2 * pr) * LDS_ + s] = tobf(c0); xT[(2 * pr + 1) * LDS_ + s] = tobf(c1);
                    if (MODE != 1) { xwT[(2 * pr) * LDS_ + s] = tobf(c0 * ws); xwT[(2 * pr + 1) * LDS_ + s] = tobf(c1 * ws); } }
            }
            if (MODE != 0) {
                const float* s0 = (MODE == 1 ? SDSS + ((size_t)u * 8 + hh) * 8192 : INP(I_SSSM) + ((size_t)(l * BS + b) * 8 + hh) * 8192);
                for (int e = tid; e < 2048; e += NTHR) { const f32x4 v = ((const f32x4*)s0)[e]; const int p = e >> 5, n4 = (e & 31) * 4;
                    *(LAS unsigned*)(Sl + p * LDN + n4) = pk2(v.x, v.y); *(LAS unsigned*)(Sl + p * LDN + n4 + 2) = pk2(v.z, v.w); }
#pragma unroll
                for (int j = 0; j < 2; ++j) { const int id = 2 * wave + j; if (id < NT_CB) {
#pragma unroll
                    for (int i = 0; i < 4; ++i) { const int t = cbt[j] * 16 + 4 * (lane >> 4) + i, s = cbs[j] * 16 + (lane & 15);
                        float wv = 0.f; if (s <= t && t < L) wv = cb[j][i] * __expf(cumL[t * 4 + r] - cumL[s * 4 + r]) * dtL[s * 4 + r];
                        Wl[t * LDS_ + s] = tobf(wv); } } }
            }
            __syncthreads();
            if (MODE != 0) {
#pragma unroll
                for (int j = 0; j < 2; ++j) { const int id = 2 * wave + j; f32x4 yv = (f32x4){0.f, 0.f, 0.f, 0.f};
                    if (id < NT_Y) { const int ti = id >> 2, pj = id & 3;
                        f32x4 y1 = (f32x4){0.f, 0.f, 0.f, 0.f}, y2 = y1;
                        y1 = mma16(Wl + ti * 16 * LDS_, LDS_, xT + pj * 16 * LDS_, LDS_, SK, y1, lane);
                        y2 = mma16(Cg + ti * 16 * LDN, LDN, Sl + pj * 16 * LDN, LDN, 128, y2, lane);
                        const int p = pj * 16 + (lane & 15); const float dsk = INP(I_DSK)[l * 8 + hh];
#pragma unroll
                        for (int i = 0; i < 4; ++i) { const int t = ti * 16 + 4 * (lane >> 4) + i; float yy = 0.f;
                            if (t < L) { const float xv = bf2f(xT[p * LDS_ + t]); const float z = bf2f(PROJ[(size_t)(m0 + t) * NPROJ + C_CZ + hh * 64 + p]);
                                yy = (y1[i] + __expf(cumL[t * 4 + r]) * y2[i] + dsk * xv) * z * sigm(z); }
                            yv[i] = yy; ssum[i] += yy * yy; if (t < L) ytmp[t * 512 + hh * 64 + p] = yy; } } }
            }
            if (MODE != 1) {
                const float dtot = __expf(cumL[(L - 1) * 4 + r]);
#pragma unroll
                for (int j = 0; j < 4; ++j) { const int pi = wave >> 1, nj = 4 * (wave & 1) + j; f32x4 d = (f32x4){0.f, 0.f, 0.f, 0.f};
                    d = mma16(xwT + pi * 16 * LDS_, LDS_, BgT + nj * 16 * LDS_, LDS_, SK, d, lane);
                    const int n = nj * 16 + (lane & 15);
#pragma unroll
                    for (int i = 0; i < 4; ++i) { const int p = pi * 16 + 4 * (lane >> 4) + i;
                        if (MODE == 0) SDDS[((size_t)u * 8 + hh) * 8192 + p * 128 + n] = d[i];
                        else { const size_t si = ((size_t)(l * BS + b) * 8 + hh) * 8192 + p * 128 + n; F.out[O_SSSM + si] = dtot * INP(I_SSSM)[si] + d[i]; } } }
                if (MODE == 0 && tid == 0) SDDEC[u * 8 + hh] = dtot;
            }
        }
    }
    if (MODE != 0) {
#pragma unroll
        for (int i = 0; i < 4; ++i) { float s = ssum[i]; s += __shfl_xor(s, 1); s += __shfl_xor(s, 2); s += __shfl_xor(s, 4); s += __shfl_xor(s, 8);
            const int id = 2 * wave; if (id < NT_Y && (lane & 15) == 0) __hip_atomic_fetch_add(&rowss[(id >> 2) * 16 + 4 * (lane >> 4) + i], s, __ATOMIC_RELAXED, __HIP_MEMORY_SCOPE_WORKGROUP); }
        __syncthreads();
        const float* ngp = INP(I_SNG) + l * 512;
#pragma unroll
        for (int g = 0; g < 2; ++g)
#pragma unroll
            for (int r = 0; r < 4; ++r)
#pragma unroll
                for (int j = 0; j < 2; ++j) { const int id = 2 * wave + j; if (id < NT_Y) { const int ti = id >> 2, pj = id & 3, chn = (g * 4 + r) * 64 + pj * 16 + (lane & 15); const float ng = ngp[chn];
#pragma unroll
                    for (int i = 0; i < 4; ++i) { const int t = ti * 16 + 4 * (lane >> 4) + i;
                        if (t < L) MIX[(size_t)(m0 + t) * D + 1024 + chn] = tobf(ytmp[t * 512 + chn] * (1.f / sqrtf(rowss[t] * (1.f / 512.f) + EPS)) * ng); } } }
    }
    if (MODE == 0 && (u & 63) == 63) for (int e = tid; e < 3 * 1024; e += NTHR) { const int j = e >> 10, c2 = e & 1023; F.out[O_PCONV + ((size_t)(l * BP + b) * 3 + j) * 1024 + c2] = bf2f(PROJ[(size_t)(m0 + 61 + j) * NPROJ + C_CX + c2]); }
    if (MODE == 2) for (int e = tid; e < 3 * 1024; e += NTHR) { const int j = e >> 10, c2 = e & 1023; F.out[O_SCONV + ((size_t)(l * BS + b) * 3 + j) * 1024 + c2] = bf2f(PROJ[(size_t)(m0 + 5 + j) * NPROJ + C_CX + c2]); }
}
template <int MODE> __device__ __forceinline__ void hgrn_unit(Frame& F, int l, int u) {
    WS_LOCALS
    constexpr int T = (MODE == 2) ? 16 : 64, SK = (MODE == 2) ? 32 : 64, L = (MODE == 2) ? 8 : 64, MID = (MODE == 2) ? 3 : 31, LDN = 136, LDS_ = SK + 8, NI = T / 4;
    constexpr int OFF_QT = T * 512, OFF_KT = OFF_QT + T * 272, OFF_KTT = OFF_KT + T * 272, OFF_VT = OFF_KTT + (MODE == 1 ? 0 : 128 * LDS_ * 2), OFF_S0T = OFF_VT + 128 * LDS_ * 2, OFF_AM = OFF_S0T + (MODE == 0 ? 0 : 128 * 272), OFF_END = OFF_AM + T * LDS_ * 2;
    static_assert(OFF_END <= RING_BYTES, "hgrn LDS map");
    const int tid = F.tid, lane = F.lane, wave = F.wave, d = tid & 127, tq = tid >> 7;
    int h, m0; size_t sidx;
    if (MODE == 2) { const int b = u >> 2; h = u & 3; m0 = MP + b * TS; sidx = ((size_t)(l * BS + b) * 4 + h) * 16384; }
    else { const int bh = u >> 6, c = u & 63, b = bh >> 2; h = bh & 3; m0 = b * TP + c * 64; sidx = (size_t)u * 16384; }
    LAS float* cum = (LAS float*)F.lds;
    LAS bf16* qt = (LAS bf16*)(F.lds + OFF_QT);
    LAS bf16* kt = (LAS bf16*)(F.lds + OFF_KT);
    LAS bf16* ktT = (LAS bf16*)(F.lds + OFF_KTT);
    LAS bf16* vT = (LAS bf16*)(F.lds + OFF_VT);
    LAS bf16* S0T = (LAS bf16*)(F.lds + OFF_S0T);
    LAS bf16* Am = (LAS bf16*)(F.lds + OFF_AM);
    LAS float* refv = (LAS float*)(F.lds + RING_BYTES + 2048);
    LAS float* efin = refv + 128; LAS float* decv = efin + 128; LAS float* erefv = decv + 128; LAS float* rowss = erefv + 128;
    const float* S0g = (MODE == 1 ? HGSS : INP(I_SHG)) + sidx;
    __syncthreads();
    float qv[NI], kv[NI], vv[NI];
    {   const float lbv = LBv[l * 512 + h * 128 + d];
#pragma unroll
        for (int i = 0; i < NI; ++i) { const int t = tq + 4 * i; float lf = 0.f, q = 0.f, k = 0.f, v = 0.f;
            if (t < L) { const bf16* row = PROJ + (size_t)(m0 + t) * NPROJ + h * 128 + d; const float fr = bf2f(row[C_AF]), qr = bf2f(row[C_AQ]); v = bf2f(row[C_AI]);
                const float e = __expf(-fr); const float sg = 1.f / (1.f + e); const float fg = lbv + (1.f - lbv) * sg;
                lf = __logf(fg); k = (1.f - lbv) * (e / (1.f + e)); q = qr * sigm(qr); }
            cum[t * 128 + d] = lf; qv[i] = q; kv[i] = k; vv[i] = v; }
        if (tid < 64) rowss[tid] = 0.f;
    }
    __syncthreads();
    if (tid < 128) { float a = 0.f, rf = 0.f;
#pragma unroll 16
        for (int t = 0; t < L; ++t) { a += cum[t * 128 + tid]; cum[t * 128 + tid] = a; if (t == MID) rf = a; }
        refv[tid] = rf; efin[tid] = __expf(a - rf); decv[tid] = __expf(a); erefv[tid] = __expf(rf); }
    __syncthreads();
    {   const float rf = refv[d];
#pragma unroll
        for (int i = 0; i < NI; ++i) { const int t = tq + 4 * i; const float c = (t < L) ? cum[t * 128 + d] : rf;
            const float qs = qv[i] * __expf(fminf(c - rf, 80.f)), ks = kv[i] * __expf(fminf(rf - c, 80.f));
            if (MODE != 0) { qt[t * LDN + d] = tobf(qs); kt[t * LDN + d] = tobf(ks); }
            if (MODE != 1) ktT[d * LDS_ + t] = tobf(ks);
            vT[d * LDS_ + t] = tobf(vv[i]); }
        if (MODE == 2) {
#pragma unroll
            for (int i = 0; i < NI; ++i) { const int t = 16 + tq + 4 * i; ktT[d * LDS_ + t] = 0; vT[d * LDS_ + t] = 0; } }
    }
    if (MODE != 0) for (int e = tid; e < 4096; e += NTHR) { const f32x4 s = ((const f32x4*)S0g)[e]; const int dd = e >> 5, v4 = (e & 31) * 4; const float er = erefv[dd];
        S0T[(v4) * LDN + dd] = tobf(s.x * er); S0T[(v4 + 1) * LDN + dd] = tobf(s.y * er); S0T[(v4 + 2) * LDN + dd] = tobf(s.z * er); S0T[(v4 + 3) * LDN + dd] = tobf(s.w * er); }
    __syncthreads();
    if (MODE != 0) {
#pragma unroll
        for (int j = 0; j < 2; ++j) { const int id = 2 * wave + j; if (id < (T / 16) * (SK / 16)) { const int ti = id / (SK / 16), si = id % (SK / 16);
            f32x4 a = (f32x4){0.f, 0.f, 0.f, 0.f};
            if (si <= ti && si < T / 16) a = mma16(qt + ti * 16 * LDN, LDN, kt + si * 16 * LDN, LDN, 128, a, lane);
#pragma unroll
            for (int i = 0; i < 4; ++i) { const int t = ti * 16 + 4 * (lane >> 4) + i, s = si * 16 + (lane & 15); Am[t * LDS_ + s] = tobf((s <= t && si <= ti && si < T / 16) ? a[i] : 0.f); } } }
        __syncthreads();
        f32x4 o[4]; float ssum[4] = {0.f, 0.f, 0.f, 0.f};
#pragma unroll
        for (int j = 0; j < 4; ++j) { const int id = 4 * wave + j; o[j] = (f32x4){0.f, 0.f, 0.f, 0.f};
            if (id < (T / 16) * 8) { const int ti = id >> 3, vj = id & 7;
                o[j] = mma16(Am + ti * 16 * LDS_, LDS_, vT + vj * 16 * LDS_, LDS_, SK, o[j], lane);
                o[j] = mma16(qt + ti * 16 * LDN, LDN, S0T + vj * 16 * LDN, LDN, 128, o[j], lane);
#pragma unroll
                for (int i = 0; i < 4; ++i) ssum[i] += o[j][i] * o[j][i]; } }
        if (4 * wave < (T / 16) * 8) {
#pragma unroll
            for (int i = 0; i < 4; ++i) { float s = ssum[i]; s += __shfl_xor(s, 1); s += __shfl_xor(s, 2); s += __shfl_xor(s, 4); s += __shfl_xor(s, 8);
                if ((lane & 15) == 0) __hip_atomic_fetch_add(&rowss[((4 * wave) >> 3) * 16 + 4 * (lane >> 4) + i], s, __ATOMIC_RELAXED, __HIP_MEMORY_SCOPE_WORKGROUP); } }
        __syncthreads();
        const float* ngp = INP(I_HNG) + l * 512 + h * 128;
#pragma unroll
        for (int j = 0; j < 4; ++j) { const int id = 4 * wave + j; if (id < (T / 16) * 8) { const int ti = id >> 3, vj = id & 7, v = vj * 16 + (lane & 15); const float ng = ngp[v];
#pragma unroll
            for (int i = 0; i < 4; ++i) { const int t = ti * 16 + 4 * (lane >> 4) + i;
                if (t < L) { const float gr = bf2f(PROJ[(size_t)(m0 + t) * NPROJ + C_AG + h * 128 + v]);
                    MIX[(size_t)(m0 + t) * D + h * 128 + v] = tobf(o[j][i] * (1.f / sqrtf(rowss[t] * (1.f / 128.f) + EPS)) * ng * sigm(gr)); } } } }
    }
    if (MODE != 1) {
#pragma unroll
        for (int j = 0; j < 8; ++j) { f32x4 a = (f32x4){0.f, 0.f, 0.f, 0.f}; a = mma16(ktT + wave * 16 * LDS_, LDS_, vT + j * 16 * LDS_, LDS_, SK, a, lane);
            const int v = j * 16 + (lane & 15);
#pragma unroll
            for (int i = 0; i < 4; ++i) { const int dd = wave * 16 + 4 * (lane >> 4) + i; const float val = efin[dd] * a[i];
                if (MODE == 0) HGDS[sidx + dd * 128 + v] = val; else F.out[O_SHG + sidx + dd * 128 + v] = decv[dd] * S0g[dd * 128 + v] + val; } }
        if (MODE == 0 && tid < 128) HGDEC[u * 128 + tid] = decv[tid];
    }
}
__device__ __forceinline__ void scan_phase(Frame& F, int l) {
    WS_LOCALS
    const int gt = blockIdx.x * NTHR + F.tid, NT = F.G * NTHR;
    for (int e = gt; e < 131072; e += NT) { const int bh = e >> 14, dv = e & 16383, d = dv >> 7; float S = 0.f;
#pragma unroll 8
        for (int c = 0; c < 64; ++c) { const size_t u = (size_t)bh * 64 + c; HGSS[u * 16384 + dv] = S; S = HGDEC[u * 128 + d] * S + HGDS[u * 16384 + dv]; }
        F.out[O_PHG + ((size_t)l * 8 + bh) * 16384 + dv] = S; }
    for (int e = gt; e < 131072; e += NT) { const int bhh = e >> 13, b = bhh >> 3, hh = bhh & 7, pn = e & 8191; float S = 0.f;
#pragma unroll 8
        for (int c = 0; c < 64; ++c) { const size_t idx = (size_t)(b * 64 + c) * 8 + hh; SDSS[idx * 8192 + pn] = S; S = SDDEC[idx] * S + SDDS[idx * 8192 + pn]; }
        F.out[O_PSSM + ((size_t)(l * BP + b) * 8 + hh) * 8192 + pn] = S; }
}
__device__ __forceinline__ float sq8(v4u w) { const float a0 = bflo(w.x), a1 = bfhi(w.x), a2 = bflo(w.y), a3 = bfhi(w.y), a4 = bflo(w.z), a5 = bfhi(w.z), a6 = bflo(w.w), a7 = bfhi(w.w);
    return ((a0 * a0 + a1 * a1) + (a2 * a2 + a3 * a3)) + ((a4 * a4 + a5 * a5) + (a6 * a6 + a7 * a7)); }
__device__ __forceinline__ float rope1(float x, float rn, float g, float c, float s, int dh) { const float xn = x * rn * g; const float other = __shfl_xor(xn, 1); return dh == 0 ? xn * c - other * s : xn * c + other * s; }
__device__ __forceinline__ v4u rope8(v4u w, float rn, const float* g, const float* rp, int dh) {
    v4u o;
    o.x = pk2(rope1(bflo(w.x), rn, g[0], rp[0], rp[32], dh), rope1(bfhi(w.x), rn, g[1], rp[1], rp[33], dh));
    o.y = pk2(rope1(bflo(w.y), rn, g[2], rp[2], rp[34], dh), rope1(bfhi(w.y), rn, g[3], rp[3], rp[35], dh));
    o.z = pk2(rope1(bflo(w.z), rn, g[4], rp[4], rp[36], dh), rope1(bfhi(w.z), rn, g[5], rp[5], rp[37], dh));
    o.w = pk2(rope1(bflo(w.w), rn, g[6], rp[6], rp[38], dh), rope1(bfhi(w.w), rn, g[7], rp[7], rp[39], dh));
    return o;
}
template <int SAMPLE> __device__ __forceinline__ void attn_unit(Frame& F, int l, int u) {
    WS_LOCALS
    constexpr int LDK = 72, LDV = 200, LDPW = 168;
    const int tid = F.tid, lane = F.lane, wave = F.wave;
    const float* const ckp = INP(I_CK); const float* const cvp = INP(I_CV);
    LAS bf16* Kb = (LAS bf16*)F.lds; LAS bf16* VT = Kb + 192 * LDK; LAS bf16* Qs = VT + 64 * LDV; LAS bf16* Pw = Qs + wave * 16 * LDPW;
    int b, g, q0, row_min; size_t mbase;
    if (SAMPLE) { b = u >> 1; g = u & 1; q0 = 0; row_min = 0; mbase = (size_t)MP + b * TS; }
    else { g = u & 1; const int qt = (u >> 1) & 63; b = u >> 7; q0 = qt * 64; row_min = q0 >= 127 ? 0 : 127 - q0; mbase = (size_t)b * TP; }
    __syncthreads();
    {   const int j8 = tid & 7; const float* kg = INP(I_KNG) + l * 64 + 8 * j8;
        float kgv[8];
#pragma unroll
        for (int e = 0; e < 8; ++e) kgv[e] = kg[e];
        float* const okp = F.out + (SAMPLE ? O_SK : O_PK); float* const ovp = F.out + (SAMPLE ? O_SV : O_PV);
        const size_t ob = SAMPLE ? ((size_t)(l * BS + b) * 128) : ((size_t)(l * BP + b) * 128);
        const int roff = SAMPLE ? 8 : 63; const bool wr_cache = SAMPLE || q0 == TP - 64;
        for (int row = tid >> 3; row < 192; row += 64) {
            float ko[8], vo[8]; bool zero = false;
            if (SAMPLE && row < 128) { const f32x4* kp = (const f32x4*)(ckp + (((size_t)(l * BS + b) * 128 + row) * 2 + g) * 64 + 8 * j8); const f32x4* vp = (const f32x4*)(cvp + (((size_t)(l * BS + b) * 128 + row) * 2 + g) * 64 + 8 * j8);
                const f32x4 k0 = kp[0], k1 = kp[1], v0 = vp[0], v1 = vp[1];
                ko[0] = k0.x; ko[1] = k0.y; ko[2] = k0.z; ko[3] = k0.w; ko[4] = k1.x; ko[5] = k1.y; ko[6] = k1.z; ko[7] = k1.w; vo[0] = v0.x; vo[1] = v0.y; vo[2] = v0.z; vo[3] = v0.w; vo[4] = v1.x; vo[5] = v1.y; vo[6] = v1.z; vo[7] = v1.w; }
            else {
                int t, prow;
                if (SAMPLE) { t = row - 128; prow = 4096 + t; if (row >= 136) zero = true; } else { t = q0 - 127 + row; prow = t; if (t < 0 || row == 191) zero = true; }
                if (zero) {
#pragma unroll
                    for (int e = 0; e < 8; ++e) { ko[e] = 0.f; vo[e] = 0.f; } }
                else {
                    const bf16* pr = PROJ + (mbase + t) * NPROJ;
                    const v4u kw = *(const v4u*)(pr + C_DK + g * 64 + 8 * j8); const v4u vw = *(const v4u*)(pr + C_DV + g * 64 + 8 * j8);
                    float kr[8] = {bflo(kw.x), bfhi(kw.x), bflo(kw.y), bfhi(kw.y), bflo(kw.z), bfhi(kw.z), bflo(kw.w), bfhi(kw.w)};
                    vo[0] = bflo(vw.x); vo[1] = bfhi(vw.x); vo[2] = bflo(vw.y); vo[3] = bfhi(vw.y); vo[4] = bflo(vw.z); vo[5] = bfhi(vw.z); vo[6] = bflo(vw.w); vo[7] = bfhi(vw.w);
                    float ss = 0.f;
#pragma unroll
                    for (int e = 0; e < 8; ++e) ss += kr[e] * kr[e];
                    ss += __shfl_xor(ss, 1); ss += __shfl_xor(ss, 2); ss += __shfl_xor(ss, 4);
                    const float rn = 1.f / sqrtf(ss * (1.f / 64.f) + EPS);
                    const float* rp = ROPE + (size_t)prow * 64 + ((8 * j8) & 31);
#pragma unroll
                    for (int e = 0; e < 8; ++e) { const float kn = kr[e] * rn * kgv[e]; const float other = __shfl_xor(kn, 4); const float c = rp[e], s = rp[32 + e];
                        ko[e] = j8 < 4 ? kn * c - other * s : kn * c + other * s; }
                }
            }
            v4u kp4; kp4.x = pk2(ko[0], ko[1]); kp4.y = pk2(ko[2], ko[3]); kp4.z = pk2(ko[4], ko[5]); kp4.w = pk2(ko[6], ko[7]);
            *(LAS v4u*)(Kb + row * LDK + 8 * j8) = kp4;
#pragma unroll
            for (int e = 0; e < 8; ++e) VT[(8 * j8 + e) * LDV + row] = tobf(vo[e]);
            if (wr_cache && row >= roff && row < roff + 128) { const size_t o = ((ob + (row - roff)) * 2 + g) * 64 + 8 * j8;
                *(f32x4*)(okp + o) = (f32x4){ko[0], ko[1], ko[2], ko[3]}; *(f32x4*)(okp + o + 4) = (f32x4){ko[4], ko[5], ko[6], ko[7]};
                *(f32x4*)(ovp + o) = (f32x4){vo[0], vo[1], vo[2], vo[3]}; *(f32x4*)(ovp + o + 4) = (f32x4){vo[4], vo[5], vo[6], vo[7]}; }
        }
    }
    const bool qwave = !SAMPLE || wave == 0;
    if (qwave) {
        const int dh = lane & 1, qi = (lane >> 1) & 7, r = lane >> 4, head = g * 4 + r;
        const int t = SAMPLE ? qi : q0 + 8 * wave + qi; const int prow = SAMPLE ? 4096 + t : t;
        const v4u* qp = (const v4u*)(PROJ + (mbase + t) * NPROJ + C_DQ + head * 64 + 32 * dh);
        const v4u w0 = qp[0], w1 = qp[1], w2 = qp[2], w3 = qp[3];
        float ss = sq8(w0) + sq8(w1) + sq8(w2) + sq8(w3);
        ss += __shfl_xor(ss, 1);
        const float rn = 0.125f / sqrtf(ss * (1.f / 64.f) + EPS);
        const float* qg = INP(I_QNG) + l * 64 + 32 * dh; const float* rp = ROPE + (size_t)prow * 64;
        LAS v4u* qd = (LAS v4u*)(Qs + (32 * wave + 16 * (r >> 1) + 8 * (r & 1) + qi) * LDK + 32 * dh);
        qd[0] = rope8(w0, rn, qg, rp, dh); qd[1] = rope8(w1, rn, qg + 8, rp + 8, dh); qd[2] = rope8(w2, rn, qg + 16, rp + 16, dh); qd[3] = rope8(w3, rn, qg + 24, rp + 24, dh);
    }
    __syncthreads();
    bf16x8v qf[2][2];
    if (qwave) {
#pragma unroll
        for (int rt = 0; rt < 2; ++rt)
#pragma unroll
            for (int ks = 0; ks < 2; ++ks) qf[rt][ks] = *(const LAS bf16x8v*)(Qs + (32 * wave + 16 * rt + (lane & 15)) * LDK + 32 * ks + 8 * (lane >> 4));
    }
    __syncthreads();
    if (qwave) {
        const int ks0 = SAMPLE ? 0 : (8 * wave < 32 ? 8 * wave : 32);
        const float* skp = INP(I_SINK) + l * 8 + g * 4;
#pragma unroll
        for (int rt = 0; rt < 2; ++rt) {
            f32x4 sc[10]; int kl = ks0 + (lane & 15); asm volatile("" : "+v"(kl));
#pragma unroll
            for (int c = 0; c < 10; ++c) { sc[c] = (f32x4){0.f, 0.f, 0.f, 0.f}; const LAS bf16* kp = Kb + (ks0 + 16 * c + (lane & 15)) * LDK + 8 * (lane >> 4);
                sc[c] = __builtin_amdgcn_mfma_f32_16x16x32_bf16(qf[rt][0], *(const LAS bf16x8v*)kp, sc[c], 0, 0, 0);
                sc[c] = __builtin_amdgcn_mfma_f32_16x16x32_bf16(qf[rt][1], *(const LAS bf16x8v*)(kp + 32), sc[c], 0, 0, 0); }
            float mx[4], sm[4], sinkv[4]; int klo[4]; unsigned span[4];
#pragma unroll
            for (int i = 0; i < 4; ++i) { const int row = 4 * (lane >> 4) + i, qi = row & 7; const int qrow = SAMPLE ? 128 + qi : 127 + 8 * wave + qi;
                sinkv[i] = skp[2 * rt + (row >> 3)]; mx[i] = sinkv[i]; sm[i] = 0.f;
                klo[i] = (qrow - 127) > row_min ? (qrow - 127) : row_min; span[i] = (unsigned)(qrow - klo[i]); }
#pragma unroll
            for (int c = 0; c < 10; ++c) { const int kr = kl + 16 * c;
#pragma unroll
                for (int i = 0; i < 4; ++i) { const float sv = ((unsigned)(kr - klo[i]) <= span[i]) ? sc[c][i] : -INFINITY; sc[c][i] = sv; mx[i] = fmaxf(mx[i], sv); } }
#pragma unroll
            for (int i = 0; i < 4; ++i) { float m = mx[i]; m = fmaxf(m, __shfl_xor(m, 1)); m = fmaxf(m, __shfl_xor(m, 2)); m = fmaxf(m, __shfl_xor(m, 4)); m = fmaxf(m, __shfl_xor(m, 8)); mx[i] = m; }
#pragma unroll
            for (int c = 0; c < 10; ++c) {
#pragma unroll
                for (int i = 0; i < 4; ++i) { const float p = __expf(sc[c][i] - mx[i]); sm[i] += p; Pw[(4 * (lane >> 4) + i) * LDPW + 16 * c + (lane & 15)] = tobf(p); } }
#pragma unroll
            for (int i = 0; i < 4; ++i) { float a = sm[i]; a += __shfl_xor(a, 1); a += __shfl_xor(a, 2); a += __shfl_xor(a, 4); a += __shfl_xor(a, 8); sm[i] = a + __expf(sinkv[i] - mx[i]); }
            asm volatile("s_waitcnt lgkmcnt(0)" ::: "memory");
#pragma unroll
            for (int dj = 0; dj < 4; ++dj) { f32x4 o = (f32x4){0.f, 0.f, 0.f, 0.f};
                o = mma16(Pw, LDPW, VT + dj * 16 * LDV + ks0, LDV, 160, o, lane);
#pragma unroll
                for (int i = 0; i < 4; ++i) { const int row = 4 * (lane >> 4) + i, qi = row & 7, head = g * 4 + 2 * rt + (row >> 3); const int t = SAMPLE ? qi : q0 + 8 * wave + qi;
                    MIX[(mbase + t) * D + 1536 + head * 64 + dj * 16 + (lane & 15)] = tobf(o[i] / sm[i]); } }
            asm volatile("s_waitcnt lgkmcnt(0)" ::: "memory");
        }
    }
}
__device__ __forceinline__ void pool_unit(Frame& F, int l, int u) {
    WS_LOCALS
    const int tid = F.tid, lane = F.lane, wave = F.wave;
    const float* const spp = INP(I_SPOOL);
    LAS bf16* pl = (LAS bf16*)F.lds; constexpr int LDP = 520;
    const bool samp = u >= 128; const int b = samp ? 0 : (u >> 6), t0 = samp ? 0 : (u & 63) * 64; const int s8 = samp ? (u - 128) * 8 : 0;
    const size_t m0 = samp ? (size_t)MP + (size_t)s8 * TS : (size_t)b * TP + t0;
    __syncthreads();
    {   const int pr = tid & 255, half = tid >> 8, c0 = 2 * pr, gi = c0 >> 7, win = 2 << gi;
        if (!samp) {
            const bf16* base = PROJ + ((size_t)b * TP) * NPROJ + C_PU + c0; const int ta = t0 + half * 32;
            float s0 = 0.f, s1 = 0.f;
            for (int j = 1; j < win; ++j) { const int t = ta - j; if (t >= 0) { const unsigned w = *(const unsigned*)(base + (size_t)t * NPROJ); s0 += bflo(w); s1 += bfhi(w); } }
#pragma unroll 4
            for (int i = 0; i < 32; ++i) { const int t = ta + i; const unsigned w = *(const unsigned*)(base + (size_t)t * NPROJ); const float a0 = bflo(w), a1 = bfhi(w); s0 += a0; s1 += a1;
                const float cnt = (float)((t + 1) < win ? (t + 1) : win); const float ic = 1.f / cnt;
                *(LAS unsigned*)(pl + (half * 32 + i) * LDP + c0) = pk2(s0 * ic - a0, s1 * ic - a1);
                const int tl = t - win + 1; if (tl >= 0) { const unsigned wl = *(const unsigned*)(base + (size_t)tl * NPROJ); s0 -= bflo(wl); s1 -= bfhi(wl); } }
        } else {
            for (int i = 0; i < 32; ++i) { const int tt = half * 32 + i, bs = s8 + (tt >> 3), ts = tt & 7; const bf16* base = PROJ + ((size_t)MP + (size_t)bs * TS) * NPROJ + C_PU + c0; const float* buf = spp + ((size_t)(l * BS + bs) * 15) * 512 + c0;
                float s0 = 0.f, s1 = 0.f, a0 = 0.f, a1 = 0.f;
                for (int j = 0; j < win; ++j) { const int e2 = 15 + ts - j; float x0, x1; if (e2 >= 15) { const unsigned w = *(const unsigned*)(base + (size_t)(e2 - 15) * NPROJ); x0 = bflo(w); x1 = bfhi(w); } else { x0 = buf[(size_t)e2 * 512]; x1 = buf[(size_t)e2 * 512 + 1]; }
                    s0 += x0; s1 += x1; if (j == 0) { a0 = x0; a1 = x1; } }
                const float ic = 1.f / (float)win;
                *(LAS unsigned*)(pl + tt * LDP + c0) = pk2(s0 * ic - a0, s1 * ic - a1); }
        }
    }
    __syncthreads();
    {   const int g = wave >> 1; const float* scp = INP(I_PSC) + l * 512 + g * 128;
        const bf16* wpt = (const bf16*)wsp(F, WS_WPT) + (size_t)(l * 4 + g) * 16384;
#pragma unroll 1
        for (int jj = 0; jj < 4; ++jj) { const int vj = 4 * (wave & 1) + jj;
            bf16x8v bfr[4];
#pragma unroll
            for (int k = 0; k < 4; ++k) bfr[k] = *(const bf16x8v*)(wpt + (size_t)(vj * 16 + (lane & 15)) * 128 + k * 32 + 8 * (lane >> 4));
            const int dd = vj * 16 + (lane & 15); const float sc = scp[dd];
#pragma unroll
            for (int ti = 0; ti < 4; ++ti) { f32x4 acc = (f32x4){0.f, 0.f, 0.f, 0.f};
                const LAS bf16* ap = pl + (ti * 16 + (lane & 15)) * LDP + g * 128 + 8 * (lane >> 4);
#pragma unroll
                for (int k = 0; k < 4; ++k) acc = __builtin_amdgcn_mfma_f32_16x16x32_bf16(*(const LAS bf16x8v*)(ap + k * 32), bfr[k], acc, 0, 0, 0);
#pragma unroll
                for (int i = 0; i < 4; ++i) MIX[(m0 + ti * 16 + 4 * (lane >> 4) + i) * D + 512 + g * 128 + dd] = tobf(acc[i] * sc); } }
    }
    if (!samp && t0 == TP - 64) for (int e = tid; e < 15 * 512; e += NTHR) { const int j = e >> 9, ch = e & 511;
        F.out[O_PPOOL + ((size_t)(l * BP + b) * 15 + j) * 512 + ch] = bf2f(PROJ[((size_t)b * TP + TP - 15 + j) * NPROJ + C_PU + ch]); }
    if (samp) for (int e = tid; e < 8 * 15 * 512; e += NTHR) { const int bs = s8 + e / (15 * 512), j = (e / 512) % 15, ch = e & 511;
        F.out[O_SPOOL + ((size_t)(l * BS + bs) * 15 + j) * 512 + ch] = j < 7 ? spp[((size_t)(l * BS + bs) * 15 + 8 + j) * 512 + ch] : bf2f(PROJ[((size_t)MP + (size_t)bs * TS + (j - 7)) * NPROJ + C_PU + ch]); }
}
#ifndef PROBE_MASK
#define PROBE_MASK 0
#endif
#ifndef PROBE_DUP
#define PROBE_DUP 0
#endif
#ifdef PH_SEL
#define PSEL(k, stmt) do { if ((k) == PH_SEL) { stmt; } } while (0)
#else
#define PSEL(k, stmt) do { stmt; } while (0)
#endif
struct Args { const float* in[N_IN]; float* out; unsigned char* ws; int ph_lo, ph_hi; };
static_assert(sizeof(Args) == (N_IN + 2) * 8 + 8, "Args has no padding");
__global__ void __launch_bounds__(NTHR, 2) hymba_fwd(Args args) {
    extern __shared__ __attribute__((aligned(16))) unsigned char lds[];
    Frame F;
    F.lds = (LAS unsigned char*)lds;
    F.MISC = (volatile LAS unsigned*)(F.lds + MISC_OFF);
    F.tid = threadIdx.x; F.lane = F.tid & 63; F.wave = __builtin_amdgcn_readfirstlane(F.tid >> 6);
    F.G = gridDim.x; F.gw = (int)blockIdx.x * NWAVES + F.wave; F.ngw = F.G * NWAVES;
    unsigned char* ws = args.ws; F.ws = ws; F.out = args.out;
    F.ctl = (gu32*)(ws + WS_CTL);
    for (int u = F.tid; u < (LDS_BYTES - LDSCTL_OFF) / 4; u += NTHR) ((LAS unsigned*)(F.lds + LDSCTL_OFF))[u] = 0u;
    __syncthreads();
    if (F.tid < N_IN) ((LAS unsigned long long*)(F.lds + PTR_OFF))[F.tid] = (unsigned long long)args.in[F.tid];
    __syncthreads();
    const int lo = args.ph_lo, hi = args.ph_hi;
    XcdBarrier bar; bar.bar = (unsigned*)(F.ctl + CW_BAR); bar.x = 0; bar.st = nullptr;
    if (hi - lo > 1) bar = xcd_barrier_post((unsigned*)(F.ctl + CW_BAR), F.MISC + 8);
#define IN(k) (lo <= (k) && (k) < hi)
#define LAUNDER(P) asm volatile("" : "+v"(P.tid), "+v"(P.lane), "+s"(P.wave), "+s"(P.gw))
#define UL(bit, q, n, k, call) do { const int nrep_ = ((PROBE_MASK >> (bit)) & 1) ? 2 : 1; int nr_ = nrep_; asm volatile("" : "+s"(nr_)); for (int rr = 0; rr < nr_; ++rr) { Frame Q = F; LAUNDER(Q); while ((u = deq(Q, l * 32 + 16 * rr + (q))) < (n)) PSEL(k, call); } } while (0)
#define PHASE_LOCALS Frame P = F; LAUNDER(P); WS_LOCALS
#define SEAM(k) do { if (IN(k) && IN((k) + 1)) xcd_barrier(bar); } while (0)
    int rp_pro = (PROBE_DUP == 1) ? 2 : 1, rp_mix = (PROBE_DUP == 2) ? 2 : 1, rp_up = (PROBE_DUP == 3) ? 2 : 1; asm volatile("" : "+s"(rp_pro), "+s"(rp_mix), "+s"(rp_up));
    for (int rp = 0; rp < rp_pro; ++rp) { if (IN(0)) { PSEL(0, p0_prologue(F)); } SEAM(0); }
    for (int l = 0; l < DEPTH; ++l) {
        const int pb = 1 + l * PH_PER_LAYER;

        if (IN(pb + 0)) { PHASE_LOCALS  PSEL(1, norm_phase(P, l, 0, l > 0 ? NSL_DN : 0)); } SEAM(pb + 0);
        if (IN(pb + 1)) { PHASE_LOCALS
            pg8::Gemm g{H, Wi + (size_t)l * NPROJ * D, M, NPROJ, D}; pg8::StaticOrder S; S.init(M, NPROJ, D, F.G, (int)blockIdx.x);
            pg8::EpiStoreBf16 E{PROJ, NPROJ, 0};
            PSEL(2, (pg8::gemm_phase<pg8::EpiStoreBf16, pg8::StaticOrder, true, true>(P.lds, g, S, E)));
        } SEAM(pb + 1);
        for (int rp = 0; rp < rp_mix; ++rp) {
        if (IN(pb + 2)) { PHASE_LOCALS
            int u;
            UL(3, 0, 128, 3, ssd_unit<0>(Q, l, u));
            UL(1, 1, 256, 4, attn_unit<0>(Q, l, u));
            UL(3, 2, 512, 5, hgrn_unit<0>(Q, l, u));
            UL(2, 3, 132, 6, pool_unit(Q, l, u));
            UL(3, 4, 32, 7, ssd_unit<2>(Q, l, u));
            UL(1, 5, 64, 8, attn_unit<1>(Q, l, u));
            UL(3, 6, 128, 9, hgrn_unit<2>(Q, l, u));
        } SEAM(pb + 2);
        if (IN(pb + 3)) { PHASE_LOCALS  { int nr_ = ((PROBE_MASK >> 4) & 1) ? 2 : 1; asm volatile("" : "+s"(nr_)); for (int rr = 0; rr < nr_; ++rr) PSEL(10, scan_phase(P, l)); } } SEAM(pb + 3);
        if (IN(pb + 4)) { PHASE_LOCALS
            int u;
            UL(5, 7, 128, 11, ssd_unit<1>(Q, l, u));
            UL(5, 8, 512, 12, hgrn_unit<1>(Q, l, u));
        } SEAM(pb + 4);
        }
        if (IN(pb + 5)) { PHASE_LOCALS
            pg8::Gemm g{MIX, Wo + (size_t)l * D * D, M, D, D}; pg8::SplitOrder S; S.init(MP, D, D, NSL_OUT, F.G, (int)blockIdx.x);
            pg8::EpiGateRes E{F.out, D, MOD + (size_t)l * NBB * NMOD + 2 * D, NMOD, (float*)wsp(F, WS_PART)};
            PSEL(13, (pg8::gemm_phase<pg8::EpiGateRes, pg8::SplitOrder, true, true>(P.lds, g, S, E)));
        } SEAM(pb + 5);
        if (IN(pb + 6)) { PHASE_LOCALS  PSEL(14, norm_phase(P, l, 1, NSL_OUT)); } SEAM(pb + 6);
        for (int rp = 0; rp < rp_up; ++rp) {
        if (IN(pb + 7)) { PHASE_LOCALS
            pg8::Gemm g{H, Wu + (size_t)l * DFF * D, M, DFF, D}; pg8::StaticOrder S; S.init(M, DFF, D, F.G, (int)blockIdx.x);
            pg8::EpiStoreBf16 E{U, DFF, 1};
            PSEL(15, (pg8::gemm_phase<pg8::EpiStoreBf16, pg8::StaticOrder, true, true>(P.lds, g, S, E)));
            if (l + 1 < DEPTH) convert_layer(P, l + 1, CQ_CONV + l + 1);
        } SEAM(pb + 7);
        }
        if (IN(pb + 8)) { PHASE_LOCALS
            pg8::Gemm g{U, Wd + (size_t)l * D * DFF, M, D, DFF}; pg8::SplitOrder S; S.init(MP, D, DFF, NSL_DN, F.G, (int)blockIdx.x);
            pg8::EpiGateRes E{F.out, D, MOD + (size_t)l * NBB * NMOD + 5 * D, NMOD, (float*)wsp(F, WS_PART)};
            PSEL(16, (pg8::gemm_phase<pg8::EpiGateRes, pg8::SplitOrder, true, true>(P.lds, g, S, E)));
        } SEAM(pb + 8);
    }
    if (IN(N_PHASES - 1)) { Frame P = F; LAUNDER(P); final_fix_phase(P, NSL_DN); }
#undef IN
#undef SEAM
}

extern "C" void kernel_launch(void* const* d_in, const int* in_sizes, int n_in, void* d_out, int out_size, void* d_ws, size_t ws_size, hipStream_t stream) {
    static int grid = 0;
    if (grid == 0) {
        if (n_in != N_IN || (size_t)out_size != O_END || ws_size < WS_END) { fprintf(stderr, "kernel_launch: unexpected shapes (n_in %d, out %d, ws %zu); nothing launched\n", n_in, out_size, ws_size); grid = -1; return; }
        int dev = 0, cus = 0, per_cu = 0;
        if (hipGetDevice(&dev) != hipSuccess || hipDeviceGetAttribute(&cus, hipDeviceAttributeMultiprocessorCount, dev) != hipSuccess) { grid = -1; return; }
        if (hipFuncSetAttribute((const void*)hymba_fwd, hipFuncAttributeMaxDynamicSharedMemorySize, LDS_BYTES) != hipSuccess) { fprintf(stderr, "kernel_launch: hipFuncSetAttribute failed\n"); grid = -1; return; }
        if (hipOccupancyMaxActiveBlocksPerMultiprocessor(&per_cu, (const void*)hymba_fwd, NTHR, LDS_BYTES) != hipSuccess || per_cu < 1) { fprintf(stderr, "kernel_launch: occupancy query says %d\n", per_cu); }
        (void)hipGetLastError();
        grid = cus < 256 ? cus : 256;
    }
    if (grid < 0) return;
    if (hipMemsetAsync((char*)d_ws + WS_CTL, 0, CTL_ZERO_BYTES, stream) != hipSuccess) return;
    Args a{};
    for (int i = 0; i < N_IN; ++i) a.in[i] = (const float*)d_in[i];
    a.out = (float*)d_out; a.ws = (unsigned char*)d_ws;
#if MK_ONE_LAUNCH
    a.ph_lo = 0; a.ph_hi = N_PHASES;
    hipLaunchKernelGGL(hymba_fwd, dim3(grid), dim3(NTHR), LDS_BYTES, stream, a);
#else
    for (int k = 0; k < N_PHASES; ++k) { a.ph_lo = k; a.ph_hi = k + 1; hipLaunchKernelGGL(hymba_fwd, dim3(grid), dim3(NTHR), LDS_BYTES, stream, a); }
#endif
}
```

```cpp
#include <hip/hip_runtime.h>
#include <cstdio>
#include <cstdint>
namespace pg8 {
#define PG8_LAS __attribute__((address_space(3)))
#define PG8_GAS __attribute__((address_space(1)))
typedef unsigned short bf16_t;
typedef short bf16x8 __attribute__((ext_vector_type(8)));
typedef float f32x4 __attribute__((ext_vector_type(4)));
typedef unsigned u32x4 __attribute__((ext_vector_type(4)));
constexpr int BM = 256, BK = 64, HALF = 128, HTB = HALF * BK * 2  , STAGE_BYTES = 8 * HTB, NXCD = 8, WGM = 8;

__host__ __device__ __forceinline__ int lds_byte(int r, int c) { const int st = (r >> 4) * 2 + (c >> 5), rr = r & 15, cc = c & 31, ob = rr * 64 + cc * 2; return st * 1024 + (ob ^ (((ob >> 9) & 1) << 5)); }
__host__ __device__ __forceinline__ void stage_rc(int b, int& R, int& C) { const int st = b / 1024, sb = b % 1024, swz = sb ^ (((sb >> 9) & 1) << 5); R = (st >> 1) * 16 + swz / 64; C = (st & 1) * 32 + (swz % 64) / 2; }
__host__ __device__ __forceinline__ int perm32(int rho) { const int n = rho >> 4, i = rho & 15; return 8 * (i >> 2) + 4 * n + (i & 3); }

struct Unit { int pm, pn, k0, nt, at; };
struct Gemm { const PG8_GAS bf16_t* A; const PG8_GAS bf16_t* Bt; int M, N, K; };

struct StaticOrder {
    int nM, nN, nwg, G, c, ntK;
    __host__ __device__ void init(int M, int N, int K, int G_, int c_) { nM = M / BM; nN = N / BM; nwg = nM * nN; G = G_; c = c_; ntK = K / BK; }
    __host__ __device__ bool next(int i, Unit& u) const {
        const long L = (long)i * G + c; if (L >= nwg) return false;
        int wgid = (int)L; { const int q = nwg / NXCD, r = nwg % NXCD, xcd = wgid % NXCD, off = wgid / NXCD; wgid = (xcd < r ? xcd * (q + 1) : r * (q + 1) + (xcd - r) * q) + off; }
        const int nig = WGM * nN, gid = wgid / nig, fm = gid * WGM, gsz = (nM - fm) < WGM ? (nM - fm) : WGM;
        u.pm = fm + ((wgid % nig) % gsz); u.pn = (wgid % nig) / gsz; u.k0 = 0; u.nt = ntK; u.at = 0; return true;
    }
    __device__ __forceinline__ void a_ready(const Unit&) const {}
    __device__ __forceinline__ void done(const Unit&) const {}
};

struct SplitOrder {
    StaticOrder so; int nfull, ntot, pmS, nN, ntS;
    __host__ __device__ void init(int Mfull, int N, int K, int nslice, int G_, int c_) { so.init(Mfull, N, K, G_, c_); nfull = so.nwg; pmS = Mfull / BM; nN = N / BM; ntS = K / BK / nslice; ntot = nfull + nN * nslice; }
    __host__ __device__ bool next(int i, Unit& u) const {
        const long L = (long)i * so.G + so.c; if (L >= ntot) return false;
        if (L < nfull) return so.next(i, u);
        const int j = (int)L - nfull; u.pm = pmS; u.pn = j % nN; u.k0 = (j / nN) * ntS * BK; u.nt = ntS; u.at = 1; return true;
    }
    __device__ __forceinline__ void a_ready(const Unit&) const {}
    __device__ __forceinline__ void done(const Unit&) const {}
};

__device__ __forceinline__ unsigned cvt_pk_bf16(float lo, float hi) { unsigned r; asm volatile("v_cvt_pk_bf16_f32 %0, %1, %2" : "=v"(r) : "v"(lo), "v"(hi)); return r; }
typedef float f32x2 __attribute__((ext_vector_type(2)));
struct EpiStoreBf16 {
    static constexpr bool PERM = true, AFTER_DRAIN = false;
    PG8_GAS bf16_t* O; int ldc; int act;
    __device__ __forceinline__ void operator()(const f32x4 (&acc)[2][2][4][2], const Unit& u, int wr, int wc, int fr, int fq) const {
        const int row0 = u.pm * BM + wr * 64 + fr; const int col0 = u.pn * BM + wc * 32 + 8 * fq;
#pragma unroll
        for (int ai = 0; ai < 2; ++ai)
#pragma unroll
            for (int m = 0; m < 4; ++m) { PG8_GAS bf16_t* rowp = O + (size_t)(row0 + ai * HALF + m * 16) * ldc + col0;
#pragma unroll
                for (int bj = 0; bj < 2; ++bj) { f32x4 v0 = acc[ai][bj][m][0], v1 = acc[ai][bj][m][1];
                    if (act) {
#pragma unroll
                        for (int j = 0; j < 4; ++j) { const float a = v0[j] > 0.f ? v0[j] : 0.f, b = v1[j] > 0.f ? v1[j] : 0.f; v0[j] = a * a; v1[j] = b * b; } }
                    u32x4 w; w.x = cvt_pk_bf16(v0[0], v0[1]); w.y = cvt_pk_bf16(v0[2], v0[3]); w.z = cvt_pk_bf16(v1[0], v1[1]); w.w = cvt_pk_bf16(v1[2], v1[3]);
                    *(PG8_GAS u32x4*)(rowp + bj * HALF) = w; } }
    }
};
struct EpiGateRes {
    static constexpr bool PERM = true, AFTER_DRAIN = false;
    PG8_GAS float* X; int ldc; const PG8_GAS float* gate; int gstride; PG8_GAS float* part;
    __device__ __forceinline__ void operator()(const f32x4 (&acc)[2][2][4][2], const Unit& u, int wr, int wc, int fr, int fq) const {
        const int row0 = u.pm * BM + wr * 64 + fr, col0 = u.pn * BM + wc * 32 + 8 * fq;
        if (!u.at) {
            const int bb = (u.pm * BM) >> 12; const PG8_GAS float* gp = gate + (size_t)bb * gstride + col0;
            f32x4 gv[2][2];
#pragma unroll
            for (int bj = 0; bj < 2; ++bj)
#pragma unroll
                for (int n = 0; n < 2; ++n) gv[bj][n] = *(const PG8_GAS f32x4*)(gp + bj * HALF + n * 4);
#pragma unroll
            for (int ai = 0; ai < 2; ++ai)
#pragma unroll
                for (int m = 0; m < 4; ++m) { PG8_GAS float* rowp = X + (size_t)(row0 + ai * HALF + m * 16) * ldc + col0;
                    f32x4 xv[2][2];
#pragma unroll
                    for (int bj = 0; bj < 2; ++bj)
#pragma unroll
                        for (int n = 0; n < 2; ++n) xv[bj][n] = *(const PG8_GAS f32x4*)(rowp + bj * HALF + n * 4);
#pragma unroll
                    for (int bj = 0; bj < 2; ++bj)
#pragma unroll
                        for (int n = 0; n < 2; ++n) *(PG8_GAS f32x4*)(rowp + bj * HALF + n * 4) = xv[bj][n] + gv[bj][n] * acc[ai][bj][m][n]; }
        } else {
            const int sl = u.k0 / (u.nt * BK);
#pragma unroll
            for (int ai = 0; ai < 2; ++ai)
#pragma unroll
                for (int m = 0; m < 4; ++m) { const int row = row0 + ai * HALF + m * 16; const int bb = 2 + ((row - 8192) >> 3);
                    const PG8_GAS float* gp = gate + (size_t)bb * gstride + col0; PG8_GAS float* pp = part + ((size_t)(sl * BM + (row - 8192)) * ldc + col0);
                    f32x4 gv[2][2];
#pragma unroll
                    for (int bj = 0; bj < 2; ++bj)
#pragma unroll
                        for (int n = 0; n < 2; ++n) gv[bj][n] = *(const PG8_GAS f32x4*)(gp + bj * HALF + n * 4);
#pragma unroll
                    for (int bj = 0; bj < 2; ++bj)
#pragma unroll
                        for (int n = 0; n < 2; ++n) *(PG8_GAS f32x4*)(pp + bj * HALF + n * 4) = gv[bj][n] * acc[ai][bj][m][n]; }
        }
    }
};
template <class Epi, class Sched, bool ALIGN_EPI = false, bool SP2 = false>
__device__ __forceinline__ void gemm_phase(PG8_LAS unsigned char* lds, const Gemm g, const Sched& S, const Epi& E) {
    int tid_ = threadIdx.x; asm volatile("" : "+v"(tid_));
    const int tid = tid_, wid = __builtin_amdgcn_readfirstlane(tid >> 6), lane = tid & 63, wr = wid >> 2, wc = wid & 3, fr = lane & 15, fq = lane >> 4;
    const int K = g.K;
    unsigned voffA[2], voffB[2];
#pragma unroll
    for (int i = 0; i < 2; ++i) { int R, C; stage_rc(tid * 16 + i * 8192, R, C); const int Rb = Epi::PERM ? ((R & ~31) + perm32(R & 31)) : R;
        voffA[i] = (unsigned)(R * K + C) * 2u; voffB[i] = (unsigned)(Rb * K + C) * 2u; }
    const size_t kstep = (size_t)(BK * 2);
    const size_t hstep = (size_t)HALF * K * 2;
    const size_t tstep = 2 * hstep;
    const unsigned ldsw = (unsigned)wid * 1024u;
    const int aoff = lds_byte(wr * 64 + fr, fq * 8), boff = lds_byte(wc * 32 + fr, fq * 8);
#define PG8_SA(b, h) (((b) * 2 + (h)) * HTB)
#define PG8_SB(b, h) ((4 + (b) * 2 + (h)) * HTB)
#define PG8_STAGE(bufoff, gbase, voff) do { _Pragma("unroll") for (int _i = 0; _i < 2; ++_i) \
        __builtin_amdgcn_global_load_lds((const PG8_GAS unsigned*)((const PG8_GAS char*)(gbase) + (voff)[_i]), (PG8_LAS unsigned*)(lds + (bufoff) + ldsw + _i * 8192), 16, 0, 0); } while (0)
#define PG8_LDA(dst, b, h) do { _Pragma("unroll") for (int m = 0; m < 4; ++m) _Pragma("unroll") for (int k = 0; k < 2; ++k) dst[m][k] = *(const PG8_LAS bf16x8*)(lds + PG8_SA(b, h) + aoff + m * 2048 + k * 1024); } while (0)
#define PG8_LDB(dst, b, h) do { _Pragma("unroll") for (int n = 0; n < 2; ++n) _Pragma("unroll") for (int k = 0; k < 2; ++k) dst[n][k] = *(const PG8_LAS bf16x8*)(lds + PG8_SB(b, h) + boff + n * 2048 + k * 1024); } while (0)
#define PG8_MMA(ai, bj, At, Bt) do { __builtin_amdgcn_s_setprio(1); _Pragma("unroll") for (int m = 0; m < 4; ++m) _Pragma("unroll") for (int n = 0; n < 2; ++n) _Pragma("unroll") for (int k = 0; k < 2; ++k) \
        acc[ai][bj][m][n] = __builtin_amdgcn_mfma_f32_16x16x32_bf16(Bt[n][k], At[m][k], acc[ai][bj][m][n], 0, 0, 0); __builtin_amdgcn_s_setprio(0); } while (0)
#define PG8_WAIT_V(n) asm volatile("s_waitcnt vmcnt(" #n ")" ::: "memory")
#define PG8_WAIT_L(n) asm volatile("s_waitcnt lgkmcnt(" #n ")" ::: "memory")
#define PG8_BAR __builtin_amdgcn_s_barrier()
#define PG8_SCHED __builtin_amdgcn_sched_barrier(0)
    Unit cur, nxt; int ui = 0;
    if (!S.next(0, cur)) return;
    f32x4 acc[2][2][4][2];
#pragma unroll
    for (int a = 0; a < 2; ++a)
#pragma unroll
        for (int b = 0; b < 2; ++b)
#pragma unroll
            for (int m = 0; m < 4; ++m)
#pragma unroll
                for (int n = 0; n < 2; ++n) acc[a][b][m][n] = (f32x4){0.f, 0.f, 0.f, 0.f};
    bf16x8 At[4][2], B0[2][2], B1[2][2];
    const PG8_GAS char* cA = (const PG8_GAS char*)g.A + (size_t)cur.pm * tstep + (size_t)cur.k0 * 2; const PG8_GAS char* cB = (const PG8_GAS char*)g.Bt + (size_t)cur.pn * tstep + (size_t)cur.k0 * 2;
    S.a_ready(cur);
    if constexpr (SP2) {
        PG8_STAGE(PG8_SB(0, 0), cB, voffB); PG8_STAGE(PG8_SB(0, 1), cB + hstep, voffB); PG8_STAGE(PG8_SA(0, 0), cA, voffA); PG8_STAGE(PG8_SA(0, 1), cA + hstep, voffA);
        if (wr == 1) PG8_BAR;
        PG8_WAIT_V(2); PG8_BAR;
        PG8_STAGE(PG8_SB(1, 0), cB + kstep, voffB); PG8_STAGE(PG8_SA(1, 0), cA + kstep, voffA); PG8_STAGE(PG8_SB(1, 1), cB + hstep + kstep, voffB);
        PG8_WAIT_V(6); PG8_BAR;
    } else {
        PG8_STAGE(PG8_SB(0, 0), cB, voffB); PG8_STAGE(PG8_SA(0, 0), cA, voffA); PG8_STAGE(PG8_SB(0, 1), cB + hstep, voffB); PG8_STAGE(PG8_SA(0, 1), cA + hstep, voffA);
        if (wr == 1) PG8_BAR;
        PG8_WAIT_V(4); PG8_BAR;
        PG8_STAGE(PG8_SB(1, 0), cB + kstep, voffB); PG8_STAGE(PG8_SA(1, 0), cA + kstep, voffA); PG8_STAGE(PG8_SB(1, 1), cB + hstep + kstep, voffB);
        PG8_WAIT_V(6); PG8_BAR;
    }
    for (;;) {
        const bool has_next = S.next(ui + 1, nxt);
        const PG8_GAS char* nA = has_next ? (const PG8_GAS char*)g.A + (size_t)nxt.pm * tstep + (size_t)nxt.k0 * 2 : cA; const PG8_GAS char* nB = has_next ? (const PG8_GAS char*)g.Bt + (size_t)nxt.pn * tstep + (size_t)nxt.k0 * 2 : cB;
        const int nt = cur.nt;
        for (int t = 0; t < nt; t += 2) {
            const bool last = (t == nt - 2);
            const PG8_GAS char* a1 = cA + (size_t)(t + 1) * kstep;
            const PG8_GAS char* a2 = last ? nA : cA + (size_t)(t + 2) * kstep; const PG8_GAS char* b2 = last ? nB : cB + (size_t)(t + 2) * kstep;
            const PG8_GAS char* a3 = a2 + kstep; const PG8_GAS char* b3 = b2 + kstep;
            if (last && has_next) S.a_ready(nxt);
            if constexpr (SP2) {
            PG8_LDB(B0, 0, 0); PG8_LDB(B1, 0, 1); PG8_SCHED; PG8_LDA(At, 0, 0); PG8_STAGE(PG8_SA(1, 1), a1 + hstep, voffA);
            PG8_WAIT_V(8); PG8_WAIT_L(0); PG8_BAR; PG8_MMA(0, 0, At, B0); PG8_MMA(0, 1, At, B1); PG8_BAR; PG8_SCHED;
            PG8_LDA(At, 0, 1); PG8_STAGE(PG8_SB(0, 0), b2, voffB); PG8_STAGE(PG8_SB(0, 1), b2 + hstep, voffB); PG8_STAGE(PG8_SA(0, 0), a2, voffA);
            PG8_WAIT_V(8); PG8_WAIT_L(0); PG8_BAR; PG8_MMA(1, 0, At, B0); PG8_MMA(1, 1, At, B1); PG8_BAR; PG8_SCHED;
            PG8_LDB(B0, 1, 0); PG8_LDB(B1, 1, 1); PG8_SCHED; PG8_LDA(At, 1, 0); PG8_STAGE(PG8_SA(0, 1), a2 + hstep, voffA);
            PG8_WAIT_V(8); PG8_WAIT_L(0); PG8_BAR; PG8_MMA(0, 0, At, B0); PG8_MMA(0, 1, At, B1); PG8_BAR; PG8_SCHED;
            PG8_LDA(At, 1, 1); PG8_STAGE(PG8_SB(1, 0), b3, voffB); PG8_STAGE(PG8_SB(1, 1), b3 + hstep, voffB); PG8_STAGE(PG8_SA(1, 0), a3, voffA);
            PG8_WAIT_V(8); PG8_WAIT_L(0); PG8_BAR; PG8_MMA(1, 0, At, B0); PG8_MMA(1, 1, At, B1); PG8_BAR; PG8_SCHED;
            } else {
            PG8_LDB(B0, 0, 0); PG8_SCHED; PG8_LDA(At, 0, 0); PG8_STAGE(PG8_SA(1, 1), a1 + hstep, voffA);
            PG8_WAIT_L(8); PG8_BAR; PG8_WAIT_L(0); PG8_MMA(0, 0, At, B0); PG8_BAR; PG8_SCHED;
            PG8_LDB(B1, 0, 1); PG8_STAGE(PG8_SB(0, 0), b2, voffB);
            PG8_BAR; PG8_WAIT_L(0); PG8_MMA(0, 1, At, B1); PG8_BAR;
            PG8_LDA(At, 0, 1); PG8_STAGE(PG8_SA(0, 0), a2, voffA);
            PG8_BAR; PG8_WAIT_L(0); PG8_MMA(1, 0, At, B0); PG8_BAR; PG8_SCHED;
            PG8_STAGE(PG8_SB(0, 1), b2 + hstep, voffB);
            PG8_WAIT_V(6); PG8_BAR; PG8_MMA(1, 1, At, B1); PG8_BAR;
            PG8_LDB(B0, 1, 0); PG8_SCHED; PG8_LDA(At, 1, 0); PG8_STAGE(PG8_SA(0, 1), a2 + hstep, voffA);
            PG8_WAIT_L(8); PG8_BAR; PG8_WAIT_L(0); PG8_MMA(0, 0, At, B0); PG8_BAR; PG8_SCHED;
            PG8_LDB(B1, 1, 1); PG8_STAGE(PG8_SB(1, 0), b3, voffB);
            PG8_BAR; PG8_WAIT_L(0); PG8_MMA(0, 1, At, B1); PG8_BAR;
            PG8_LDA(At, 1, 1); PG8_STAGE(PG8_SA(1, 0), a3, voffA);
            PG8_BAR; PG8_WAIT_L(0); PG8_MMA(1, 0, At, B0); PG8_BAR; PG8_SCHED;
            PG8_STAGE(PG8_SB(1, 1), b3 + hstep, voffB);
            PG8_WAIT_V(6); PG8_BAR; PG8_MMA(1, 1, At, B1); PG8_BAR;
            }
        }
        if constexpr (ALIGN_EPI) { if (wr == 0) PG8_BAR; }
        if constexpr (!Epi::AFTER_DRAIN) { E(acc, cur, wr, wc, fr, fq); S.done(cur); }
        if (!has_next) break;
#pragma unroll
        for (int a = 0; a < 2; ++a)
#pragma unroll
            for (int b = 0; b < 2; ++b)
#pragma unroll
                for (int m = 0; m < 4; ++m)
#pragma unroll
                    for (int n = 0; n < 2; ++n) acc[a][b][m][n] = (f32x4){0.f, 0.f, 0.f, 0.f};
        cur = nxt; cA = nA; cB = nB; ++ui;
        if constexpr (ALIGN_EPI) { if (wr == 1) PG8_BAR; }
    }
    PG8_WAIT_V(0);
    if constexpr (!ALIGN_EPI) { if (wr == 0) PG8_BAR; }
    PG8_BAR;
    if constexpr (Epi::AFTER_DRAIN) { E.fused(acc, cur, wr, wc, fr, fq, lds, wid, lane); S.done(cur); }
#undef PG8_SA
#undef PG8_SB
#undef PG8_STAGE
#undef PG8_LDA
#undef PG8_LDB
#undef PG8_MMA
#undef PG8_WAIT_V
#undef PG8_WAIT_L
#undef PG8_BAR
#undef PG8_SCHED
}
}
constexpr int NWAVES = 8, NTHR = 512;
constexpr int D = 2048, DEPTH = 4, BP = 2, TP = 4096, BS = 32, TS = 8;
constexpr int MP = BP * TP, MS = BS * TS, M = MP + MS, NBB = BP + BS;
constexpr int NINW = 4872, NPROJ = 4864, DFF = 8192, NMOD = 6 * D, PAST = 16384;
constexpr int C_AQ = 0, C_AF = 512, C_AI = 1024, C_AG = 1536, C_PU = 2048, C_CZ = 2560, C_CX = 3072, C_DQ = 4096, C_DK = 4608, C_DV = 4736;
constexpr float EPS = 1e-6f;
enum { I_XP = 0, I_XS, I_CP, I_CS, I_SHG, I_SPOOL, I_SSSM, I_SCONV, I_CK, I_CV, I_N1G, I_N2G, I_WADA, I_BADA, I_WIN, I_LBL, I_HNG, I_PW, I_PSC, I_CW, I_CB, I_DTB, I_ALOG, I_DSK, I_SNG, I_QNG, I_KNG, I_SINK, I_WOUT, I_WUP, I_WDN, N_IN };
constexpr size_t O_Y = 0, O_PHG = (size_t)M * D, O_PPOOL = O_PHG + 4 * 2 * 4 * 16384, O_PSSM = O_PPOOL + 4 * 2 * 15 * 512, O_PCONV = O_PSSM + 4 * 2 * 8 * 8192, O_PK = O_PCONV + 4 * 2 * 3 * 1024,
    O_PV = O_PK + 4 * 2 * 128 * 128, O_SHG = O_PV + 4 * 2 * 128 * 128, O_SPOOL = O_SHG + (size_t)4 * 32 * 4 * 16384, O_SSSM = O_SPOOL + 4 * 32 * 15 * 512, O_SCONV = O_SSSM + (size_t)4 * 32 * 8 * 8192,
    O_SK = O_SCONV + 4 * 32 * 3 * 1024, O_SV = O_SK + 4 * 32 * 128 * 128, O_END = O_SV + 4 * 32 * 128 * 128;
static_assert(O_END == 41046016, "output size");
constexpr size_t MiB = 1u << 20;
constexpr size_t WS_CTL = 0, CTL_ZERO_BYTES = 1 * MiB;
constexpr size_t WS_MOD = 1 * MiB, WS_LB = 8 * MiB, WS_ROPE = 8 * MiB + 65536, WS_DT = 10 * MiB;
constexpr size_t WS_WIN = 16 * MiB, WS_WOUT = 92 * MiB, WS_WUP = 124 * MiB, WS_WDN = 252 * MiB;
constexpr size_t WS_H = 380 * MiB, WS_PROJ = 413 * MiB, WS_MIX = 492 * MiB, WS_U = 525 * MiB;
constexpr size_t WS_HGDS = 657 * MiB, WS_HGSS = 689 * MiB, WS_SDDS = 721 * MiB, WS_SDSS = 753 * MiB, WS_HGDEC = 785 * MiB, WS_SDDEC = 785 * MiB + 524288, WS_PART = 786 * MiB, WS_YTMP = 818 * MiB, WS_WPT = 850 * MiB, WS_WDT = 850 * MiB + 524288, WS_END = 851 * MiB;
static_assert(WS_WIN + (size_t)4 * NPROJ * D * 2 <= WS_WOUT && WS_PROJ + (size_t)M * NPROJ * 2 <= WS_MIX && WS_U + (size_t)M * DFF * 2 <= WS_HGDS, "ws map");
constexpr int CW_BAR = 4096, CW_Q = 16384, CQ_CONV = 160;
constexpr int RING_BYTES = 131072, LDSCTL_OFF = RING_BYTES, MISC_OFF = LDSCTL_OFF + 320, PTR_OFF = LDSCTL_OFF + 1024, LDS_BYTES = 147456;
constexpr int PH_PER_LAYER = 9, N_PHASES = 2 + DEPTH * PH_PER_LAYER;
constexpr int NSL_OUT = 8, NSL_DN = 16;
#ifndef MK_ONE_LAUNCH
#define MK_ONE_LAUNCH 1
#endif
#define GAS __attribute__((address_space(1)))
#define LAS __attribute__((address_space(3)))
typedef unsigned short bf16;
typedef unsigned v4u __attribute__((ext_vector_type(4)));
typedef float f32x4 __attribute__((ext_vector_type(4)));
typedef short bf16x8 __attribute__((ext_vector_type(8)));
typedef GAS unsigned gu32;
typedef GAS unsigned long long gu64;
#define RLX_AGENT __ATOMIC_RELAXED, __HIP_MEMORY_SCOPE_AGENT
#define LDS_WAIT() asm volatile("s_waitcnt lgkmcnt(0)" ::: "memory")
#define VM_WAIT() asm volatile("s_waitcnt vmcnt(0)" ::: "memory")
__device__ __forceinline__ unsigned long long rt() { return __builtin_amdgcn_s_memrealtime(); }
__device__ __forceinline__ unsigned f2bf(float f) { unsigned u = __builtin_bit_cast(unsigned, f); return (u + 0x7fffu + ((u >> 16) & 1u)) >> 16; }
__device__ __forceinline__ unsigned pk2(float lo, float hi) { return f2bf(lo) | (f2bf(hi) << 16); }

#define XB_TMO      128
#define XB_XCNT(j)  (256  + 64 * (j))
#define XB_XSUB(j)  (1280 + 64 * (j))
#define XB_XGEN(j)  (2304 + 64 * (j))
#define XB_TOP      3328
#define XB_TOPGEN   3392
#define XCD_BAR_WORDS 3456
#define XB_SPIN_CAP (1u << 18)

__device__ __forceinline__ unsigned xb_ld(unsigned* p)              { return __hip_atomic_load(p, __ATOMIC_RELAXED, __HIP_MEMORY_SCOPE_AGENT); }
__device__ __forceinline__ unsigned xb_add(unsigned* p, unsigned v) { return __hip_atomic_fetch_add(p, v, __ATOMIC_RELAXED, __HIP_MEMORY_SCOPE_AGENT); }
__device__ __forceinline__ unsigned xb_xcc_id() { return (unsigned)__builtin_amdgcn_s_getreg((3 << 11) | 20) & 0xFu; }
#define XB_SPIN(cond, bar) do { unsigned _sp = 0; while (cond) { __builtin_amdgcn_s_sleep(1); \
    if ((++_sp & 255u) == 0u) { if (xb_ld(&(bar)[XB_TMO])) break; if (_sp > XB_SPIN_CAP) { atomicAdd(&(bar)[XB_TMO], 1u); break; } } } } while (0)

struct XcdBarrier {
    unsigned* bar; unsigned x;
    volatile LAS unsigned* st;
};

__device__ __forceinline__ XcdBarrier xcd_barrier_post(unsigned* bar, volatile LAS unsigned* st) {
    XcdBarrier b; b.bar = bar; b.x = xb_xcc_id(); b.st = st;
    if (threadIdx.x == 0) (void)xb_add(&bar[XB_XCNT(b.x)], 1u);
    return b;
}
__device__ __forceinline__ void xcd_barrier_complete(unsigned* bar, unsigned x, unsigned& nloc, unsigned& nx) {
    const unsigned G = gridDim.x * gridDim.y * gridDim.z;
    unsigned sum, cnt, mine, sp = 0u;
    for (;;) {
        sum = 0u; cnt = 0u; mine = 0u;
#pragma unroll
        for (unsigned j = 0; j < 16; ++j) { const unsigned c = xb_ld(&bar[XB_XCNT(j)]); sum += c; cnt += (c > 0u) ? 1u : 0u; mine = (j == x) ? c : mine; }
        if (sum == G) break;
        __builtin_amdgcn_s_sleep(1);
        if ((++sp & 255u) == 0u) { if (xb_ld(&bar[XB_TMO])) break; if (sp > XB_SPIN_CAP) { atomicAdd(&bar[XB_TMO], 1u); break; } }
    }
    nloc = mine > 0u ? mine : 1u; nx = cnt > 0u ? cnt : 1u;
}

__device__ __forceinline__ void xcd_barrier(const XcdBarrier& b) {
    asm volatile("s_waitcnt vmcnt(0)" ::: "memory");
    __syncthreads();
    if (threadIdx.x == 0) {
        unsigned* bar = b.bar;
        __builtin_amdgcn_s_waitcnt(0);
        unsigned nloc = b.st[0], nx = b.st[1];
        if (nloc == 0u) { xcd_barrier_complete(bar, b.x, nloc, nx); b.st[0] = nloc; b.st[1] = nx; }
        const unsigned old = xb_add(&bar[XB_XSUB(b.x)], 1u);
        const unsigned gen = old / nloc;
        if (old + 1u == (gen + 1u) * nloc) {
            __builtin_amdgcn_fence(__ATOMIC_RELEASE, "agent");
            asm volatile("s_waitcnt vmcnt(0)" ::: "memory");
            const unsigned og = xb_add(&bar[XB_TOP], 1u);
            const unsigned tg = og / nx;
            if (og + 1u == (tg + 1u) * nx) xb_add(&bar[XB_TOPGEN], 1u);
            else XB_SPIN(xb_ld(&bar[XB_TOPGEN]) == tg, bar);
            __builtin_amdgcn_fence(__ATOMIC_ACQUIRE, "agent");
            xb_add(&bar[XB_XGEN(b.x)], 1u);
            asm volatile("s_waitcnt vmcnt(0)" ::: "memory");
        } else {
            XB_SPIN(xb_ld(&bar[XB_XGEN(b.x)]) == gen, bar);
            __builtin_amdgcn_fence(__ATOMIC_ACQUIRE, "agent");
            asm volatile("s_waitcnt vmcnt(0)" ::: "memory");
        }
    }
    __syncthreads();
}

struct Frame {
    LAS unsigned char* lds;
    volatile LAS unsigned* MISC;
    gu32* ctl;
    int tid, lane, wave, G, gw, ngw;
    GAS float* out; GAS unsigned char* ws;
};
__device__ __forceinline__ const GAS float* inp(const Frame& F, int i) {
    int off = PTR_OFF + 8 * i; asm volatile("" : "+s"(off));
    const unsigned long long v = *(const LAS unsigned long long*)(F.lds + off);
    const unsigned lo = __builtin_amdgcn_readfirstlane((unsigned)v), hi = __builtin_amdgcn_readfirstlane((unsigned)(v >> 32));
    return (const GAS float*)(((unsigned long long)hi << 32) | lo);
}
__device__ __forceinline__ GAS unsigned char* wsp(const Frame& F, size_t off) { GAS unsigned char* p = F.ws; asm volatile("" : "+s"(p)); return p + off; }
#define INP(i) inp(F, i)
#define WS_LOCALS \
    GAS float* const MOD = (GAS float*)wsp(F, WS_MOD); GAS float* const LBv = (GAS float*)wsp(F, WS_LB); GAS float* const ROPE = (GAS float*)wsp(F, WS_ROPE); GAS float* const DT = (GAS float*)wsp(F, WS_DT); \
    GAS bf16* const Wi = (GAS bf16*)wsp(F, WS_WIN); GAS bf16* const Wo = (GAS bf16*)wsp(F, WS_WOUT); GAS bf16* const Wu = (GAS bf16*)wsp(F, WS_WUP); GAS bf16* const Wd = (GAS bf16*)wsp(F, WS_WDN); \
    GAS bf16* const H = (GAS bf16*)wsp(F, WS_H); GAS bf16* const PROJ = (GAS bf16*)wsp(F, WS_PROJ); GAS bf16* const MIX = (GAS bf16*)wsp(F, WS_MIX); GAS bf16* const U = (GAS bf16*)wsp(F, WS_U); \
    GAS float* const HGDS = (GAS float*)wsp(F, WS_HGDS); GAS float* const HGSS = (GAS float*)wsp(F, WS_HGSS); GAS float* const SDDS = (GAS float*)wsp(F, WS_SDDS); GAS float* const SDSS = (GAS float*)wsp(F, WS_SDSS); \
    GAS float* const HGDEC = (GAS float*)wsp(F, WS_HGDEC); GAS float* const SDDEC = (GAS float*)wsp(F, WS_SDDEC); \
    (void)MOD; (void)LBv; (void)ROPE; (void)DT; (void)Wi; (void)Wo; (void)Wu; (void)Wd; (void)H; (void)PROJ; (void)MIX; (void)U; (void)HGDS; (void)HGSS; (void)SDDS; (void)SDSS; (void)HGDEC; (void)SDDEC;
__device__ __forceinline__ float wave_sum(float v) {
#pragma unroll
    for (int o = 1; o < 64; o <<= 1) v += __shfl_xor(v, o);
    return v;
}
__device__ __forceinline__ float bf2f(bf16 b) { return __builtin_bit_cast(float, (unsigned)b << 16); }
__device__ __forceinline__ float bflo(unsigned w) { return __builtin_bit_cast(float, w << 16); }
__device__ __forceinline__ float bfhi(unsigned w) { return __builtin_bit_cast(float, w & 0xffff0000u); }
__device__ __forceinline__ float sigm(float x) { return __builtin_amdgcn_rcpf(1.f + __expf(-x)); }
__device__ __forceinline__ float rsq(float x) { return __builtin_amdgcn_rsqf(x); }
__device__ __forceinline__ int row_bb(int m) { return m < MP ? (m >> 12) : BP + ((m - MP) >> 3); }
typedef short bf16x8v __attribute__((ext_vector_type(8)));
__device__ __forceinline__ f32x4 mma16(const LAS bf16* A, int lda, const LAS bf16* B, int ldb, int K, f32x4 acc, int lane) {
    const LAS bf16* ap = A + (lane & 15) * lda + 8 * (lane >> 4); const LAS bf16* bp = B + (lane & 15) * ldb + 8 * (lane >> 4);
    for (int k = 0; k < K; k += 32) { const bf16x8v a = *(const LAS bf16x8v*)(ap + k); const bf16x8v b = *(const LAS bf16x8v*)(bp + k); acc = __builtin_amdgcn_mfma_f32_16x16x32_bf16(a, b, acc, 0, 0, 0); }
    return acc;
}
__device__ __forceinline__ bf16 tobf(float f) { return (bf16)f2bf(f); }

#ifndef UT_MASK
#define UT_MASK 0
#endif
#define UTS(bit) do { if ((UT_MASK >> (bit)) & 1) { if (F.tid == 0) { const unsigned long long t_ = __builtin_amdgcn_s_memrealtime(); F.MISC[18] = (unsigned)t_; F.MISC[19] = (unsigned)(t_ >> 32); } } } while (0)
#define UTE(bit) do { if ((UT_MASK >> (bit)) & 1) { if (F.tid == 0) { const unsigned long long t0_ = ((unsigned long long)F.MISC[19] << 32) | F.MISC[18]; const unsigned long long a_ = (((unsigned long long)F.MISC[17] << 32) | F.MISC[16]) + (__builtin_amdgcn_s_memrealtime() - t0_); F.MISC[16] = (unsigned)a_; F.MISC[17] = (unsigned)(a_ >> 32); } } } while (0)
__device__ __forceinline__ int deq(Frame& F, int q) {
    __syncthreads();
    if (F.tid == 0) F.MISC[0] = __hip_atomic_fetch_add(F.ctl + CW_Q + 64 * q, 1u, RLX_AGENT);
    __syncthreads();
    return (int)F.MISC[0];
}

__device__ __forceinline__ void p0_transpose_item(const GAS float* W, int K, int ldw, GAS bf16* WT, int k0, int src_n0, int dst_n0, LAS float* scr, int lane) {
    float tv[32];
#pragma unroll
    for (int i = 0; i < 32; ++i) { const int kk = 2 * i + (lane >> 5); tv[i] = W[(size_t)(k0 + kk) * ldw + src_n0 + (lane & 31)]; }
#pragma unroll
    for (int i = 0; i < 32; ++i) { const int kk = 2 * i + (lane >> 5); scr[kk * 33 + (lane & 31)] = tv[i]; }
    LDS_WAIT(); asm volatile("" ::: "memory");
    const int c = lane & 7;
#pragma unroll
    for (int j = 0; j < 4; ++j) { const int n = (lane >> 3) + 8 * j; const LAS float* s = scr + (8 * c) * 33 + n;
        v4u o; o.x = pk2(s[0 * 33], s[1 * 33]); o.y = pk2(s[2 * 33], s[3 * 33]); o.z = pk2(s[4 * 33], s[5 * 33]); o.w = pk2(s[6 * 33], s[7 * 33]);
        *(GAS v4u*)(WT + (size_t)(dst_n0 + n) * K + k0 + 8 * c) = o; }
    LDS_WAIT(); asm volatile("" ::: "memory");
}
__device__ __forceinline__ void p0_adaln(Frame& F) {
    WS_LOCALS
    constexpr int LDC = 520, NITEM = DEPTH * NMOD / 32;
    LAS bf16* cs = (LAS bf16*)F.lds;
    const GAS float* const cpp = INP(I_CP); const GAS float* const csp = INP(I_CS); const GAS float* const wada = INP(I_WADA); const GAS float* const bada = INP(I_BADA);
    const int lane = F.lane, item = (int)blockIdx.x + F.G * F.wave; const bool act = item < NITEM;
    const int l = act ? item / (NMOD / 32) : 0, n0 = act ? (item % (NMOD / 32)) * 32 : 0;
    f32x4 acc[2][3];
#pragma unroll
    for (int a = 0; a < 2; ++a)
#pragma unroll
        for (int r = 0; r < 3; ++r) acc[a][r] = (f32x4){0.f, 0.f, 0.f, 0.f};
    const GAS float* wl = wada + (size_t)l * D * NMOD + n0 + (lane & 15);
    for (int kc = 0; kc < 4; ++kc) {
        __syncthreads();
        for (int e = F.tid; e < 48 * 512; e += NTHR) { const int bb = e >> 9, kk = e & 511; float v = 0.f;
            if (bb < NBB) { const float c = bb < BP ? cpp[bb * D + kc * 512 + kk] : csp[(bb - BP) * D + kc * 512 + kk]; v = c * sigm(c); }
            cs[bb * LDC + kk] = tobf(v); }
        __syncthreads();
        if (act) {
#pragma unroll 2
            for (int ks = 0; ks < 16; ++ks) { const int kg = kc * 512 + ks * 32 + 8 * (lane >> 4);
                float w0[8], w1[8];
#pragma unroll
                for (int j = 0; j < 8; ++j) { w0[j] = wl[(size_t)(kg + j) * NMOD]; w1[j] = wl[(size_t)(kg + j) * NMOD + 16]; }
                v4u b0, b1; b0.x = pg8::cvt_pk_bf16(w0[0], w0[1]); b0.y = pg8::cvt_pk_bf16(w0[2], w0[3]); b0.z = pg8::cvt_pk_bf16(w0[4], w0[5]); b0.w = pg8::cvt_pk_bf16(w0[6], w0[7]);
                b1.x = pg8::cvt_pk_bf16(w1[0], w1[1]); b1.y = pg8::cvt_pk_bf16(w1[2], w1[3]); b1.z = pg8::cvt_pk_bf16(w1[4], w1[5]); b1.w = pg8::cvt_pk_bf16(w1[6], w1[7]);
                const bf16x8v bf0 = __builtin_bit_cast(bf16x8v, b0), bf1 = __builtin_bit_cast(bf16x8v, b1);
#pragma unroll
                for (int r = 0; r < 3; ++r) { const bf16x8v a = *(const LAS bf16x8v*)(cs + (16 * r + (lane & 15)) * LDC + ks * 32 + 8 * (lane >> 4));
                    acc[0][r] = __builtin_amdgcn_mfma_f32_16x16x32_bf16(a, bf0, acc[0][r], 0, 0, 0); acc[1][r] = __builtin_amdgcn_mfma_f32_16x16x32_bf16(a, bf1, acc[1][r], 0, 0, 0); } }
        }
    }
    if (act) {
#pragma unroll
        for (int a = 0; a < 2; ++a) { const int n = n0 + 16 * a + (lane & 15); const float bias = bada[l * NMOD + n];
#pragma unroll
            for (int r = 0; r < 3; ++r)
#pragma unroll
                for (int i = 0; i < 4; ++i) { const int bb = 16 * r + 4 * (lane >> 4) + i; if (bb < NBB) MOD[((size_t)l * NBB + bb) * NMOD + n] = acc[a][r][i] + bias; } }
    }
    __syncthreads();
}
__device__ __forceinline__ void convert_layer(Frame& F, int l, int first, int nblk_) {
    WS_LOCALS
    LAS float* scr = (LAS float*)(F.lds + F.wave * 16384);
    constexpr int IT_IN = (D / 64) * (NPROJ / 32), IT_OUT = (D / 64) * (D / 32), IT_UP = (D / 64) * (DFF / 32), IT_DN = (DFF / 64) * (D / 32), IT_L = IT_IN + IT_OUT + IT_UP + IT_DN, NBATCH = (IT_L + 15) / 16;
    const GAS float* const win = INP(I_WIN) + (size_t)l * D * NINW; const GAS float* const wout = INP(I_WOUT) + (size_t)l * D * D; const GAS float* const wup = INP(I_WUP) + (size_t)l * D * DFF; const GAS float* const wdn = INP(I_WDN) + (size_t)l * DFF * D;
    const int me = (int)blockIdx.x - first; if (me < 0 || me >= nblk_) return;
    for (int bt = me; bt < NBATCH; bt += nblk_) {
#pragma unroll 1
        for (int s = 0; s < 2; ++s) { int r = bt * 16 + s * 8 + F.wave; if (r >= IT_L) continue;
            if (r < IT_IN) { const int nblk = NPROJ / 32, kb = r / nblk, nb = r % nblk, dn0 = 32 * nb, sn0 = dn0 + (dn0 >= 4096 ? 8 : 0);
                p0_transpose_item(win, D, NINW, Wi + (size_t)l * NPROJ * D, 64 * kb, sn0, dn0, scr, F.lane); continue; } r -= IT_IN;
            if (r < IT_OUT) { const int nblk = D / 32, kb = r / nblk, nb = r % nblk;
                p0_transpose_item(wout, D, D, Wo + (size_t)l * D * D, 64 * kb, 32 * nb, 32 * nb, scr, F.lane); continue; } r -= IT_OUT;
            if (r < IT_UP) { const int nblk = DFF / 32, kb = r / nblk, nb = r % nblk;
                p0_transpose_item(wup, D, DFF, Wu + (size_t)l * DFF * D, 64 * kb, 32 * nb, 32 * nb, scr, F.lane); continue; } r -= IT_UP;
            { const int nblk = D / 32, kb = r / nblk, nb = r % nblk;
                p0_transpose_item(wdn, DFF, D, Wd + (size_t)l * D * DFF, 64 * kb, 32 * nb, 32 * nb, scr, F.lane); } }
    }
}
__device__ __forceinline__ void p0_prologue(Frame& F) {
    WS_LOCALS
    const int gt = blockIdx.x * NTHR + F.tid, NT = F.G * NTHR;
    { const GAS f32x4* s = (const GAS f32x4*)INP(I_XP); GAS f32x4* d = (GAS f32x4*)F.out;
      for (int i = gt; i < MP * D / 4; i += NT) d[i] = s[i];
      s = (const GAS f32x4*)INP(I_XS); d = (GAS f32x4*)(F.out + (size_t)MP * D);
      for (int i = gt; i < MS * D / 4; i += NT) d[i] = s[i]; }
    if (gt < 512) { const GAS float* lg = INP(I_LBL); const float a0 = lg[gt], a1 = lg[512 + gt], a2 = lg[1024 + gt], a3 = lg[1536 + gt];
        const float mx = fmaxf(fmaxf(a0, a1), fmaxf(a2, a3)); const float e0 = expf(a0 - mx), e1 = expf(a1 - mx), e2 = expf(a2 - mx), e3 = expf(a3 - mx); const float inv = 1.f / (e0 + e1 + e2 + e3);
        LBv[gt] = 0.f; LBv[512 + gt] = e1 * inv; LBv[1024 + gt] = (e1 + e2) * inv; LBv[1536 + gt] = (e1 + e2 + e3) * inv; }
    for (int e = gt; e < 4104 * 32; e += NT) { const int r = e >> 5, i = e & 31; const int pos = r < 4096 ? r : PAST + (r - 4096);
        const double inv = exp2(-(double)i * (13.287712379549449 / 32.0)); const double rev = (double)pos * inv * 0.15915494309189535;
        const float fr = (float)(rev - floor(rev));
        ROPE[r * 64 + i] = __builtin_amdgcn_cosf(fr); ROPE[r * 64 + 32 + i] = __builtin_amdgcn_sinf(fr); }
    { const GAS float* wi = INP(I_WIN); GAS float* wdtg = (GAS float*)wsp(F, WS_WDT);
      for (int e = gt; e < DEPTH * D * 8; e += NT) { const int ll = e >> 14, d2 = (e >> 3) & 2047, j = e & 7; wdtg[(ll * 8 + j) * D + d2] = wi[((size_t)ll * D + d2) * NINW + 4096 + j]; } }
    { const GAS float* pw = INP(I_PW); GAS bf16* wpt = (GAS bf16*)wsp(F, WS_WPT);
      for (int e = gt; e < 16 * 16384; e += NT) { const int lg = e >> 14, dd = (e >> 7) & 127, c = e & 127; wpt[e] = (bf16)f2bf(pw[(size_t)lg * 16384 + c * 128 + dd]); } }
    p0_adaln(F);
    convert_layer(F, 0, 0, F.G);
}

__device__ __forceinline__ void norm_row(Frame& F, int l, int which, int m, f32x4 (&v)[8], const GAS f32x4* g4, const GAS float* MOD, GAS bf16* H, GAS float* DT, const LAS float* wdt) {
    const int bb = row_bb(m);
    const GAS float* modp = MOD + ((size_t)l * NBB + bb) * NMOD + (which ? 3 * D : 0);
    const GAS f32x4* sh4 = (const GAS f32x4*)modp; const GAS f32x4* sc4 = (const GAS f32x4*)(modp + D);
    float ss = 0.f;
#pragma unroll
    for (int j = 0; j < 8; ++j) ss += (v[j].x * v[j].x + v[j].y * v[j].y) + (v[j].z * v[j].z + v[j].w * v[j].w);
    GAS unsigned long long* o8 = (GAS unsigned long long*)(H + (size_t)m * D);
    f32x4 gs[8], shv[8];
#pragma unroll
    for (int j = 0; j < 8; ++j) { const int q = 64 * j + F.lane; const f32x4 g = g4[q], sc = sc4[q]; shv[j] = sh4[q]; gs[j] = g * (sc + 1.f); }
    const float r = rsq(wave_sum(ss) * (1.f / D) + EPS);
#pragma unroll
    for (int j = 0; j < 8; ++j) { const int q = 64 * j + F.lane;
        f32x4 h; h.x = v[j].x * r * gs[j].x + shv[j].x; h.y = v[j].y * r * gs[j].y + shv[j].y; h.z = v[j].z * r * gs[j].z + shv[j].z; h.w = v[j].w * r * gs[j].w + shv[j].w;
        o8[q] = (unsigned long long)pk2(h.x, h.y) | ((unsigned long long)pk2(h.z, h.w) << 32);
        v[j] = h; }
    if (which == 0) { float dta[8];
#pragma unroll
        for (int jj = 0; jj < 8; ++jj) { float a = 0.f;
#pragma unroll
            for (int j = 0; j < 8; ++j) { const f32x4 w = ((const LAS f32x4*)wdt)[jj * (D / 4) + 64 * j + F.lane]; a += (v[j].x * w.x + v[j].y * w.y) + (v[j].z * w.z + v[j].w * w.w); }
            dta[jj] = wave_sum(a); __builtin_amdgcn_sched_barrier(0); }
        if (F.lane == 0) { GAS f32x4* dp = (GAS f32x4*)(DT + (size_t)m * 8); dp[0] = (f32x4){dta[0], dta[1], dta[2], dta[3]}; dp[1] = (f32x4){dta[4], dta[5], dta[6], dta[7]}; } }
}
__device__ __forceinline__ void sample_row_reduce(Frame& F, int ms, int nsl, f32x4 (&v)[8], LAS float* partl) {
    const GAS f32x4* pp = (const GAS f32x4*)wsp(F, WS_PART) + (size_t)ms * (D / 4); GAS f32x4* xw = (GAS f32x4*)(F.out + (size_t)(MP + ms) * D);
#pragma unroll
    for (int j = 0; j < 8; ++j) v[j] = (F.wave == 0) ? xw[64 * j + F.lane] : (f32x4){0.f, 0.f, 0.f, 0.f};
#pragma unroll 1
    for (int s = F.wave; s < nsl; s += 8) {
#pragma unroll
        for (int j = 0; j < 8; ++j) v[j] = v[j] + pp[(size_t)s * (MS * D / 4) + 64 * j + F.lane]; }
    if (F.wave != 0) {
#pragma unroll
        for (int j = 0; j < 8; ++j) ((LAS f32x4*)partl)[(F.wave - 1) * (D / 4) + 64 * j + F.lane] = v[j]; }
    __syncthreads();
    if (F.wave == 0) {
#pragma unroll 1
        for (int w = 0; w < 7; ++w) {
#pragma unroll
            for (int j = 0; j < 8; ++j) v[j] = v[j] + ((const LAS f32x4*)partl)[w * (D / 4) + 64 * j + F.lane]; }
#pragma unroll
        for (int j = 0; j < 8; ++j) xw[64 * j + F.lane] = v[j]; }
}
__device__ __forceinline__ void norm_phase(Frame& F, int l, int which, int nsl) {
    WS_LOCALS
    LAS float* wdt = (LAS float*)F.lds;
    LAS float* partl = (LAS float*)(F.lds + 65536);
    if (which == 0) { const GAS f32x4* wsrc = (const GAS f32x4*)((const GAS float*)wsp(F, WS_WDT) + (size_t)l * 8 * D);
        for (int e = F.tid; e < D * 8 / 4; e += NTHR) ((LAS f32x4*)wdt)[e] = wsrc[e]; }
    __syncthreads();
    const GAS f32x4* g4 = (const GAS f32x4*)(INP(which ? I_N2G : I_N1G) + l * D);
    f32x4 v[8];
    if (nsl > 0) for (int ms = (int)blockIdx.x; ms < MS; ms += F.G) { sample_row_reduce(F, ms, nsl, v, partl); if (F.wave == 0) norm_row(F, l, which, MP + ms, v, g4, MOD, H, DT, wdt); __syncthreads(); }
    const int mend = nsl > 0 ? MP : M;
    for (int m = F.gw; m < mend; m += F.ngw) { const GAS f32x4* xr = (const GAS f32x4*)(F.out + (size_t)m * D);
#pragma unroll
        for (int j = 0; j < 8; ++j) v[j] = xr[64 * j + F.lane];
        norm_row(F, l, which, m, v, g4, MOD, H, DT, wdt); }
}
__device__ __forceinline__ void final_fix_phase(Frame& F, int nsl) {
    LAS float* partl = (LAS float*)(F.lds + 65536); f32x4 v[8];
    __syncthreads();
    for (int ms = (int)blockIdx.x; ms < MS; ms += F.G) { sample_row_reduce(F, ms, nsl, v, partl); __syncthreads(); }
}
template <int MODE> __device__ __forceinline__ unsigned ssd_raw(const GAS bf16* PROJ, const GAS float* scv, int l, int b, int m0, int tseq0, int r, int ch) {
    if (MODE == 2) { const int rp = r < 0 ? 0 : (r > 7 ? 7 : r), rs = r < 0 ? 3 + r : 0;
        const unsigned a = *(const GAS unsigned*)(PROJ + (size_t)(m0 + rp) * NPROJ + C_CX + ch); const GAS float* sc = scv + ((size_t)(l * BS + b) * 3 + rs) * 1024 + ch; const unsigned c = pk2(sc[0], sc[1]);
        return r < 0 ? c : (r > 7 ? 0u : a); }
    const int rc = (tseq0 + r >= 0) ? r : -tseq0; const unsigned a = *(const GAS unsigned*)(PROJ + (size_t)(m0 + rc) * NPROJ + C_CX + ch);
    return (tseq0 + r >= 0) ? a : 0u;
}
template <int MODE> __device__ __forceinline__ void ssd_unit(Frame& F, int l, int u) {
    WS_LOCALS
    constexpr int T = (MODE == 2) ? 16 : 64, SK = (MODE == 2) ? 32 : 64, L = (MODE == 2) ? 8 : 64, LDN = 136, LDS_ = SK + 8;
    constexpr int NT_CB = (T / 16) * (SK / 16), NT_Y = (T / 16) * 4;
    constexpr int OFF_BG = (MODE == 0 ? 0 : T * LDN * 2), OFF_BGT = OFF_BG + (MODE == 0 ? 0 : T * LDN * 2), OFF_XT = OFF_BGT + (MODE == 1 ? 0 : 128 * LDS_ * 2), OFF_XWT = OFF_XT + (MODE == 0 ? 0 : 4 * 64 * LDS_ * 2),
                  OFF_WL = OFF_XWT + (MODE == 1 ? 0 : 4 * 64 * LDS_ * 2), OFF_SM = OFF_WL + (MODE == 0 ? 0 : 4 * T * LDS_ * 2);
    constexpr int OFF_S0 = (MODE == 2) ? OFF_SM + 2304 : 0;
    static_assert(OFF_SM + 2304 <= RING_BYTES && (MODE != 2 || OFF_S0 + 2 * 64 * 136 * 2 <= RING_BYTES) && (MODE != 1 || 2 * 64 * 136 * 2 <= OFF_XT), "ssd LDS map");
    const int tid0 = F.tid, lane0 = F.lane, wave = F.wave;
    const GAS float* const cwp = INP(I_CW); const GAS float* const cbp = INP(I_CB); const GAS float* const scv = INP(I_SCONV);
    int b, m0, tseq0;
    if (MODE == 2) { b = u; m0 = MP + b * TS; tseq0 = 0; } else { b = u >> 6; m0 = b * TP + (u & 63) * 64; tseq0 = (u & 63) * 64; }
    LAS bf16* Cg = (LAS bf16*)F.lds;
    LAS bf16* Bg = (LAS bf16*)(F.lds + OFF_BG);
    LAS bf16* BgT = (LAS bf16*)(F.lds + OFF_BGT);
    LAS bf16* xT = (LAS bf16*)(F.lds + OFF_XT);
    LAS bf16* xwT = (LAS bf16*)(F.lds + OFF_XWT);
    LAS bf16* Wl = (LAS bf16*)(F.lds + OFF_WL);
    LAS float* cumL = (LAS float*)(F.lds + OFF_SM);
    LAS float* dtL = cumL + 256;
    LAS float* rowss = dtL + 256;
    GAS float* const ytmp = (GAS float*)wsp(F, WS_YTMP) + (size_t)blockIdx.x * (64 * 512);
    float ssum[4] = {0.f, 0.f, 0.f, 0.f};
    if (tid0 < 64) rowss[tid0] = 0.f;
#pragma unroll 1
    for (int g = 0; g < 2; ++g) {
        int tid = tid0, lane = lane0; asm volatile("" : "+v"(tid), "+v"(lane));
        __syncthreads();
        if (MODE == 1) UTS(0);
        if (wave < 4) { const int hh = g * 4 + wave; float dtv = 0.f, a = 0.f;
            { const int tl = lane < L ? lane : L - 1; const float raw = DT[(size_t)(m0 + tl) * 8 + hh] + INP(I_DTB)[l * 8 + hh]; const float dt1 = raw > 20.f ? raw : log1pf(__expf(raw)); const float a1 = -dt1 * __expf(INP(I_ALOG)[l * 8 + hh]);
              dtv = lane < L ? dt1 : 0.f; a = lane < L ? a1 : 0.f; }
#pragma unroll
            for (int o = 1; o < 64; o <<= 1) { const float y = __shfl_up(a, o); if (lane >= o) a += y; }
            cumL[lane * 4 + wave] = a; dtL[lane * 4 + wave] = dtv; }
        {   const int pr = tid & 127, rq = tid >> 7;
            const int isC = pr >> 6, n0 = 2 * (pr & 63), ch = 512 + isC * 256 + g * 128 + n0;
            if (MODE != 0 || !isC) {
                float w[4][2], bia[2];
#pragma unroll
                for (int j = 0; j < 4; ++j) { w[j][0] = cwp[(l * 4 + j) * 1024 + ch]; w[j][1] = cwp[(l * 4 + j) * 1024 + ch + 1]; }
                bia[0] = cbp[l * 1024 + ch]; bia[1] = cbp[l * 1024 + ch + 1];
                constexpr int RQ = T / 4; const int r0 = rq * RQ;
                unsigned ra[RQ + 3];
#pragma unroll
                for (int i = 0; i < RQ + 3; ++i) ra[i] = ssd_raw<MODE>(PROJ, scv, l, b, m0, tseq0, r0 - 3 + i, ch);
#pragma unroll
                for (int i = 0; i < RQ; ++i) { const int r = r0 + i; float c0 = 0.f, c1 = 0.f;
                    if (r < L) { c0 = bia[0] + w[0][0] * bflo(ra[i]) + w[1][0] * bflo(ra[i + 1]) + w[2][0] * bflo(ra[i + 2]) + w[3][0] * bflo(ra[i + 3]); c1 = bia[1] + w[0][1] * bfhi(ra[i]) + w[1][1] * bfhi(ra[i + 1]) + w[2][1] * bfhi(ra[i + 2]) + w[3][1] * bfhi(ra[i + 3]);
                        c0 = c0 * sigm(c0); c1 = c1 * sigm(c1); }
                    if (isC) { if (MODE != 0) *(LAS unsigned*)(Cg + r * LDN + n0) = pk2(c0, c1); }
                    else { if (MODE != 0) *(LAS unsigned*)(Bg + r * LDN + n0) = pk2(c0, c1);
                           if (MODE != 1) { BgT[n0 * LDS_ + r] = tobf(c0); BgT[(n0 + 1) * LDS_ + r] = tobf(c1); } } }
                if (MODE == 2 && !isC) { for (int r = T + rq * 4; r < T + rq * 4 + 4; ++r) { BgT[n0 * LDS_ + r] = 0; BgT[(n0 + 1) * LDS_ + r] = 0; } }
            }
        }
        __syncthreads();
        if (MODE == 1) { UTE(0); UTS(1); }
        { int t_ = tid0, l_ = lane0; asm volatile("" : "+v"(t_), "+v"(l_)); tid = t_; lane = l_; }
        {   const int pr = tid & 127, rq = tid >> 7, r = pr >> 5, pp = pr & 31; const int ch = (g * 4 + r) * 64 + 2 * pp;
            float w[4][2], bia[2];
#pragma unroll
            for (int j = 0; j < 4; ++j) { w[j][0] = cwp[(l * 4 + j) * 1024 + ch]; w[j][1] = cwp[(l * 4 + j) * 1024 + ch + 1]; }
            bia[0] = cbp[l * 1024 + ch]; bia[1] = cbp[l * 1024 + ch + 1];
            constexpr int RS = SK / 4; const int r0 = rq * RS;
            const float cl = cumL[(L - 1) * 4 + r];
            unsigned ra[RS + 3];
#pragma unroll
            for (int i = 0; i < RS + 3; ++i) ra[i] = ssd_raw<MODE>(PROJ, scv, l, b, m0, tseq0, r0 - 3 + i, ch);
            LAS bf16* x0 = xT + (r * 64 + 2 * pp) * LDS_; LAS bf16* xw0 = xwT + (r * 64 + 2 * pp) * LDS_;
#pragma unroll
            for (int i = 0; i < RS; ++i) { const int s = r0 + i; float c0 = 0.f, c1 = 0.f, ws = 0.f;
                if (s < L) { c0 = bia[0] + w[0][0] * bflo(ra[i]) + w[1][0] * bflo(ra[i + 1]) + w[2][0] * bflo(ra[i + 2]) + w[3][0] * bflo(ra[i + 3]); c1 = bia[1] + w[0][1] * bfhi(ra[i]) + w[1][1] * bfhi(ra[i + 1]) + w[2][1] * bfhi(ra[i + 2]) + w[3][1] * bfhi(ra[i + 3]);
                    c0 = c0 * sigm(c0); c1 = c1 * sigm(c1); ws = dtL[s * 4 + r] * __expf(cl - cumL[s * 4 + r]); }
                if (MODE != 0) { x0[s] = tobf(c0); x0[LDS_ + s] = tobf(c1); }
                if (MODE != 1) { xw0[s] = tobf(c0 * ws); xw0[LDS_ + s] = tobf(c1 * ws); } }
        }
        if (MODE != 0) {
#pragma unroll
            for (int j = 0; j < 2; ++j) { const int id = 2 * wave + j; if (id < NT_CB) { const int ti = id / (SK / 16), si = id % (SK / 16); f32x4 cb = (f32x4){0.f, 0.f, 0.f, 0.f};
                if (!(MODE == 2 && si > 0) && si <= ti) cb = mma16(Cg + ti * 16 * LDN, LDN, Bg + si * 16 * LDN, LDN, 128, cb, lane);
#pragma unroll
                for (int r = 0; r < 4; ++r)
#pragma unroll
                    for (int i = 0; i < 4; ++i) { const int t = ti * 16 + 4 * (lane >> 4) + i, s = si * 16 + (lane & 15);
                        float wv = 0.f; if (s <= t && (MODE != 2 || t < L)) wv = cb[i] * __expf(cumL[t * 4 + r] - cumL[s * 4 + r]) * dtL[s * 4 + r];
                        Wl[(r * T + t) * LDS_ + s] = tobf(wv); } } }
        }
        __syncthreads();
        if (MODE == 1) { UTE(1); UTS(2); }
        { int t_ = tid0, l_ = lane0; asm volatile("" : "+v"(t_), "+v"(l_)); tid = t_; lane = l_; }
        if (MODE != 0) {
            LAS bf16* Sl = (LAS bf16*)(F.lds + OFF_S0);
            const bool ywave = 2 * wave < NT_Y; const int ti = (2 * wave) >> 2;
            bf16x8v ca[4];
#pragma unroll
            for (int ks = 0; ks < 4; ++ks) ca[ks] = *(const LAS bf16x8v*)(Cg + (ti * 16 + (lane & 15)) * LDN + ks * 32 + 8 * (lane >> 4));
            const GAS float* dskp = INP(I_DSK) + l * 8 + g * 4; const float dsk4[4] = {dskp[0], dskp[1], dskp[2], dskp[3]};
#pragma unroll
            for (int half = 0; half < 2; ++half) {
                float zv[2][2][4];
                if (ywave) {
#pragma unroll
                    for (int rr = 0; rr < 2; ++rr)
#pragma unroll
                        for (int j = 0; j < 2; ++j)
#pragma unroll
                            for (int i = 0; i < 4; ++i) { const int t = ti * 16 + 4 * (lane >> 4) + i, p = ((2 * wave + j) & 3) * 16 + (lane & 15); const int tc = t < L ? t : L - 1; zv[rr][j][i] = bf2f(PROJ[(size_t)(m0 + tc) * NPROJ + C_CZ + (g * 4 + 2 * half + rr) * 64 + p]); } }
                __syncthreads();
                for (int e = tid; e < 4096; e += NTHR) { const int rr = e >> 11, e2 = e & 2047, hh_ = g * 4 + 2 * half + rr;
                    const f32x4 v = ((const GAS f32x4*)(MODE == 1 ? SDSS + ((size_t)u * 8 + hh_) * 8192 : INP(I_SSSM) + ((size_t)(l * BS + b) * 8 + hh_) * 8192))[e2]; const int p = e2 >> 5, n4 = (e2 & 31) * 4;
                    *(LAS unsigned*)(Sl + (rr * 64 + p) * LDN + n4) = pk2(v.x, v.y); *(LAS unsigned*)(Sl + (rr * 64 + p) * LDN + n4 + 2) = pk2(v.z, v.w); }
                __syncthreads();
                if (ywave) {
#pragma unroll
                    for (int rr = 0; rr < 2; ++rr)
#pragma unroll
                        for (int j = 0; j < 2; ++j) { const int r = 2 * half + rr, hh = g * 4 + r, pj = (2 * wave + j) & 3;
                            f32x4 y1 = (f32x4){0.f, 0.f, 0.f, 0.f}, y2 = y1;
                            y1 = mma16(Wl + (r * T + ti * 16) * LDS_, LDS_, xT + (r * 64 + pj * 16) * LDS_, LDS_, SK, y1, lane);
#pragma unroll
                            for (int ks = 0; ks < 4; ++ks) y2 = __builtin_amdgcn_mfma_f32_16x16x32_bf16(ca[ks], *(const LAS bf16x8v*)(Sl + (rr * 64 + pj * 16 + (lane & 15)) * LDN + ks * 32 + 8 * (lane >> 4)), y2, 0, 0, 0);
                            const int p = pj * 16 + (lane & 15); const float dsk = dsk4[r];
#pragma unroll
                            for (int i = 0; i < 4; ++i) { const int t = ti * 16 + 4 * (lane >> 4) + i;
                                if (MODE != 2 || t < L) { const float xv = bf2f(xT[(r * 64 + p) * LDS_ + t]); const float z = zv[rr][j][i];
                                    const float yy = (y1[i] + __expf(cumL[t * 4 + r]) * y2[i] + dsk * xv) * z * sigm(z); ssum[i] += yy * yy; ytmp[t * 512 + hh * 64 + p] = yy; } } } }
            }
        }
        if (MODE == 1) UTE(2);
        if (MODE != 1) {
            const int r = wave >> 1, hh = g * 4 + r; const float dtot = __expf(cumL[(L - 1) * 4 + r]);
#pragma unroll 1
            for (int pi = 0; pi < 4; ++pi)
#pragma unroll
                for (int j = 0; j < 4; ++j) { const int nj = 4 * (wave & 1) + j; f32x4 d = (f32x4){0.f, 0.f, 0.f, 0.f};
                    d = mma16(xwT + (r * 64 + pi * 16) * LDS_, LDS_, BgT + nj * 16 * LDS_, LDS_, SK, d, lane);
                    const int n = nj * 16 + (lane & 15);
                    if (MODE == 0) {
#pragma unroll
                        for (int i = 0; i < 4; ++i) { const int p = pi * 16 + 4 * (lane >> 4) + i; SDDS[((size_t)u * 8 + hh) * 8192 + p * 128 + n] = d[i]; } }
                    else { const size_t sb0 = ((size_t)(l * BS + b) * 8 + hh) * 8192 + n; const GAS float* sin_ = INP(I_SSSM) + sb0; float sv[4];
#pragma unroll
                        for (int i = 0; i < 4; ++i) sv[i] = sin_[(pi * 16 + 4 * (lane >> 4) + i) * 128];
#pragma unroll
                        for (int i = 0; i < 4; ++i) F.out[O_SSSM + sb0 + (pi * 16 + 4 * (lane >> 4) + i) * 128] = dtot * sv[i] + d[i]; } }
            if (MODE == 0 && (lane & 63) == 0 && (wave & 1) == 0) SDDEC[u * 8 + hh] = dtot;
        }
    }
    const int tid = tid0, lane = lane0;
    if (MODE == 1) UTS(3);
    if (MODE != 0) {
#pragma unroll
        for (int i = 0; i < 4; ++i) { float s = ssum[i]; s += __shfl_xor(s, 1); s += __shfl_xor(s, 2); s += __shfl_xor(s, 4); s += __shfl_xor(s, 8);
            const int id = 2 * wave; if (id < NT_Y && (lane & 15) == 0) __hip_atomic_fetch_add(&rowss[(id >> 2) * 16 + 4 * (lane >> 4) + i], s, __ATOMIC_RELAXED, __HIP_MEMORY_SCOPE_WORKGROUP); }
        __syncthreads();
        const GAS float* ngp = INP(I_SNG) + l * 512;
        if (2 * wave < NT_Y) {
            float rinv[4];
#pragma unroll
            for (int i = 0; i < 4; ++i) { const int t = ((2 * wave) >> 2) * 16 + 4 * (lane >> 4) + i; rinv[i] = rsq(rowss[t] * (1.f / 512.f) + EPS); }
#pragma unroll 1
            for (int gh = 0; gh < 2; ++gh) { float yv[4][2][4], ngv[4][2];
#pragma unroll
                for (int g4 = 0; g4 < 4; ++g4)
#pragma unroll
                    for (int j = 0; j < 2; ++j) { const int id = 2 * wave + j, ti = id >> 2, pj = id & 3, chn = (gh * 4 + g4) * 64 + pj * 16 + (lane & 15); ngv[g4][j] = ngp[chn];
#pragma unroll
                        for (int i = 0; i < 4; ++i) { const int t = ti * 16 + 4 * (lane >> 4) + i; yv[g4][j][i] = ytmp[(t < L ? t : 0) * 512 + chn]; } }
#pragma unroll
                for (int g4 = 0; g4 < 4; ++g4)
#pragma unroll
                    for (int j = 0; j < 2; ++j) { const int id = 2 * wave + j, ti = id >> 2, pj = id & 3, chn = (gh * 4 + g4) * 64 + pj * 16 + (lane & 15);
#pragma unroll
                        for (int i = 0; i < 4; ++i) { const int t = ti * 16 + 4 * (lane >> 4) + i; if (MODE != 2 || t < L) MIX[(size_t)(m0 + t) * D + 1024 + chn] = tobf(yv[g4][j][i] * rinv[i] * ngv[g4][j]); } } }
        }
    }
    if (MODE == 1) { __syncthreads(); UTE(3); }
    if (MODE == 0 && (u & 63) == 63) for (int e = tid; e < 3 * 1024; e += NTHR) { const int j = e >> 10, c2 = e & 1023; F.out[O_PCONV + ((size_t)(l * BP + b) * 3 + j) * 1024 + c2] = bf2f(PROJ[(size_t)(m0 + 61 + j) * NPROJ + C_CX + c2]); }
    if (MODE == 2) for (int e = tid; e < 3 * 1024; e += NTHR) { const int j = e >> 10, c2 = e & 1023; F.out[O_SCONV + ((size_t)(l * BS + b) * 3 + j) * 1024 + c2] = bf2f(PROJ[(size_t)(m0 + 5 + j) * NPROJ + C_CX + c2]); }
}
template <int MODE> __device__ __forceinline__ void hgrn_unit(Frame& F, int l, int u) {
    WS_LOCALS
    constexpr int T = (MODE == 2) ? 16 : 64, SK = (MODE == 2) ? 32 : 64, L = (MODE == 2) ? 8 : 64, MID = (MODE == 2) ? 3 : 31, LDN = 136, LDS_ = SK + 8, NI = T / 4;
    constexpr int OFF_QT = T * 512, OFF_KT = OFF_QT + T * 272, OFF_KTT = OFF_KT + T * 272, OFF_VT = OFF_KTT + (MODE == 1 ? 0 : 128 * LDS_ * 2), OFF_S0T = OFF_VT + 128 * LDS_ * 2, OFF_AM = OFF_S0T + (MODE == 0 ? 0 : 128 * 272), OFF_END = OFF_AM + T * LDS_ * 2;
    static_assert(OFF_END <= RING_BYTES, "hgrn LDS map");
    const int tid = F.tid, lane = F.lane, wave = F.wave, d = tid & 127, tq = tid >> 7;
    int h, m0; size_t sidx;
    if (MODE == 2) { const int b = u >> 2; h = u & 3; m0 = MP + b * TS; sidx = ((size_t)(l * BS + b) * 4 + h) * 16384; }
    else { const int bh = u >> 6, c = u & 63, b = bh >> 2; h = bh & 3; m0 = b * TP + c * 64; sidx = (size_t)u * 16384; }
    LAS float* cum = (LAS float*)F.lds;
    LAS bf16* qt = (LAS bf16*)(F.lds + OFF_QT);
    LAS bf16* kt = (LAS bf16*)(F.lds + OFF_KT);
    LAS bf16* ktT = (LAS bf16*)(F.lds + OFF_KTT);
    LAS bf16* vT = (LAS bf16*)(F.lds + OFF_VT);
    LAS bf16* S0T = (LAS bf16*)(F.lds + OFF_S0T);
    LAS bf16* Am = (LAS bf16*)(F.lds + OFF_AM);
    LAS float* refv = (LAS float*)(F.lds + RING_BYTES + 2048);
    LAS float* efin = refv + 128; LAS float* decv = efin + 128; LAS float* erefv = decv + 128; LAS float* rowss = erefv + 128;
    const GAS float* S0g = (MODE == 1 ? HGSS : INP(I_SHG)) + sidx;
    __syncthreads();
    float qv[NI], kv[NI], vv[NI];
    {   const float lbv = LBv[l * 512 + h * 128 + d];
#pragma unroll
        for (int i = 0; i < NI; ++i) { const int t = tq + 4 * i; float lf = 0.f, q = 0.f, k = 0.f, v = 0.f;
            { const int tc = t < L ? t : L - 1; const GAS bf16* row = PROJ + (size_t)(m0 + tc) * NPROJ + h * 128 + d; const float fr = bf2f(row[C_AF]), qr = bf2f(row[C_AQ]), v1 = bf2f(row[C_AI]);
                const float e = __expf(-fr); const float sg = 1.f / (1.f + e); const float fg = lbv + (1.f - lbv) * sg;
                const bool ok = t < L; lf = ok ? __logf(fg) : 0.f; k = ok ? (1.f - lbv) * (e / (1.f + e)) : 0.f; q = ok ? qr * sigm(qr) : 0.f; v = ok ? v1 : 0.f; }
            cum[t * 128 + d] = lf; qv[i] = q; kv[i] = k; vv[i] = v; }
        if (tid < 64) rowss[tid] = 0.f;
    }
    __syncthreads();
    if (tid < 128) { float a = 0.f, rf = 0.f;
#pragma unroll 16
        for (int t = 0; t < L; ++t) { a += cum[t * 128 + tid]; cum[t * 128 + tid] = a; if (t == MID) rf = a; }
        refv[tid] = rf; efin[tid] = __expf(a - rf); decv[tid] = __expf(a); erefv[tid] = __expf(rf); }
    __syncthreads();
    {   const float rf = refv[d];
#pragma unroll
        for (int i = 0; i < NI; ++i) { const int t = tq + 4 * i; const float c = (t < L) ? cum[t * 128 + d] : rf;
            const float qs = qv[i] * __expf(fminf(c - rf, 80.f)), ks = kv[i] * __expf(fminf(rf - c, 80.f));
            if (MODE != 0) { qt[t * LDN + d] = tobf(qs); kt[t * LDN + d] = tobf(ks); }
            if (MODE != 1) ktT[d * LDS_ + t] = tobf(ks);
            vT[d * LDS_ + t] = tobf(vv[i]); }
        if (MODE == 2) {
#pragma unroll
            for (int i = 0; i < NI; ++i) { const int t = 16 + tq + 4 * i; ktT[d * LDS_ + t] = 0; vT[d * LDS_ + t] = 0; } }
    }
    if (MODE == 1) for (int e = tid; e < 4096; e += NTHR) { const f32x4 s = ((const GAS f32x4*)S0g)[e]; const int v = e >> 5, d4 = (e & 31) * 4; const f32x4 er = *(const LAS f32x4*)(erefv + d4);
        *(LAS unsigned*)(S0T + v * LDN + d4) = pk2(s.x * er.x, s.y * er.y); *(LAS unsigned*)(S0T + v * LDN + d4 + 2) = pk2(s.z * er.z, s.w * er.w); }
    if (MODE == 2) for (int e = tid; e < 4096; e += NTHR) { const f32x4 s = ((const GAS f32x4*)S0g)[e]; const int dd = e >> 5, v4 = (e & 31) * 4; const float er = erefv[dd];
        S0T[(v4) * LDN + dd] = tobf(s.x * er); S0T[(v4 + 1) * LDN + dd] = tobf(s.y * er); S0T[(v4 + 2) * LDN + dd] = tobf(s.z * er); S0T[(v4 + 3) * LDN + dd] = tobf(s.w * er); }
    __syncthreads();
    if (MODE != 0) {
#pragma unroll
        for (int j = 0; j < 2; ++j) { const int id = 2 * wave + j; if (id < (T / 16) * (SK / 16)) { const int ti = id / (SK / 16), si = id % (SK / 16);
            f32x4 a = (f32x4){0.f, 0.f, 0.f, 0.f};
            if (si <= ti && si < T / 16) a = mma16(qt + ti * 16 * LDN, LDN, kt + si * 16 * LDN, LDN, 128, a, lane);
#pragma unroll
            for (int i = 0; i < 4; ++i) { const int t = ti * 16 + 4 * (lane >> 4) + i, s = si * 16 + (lane & 15); Am[t * LDS_ + s] = tobf((s <= t && si <= ti && si < T / 16) ? a[i] : 0.f); } } }
        __syncthreads();
        f32x4 o[4]; float ssum[4] = {0.f, 0.f, 0.f, 0.f};
#pragma unroll
        for (int j = 0; j < 4; ++j) { const int id = 4 * wave + j; o[j] = (f32x4){0.f, 0.f, 0.f, 0.f};
            if (id < (T / 16) * 8) { const int ti = id >> 3, vj = id & 7;
                o[j] = mma16(Am + ti * 16 * LDS_, LDS_, vT + vj * 16 * LDS_, LDS_, SK, o[j], lane);
                o[j] = mma16(qt + ti * 16 * LDN, LDN, S0T + vj * 16 * LDN, LDN, 128, o[j], lane);
#pragma unroll
                for (int i = 0; i < 4; ++i) ssum[i] += o[j][i] * o[j][i]; } }
        if (4 * wave < (T / 16) * 8) {
#pragma unroll
            for (int i = 0; i < 4; ++i) { float s = ssum[i]; s += __shfl_xor(s, 1); s += __shfl_xor(s, 2); s += __shfl_xor(s, 4); s += __shfl_xor(s, 8);
                if ((lane & 15) == 0) __hip_atomic_fetch_add(&rowss[((4 * wave) >> 3) * 16 + 4 * (lane >> 4) + i], s, __ATOMIC_RELAXED, __HIP_MEMORY_SCOPE_WORKGROUP); } }
        __syncthreads();
        const GAS float* ngp = INP(I_HNG) + l * 512 + h * 128;
        float grv[4][4], ngv[4];
#pragma unroll
        for (int j = 0; j < 4; ++j) { const int id = 4 * wave + j, ti = (id >> 3) & (T / 16 - 1), vj = id & 7, v = vj * 16 + (lane & 15); ngv[j] = ngp[v];
#pragma unroll
            for (int i = 0; i < 4; ++i) { const int t = ti * 16 + 4 * (lane >> 4) + i; const int tc = t < L ? t : L - 1; grv[j][i] = bf2f(PROJ[(size_t)(m0 + tc) * NPROJ + C_AG + h * 128 + v]); } }
#pragma unroll
        for (int j = 0; j < 4; ++j) { const int id = 4 * wave + j; if (id < (T / 16) * 8) { const int ti = id >> 3, vj = id & 7, v = vj * 16 + (lane & 15);
#pragma unroll
            for (int i = 0; i < 4; ++i) { const int t = ti * 16 + 4 * (lane >> 4) + i;
                if (MODE != 2 || t < L) MIX[(size_t)(m0 + t) * D + h * 128 + v] = tobf(o[j][i] * rsq(rowss[t] * (1.f / 128.f) + EPS) * ngv[j] * sigm(grv[j][i])); } } }
    }
    if (MODE != 1) {
#pragma unroll
        for (int j = 0; j < 8; ++j) { f32x4 a = (f32x4){0.f, 0.f, 0.f, 0.f}; a = mma16(ktT + wave * 16 * LDS_, LDS_, vT + j * 16 * LDS_, LDS_, SK, a, lane);
            const int v = j * 16 + (lane & 15);
            if (MODE == 0) { const int d0 = wave * 16 + 4 * (lane >> 4); const f32x4 ef = *(const LAS f32x4*)(efin + d0);
                *(GAS f32x4*)(HGDS + sidx + v * 128 + d0) = (f32x4){ef.x * a[0], ef.y * a[1], ef.z * a[2], ef.w * a[3]}; }
            else { float sv[4];
#pragma unroll
                for (int i = 0; i < 4; ++i) sv[i] = S0g[(wave * 16 + 4 * (lane >> 4) + i) * 128 + v];
#pragma unroll
                for (int i = 0; i < 4; ++i) { const int dd = wave * 16 + 4 * (lane >> 4) + i; F.out[O_SHG + sidx + dd * 128 + v] = decv[dd] * sv[i] + efin[dd] * a[i]; } } }
        if (MODE == 0 && tid < 128) HGDEC[u * 128 + tid] = decv[tid];
    }
}
__device__ __forceinline__ void scan_phase(Frame& F, int l) {
    WS_LOCALS
    const int gt = blockIdx.x * NTHR + F.tid, NT = F.G * NTHR;
    for (int e = gt; e < 131072; e += NT) {
        const int bh = e >> 14, vd = e & 16383, d = vd & 127, v = vd >> 7; const int bhh = e >> 13, b = bhh >> 3, hh = bhh & 7, pn = e & 8191;
        float Sh = 0.f, Ss = 0.f;
#pragma unroll 1
        for (int c0 = 0; c0 < 64; c0 += 8) { float dh[8], xh[8], ds[8], xs[8];
#pragma unroll
            for (int k = 0; k < 8; ++k) { const size_t u = (size_t)bh * 64 + c0 + k; const size_t idx = (size_t)(b * 64 + c0 + k) * 8 + hh; dh[k] = HGDEC[u * 128 + d]; xh[k] = HGDS[u * 16384 + vd]; ds[k] = SDDEC[idx]; xs[k] = SDDS[idx * 8192 + pn]; }
#pragma unroll
            for (int k = 0; k < 8; ++k) { const size_t u = (size_t)bh * 64 + c0 + k; const size_t idx = (size_t)(b * 64 + c0 + k) * 8 + hh;
                HGSS[u * 16384 + vd] = Sh; SDSS[idx * 8192 + pn] = Ss; Sh = dh[k] * Sh + xh[k]; Ss = ds[k] * Ss + xs[k]; } }
        F.out[O_PHG + ((size_t)l * 8 + bh) * 16384 + d * 128 + v] = Sh; F.out[O_PSSM + ((size_t)(l * BP + b) * 8 + hh) * 8192 + pn] = Ss; }
}
__device__ __forceinline__ float sq8(v4u w) { const float a0 = bflo(w.x), a1 = bfhi(w.x), a2 = bflo(w.y), a3 = bfhi(w.y), a4 = bflo(w.z), a5 = bfhi(w.z), a6 = bflo(w.w), a7 = bfhi(w.w);
    return ((a0 * a0 + a1 * a1) + (a2 * a2 + a3 * a3)) + ((a4 * a4 + a5 * a5) + (a6 * a6 + a7 * a7)); }
__device__ __forceinline__ float rope1(float x, float rn, float g, float c, float s, int dh) { const float xn = x * rn * g; const float other = __shfl_xor(xn, 1); return dh == 0 ? xn * c - other * s : xn * c + other * s; }
__device__ __forceinline__ v4u rope8(v4u w, float rn, const GAS float* g, const GAS float* rp, int dh) {
    v4u o;
    o.x = pk2(rope1(bflo(w.x), rn, g[0], rp[0], rp[32], dh), rope1(bfhi(w.x), rn, g[1], rp[1], rp[33], dh));
    o.y = pk2(rope1(bflo(w.y), rn, g[2], rp[2], rp[34], dh), rope1(bfhi(w.y), rn, g[3], rp[3], rp[35], dh));
    o.z = pk2(rope1(bflo(w.z), rn, g[4], rp[4], rp[36], dh), rope1(bfhi(w.z), rn, g[5], rp[5], rp[37], dh));
    o.w = pk2(rope1(bflo(w.w), rn, g[6], rp[6], rp[38], dh), rope1(bfhi(w.w), rn, g[7], rp[7], rp[39], dh));
    return o;
}
template <int SAMPLE> __device__ __forceinline__ void attn_unit(Frame& F, int l, int u) {
    WS_LOCALS
    constexpr int LDK = 72, LDV = 200, LDPW = 168;
    const int tid = F.tid, lane = F.lane, wave = F.wave;
    const GAS float* const ckp = INP(I_CK); const GAS float* const cvp = INP(I_CV);
    LAS bf16* Kb = (LAS bf16*)F.lds; LAS bf16* VT = Kb + 192 * LDK; LAS bf16* Qs = VT + 64 * LDV; LAS bf16* Pw = Qs + wave * 16 * LDPW;
    int b, g, q0, row_min; size_t mbase;
    if (SAMPLE) { b = u >> 1; g = u & 1; q0 = 0; row_min = 0; mbase = (size_t)MP + b * TS; }
    else { g = u & 1; const int qt = (u >> 1) & 63; b = u >> 7; q0 = qt * 64; row_min = q0 >= 127 ? 0 : 127 - q0; mbase = (size_t)b * TP; }
    __syncthreads();
    {   const int j8 = tid & 7; const GAS float* kg = INP(I_KNG) + l * 64 + 8 * j8;
        float kgv[8];
#pragma unroll
        for (int e = 0; e < 8; ++e) kgv[e] = kg[e];
        GAS float* const okp = F.out + (SAMPLE ? O_SK : O_PK); GAS float* const ovp = F.out + (SAMPLE ? O_SV : O_PV);
        const size_t ob = SAMPLE ? ((size_t)(l * BS + b) * 128) : ((size_t)(l * BP + b) * 128);
        const int roff = SAMPLE ? 8 : 63; const bool wr_cache = SAMPLE || q0 == TP - 64;
        for (int row = tid >> 3; row < 192; row += 64) {
            float ko[8], vo[8]; bool zero = false;
            if (SAMPLE && row < 128) { const GAS f32x4* kp = (const GAS f32x4*)(ckp + (((size_t)(l * BS + b) * 128 + row) * 2 + g) * 64 + 8 * j8); const GAS f32x4* vp = (const GAS f32x4*)(cvp + (((size_t)(l * BS + b) * 128 + row) * 2 + g) * 64 + 8 * j8);
                const f32x4 k0 = kp[0], k1 = kp[1], v0 = vp[0], v1 = vp[1];
                ko[0] = k0.x; ko[1] = k0.y; ko[2] = k0.z; ko[3] = k0.w; ko[4] = k1.x; ko[5] = k1.y; ko[6] = k1.z; ko[7] = k1.w; vo[0] = v0.x; vo[1] = v0.y; vo[2] = v0.z; vo[3] = v0.w; vo[4] = v1.x; vo[5] = v1.y; vo[6] = v1.z; vo[7] = v1.w; }
            else {
                int t, prow;
                if (SAMPLE) { t = row - 128; prow = 4096 + t; if (row >= 136) zero = true; } else { t = q0 - 127 + row; prow = t; if (t < 0 || row == 191) zero = true; }
                if (zero) {
#pragma unroll
                    for (int e = 0; e < 8; ++e) { ko[e] = 0.f; vo[e] = 0.f; } }
                else {
                    const GAS bf16* pr = PROJ + (mbase + t) * NPROJ;
                    const v4u kw = *(const GAS v4u*)(pr + C_DK + g * 64 + 8 * j8); const v4u vw = *(const GAS v4u*)(pr + C_DV + g * 64 + 8 * j8);
                    float kr[8] = {bflo(kw.x), bfhi(kw.x), bflo(kw.y), bfhi(kw.y), bflo(kw.z), bfhi(kw.z), bflo(kw.w), bfhi(kw.w)};
                    vo[0] = bflo(vw.x); vo[1] = bfhi(vw.x); vo[2] = bflo(vw.y); vo[3] = bfhi(vw.y); vo[4] = bflo(vw.z); vo[5] = bfhi(vw.z); vo[6] = bflo(vw.w); vo[7] = bfhi(vw.w);
                    float ss = 0.f;
#pragma unroll
                    for (int e = 0; e < 8; ++e) ss += kr[e] * kr[e];
                    ss += __shfl_xor(ss, 1); ss += __shfl_xor(ss, 2); ss += __shfl_xor(ss, 4);
                    const float rn = 1.f / sqrtf(ss * (1.f / 64.f) + EPS);
                    const GAS float* rp = ROPE + (size_t)prow * 64 + ((8 * j8) & 31);
#pragma unroll
                    for (int e = 0; e < 8; ++e) { const float kn = kr[e] * rn * kgv[e]; const float other = __shfl_xor(kn, 4); const float c = rp[e], s = rp[32 + e];
                        ko[e] = j8 < 4 ? kn * c - other * s : kn * c + other * s; }
                }
            }
            v4u kp4; kp4.x = pk2(ko[0], ko[1]); kp4.y = pk2(ko[2], ko[3]); kp4.z = pk2(ko[4], ko[5]); kp4.w = pk2(ko[6], ko[7]);
            *(LAS v4u*)(Kb + row * LDK + 8 * j8) = kp4;
#pragma unroll
            for (int e = 0; e < 8; ++e) VT[(8 * j8 + e) * LDV + row] = tobf(vo[e]);
            if (wr_cache && row >= roff && row < roff + 128) { const size_t o = ((ob + (row - roff)) * 2 + g) * 64 + 8 * j8;
                *(GAS f32x4*)(okp + o) = (f32x4){ko[0], ko[1], ko[2], ko[3]}; *(GAS f32x4*)(okp + o + 4) = (f32x4){ko[4], ko[5], ko[6], ko[7]};
                *(GAS f32x4*)(ovp + o) = (f32x4){vo[0], vo[1], vo[2], vo[3]}; *(GAS f32x4*)(ovp + o + 4) = (f32x4){vo[4], vo[5], vo[6], vo[7]}; }
        }
    }
    const bool qwave = !SAMPLE || wave == 0;
    if (qwave) {
        const int dh = lane & 1, qi = (lane >> 1) & 7, r = lane >> 4, head = g * 4 + r;
        const int t = SAMPLE ? qi : q0 + 8 * wave + qi; const int prow = SAMPLE ? 4096 + t : t;
        const GAS v4u* qp = (const GAS v4u*)(PROJ + (mbase + t) * NPROJ + C_DQ + head * 64 + 32 * dh);
        const v4u w0 = qp[0], w1 = qp[1], w2 = qp[2], w3 = qp[3];
        float ss = sq8(w0) + sq8(w1) + sq8(w2) + sq8(w3);
        ss += __shfl_xor(ss, 1);
        const float rn = 0.125f / sqrtf(ss * (1.f / 64.f) + EPS);
        const GAS float* qg = INP(I_QNG) + l * 64 + 32 * dh; const GAS float* rp = ROPE + (size_t)prow * 64;
        LAS v4u* qd = (LAS v4u*)(Qs + (32 * wave + 16 * (r >> 1) + 8 * (r & 1) + qi) * LDK + 32 * dh);
        qd[0] = rope8(w0, rn, qg, rp, dh); qd[1] = rope8(w1, rn, qg + 8, rp + 8, dh); qd[2] = rope8(w2, rn, qg + 16, rp + 16, dh); qd[3] = rope8(w3, rn, qg + 24, rp + 24, dh);
    }
    __syncthreads();
    bf16x8v qf[2][2];
    if (qwave) {
#pragma unroll
        for (int rt = 0; rt < 2; ++rt)
#pragma unroll
            for (int ks = 0; ks < 2; ++ks) qf[rt][ks] = *(const LAS bf16x8v*)(Qs + (32 * wave + 16 * rt + (lane & 15)) * LDK + 32 * ks + 8 * (lane >> 4));
    }
    __syncthreads();
    if (qwave) {
        const int ks0 = SAMPLE ? 0 : (8 * wave < 32 ? 8 * wave : 32);
        const GAS float* skp = INP(I_SINK) + l * 8 + g * 4;
#pragma unroll
        for (int rt = 0; rt < 2; ++rt) {
            f32x4 sc[10]; int kl = ks0 + (lane & 15); asm volatile("" : "+v"(kl));
#pragma unroll
            for (int c = 0; c < 10; ++c) { sc[c] = (f32x4){0.f, 0.f, 0.f, 0.f}; const LAS bf16* kp = Kb + (ks0 + 16 * c + (lane & 15)) * LDK + 8 * (lane >> 4);
                sc[c] = __builtin_amdgcn_mfma_f32_16x16x32_bf16(qf[rt][0], *(const LAS bf16x8v*)kp, sc[c], 0, 0, 0);
                sc[c] = __builtin_amdgcn_mfma_f32_16x16x32_bf16(qf[rt][1], *(const LAS bf16x8v*)(kp + 32), sc[c], 0, 0, 0); }
            float mx[4], sm[4], sinkv[4]; int klo[4]; unsigned span[4];
#pragma unroll
            for (int i = 0; i < 4; ++i) { const int row = 4 * (lane >> 4) + i, qi = row & 7; const int qrow = SAMPLE ? 128 + qi : 127 + 8 * wave + qi;
                sinkv[i] = skp[2 * rt + (row >> 3)]; mx[i] = sinkv[i]; sm[i] = 0.f;
                klo[i] = (qrow - 127) > row_min ? (qrow - 127) : row_min; span[i] = (unsigned)(qrow - klo[i]); }
#pragma unroll
            for (int c = 0; c < 10; ++c) { const int kr = kl + 16 * c;
#pragma unroll
                for (int i = 0; i < 4; ++i) { const float sv = ((unsigned)(kr - klo[i]) <= span[i]) ? sc[c][i] : -INFINITY; sc[c][i] = sv; mx[i] = fmaxf(mx[i], sv); } }
#pragma unroll
            for (int i = 0; i < 4; ++i) { float m = mx[i]; m = fmaxf(m, __shfl_xor(m, 1)); m = fmaxf(m, __shfl_xor(m, 2)); m = fmaxf(m, __shfl_xor(m, 4)); m = fmaxf(m, __shfl_xor(m, 8)); mx[i] = m; }
#pragma unroll
            for (int c = 0; c < 10; ++c) {
#pragma unroll
                for (int i = 0; i < 4; ++i) { const float p = __expf(sc[c][i] - mx[i]); sm[i] += p; Pw[(4 * (lane >> 4) + i) * LDPW + 16 * c + (lane & 15)] = tobf(p); } }
#pragma unroll
            for (int i = 0; i < 4; ++i) { float a = sm[i]; a += __shfl_xor(a, 1); a += __shfl_xor(a, 2); a += __shfl_xor(a, 4); a += __shfl_xor(a, 8); sm[i] = a + __expf(sinkv[i] - mx[i]); }
            asm volatile("s_waitcnt lgkmcnt(0)" ::: "memory");
#pragma unroll
            for (int dj = 0; dj < 4; ++dj) { f32x4 o = (f32x4){0.f, 0.f, 0.f, 0.f};
                o = mma16(Pw, LDPW, VT + dj * 16 * LDV + ks0, LDV, 160, o, lane);
#pragma unroll
                for (int i = 0; i < 4; ++i) { const int row = 4 * (lane >> 4) + i, qi = row & 7, head = g * 4 + 2 * rt + (row >> 3); const int t = SAMPLE ? qi : q0 + 8 * wave + qi;
                    MIX[(mbase + t) * D + 1536 + head * 64 + dj * 16 + (lane & 15)] = tobf(o[i] / sm[i]); } }
            asm volatile("s_waitcnt lgkmcnt(0)" ::: "memory");
        }
    }
}
__device__ __forceinline__ void pool_unit(Frame& F, int l, int u) {
    WS_LOCALS
    const int tid = F.tid, lane = F.lane, wave = F.wave;
    const GAS float* const spp = INP(I_SPOOL);
    LAS bf16* pl = (LAS bf16*)F.lds; constexpr int LDP = 520;
    const bool samp = u >= 128; const int b = samp ? 0 : (u >> 6), t0 = samp ? 0 : (u & 63) * 64; const int s8 = samp ? (u - 128) * 8 : 0;
    const size_t m0 = samp ? (size_t)MP + (size_t)s8 * TS : (size_t)b * TP + t0;
    __syncthreads();
    {   const int pr = tid & 255, half = tid >> 8, c0 = 2 * pr, gi = c0 >> 7, win = 2 << gi;
        if (!samp) {
            const GAS bf16* base = PROJ + ((size_t)b * TP) * NPROJ + C_PU + c0; const int ta = t0 + half * 32;
            float s0 = 0.f, s1 = 0.f;
            for (int j = 1; j < win; ++j) { const int t = ta - j; const unsigned w = *(const GAS unsigned*)(base + (size_t)(t >= 0 ? t : 0) * NPROJ); if (t >= 0) { s0 += bflo(w); s1 += bfhi(w); } }
#pragma unroll 4
            for (int i = 0; i < 32; ++i) { const int t = ta + i; const unsigned w = *(const GAS unsigned*)(base + (size_t)t * NPROJ); const float a0 = bflo(w), a1 = bfhi(w); s0 += a0; s1 += a1;
                const float cnt = (float)((t + 1) < win ? (t + 1) : win); const float ic = 1.f / cnt;
                *(LAS unsigned*)(pl + (half * 32 + i) * LDP + c0) = pk2(s0 * ic - a0, s1 * ic - a1);
                const int tl = t - win + 1; const unsigned wl = *(const GAS unsigned*)(base + (size_t)(tl >= 0 ? tl : 0) * NPROJ); if (tl >= 0) { s0 -= bflo(wl); s1 -= bfhi(wl); } }
        } else {
            for (int i = 0; i < 32; ++i) { const int tt = half * 32 + i, bs = s8 + (tt >> 3), ts = tt & 7; const GAS bf16* base = PROJ + ((size_t)MP + (size_t)bs * TS) * NPROJ + C_PU + c0; const GAS float* buf = spp + ((size_t)(l * BS + bs) * 15) * 512 + c0;
                float s0 = 0.f, s1 = 0.f, a0 = 0.f, a1 = 0.f;
                for (int j = 0; j < win; ++j) { const int e2 = 15 + ts - j; float x0, x1; if (e2 >= 15) { const unsigned w = *(const GAS unsigned*)(base + (size_t)(e2 - 15) * NPROJ); x0 = bflo(w); x1 = bfhi(w); } else { x0 = buf[(size_t)e2 * 512]; x1 = buf[(size_t)e2 * 512 + 1]; }
                    s0 += x0; s1 += x1; if (j == 0) { a0 = x0; a1 = x1; } }
                const float ic = 1.f / (float)win;
                *(LAS unsigned*)(pl + tt * LDP + c0) = pk2(s0 * ic - a0, s1 * ic - a1); }
        }
    }
    __syncthreads();
    {   const int g = wave >> 1; const GAS float* scp = INP(I_PSC) + l * 512 + g * 128;
        const GAS bf16* wpt = (const GAS bf16*)wsp(F, WS_WPT) + (size_t)(l * 4 + g) * 16384;
#pragma unroll 1
        for (int jj = 0; jj < 4; ++jj) { const int vj = 4 * (wave & 1) + jj;
            bf16x8v bfr[4];
#pragma unroll
            for (int k = 0; k < 4; ++k) bfr[k] = *(const GAS bf16x8v*)(wpt + (size_t)(vj * 16 + (lane & 15)) * 128 + k * 32 + 8 * (lane >> 4));
            const int dd = vj * 16 + (lane & 15); const float sc = scp[dd];
#pragma unroll
            for (int ti = 0; ti < 4; ++ti) { f32x4 acc = (f32x4){0.f, 0.f, 0.f, 0.f};
                const LAS bf16* ap = pl + (ti * 16 + (lane & 15)) * LDP + g * 128 + 8 * (lane >> 4);
#pragma unroll
                for (int k = 0; k < 4; ++k) acc = __builtin_amdgcn_mfma_f32_16x16x32_bf16(*(const LAS bf16x8v*)(ap + k * 32), bfr[k], acc, 0, 0, 0);
#pragma unroll
                for (int i = 0; i < 4; ++i) MIX[(m0 + ti * 16 + 4 * (lane >> 4) + i) * D + 512 + g * 128 + dd] = tobf(acc[i] * sc); } }
    }
    if (!samp && t0 == TP - 64) {
        float tv[15];
#pragma unroll
        for (int j = 0; j < 15; ++j) tv[j] = bf2f(PROJ[((size_t)b * TP + TP - 15 + j) * NPROJ + C_PU + tid]);
#pragma unroll
        for (int j = 0; j < 15; ++j) F.out[O_PPOOL + ((size_t)(l * BP + b) * 15 + j) * 512 + tid] = tv[j]; }
    if (samp) {
#pragma unroll 1
        for (int q = 0; q < 8; ++q) { const int bs = s8 + q; float tv[15];
#pragma unroll
            for (int j = 0; j < 15; ++j) tv[j] = j < 7 ? spp[((size_t)(l * BS + bs) * 15 + 8 + j) * 512 + tid] : bf2f(PROJ[((size_t)MP + (size_t)bs * TS + (j - 7)) * NPROJ + C_PU + tid]);
#pragma unroll
            for (int j = 0; j < 15; ++j) F.out[O_SPOOL + ((size_t)(l * BS + bs) * 15 + j) * 512 + tid] = tv[j]; } }
}
#ifndef TIME_MASK
#define TIME_MASK 0
#endif
#ifndef TIME_BLOCK
#define TIME_BLOCK 0
#endif
#define TSTART(bit) do { if ((TIME_MASK >> (bit)) & 1) tph = __builtin_amdgcn_s_memrealtime(); } while (0)
#define TSTOP(bit) do { if ((TIME_MASK >> (bit)) & 1) tacc += __builtin_amdgcn_s_memrealtime() - tph; } while (0)
#ifndef PROBE_MASK
#define PROBE_MASK 0
#endif
#ifndef PROBE_DUP
#define PROBE_DUP 0
#endif
#ifdef PH_SEL
#define PSEL(k, stmt) do { if ((k) == PH_SEL) { stmt; } } while (0)
#else
#define PSEL(k, stmt) do { stmt; } while (0)
#endif
struct Args { const float* in[N_IN]; float* out; unsigned char* ws; int ph_lo, ph_hi; };
static_assert(sizeof(Args) == (N_IN + 2) * 8 + 8, "Args has no padding");
__global__ void __launch_bounds__(NTHR, 2) hymba_fwd(Args args) {
    extern __shared__ __attribute__((aligned(16))) unsigned char lds[];
    Frame F;
    F.lds = (LAS unsigned char*)lds;
    F.MISC = (volatile LAS unsigned*)(F.lds + MISC_OFF);
    F.tid = threadIdx.x; F.lane = F.tid & 63; F.wave = __builtin_amdgcn_readfirstlane(F.tid >> 6);
    F.G = gridDim.x; F.gw = (int)blockIdx.x * NWAVES + F.wave; F.ngw = F.G * NWAVES;
    GAS unsigned char* ws = (GAS unsigned char*)args.ws; F.ws = ws; F.out = (GAS float*)args.out;
    F.ctl = (gu32*)(ws + WS_CTL);
    for (int u = F.tid; u < (LDS_BYTES - LDSCTL_OFF) / 4; u += NTHR) ((LAS unsigned*)(F.lds + LDSCTL_OFF))[u] = 0u;
    __syncthreads();
    if (F.tid < N_IN) ((LAS unsigned long long*)(F.lds + PTR_OFF))[F.tid] = (unsigned long long)args.in[F.tid];
    __syncthreads();
    const int lo = args.ph_lo, hi = args.ph_hi;
    XcdBarrier bar; bar.bar = (unsigned*)(F.ctl + CW_BAR); bar.x = 0; bar.st = nullptr;
    if (hi - lo > 1) bar = xcd_barrier_post((unsigned*)(F.ctl + CW_BAR), F.MISC + 8);
#define IN(k) (lo <= (k) && (k) < hi)
#define LAUNDER(P) asm volatile("" : "+v"(P.tid), "+v"(P.lane), "+s"(P.wave), "+s"(P.gw))
#define UL_DYN(bit, q, n, k, call) do { const int nrep_ = ((PROBE_MASK >> (bit)) & 1) ? 2 : 1; int nr_ = nrep_; asm volatile("" : "+s"(nr_)); for (int rr = 0; rr < nr_; ++rr) { Frame Q = F; LAUNDER(Q); while ((u = deq(Q, l * 32 + 16 * rr + (q))) < (n)) PSEL(k, call); } } while (0)
#define UL(bit, off, n, k, call) do { const int nrep_ = ((PROBE_MASK >> (bit)) & 1) ? 2 : 1; int nr_ = nrep_; asm volatile("" : "+s"(nr_)); for (int rr = 0; rr < nr_; ++rr) { Frame Q = F; LAUNDER(Q); for (u = ((int)blockIdx.x + F.G - ((off) % F.G)) % F.G; u < (n); u += F.G) { __syncthreads(); PSEL(k, call); } } } while (0)
#define PHASE_LOCALS Frame P = F; LAUNDER(P); WS_LOCALS
#define SEAM(k) do { if (IN(k) && IN((k) + 1)) xcd_barrier(bar); } while (0)
    unsigned long long tacc = 0, tph = 0; (void)tph;
    int rp_pro = (PROBE_DUP == 1) ? 2 : 1, rp_mix = (PROBE_DUP == 2) ? 2 : 1, rp_up = (PROBE_DUP == 3) ? 2 : 1, rp_in = (PROBE_DUP == 4) ? 2 : 1; asm volatile("" : "+s"(rp_pro), "+s"(rp_mix), "+s"(rp_up), "+s"(rp_in));
    TSTART(0); for (int rp = 0; rp < rp_pro; ++rp) { if (IN(0)) { PSEL(0, p0_prologue(F)); } SEAM(0); } TSTOP(0);
    for (int l = 0; l < DEPTH; ++l) {
        const int pb = 1 + l * PH_PER_LAYER;

        TSTART(1); if (IN(pb + 0)) { PHASE_LOCALS  PSEL(1, norm_phase(P, l, 0, l > 0 ? NSL_DN : 0)); } SEAM(pb + 0); TSTOP(1);
        for (int rq = 0; rq < rp_in; ++rq) {
        TSTART(2); if (IN(pb + 1)) { PHASE_LOCALS
            pg8::Gemm g{H, Wi + (size_t)l * NPROJ * D, M, NPROJ, D}; pg8::StaticOrder S; S.init(M, NPROJ, D, F.G, (int)blockIdx.x);
            pg8::EpiStoreBf16 E{PROJ, NPROJ, 0};
            PSEL(2, (pg8::gemm_phase<pg8::EpiStoreBf16, pg8::StaticOrder, true, true>(P.lds, g, S, E)));
        } SEAM(pb + 1); TSTOP(2);
        }
        for (int rp = 0; rp < rp_mix; ++rp) {
        TSTART(3); if (IN(pb + 2)) { PHASE_LOCALS
            int u;
            TSTART(11); UL(3, 0, 128, 3, ssd_unit<0>(Q, l, u)); TSTOP(11);
            TSTART(12); UL(1, 0, 256, 4, attn_unit<0>(Q, l, u)); TSTOP(12);
            TSTART(13); UL(7, 0, 512, 5, hgrn_unit<0>(Q, l, u)); TSTOP(13);
            TSTART(14); UL(2, 128, 132, 6, pool_unit(Q, l, u)); TSTOP(14);
            TSTART(15); UL(3, 128, 32, 7, ssd_unit<2>(Q, l, u)); TSTOP(15);
            TSTART(16); UL(1, 160, 64, 8, attn_unit<1>(Q, l, u)); TSTOP(16);
            TSTART(17); UL(3, 128, 128, 9, hgrn_unit<2>(Q, l, u)); TSTOP(17);
        } SEAM(pb + 2); TSTOP(3);
        TSTART(4); if (IN(pb + 3)) { PHASE_LOCALS  { int nr_ = ((PROBE_MASK >> 4) & 1) ? 2 : 1; asm volatile("" : "+s"(nr_)); for (int rr = 0; rr < nr_; ++rr) PSEL(10, scan_phase(P, l)); } } SEAM(pb + 3); TSTOP(4);
        TSTART(5); if (IN(pb + 4)) { PHASE_LOCALS
            int u;
            TSTART(18); UL(5, 0, 128, 11, ssd_unit<1>(Q, l, u)); TSTOP(18);
            TSTART(19); { Frame Q = F; LAUNDER(Q); const int bx = (int)blockIdx.x; if (F.G == 256) { if (bx < 128) { __syncthreads(); hgrn_unit<1>(Q, l, 384 + bx); } else { for (u = bx - 128; u < 384; u += 128) { __syncthreads(); hgrn_unit<1>(Q, l, u); } } } else { for (u = bx; u < 512; u += F.G) { __syncthreads(); hgrn_unit<1>(Q, l, u); } } } TSTOP(19);
        } SEAM(pb + 4); TSTOP(5);
        }
        TSTART(6); if (IN(pb + 5)) { PHASE_LOCALS
            pg8::Gemm g{MIX, Wo + (size_t)l * D * D, M, D, D}; pg8::SplitOrder S; S.init(MP, D, D, NSL_OUT, F.G, (int)blockIdx.x);
            pg8::EpiGateRes E{F.out, D, MOD + (size_t)l * NBB * NMOD + 2 * D, NMOD, (GAS float*)wsp(F, WS_PART)};
            PSEL(13, (pg8::gemm_phase<pg8::EpiGateRes, pg8::SplitOrder, true, true>(P.lds, g, S, E)));
        } SEAM(pb + 5); TSTOP(6);
        TSTART(7); if (IN(pb + 6)) { PHASE_LOCALS  PSEL(14, norm_phase(P, l, 1, NSL_OUT)); } SEAM(pb + 6); TSTOP(7);
        for (int rp = 0; rp < rp_up; ++rp) {
        TSTART(8); if (IN(pb + 7)) { PHASE_LOCALS
            pg8::Gemm g{H, Wu + (size_t)l * DFF * D, M, DFF, D}; pg8::StaticOrder S; S.init(M, DFF, D, F.G, (int)blockIdx.x);
            pg8::EpiStoreBf16 E{U, DFF, 1};
            PSEL(15, (pg8::gemm_phase<pg8::EpiStoreBf16, pg8::StaticOrder, true, true>(P.lds, g, S, E)));
            if (l + 1 < DEPTH) convert_layer(P, l + 1, 32, F.G - 32);
        } SEAM(pb + 7); TSTOP(8);
        }
        TSTART(9); if (IN(pb + 8)) { PHASE_LOCALS
            pg8::Gemm g{U, Wd + (size_t)l * D * DFF, M, D, DFF}; pg8::SplitOrder S; S.init(MP, D, DFF, NSL_DN, F.G, (int)blockIdx.x);
            pg8::EpiGateRes E{F.out, D, MOD + (size_t)l * NBB * NMOD + 5 * D, NMOD, (GAS float*)wsp(F, WS_PART)};
            PSEL(16, (pg8::gemm_phase<pg8::EpiGateRes, pg8::SplitOrder, true, true>(P.lds, g, S, E)));
        } SEAM(pb + 8); TSTOP(9);
    }
    TSTART(10); if (IN(N_PHASES - 1)) { Frame P = F; LAUNDER(P); final_fix_phase(P, NSL_DN); } TSTOP(10);
    if (UT_MASK != 0) tacc += ((unsigned long long)F.MISC[17] << 32) | F.MISC[16];
    if ((TIME_MASK != 0 || UT_MASK != 0) && blockIdx.x == TIME_BLOCK) { const unsigned long long te = __builtin_amdgcn_s_memrealtime() + tacc; while (__builtin_amdgcn_s_memrealtime() < te) __builtin_amdgcn_s_sleep(8); }
#undef IN
#undef SEAM
}

extern "C" void kernel_launch(void* const* d_in, const int* in_sizes, int n_in, void* d_out, int out_size, void* d_ws, size_t ws_size, hipStream_t stream) {
    static int grid = 0;
    if (grid == 0) {
        if (n_in != N_IN || (size_t)out_size != O_END || ws_size < WS_END) { fprintf(stderr, "kernel_launch: unexpected shapes (n_in %d, out %d, ws %zu); nothing launched\n", n_in, out_size, ws_size); grid = -1; return; }
        int dev = 0, cus = 0, per_cu = 0;
        if (hipGetDevice(&dev) != hipSuccess || hipDeviceGetAttribute(&cus, hipDeviceAttributeMultiprocessorCount, dev) != hipSuccess) { grid = -1; return; }
        if (hipFuncSetAttribute((const void*)hymba_fwd, hipFuncAttributeMaxDynamicSharedMemorySize, LDS_BYTES) != hipSuccess) { fprintf(stderr, "kernel_launch: hipFuncSetAttribute failed\n"); grid = -1; return; }
        if (hipOccupancyMaxActiveBlocksPerMultiprocessor(&per_cu, (const void*)hymba_fwd, NTHR, LDS_BYTES) != hipSuccess || per_cu < 1) { fprintf(stderr, "kernel_launch: occupancy query says %d\n", per_cu); }
        (void)hipGetLastError();
        grid = cus < 256 ? cus : 256;
    }
    if (grid < 0) return;
    if (hipMemsetAsync((char*)d_ws + WS_CTL, 0, CTL_ZERO_BYTES, stream) != hipSuccess) return;
    Args a{};
    for (int i = 0; i < N_IN; ++i) a.in[i] = (const float*)d_in[i];
    a.out = (float*)d_out; a.ws = (unsigned char*)d_ws;
#if MK_ONE_LAUNCH
    a.ph_lo = 0; a.ph_hi = N_PHASES;
    hipLaunchKernelGGL(hymba_fwd, dim3(grid), dim3(NTHR), LDS_BYTES, stream, a);
#else
    for (int k = 0; k < N_PHASES; ++k) { a.ph_lo = k; a.ph_hi = k + 1; hipLaunchKernelGGL(hymba_fwd, dim3(grid), dim3(NTHR), LDS_BYTES, stream, a); }
#endif
}
```

```cpp
#include <hip/hip_runtime.h>
#include <cstdio>
#include <cstdint>
namespace pg8 {
#define PG8_LAS __attribute__((address_space(3)))
#define PG8_GAS __attribute__((address_space(1)))
typedef unsigned short bf16_t;
typedef short bf16x8 __attribute__((ext_vector_type(8)));
typedef float f32x4 __attribute__((ext_vector_type(4)));
typedef unsigned u32x4 __attribute__((ext_vector_type(4)));
constexpr int BM = 256, BK = 64, HALF = 128, HTB = HALF * BK * 2  , STAGE_BYTES = 8 * HTB, NXCD = 8, WGM = 8;

__host__ __device__ __forceinline__ int lds_byte(int r, int c) { const int st = (r >> 4) * 2 + (c >> 5), rr = r & 15, cc = c & 31, ob = rr * 64 + cc * 2; return st * 1024 + (ob ^ (((ob >> 9) & 1) << 5)); }
__host__ __device__ __forceinline__ void stage_rc(int b, int& R, int& C) { const int st = b / 1024, sb = b % 1024, swz = sb ^ (((sb >> 9) & 1) << 5); R = (st >> 1) * 16 + swz / 64; C = (st & 1) * 32 + (swz % 64) / 2; }
__host__ __device__ __forceinline__ int perm32(int rho) { const int n = rho >> 4, i = rho & 15; return 8 * (i >> 2) + 4 * n + (i & 3); }

struct Unit { int pm, pn, k0, nt, at; };
struct Gemm { const PG8_GAS bf16_t* A; const PG8_GAS bf16_t* Bt; int M, N, K; };

struct StaticOrder {
    int nM, nN, nwg, G, c, ntK;
    __host__ __device__ void init(int M, int N, int K, int G_, int c_) { nM = M / BM; nN = N / BM; nwg = nM * nN; G = G_; c = c_; ntK = K / BK; }
    __host__ __device__ bool next(int i, Unit& u) const {
        const long L = (long)i * G + c; if (L >= nwg) return false;
        int wgid = (int)L; { const int q = nwg / NXCD, r = nwg % NXCD, xcd = wgid % NXCD, off = wgid / NXCD; wgid = (xcd < r ? xcd * (q + 1) : r * (q + 1) + (xcd - r) * q) + off; }
        const int nig = WGM * nN, gid = wgid / nig, fm = gid * WGM, gsz = (nM - fm) < WGM ? (nM - fm) : WGM;
        u.pm = fm + ((wgid % nig) % gsz); u.pn = (wgid % nig) / gsz; u.k0 = 0; u.nt = ntK; u.at = 0; return true;
    }
    __device__ __forceinline__ void a_ready(const Unit&) const {}
    __device__ __forceinline__ void done(const Unit&) const {}
};

struct SplitOrder {
    StaticOrder so; int nfull, ntot, pmS, nN, ntS;
    __host__ __device__ void init(int Mfull, int N, int K, int nslice, int G_, int c_) { so.init(Mfull, N, K, G_, c_); nfull = so.nwg; pmS = Mfull / BM; nN = N / BM; ntS = K / BK / nslice; ntot = nfull + nN * nslice; }
    __host__ __device__ bool next(int i, Unit& u) const {
        const long L = (long)i * so.G + so.c; if (L >= ntot) return false;
        if (L < nfull) return so.next(i, u);
        const int j = (int)L - nfull; u.pm = pmS; u.pn = j % nN; u.k0 = (j / nN) * ntS * BK; u.nt = ntS; u.at = 1; return true;
    }
    __device__ __forceinline__ void a_ready(const Unit&) const {}
    __device__ __forceinline__ void done(const Unit&) const {}
};

__device__ __forceinline__ unsigned cvt_pk_bf16(float lo, float hi) { unsigned r; asm volatile("v_cvt_pk_bf16_f32 %0, %1, %2" : "=v"(r) : "v"(lo), "v"(hi)); return r; }
typedef float f32x2 __attribute__((ext_vector_type(2)));
struct EpiStoreBf16 {
    static constexpr bool PERM = true, AFTER_DRAIN = false;
    PG8_GAS bf16_t* O; int ldc; int act;
    __device__ __forceinline__ void operator()(const f32x4 (&acc)[2][2][4][2], const Unit& u, int wr, int wc, int fr, int fq) const {
        const int row0 = u.pm * BM + wr * 64 + fr; const int col0 = u.pn * BM + wc * 32 + 8 * fq;
#pragma unroll
        for (int ai = 0; ai < 2; ++ai)
#pragma unroll
            for (int m = 0; m < 4; ++m) { PG8_GAS bf16_t* rowp = O + (size_t)(row0 + ai * HALF + m * 16) * ldc + col0;
#pragma unroll
                for (int bj = 0; bj < 2; ++bj) { f32x4 v0 = acc[ai][bj][m][0], v1 = acc[ai][bj][m][1];
                    if (act) {
#pragma unroll
                        for (int j = 0; j < 4; ++j) { const float a = v0[j] > 0.f ? v0[j] : 0.f, b = v1[j] > 0.f ? v1[j] : 0.f; v0[j] = a * a; v1[j] = b * b; } }
                    u32x4 w; w.x = cvt_pk_bf16(v0[0], v0[1]); w.y = cvt_pk_bf16(v0[2], v0[3]); w.z = cvt_pk_bf16(v1[0], v1[1]); w.w = cvt_pk_bf16(v1[2], v1[3]);
                    *(PG8_GAS u32x4*)(rowp + bj * HALF) = w; } }
    }
};
struct EpiGateRes {
    static constexpr bool PERM = true, AFTER_DRAIN = false;
    PG8_GAS float* X; int ldc; const PG8_GAS float* gate; int gstride; PG8_GAS float* part;
    __device__ __forceinline__ void operator()(const f32x4 (&acc)[2][2][4][2], const Unit& u, int wr, int wc, int fr, int fq) const {
        const int row0 = u.pm * BM + wr * 64 + fr, col0 = u.pn * BM + wc * 32 + 8 * fq;
        if (!u.at) {
            const int bb = (u.pm * BM) >> 12; const PG8_GAS float* gp = gate + (size_t)bb * gstride + col0;
            f32x4 gv[2][2];
#pragma unroll
            for (int bj = 0; bj < 2; ++bj)
#pragma unroll
                for (int n = 0; n < 2; ++n) gv[bj][n] = *(const PG8_GAS f32x4*)(gp + bj * HALF + n * 4);
#pragma unroll
            for (int ai = 0; ai < 2; ++ai)
#pragma unroll
                for (int m = 0; m < 4; ++m) { PG8_GAS float* rowp = X + (size_t)(row0 + ai * HALF + m * 16) * ldc + col0;
                    f32x4 xv[2][2];
#pragma unroll
                    for (int bj = 0; bj < 2; ++bj)
#pragma unroll
                        for (int n = 0; n < 2; ++n) xv[bj][n] = *(const PG8_GAS f32x4*)(rowp + bj * HALF + n * 4);
#pragma unroll
                    for (int bj = 0; bj < 2; ++bj)
#pragma unroll
                        for (int n = 0; n < 2; ++n) *(PG8_GAS f32x4*)(rowp + bj * HALF + n * 4) = xv[bj][n] + gv[bj][n] * acc[ai][bj][m][n]; }
        } else {
            const int sl = u.k0 / (u.nt * BK);
#pragma unroll
            for (int ai = 0; ai < 2; ++ai)
#pragma unroll
                for (int m = 0; m < 4; ++m) { const int row = row0 + ai * HALF + m * 16; const int bb = 2 + ((row - 8192) >> 3);
                    const PG8_GAS float* gp = gate + (size_t)bb * gstride + col0; PG8_GAS float* pp = part + ((size_t)(sl * BM + (row - 8192)) * ldc + col0);
                    f32x4 gv[2][2];
#pragma unroll
                    for (int bj = 0; bj < 2; ++bj)
#pragma unroll
                        for (int n = 0; n < 2; ++n) gv[bj][n] = *(const PG8_GAS f32x4*)(gp + bj * HALF + n * 4);
#pragma unroll
                    for (int bj = 0; bj < 2; ++bj)
#pragma unroll
                        for (int n = 0; n < 2; ++n) *(PG8_GAS f32x4*)(pp + bj * HALF + n * 4) = gv[bj][n] * acc[ai][bj][m][n]; }
        }
    }
};
template <class Epi, class Sched, bool ALIGN_EPI = false, bool SP2 = false>
__device__ __forceinline__ void gemm_phase(PG8_LAS unsigned char* lds, const Gemm g, const Sched& S, const Epi& E) {
    int tid_ = threadIdx.x; asm volatile("" : "+v"(tid_));
    const int tid = tid_, wid = __builtin_amdgcn_readfirstlane(tid >> 6), lane = tid & 63, wr = wid >> 2, wc = wid & 3, fr = lane & 15, fq = lane >> 4;
    const int K = g.K;
    unsigned voffA[2], voffB[2];
#pragma unroll
    for (int i = 0; i < 2; ++i) { int R, C; stage_rc(tid * 16 + i * 8192, R, C); const int Rb = Epi::PERM ? ((R & ~31) + perm32(R & 31)) : R;
        voffA[i] = (unsigned)(R * K + C) * 2u; voffB[i] = (unsigned)(Rb * K + C) * 2u; }
    const size_t kstep = (size_t)(BK * 2);
    const size_t hstep = (size_t)HALF * K * 2;
    const size_t tstep = 2 * hstep;
    const unsigned ldsw = (unsigned)wid * 1024u;
    const int aoff = lds_byte(wr * 64 + fr, fq * 8), boff = lds_byte(wc * 32 + fr, fq * 8);
#define PG8_SA(b, h) (((b) * 2 + (h)) * HTB)
#define PG8_SB(b, h) ((4 + (b) * 2 + (h)) * HTB)
#define PG8_STAGE(bufoff, gbase, voff) do { _Pragma("unroll") for (int _i = 0; _i < 2; ++_i) \
        __builtin_amdgcn_global_load_lds((const PG8_GAS unsigned*)((const PG8_GAS char*)(gbase) + (voff)[_i]), (PG8_LAS unsigned*)(lds + (bufoff) + ldsw + _i * 8192), 16, 0, 0); } while (0)
#define PG8_LDA(dst, b, h) do { _Pragma("unroll") for (int m = 0; m < 4; ++m) _Pragma("unroll") for (int k = 0; k < 2; ++k) dst[m][k] = *(const PG8_LAS bf16x8*)(lds + PG8_SA(b, h) + aoff + m * 2048 + k * 1024); } while (0)
#define PG8_LDB(dst, b, h) do { _Pragma("unroll") for (int n = 0; n < 2; ++n) _Pragma("unroll") for (int k = 0; k < 2; ++k) dst[n][k] = *(const PG8_LAS bf16x8*)(lds + PG8_SB(b, h) + boff + n * 2048 + k * 1024); } while (0)
#define PG8_MMA(ai, bj, At, Bt) do { __builtin_amdgcn_s_setprio(1); _Pragma("unroll") for (int m = 0; m < 4; ++m) _Pragma("unroll") for (int n = 0; n < 2; ++n) _Pragma("unroll") for (int k = 0; k < 2; ++k) \
        acc[ai][bj][m][n] = __builtin_amdgcn_mfma_f32_16x16x32_bf16(Bt[n][k], At[m][k], acc[ai][bj][m][n], 0, 0, 0); __builtin_amdgcn_s_setprio(0); } while (0)
#define PG8_WAIT_V(n) asm volatile("s_waitcnt vmcnt(" #n ")" ::: "memory")
#define PG8_WAIT_L(n) asm volatile("s_waitcnt lgkmcnt(" #n ")" ::: "memory")
#define PG8_BAR __builtin_amdgcn_s_barrier()
#define PG8_SCHED __builtin_amdgcn_sched_barrier(0)
    Unit cur, nxt; int ui = 0;
    if (!S.next(0, cur)) return;
    f32x4 acc[2][2][4][2];
#pragma unroll
    for (int a = 0; a < 2; ++a)
#pragma unroll
        for (int b = 0; b < 2; ++b)
#pragma unroll
            for (int m = 0; m < 4; ++m)
#pragma unroll
                for (int n = 0; n < 2; ++n) acc[a][b][m][n] = (f32x4){0.f, 0.f, 0.f, 0.f};
    bf16x8 At[4][2], B0[2][2], B1[2][2];
    const PG8_GAS char* cA = (const PG8_GAS char*)g.A + (size_t)cur.pm * tstep + (size_t)cur.k0 * 2; const PG8_GAS char* cB = (const PG8_GAS char*)g.Bt + (size_t)cur.pn * tstep + (size_t)cur.k0 * 2;
    S.a_ready(cur);
    if constexpr (SP2) {
        PG8_STAGE(PG8_SB(0, 0), cB, voffB); PG8_STAGE(PG8_SB(0, 1), cB + hstep, voffB); PG8_STAGE(PG8_SA(0, 0), cA, voffA); PG8_STAGE(PG8_SA(0, 1), cA + hstep, voffA);
        if (wr == 1) PG8_BAR;
        PG8_WAIT_V(2); PG8_BAR;
        PG8_STAGE(PG8_SB(1, 0), cB + kstep, voffB); PG8_STAGE(PG8_SA(1, 0), cA + kstep, voffA); PG8_STAGE(PG8_SB(1, 1), cB + hstep + kstep, voffB);
        PG8_WAIT_V(6); PG8_BAR;
    } else {
        PG8_STAGE(PG8_SB(0, 0), cB, voffB); PG8_STAGE(PG8_SA(0, 0), cA, voffA); PG8_STAGE(PG8_SB(0, 1), cB + hstep, voffB); PG8_STAGE(PG8_SA(0, 1), cA + hstep, voffA);
        if (wr == 1) PG8_BAR;
        PG8_WAIT_V(4); PG8_BAR;
        PG8_STAGE(PG8_SB(1, 0), cB + kstep, voffB); PG8_STAGE(PG8_SA(1, 0), cA + kstep, voffA); PG8_STAGE(PG8_SB(1, 1), cB + hstep + kstep, voffB);
        PG8_WAIT_V(6); PG8_BAR;
    }
    for (;;) {
        const bool has_next = S.next(ui + 1, nxt);
        const PG8_GAS char* nA = has_next ? (const PG8_GAS char*)g.A + (size_t)nxt.pm * tstep + (size_t)nxt.k0 * 2 : cA; const PG8_GAS char* nB = has_next ? (const PG8_GAS char*)g.Bt + (size_t)nxt.pn * tstep + (size_t)nxt.k0 * 2 : cB;
        const int nt = cur.nt;
        for (int t = 0; t < nt; t += 2) {
            const bool last = (t == nt - 2);
            const PG8_GAS char* a1 = cA + (size_t)(t + 1) * kstep;
            const PG8_GAS char* a2 = last ? nA : cA + (size_t)(t + 2) * kstep; const PG8_GAS char* b2 = last ? nB : cB + (size_t)(t + 2) * kstep;
            const PG8_GAS char* a3 = a2 + kstep; const PG8_GAS char* b3 = b2 + kstep;
            if (last && has_next) S.a_ready(nxt);
            if constexpr (SP2) {
            PG8_LDB(B0, 0, 0); PG8_LDB(B1, 0, 1); PG8_SCHED; PG8_LDA(At, 0, 0); PG8_STAGE(PG8_SA(1, 1), a1 + hstep, voffA);
            PG8_WAIT_V(8); PG8_WAIT_L(0); PG8_BAR; PG8_MMA(0, 0, At, B0); PG8_MMA(0, 1, At, B1); PG8_BAR; PG8_SCHED;
            PG8_LDA(At, 0, 1); PG8_STAGE(PG8_SB(0, 0), b2, voffB); PG8_STAGE(PG8_SB(0, 1), b2 + hstep, voffB); PG8_STAGE(PG8_SA(0, 0), a2, voffA);
            PG8_WAIT_V(8); PG8_WAIT_L(0); PG8_BAR; PG8_MMA(1, 0, At, B0); PG8_MMA(1, 1, At, B1); PG8_BAR; PG8_SCHED;
            PG8_LDB(B0, 1, 0); PG8_LDB(B1, 1, 1); PG8_SCHED; PG8_LDA(At, 1, 0); PG8_STAGE(PG8_SA(0, 1), a2 + hstep, voffA);
            PG8_WAIT_V(8); PG8_WAIT_L(0); PG8_BAR; PG8_MMA(0, 0, At, B0); PG8_MMA(0, 1, At, B1); PG8_BAR; PG8_SCHED;
            PG8_LDA(At, 1, 1); PG8_STAGE(PG8_SB(1, 0), b3, voffB); PG8_STAGE(PG8_SB(1, 1), b3 + hstep, voffB); PG8_STAGE(PG8_SA(1, 0), a3, voffA);
            PG8_WAIT_V(8); PG8_WAIT_L(0); PG8_BAR; PG8_MMA(1, 0, At, B0); PG8_MMA(1, 1, At, B1); PG8_BAR; PG8_SCHED;
            } else {
            PG8_LDB(B0, 0, 0); PG8_SCHED; PG8_LDA(At, 0, 0); PG8_STAGE(PG8_SA(1, 1), a1 + hstep, voffA);
            PG8_WAIT_L(8); PG8_BAR; PG8_WAIT_L(0); PG8_MMA(0, 0, At, B0); PG8_BAR; PG8_SCHED;
            PG8_LDB(B1, 0, 1); PG8_STAGE(PG8_SB(0, 0), b2, voffB);
            PG8_BAR; PG8_WAIT_L(0); PG8_MMA(0, 1, At, B1); PG8_BAR;
            PG8_LDA(At, 0, 1); PG8_STAGE(PG8_SA(0, 0), a2, voffA);
            PG8_BAR; PG8_WAIT_L(0); PG8_MMA(1, 0, At, B0); PG8_BAR; PG8_SCHED;
            PG8_STAGE(PG8_SB(0, 1), b2 + hstep, voffB);
            PG8_WAIT_V(6); PG8_BAR; PG8_MMA(1, 1, At, B1); PG8_BAR;
            PG8_LDB(B0, 1, 0); PG8_SCHED; PG8_LDA(At, 1, 0); PG8_STAGE(PG8_SA(0, 1), a2 + hstep, voffA);
            PG8_WAIT_L(8); PG8_BAR; PG8_WAIT_L(0); PG8_MMA(0, 0, At, B0); PG8_BAR; PG8_SCHED;
            PG8_LDB(B1, 1, 1); PG8_STAGE(PG8_SB(1, 0), b3, voffB);
            PG8_BAR; PG8_WAIT_L(0); PG8_MMA(0, 1, At, B1); PG8_BAR;
            PG8_LDA(At, 1, 1); PG8_STAGE(PG8_SA(1, 0), a3, voffA);
            PG8_BAR; PG8_WAIT_L(0); PG8_MMA(1, 0, At, B0); PG8_BAR; PG8_SCHED;
            PG8_STAGE(PG8_SB(1, 1), b3 + hstep, voffB);
            PG8_WAIT_V(6); PG8_BAR; PG8_MMA(1, 1, At, B1); PG8_BAR;
            }
        }
        if constexpr (ALIGN_EPI) { if (wr == 0) PG8_BAR; }
        if constexpr (!Epi::AFTER_DRAIN) { E(acc, cur, wr, wc, fr, fq); S.done(cur); }
        if (!has_next) break;
#pragma unroll
        for (int a = 0; a < 2; ++a)
#pragma unroll
            for (int b = 0; b < 2; ++b)
#pragma unroll
                for (int m = 0; m < 4; ++m)
#pragma unroll
                    for (int n = 0; n < 2; ++n) acc[a][b][m][n] = (f32x4){0.f, 0.f, 0.f, 0.f};
        cur = nxt; cA = nA; cB = nB; ++ui;
        if constexpr (ALIGN_EPI) { if (wr == 1) PG8_BAR; }
    }
    PG8_WAIT_V(0);
    if constexpr (!ALIGN_EPI) { if (wr == 0) PG8_BAR; }
    PG8_BAR;
    if constexpr (Epi::AFTER_DRAIN) { E.fused(acc, cur, wr, wc, fr, fq, lds, wid, lane); S.done(cur); }
#undef PG8_SA
#undef PG8_SB
#undef PG8_STAGE
#undef PG8_LDA
#undef PG8_LDB
#undef PG8_MMA
#undef PG8_WAIT_V
#undef PG8_WAIT_L
#undef PG8_BAR
#undef PG8_SCHED
}
}
constexpr int NWAVES = 8, NTHR = 512;
constexpr int D = 2048, DEPTH = 4, BP = 2, TP = 4096, BS = 32, TS = 8;
constexpr int MP = BP * TP, MS = BS * TS, M = MP + MS, NBB = BP + BS;
constexpr int NINW = 4872, NPROJ = 4864, DFF = 8192, NMOD = 6 * D, PAST = 16384;
constexpr int C_AQ = 0, C_AF = 512, C_AI = 1024, C_AG = 1536, C_PU = 2048, C_CZ = 2560, C_CX = 3072, C_DQ = 4096, C_DK = 4608, C_DV = 4736;
constexpr float EPS = 1e-6f;
enum { I_XP = 0, I_XS, I_CP, I_CS, I_SHG, I_SPOOL, I_SSSM, I_SCONV, I_CK, I_CV, I_N1G, I_N2G, I_WADA, I_BADA, I_WIN, I_LBL, I_HNG, I_PW, I_PSC, I_CW, I_CB, I_DTB, I_ALOG, I_DSK, I_SNG, I_QNG, I_KNG, I_SINK, I_WOUT, I_WUP, I_WDN, N_IN };
constexpr size_t O_Y = 0, O_PHG = (size_t)M * D, O_PPOOL = O_PHG + 4 * 2 * 4 * 16384, O_PSSM = O_PPOOL + 4 * 2 * 15 * 512, O_PCONV = O_PSSM + 4 * 2 * 8 * 8192, O_PK = O_PCONV + 4 * 2 * 3 * 1024,
    O_PV = O_PK + 4 * 2 * 128 * 128, O_SHG = O_PV + 4 * 2 * 128 * 128, O_SPOOL = O_SHG + (size_t)4 * 32 * 4 * 16384, O_SSSM = O_SPOOL + 4 * 32 * 15 * 512, O_SCONV = O_SSSM + (size_t)4 * 32 * 8 * 8192,
    O_SK = O_SCONV + 4 * 32 * 3 * 1024, O_SV = O_SK + 4 * 32 * 128 * 128, O_END = O_SV + 4 * 32 * 128 * 128;
static_assert(O_END == 41046016, "output size");
constexpr size_t MiB = 1u << 20;
constexpr size_t WS_CTL = 0, CTL_ZERO_BYTES = 1 * MiB;
constexpr size_t WS_MOD = 1 * MiB, WS_LB = 8 * MiB, WS_ROPE = 8 * MiB + 65536, WS_DT = 10 * MiB;
constexpr size_t WS_WIN = 16 * MiB, WS_WOUT = 92 * MiB, WS_WUP = 124 * MiB, WS_WDN = 252 * MiB;
constexpr size_t WS_H = 380 * MiB, WS_PROJ = 413 * MiB, WS_MIX = 492 * MiB, WS_U = 525 * MiB;
constexpr size_t WS_HGDS = 657 * MiB, WS_HGSS = 689 * MiB, WS_SDDS = 721 * MiB, WS_SDSS = 753 * MiB, WS_HGDEC = 785 * MiB, WS_SDDEC = 785 * MiB + 524288, WS_PART = 786 * MiB, WS_YTMP = 818 * MiB, WS_WPT = 850 * MiB, WS_WDT = 850 * MiB + 524288, WS_END = 851 * MiB;
static_assert(WS_WIN + (size_t)4 * NPROJ * D * 2 <= WS_WOUT && WS_PROJ + (size_t)M * NPROJ * 2 <= WS_MIX && WS_U + (size_t)M * DFF * 2 <= WS_HGDS, "ws map");
constexpr int CW_BAR = 4096, CW_Q = 16384, CQ_CONV = 160;
constexpr int RING_BYTES = 131072, LDSCTL_OFF = RING_BYTES, MISC_OFF = LDSCTL_OFF + 320, PTR_OFF = LDSCTL_OFF + 1024, LDS_BYTES = 147456;
constexpr int PH_PER_LAYER = 9, N_PHASES = 2 + DEPTH * PH_PER_LAYER;
constexpr int NSL_OUT = 8, NSL_DN = 16;
#ifndef MK_ONE_LAUNCH
#define MK_ONE_LAUNCH 1
#endif
#define GAS __attribute__((address_space(1)))
#define LAS __attribute__((address_space(3)))
typedef unsigned short bf16;
typedef unsigned v4u __attribute__((ext_vector_type(4)));
typedef float f32x4 __attribute__((ext_vector_type(4)));
typedef short bf16x8 __attribute__((ext_vector_type(8)));
typedef GAS unsigned gu32;
typedef GAS unsigned long long gu64;
#define RLX_AGENT __ATOMIC_RELAXED, __HIP_MEMORY_SCOPE_AGENT
#define LDS_WAIT() asm volatile("s_waitcnt lgkmcnt(0)" ::: "memory")
#define VM_WAIT() asm volatile("s_waitcnt vmcnt(0)" ::: "memory")
__device__ __forceinline__ unsigned long long rt() { return __builtin_amdgcn_s_memrealtime(); }
__device__ __forceinline__ unsigned f2bf(float f) { unsigned u = __builtin_bit_cast(unsigned, f); return (u + 0x7fffu + ((u >> 16) & 1u)) >> 16; }
__device__ __forceinline__ unsigned pk2(float lo, float hi) { return f2bf(lo) | (f2bf(hi) << 16); }

#define XB_TMO      128
#define XB_XCNT(j)  (256  + 64 * (j))
#define XB_XSUB(j)  (1280 + 64 * (j))
#define XB_XGEN(j)  (2304 + 64 * (j))
#define XB_TOP      3328
#define XB_TOPGEN   3392
#define XCD_BAR_WORDS 3456
#define XB_SPIN_CAP (1u << 18)

__device__ __forceinline__ unsigned xb_ld(unsigned* p)              { return __hip_atomic_load(p, __ATOMIC_RELAXED, __HIP_MEMORY_SCOPE_AGENT); }
__device__ __forceinline__ unsigned xb_add(unsigned* p, unsigned v) { return __hip_atomic_fetch_add(p, v, __ATOMIC_RELAXED, __HIP_MEMORY_SCOPE_AGENT); }
__device__ __forceinline__ unsigned xb_xcc_id() { return (unsigned)__builtin_amdgcn_s_getreg((3 << 11) | 20) & 0xFu; }
#define XB_SPIN(cond, bar) do { unsigned _sp = 0; while (cond) { __builtin_amdgcn_s_sleep(1); \
    if ((++_sp & 255u) == 0u) { if (xb_ld(&(bar)[XB_TMO])) break; if (_sp > XB_SPIN_CAP) { atomicAdd(&(bar)[XB_TMO], 1u); break; } } } } while (0)

struct XcdBarrier {
    unsigned* bar; unsigned x;
    volatile LAS unsigned* st;
};

__device__ __forceinline__ XcdBarrier xcd_barrier_post(unsigned* bar, volatile LAS unsigned* st) {
    XcdBarrier b; b.bar = bar; b.x = xb_xcc_id(); b.st = st;
    if (threadIdx.x == 0) (void)xb_add(&bar[XB_XCNT(b.x)], 1u);
    return b;
}
__device__ __forceinline__ void xcd_barrier_complete(unsigned* bar, unsigned x, unsigned& nloc, unsigned& nx) {
    const unsigned G = gridDim.x * gridDim.y * gridDim.z;
    unsigned sum, cnt, mine, sp = 0u;
    for (;;) {
        sum = 0u; cnt = 0u; mine = 0u;
#pragma unroll
        for (unsigned j = 0; j < 16; ++j) { const unsigned c = xb_ld(&bar[XB_XCNT(j)]); sum += c; cnt += (c > 0u) ? 1u : 0u; mine = (j == x) ? c : mine; }
        if (sum == G) break;
        __builtin_amdgcn_s_sleep(1);
        if ((++sp & 255u) == 0u) { if (xb_ld(&bar[XB_TMO])) break; if (sp > XB_SPIN_CAP) { atomicAdd(&bar[XB_TMO], 1u); break; } }
    }
    nloc = mine > 0u ? mine : 1u; nx = cnt > 0u ? cnt : 1u;
}

__device__ __forceinline__ void xcd_barrier(const XcdBarrier& b) {
    asm volatile("s_waitcnt vmcnt(0)" ::: "memory");
    __syncthreads();
    if (threadIdx.x == 0) {
        unsigned* bar = b.bar;
        __builtin_amdgcn_s_waitcnt(0);
        unsigned nloc = b.st[0], nx = b.st[1];
        if (nloc == 0u) { xcd_barrier_complete(bar, b.x, nloc, nx); b.st[0] = nloc; b.st[1] = nx; }
        const unsigned old = xb_add(&bar[XB_XSUB(b.x)], 1u);
        const unsigned gen = old / nloc;
        if (old + 1u == (gen + 1u) * nloc) {
            __builtin_amdgcn_fence(__ATOMIC_RELEASE, "agent");
            asm volatile("s_waitcnt vmcnt(0)" ::: "memory");
            const unsigned og = xb_add(&bar[XB_TOP], 1u);
            const unsigned tg = og / nx;
            if (og + 1u == (tg + 1u) * nx) xb_add(&bar[XB_TOPGEN], 1u);
            else XB_SPIN(xb_ld(&bar[XB_TOPGEN]) == tg, bar);
            __builtin_amdgcn_fence(__ATOMIC_ACQUIRE, "agent");
            xb_add(&bar[XB_XGEN(b.x)], 1u);
            asm volatile("s_waitcnt vmcnt(0)" ::: "memory");
        } else {
            XB_SPIN(xb_ld(&bar[XB_XGEN(b.x)]) == gen, bar);
            __builtin_amdgcn_fence(__ATOMIC_ACQUIRE, "agent");
            asm volatile("s_waitcnt vmcnt(0)" ::: "memory");
        }
    }
    __syncthreads();
}

struct Frame {
    LAS unsigned char* lds;
    volatile LAS unsigned* MISC;
    gu32* ctl;
    int tid, lane, wave, G, gw, ngw;
    GAS float* out; GAS unsigned char* ws;
};
__device__ __forceinline__ const GAS float* inp(const Frame& F, int i) {
    int off = PTR_OFF + 8 * i; asm volatile("" : "+s"(off));
    const unsigned long long v = *(const LAS unsigned long long*)(F.lds + off);
    const unsigned lo = __builtin_amdgcn_readfirstlane((unsigned)v), hi = __builtin_amdgcn_readfirstlane((unsigned)(v >> 32));
    return (const GAS float*)(((unsigned long long)hi << 32) | lo);
}
__device__ __forceinline__ GAS unsigned char* wsp(const Frame& F, size_t off) { GAS unsigned char* p = F.ws; asm volatile("" : "+s"(p)); return p + off; }
#define INP(i) inp(F, i)
#define WS_LOCALS \
    GAS float* const MOD = (GAS float*)wsp(F, WS_MOD); GAS float* const LBv = (GAS float*)wsp(F, WS_LB); GAS float* const ROPE = (GAS float*)wsp(F, WS_ROPE); GAS float* const DT = (GAS float*)wsp(F, WS_DT); \
    GAS bf16* const Wi = (GAS bf16*)wsp(F, WS_WIN); GAS bf16* const Wo = (GAS bf16*)wsp(F, WS_WOUT); GAS bf16* const Wu = (GAS bf16*)wsp(F, WS_WUP); GAS bf16* const Wd = (GAS bf16*)wsp(F, WS_WDN); \
    GAS bf16* const H = (GAS bf16*)wsp(F, WS_H); GAS bf16* const PROJ = (GAS bf16*)wsp(F, WS_PROJ); GAS bf16* const MIX = (GAS bf16*)wsp(F, WS_MIX); GAS bf16* const U = (GAS bf16*)wsp(F, WS_U); \
    GAS float* const HGDS = (GAS float*)wsp(F, WS_HGDS); GAS float* const HGSS = (GAS float*)wsp(F, WS_HGSS); GAS float* const SDDS = (GAS float*)wsp(F, WS_SDDS); GAS float* const SDSS = (GAS float*)wsp(F, WS_SDSS); \
    GAS float* const HGDEC = (GAS float*)wsp(F, WS_HGDEC); GAS float* const SDDEC = (GAS float*)wsp(F, WS_SDDEC); \
    (void)MOD; (void)LBv; (void)ROPE; (void)DT; (void)Wi; (void)Wo; (void)Wu; (void)Wd; (void)H; (void)PROJ; (void)MIX; (void)U; (void)HGDS; (void)HGSS; (void)SDDS; (void)SDSS; (void)HGDEC; (void)SDDEC;
__device__ __forceinline__ float wave_sum(float v) {
#pragma unroll
    for (int o = 1; o < 64; o <<= 1) v += __shfl_xor(v, o);
    return v;
}
__device__ __forceinline__ float bf2f(bf16 b) { return __builtin_bit_cast(float, (unsigned)b << 16); }
__device__ __forceinline__ float bflo(unsigned w) { return __builtin_bit_cast(float, w << 16); }
__device__ __forceinline__ float bfhi(unsigned w) { return __builtin_bit_cast(float, w & 0xffff0000u); }
__device__ __forceinline__ float sigm(float x) { return __builtin_amdgcn_rcpf(1.f + __expf(-x)); }
__device__ __forceinline__ float rsq(float x) { return __builtin_amdgcn_rsqf(x); }
__device__ __forceinline__ int row_bb(int m) { return m < MP ? (m >> 12) : BP + ((m - MP) >> 3); }
typedef short bf16x8v __attribute__((ext_vector_type(8)));
__device__ __forceinline__ f32x4 mma16(const LAS bf16* A, int lda, const LAS bf16* B, int ldb, int K, f32x4 acc, int lane) {
    const LAS bf16* ap = A + (lane & 15) * lda + 8 * (lane >> 4); const LAS bf16* bp = B + (lane & 15) * ldb + 8 * (lane >> 4);
    for (int k = 0; k < K; k += 32) { const bf16x8v a = *(const LAS bf16x8v*)(ap + k); const bf16x8v b = *(const LAS bf16x8v*)(bp + k); acc = __builtin_amdgcn_mfma_f32_16x16x32_bf16(a, b, acc, 0, 0, 0); }
    return acc;
}
__device__ __forceinline__ bf16 tobf(float f) { return (bf16)f2bf(f); }

#ifndef UT_MASK
#define UT_MASK 0
#endif
#define UTS(bit) do { if ((UT_MASK >> (bit)) & 1) { if (F.tid == 0) { const unsigned long long t_ = __builtin_amdgcn_s_memrealtime(); F.MISC[18] = (unsigned)t_; F.MISC[19] = (unsigned)(t_ >> 32); } } } while (0)
#define UTE(bit) do { if ((UT_MASK >> (bit)) & 1) { if (F.tid == 0) { const unsigned long long t0_ = ((unsigned long long)F.MISC[19] << 32) | F.MISC[18]; const unsigned long long a_ = (((unsigned long long)F.MISC[17] << 32) | F.MISC[16]) + (__builtin_amdgcn_s_memrealtime() - t0_); F.MISC[16] = (unsigned)a_; F.MISC[17] = (unsigned)(a_ >> 32); } } } while (0)
__device__ __forceinline__ int deq(Frame& F, int q) {
    __syncthreads();
    if (F.tid == 0) F.MISC[0] = __hip_atomic_fetch_add(F.ctl + CW_Q + 64 * q, 1u, RLX_AGENT);
    __syncthreads();
    return (int)F.MISC[0];
}

__device__ __forceinline__ void p0_transpose_item(const GAS float* W, int K, int ldw, GAS bf16* WT, int k0, int src_n0, int dst_n0, LAS float* scr, int lane) {
    float tv[32];
#pragma unroll
    for (int i = 0; i < 32; ++i) { const int kk = 2 * i + (lane >> 5); tv[i] = W[(size_t)(k0 + kk) * ldw + src_n0 + (lane & 31)]; }
#pragma unroll
    for (int i = 0; i < 32; ++i) { const int kk = 2 * i + (lane >> 5); scr[kk * 33 + (lane & 31)] = tv[i]; }
    LDS_WAIT(); asm volatile("" ::: "memory");
    const int c = lane & 7;
#pragma unroll
    for (int j = 0; j < 4; ++j) { const int n = (lane >> 3) + 8 * j; const LAS float* s = scr + (8 * c) * 33 + n;
        v4u o; o.x = pk2(s[0 * 33], s[1 * 33]); o.y = pk2(s[2 * 33], s[3 * 33]); o.z = pk2(s[4 * 33], s[5 * 33]); o.w = pk2(s[6 * 33], s[7 * 33]);
        *(GAS v4u*)(WT + (size_t)(dst_n0 + n) * K + k0 + 8 * c) = o; }
    LDS_WAIT(); asm volatile("" ::: "memory");
}
__device__ __forceinline__ void p0_adaln(Frame& F) {
    WS_LOCALS
    constexpr int LDC = 520, NITEM = DEPTH * NMOD / 32;
    LAS bf16* cs = (LAS bf16*)F.lds;
    const GAS float* const cpp = INP(I_CP); const GAS float* const csp = INP(I_CS); const GAS float* const wada = INP(I_WADA); const GAS float* const bada = INP(I_BADA);
    const int lane = F.lane, item = (int)blockIdx.x + F.G * F.wave; const bool act = item < NITEM;
    const int l = act ? item / (NMOD / 32) : 0, n0 = act ? (item % (NMOD / 32)) * 32 : 0;
    f32x4 acc[2][3];
#pragma unroll
    for (int a = 0; a < 2; ++a)
#pragma unroll
        for (int r = 0; r < 3; ++r) acc[a][r] = (f32x4){0.f, 0.f, 0.f, 0.f};
    const GAS float* wl = wada + (size_t)l * D * NMOD + n0 + (lane & 15);
    for (int kc = 0; kc < 4; ++kc) {
        __syncthreads();
        for (int e = F.tid; e < 48 * 512; e += NTHR) { const int bb = e >> 9, kk = e & 511; float v = 0.f;
            if (bb < NBB) { const float c = bb < BP ? cpp[bb * D + kc * 512 + kk] : csp[(bb - BP) * D + kc * 512 + kk]; v = c * sigm(c); }
            cs[bb * LDC + kk] = tobf(v); }
        __syncthreads();
        if (act) {
#pragma unroll 2
            for (int ks = 0; ks < 16; ++ks) { const int kg = kc * 512 + ks * 32 + 8 * (lane >> 4);
                float w0[8], w1[8];
#pragma unroll
                for (int j = 0; j < 8; ++j) { w0[j] = wl[(size_t)(kg + j) * NMOD]; w1[j] = wl[(size_t)(kg + j) * NMOD + 16]; }
                v4u b0, b1; b0.x = pg8::cvt_pk_bf16(w0[0], w0[1]); b0.y = pg8::cvt_pk_bf16(w0[2], w0[3]); b0.z = pg8::cvt_pk_bf16(w0[4], w0[5]); b0.w = pg8::cvt_pk_bf16(w0[6], w0[7]);
                b1.x = pg8::cvt_pk_bf16(w1[0], w1[1]); b1.y = pg8::cvt_pk_bf16(w1[2], w1[3]); b1.z = pg8::cvt_pk_bf16(w1[4], w1[5]); b1.w = pg8::cvt_pk_bf16(w1[6], w1[7]);
                const bf16x8v bf0 = __builtin_bit_cast(bf16x8v, b0), bf1 = __builtin_bit_cast(bf16x8v, b1);
#pragma unroll
                for (int r = 0; r < 3; ++r) { const bf16x8v a = *(const LAS bf16x8v*)(cs + (16 * r + (lane & 15)) * LDC + ks * 32 + 8 * (lane >> 4));
                    acc[0][r] = __builtin_amdgcn_mfma_f32_16x16x32_bf16(a, bf0, acc[0][r], 0, 0, 0); acc[1][r] = __builtin_amdgcn_mfma_f32_16x16x32_bf16(a, bf1, acc[1][r], 0, 0, 0); } }
        }
    }
    if (act) {
#pragma unroll
        for (int a = 0; a < 2; ++a) { const int n = n0 + 16 * a + (lane & 15); const float bias = bada[l * NMOD + n];
#pragma unroll
            for (int r = 0; r < 3; ++r)
#pragma unroll
                for (int i = 0; i < 4; ++i) { const int bb = 16 * r + 4 * (lane >> 4) + i; if (bb < NBB) MOD[((size_t)l * NBB + bb) * NMOD + n] = acc[a][r][i] + bias; } }
    }
    __syncthreads();
}
__device__ __forceinline__ void convert_layer(Frame& F, int l, int first, int nblk_, int bt0, int bt1) {
    WS_LOCALS
    LAS float* scr = (LAS float*)(F.lds + F.wave * 16384);
    constexpr int IT_IN = (D / 64) * (NPROJ / 32), IT_OUT = (D / 64) * (D / 32), IT_UP = (D / 64) * (DFF / 32), IT_DN = (DFF / 64) * (D / 32), IT_L = IT_IN + IT_OUT + IT_UP + IT_DN, NBATCH = (IT_L + 15) / 16;
    const GAS float* const win = INP(I_WIN) + (size_t)l * D * NINW; const GAS float* const wout = INP(I_WOUT) + (size_t)l * D * D; const GAS float* const wup = INP(I_WUP) + (size_t)l * D * DFF; const GAS float* const wdn = INP(I_WDN) + (size_t)l * DFF * D;
    const int me = (int)blockIdx.x - first; if (me < 0 || me >= nblk_) return;
    const int bte = bt1 < NBATCH ? bt1 : NBATCH;
    for (int bt = bt0 + me; bt < bte; bt += nblk_) {
#pragma unroll 1
        for (int s = 0; s < 2; ++s) { int r = bt * 16 + s * 8 + F.wave; if (r >= IT_L) continue;
            if (r < IT_IN) { const int nblk = NPROJ / 32, kb = r / nblk, nb = r % nblk, dn0 = 32 * nb, sn0 = dn0 + (dn0 >= 4096 ? 8 : 0);
                p0_transpose_item(win, D, NINW, Wi + (size_t)l * NPROJ * D, 64 * kb, sn0, dn0, scr, F.lane); continue; } r -= IT_IN;
            if (r < IT_OUT) { const int nblk = D / 32, kb = r / nblk, nb = r % nblk;
                p0_transpose_item(wout, D, D, Wo + (size_t)l * D * D, 64 * kb, 32 * nb, 32 * nb, scr, F.lane); continue; } r -= IT_OUT;
            if (r < IT_UP) { const int nblk = DFF / 32, kb = r / nblk, nb = r % nblk;
                p0_transpose_item(wup, D, DFF, Wu + (size_t)l * DFF * D, 64 * kb, 32 * nb, 32 * nb, scr, F.lane); continue; } r -= IT_UP;
            { const int nblk = D / 32, kb = r / nblk, nb = r % nblk;
                p0_transpose_item(wdn, DFF, D, Wd + (size_t)l * D * DFF, 64 * kb, 32 * nb, 32 * nb, scr, F.lane); } }
    }
}
__device__ __forceinline__ void p0_prologue(Frame& F) {
    WS_LOCALS
    const int gt = blockIdx.x * NTHR + F.tid, NT = F.G * NTHR;
    { const GAS f32x4* s = (const GAS f32x4*)INP(I_XP); GAS f32x4* d = (GAS f32x4*)F.out;
      for (int i = gt; i < MP * D / 4; i += NT) d[i] = s[i];
      s = (const GAS f32x4*)INP(I_XS); d = (GAS f32x4*)(F.out + (size_t)MP * D);
      for (int i = gt; i < MS * D / 4; i += NT) d[i] = s[i]; }
    if (gt < 512) { const GAS float* lg = INP(I_LBL); const float a0 = lg[gt], a1 = lg[512 + gt], a2 = lg[1024 + gt], a3 = lg[1536 + gt];
        const float mx = fmaxf(fmaxf(a0, a1), fmaxf(a2, a3)); const float e0 = expf(a0 - mx), e1 = expf(a1 - mx), e2 = expf(a2 - mx), e3 = expf(a3 - mx); const float inv = 1.f / (e0 + e1 + e2 + e3);
        LBv[gt] = 0.f; LBv[512 + gt] = e1 * inv; LBv[1024 + gt] = (e1 + e2) * inv; LBv[1536 + gt] = (e1 + e2 + e3) * inv; }
    for (int e = gt; e < 4104 * 32; e += NT) { const int r = e >> 5, i = e & 31; const int pos = r < 4096 ? r : PAST + (r - 4096);
        const double inv = exp2(-(double)i * (13.287712379549449 / 32.0)); const double rev = (double)pos * inv * 0.15915494309189535;
        const float fr = (float)(rev - floor(rev));
        ROPE[r * 64 + i] = __builtin_amdgcn_cosf(fr); ROPE[r * 64 + 32 + i] = __builtin_amdgcn_sinf(fr); }
    { const GAS float* wi = INP(I_WIN); GAS float* wdtg = (GAS float*)wsp(F, WS_WDT);
      for (int e = gt; e < DEPTH * D * 8; e += NT) { const int ll = e >> 14, d2 = (e >> 3) & 2047, j = e & 7; wdtg[(ll * 8 + j) * D + d2] = wi[((size_t)ll * D + d2) * NINW + 4096 + j]; } }
    { const GAS float* pw = INP(I_PW); GAS bf16* wpt = (GAS bf16*)wsp(F, WS_WPT);
      for (int e = gt; e < 16 * 16384; e += NT) { const int lg = e >> 14, dd = (e >> 7) & 127, c = e & 127; wpt[e] = (bf16)f2bf(pw[(size_t)lg * 16384 + c * 128 + dd]); } }
    p0_adaln(F);
    convert_layer(F, 0, 0, F.G, 0, 1 << 30);
}

__device__ __forceinline__ void norm_row(Frame& F, int l, int which, int m, f32x4 (&v)[8], const GAS f32x4* g4, const GAS float* MOD, GAS bf16* H, GAS float* DT, const LAS float* wdt) {
    const int bb = row_bb(m);
    const GAS float* modp = MOD + ((size_t)l * NBB + bb) * NMOD + (which ? 3 * D : 0);
    const GAS f32x4* sh4 = (const GAS f32x4*)modp; const GAS f32x4* sc4 = (const GAS f32x4*)(modp + D);
    float ss = 0.f;
#pragma unroll
    for (int j = 0; j < 8; ++j) ss += (v[j].x * v[j].x + v[j].y * v[j].y) + (v[j].z * v[j].z + v[j].w * v[j].w);
    GAS unsigned long long* o8 = (GAS unsigned long long*)(H + (size_t)m * D);
    f32x4 gs[8], shv[8];
#pragma unroll
    for (int j = 0; j < 8; ++j) { const int q = 64 * j + F.lane; const f32x4 g = g4[q], sc = sc4[q]; shv[j] = sh4[q]; gs[j] = g * (sc + 1.f); }
    const float r = rsq(wave_sum(ss) * (1.f / D) + EPS);
#pragma unroll
    for (int j = 0; j < 8; ++j) { const int q = 64 * j + F.lane;
        f32x4 h; h.x = v[j].x * r * gs[j].x + shv[j].x; h.y = v[j].y * r * gs[j].y + shv[j].y; h.z = v[j].z * r * gs[j].z + shv[j].z; h.w = v[j].w * r * gs[j].w + shv[j].w;
        o8[q] = (unsigned long long)pk2(h.x, h.y) | ((unsigned long long)pk2(h.z, h.w) << 32);
        v[j] = h; }
    if (which == 0) { float dta[8];
#pragma unroll
        for (int jj = 0; jj < 8; ++jj) { float a = 0.f;
#pragma unroll
            for (int j = 0; j < 8; ++j) { const f32x4 w = ((const LAS f32x4*)wdt)[jj * (D / 4) + 64 * j + F.lane]; a += (v[j].x * w.x + v[j].y * w.y) + (v[j].z * w.z + v[j].w * w.w); }
            dta[jj] = a; __builtin_amdgcn_sched_barrier(0); }
#pragma unroll
        for (int o = 1; o < 64; o <<= 1) {
#pragma unroll
            for (int jj = 0; jj < 8; ++jj) dta[jj] += __shfl_xor(dta[jj], o); }
        if (F.lane == 0) { GAS f32x4* dp = (GAS f32x4*)(DT + (size_t)m * 8); dp[0] = (f32x4){dta[0], dta[1], dta[2], dta[3]}; dp[1] = (f32x4){dta[4], dta[5], dta[6], dta[7]}; } }
}
__device__ __forceinline__ void sample_row_reduce(Frame& F, int ms, int nsl, f32x4 (&v)[8], LAS float* partl) {
    const GAS f32x4* pp = (const GAS f32x4*)wsp(F, WS_PART) + (size_t)ms * (D / 4); GAS f32x4* xw = (GAS f32x4*)(F.out + (size_t)(MP + ms) * D);
#pragma unroll
    for (int j = 0; j < 8; ++j) v[j] = (F.wave == 0) ? xw[64 * j + F.lane] : (f32x4){0.f, 0.f, 0.f, 0.f};
#pragma unroll 1
    for (int s = F.wave; s < nsl; s += 8) {
#pragma unroll
        for (int j = 0; j < 8; ++j) v[j] = v[j] + pp[(size_t)s * (MS * D / 4) + 64 * j + F.lane]; }
    if (F.wave != 0) {
#pragma unroll
        for (int j = 0; j < 8; ++j) ((LAS f32x4*)partl)[(F.wave - 1) * (D / 4) + 64 * j + F.lane] = v[j]; }
    __syncthreads();
    if (F.wave == 0) {
#pragma unroll 1
        for (int w = 0; w < 7; ++w) {
#pragma unroll
            for (int j = 0; j < 8; ++j) v[j] = v[j] + ((const LAS f32x4*)partl)[w * (D / 4) + 64 * j + F.lane]; }
#pragma unroll
        for (int j = 0; j < 8; ++j) xw[64 * j + F.lane] = v[j]; }
}
__device__ __forceinline__ void norm_phase(Frame& F, int l, int which, int nsl) {
    WS_LOCALS
    LAS float* wdt = (LAS float*)F.lds;
    LAS float* partl = (LAS float*)(F.lds + 65536);
    if (which == 0) { const GAS f32x4* wsrc = (const GAS f32x4*)((const GAS float*)wsp(F, WS_WDT) + (size_t)l * 8 * D);
        for (int e = F.tid; e < D * 8 / 4; e += NTHR) ((LAS f32x4*)wdt)[e] = wsrc[e]; }
    __syncthreads();
    const GAS f32x4* g4 = (const GAS f32x4*)(INP(which ? I_N2G : I_N1G) + l * D);
    f32x4 v[8];
    if (nsl > 0) for (int ms = (int)blockIdx.x; ms < MS; ms += F.G) { sample_row_reduce(F, ms, nsl, v, partl); if (F.wave == 0) norm_row(F, l, which, MP + ms, v, g4, MOD, H, DT, wdt); __syncthreads(); }
    const int mend = nsl > 0 ? MP : M;
    f32x4 vn[8];
    if (F.gw < mend) { const GAS f32x4* xr = (const GAS f32x4*)(F.out + (size_t)F.gw * D);
#pragma unroll
        for (int j = 0; j < 8; ++j) vn[j] = xr[64 * j + F.lane]; }
    for (int m = F.gw; m < mend; m += F.ngw) {
#pragma unroll
        for (int j = 0; j < 8; ++j) v[j] = vn[j];
        const int mn = (m + F.ngw < mend) ? m + F.ngw : m; const GAS f32x4* xr = (const GAS f32x4*)(F.out + (size_t)mn * D);
#pragma unroll
        for (int j = 0; j < 8; ++j) vn[j] = xr[64 * j + F.lane];
        norm_row(F, l, which, m, v, g4, MOD, H, DT, wdt); }
}
__device__ __forceinline__ void final_fix_phase(Frame& F, int nsl) {
    LAS float* partl = (LAS float*)(F.lds + 65536); f32x4 v[8];
    __syncthreads();
    for (int ms = (int)blockIdx.x; ms < MS; ms += F.G) { sample_row_reduce(F, ms, nsl, v, partl); __syncthreads(); }
}
template <int MODE> __device__ __forceinline__ unsigned ssd_raw(const GAS bf16* PROJ, const GAS float* scv, int l, int b, int m0, int tseq0, int r, int ch) {
    if (MODE == 2) { const int rp = r < 0 ? 0 : (r > 7 ? 7 : r), rs = r < 0 ? 3 + r : 0;
        const unsigned a = *(const GAS unsigned*)(PROJ + (size_t)(m0 + rp) * NPROJ + C_CX + ch); const GAS float* sc = scv + ((size_t)(l * BS + b) * 3 + rs) * 1024 + ch; const unsigned c = pk2(sc[0], sc[1]);
        return r < 0 ? c : (r > 7 ? 0u : a); }
    const int rc = (tseq0 + r >= 0) ? r : -tseq0; const unsigned a = *(const GAS unsigned*)(PROJ + (size_t)(m0 + rc) * NPROJ + C_CX + ch);
    return (tseq0 + r >= 0) ? a : 0u;
}
template <int MODE> __device__ __forceinline__ void ssd_unit(Frame& F, int l, int u) {
    WS_LOCALS
    constexpr int T = (MODE == 2) ? 16 : 64, SK = (MODE == 2) ? 32 : 64, L = (MODE == 2) ? 8 : 64, LDN = 136, LDS_ = SK + 8;
    constexpr int NT_CB = (T / 16) * (SK / 16), NT_Y = (T / 16) * 4;
    constexpr int OFF_BG = (MODE == 0 ? 0 : T * LDN * 2), OFF_BGT = OFF_BG + (MODE == 0 ? 0 : T * LDN * 2), OFF_XT = OFF_BGT + (MODE == 1 ? 0 : 128 * LDS_ * 2), OFF_XWT = OFF_XT + (MODE == 0 ? 0 : 4 * 64 * LDS_ * 2),
                  OFF_WL = OFF_XWT + (MODE == 1 ? 0 : 4 * 64 * LDS_ * 2), OFF_SM = OFF_WL + (MODE == 0 ? 0 : 4 * T * LDS_ * 2);
    constexpr int OFF_S0 = (MODE == 2) ? OFF_SM + 2304 : 0;
    static_assert(OFF_SM + 2304 <= RING_BYTES && (MODE != 2 || OFF_S0 + 2 * 64 * 136 * 2 <= RING_BYTES) && (MODE != 1 || 2 * 64 * 136 * 2 <= OFF_XT), "ssd LDS map");
    const int tid0 = F.tid, lane0 = F.lane, wave = F.wave;
    const GAS float* const cwp = INP(I_CW); const GAS float* const cbp = INP(I_CB); const GAS float* const scv = INP(I_SCONV);
    int b, m0, tseq0;
    if (MODE == 2) { b = u; m0 = MP + b * TS; tseq0 = 0; } else { b = u >> 6; m0 = b * TP + (u & 63) * 64; tseq0 = (u & 63) * 64; }
    LAS bf16* Cg = (LAS bf16*)F.lds;
    LAS bf16* Bg = (LAS bf16*)(F.lds + OFF_BG);
    LAS bf16* BgT = (LAS bf16*)(F.lds + OFF_BGT);
    LAS bf16* xT = (LAS bf16*)(F.lds + OFF_XT);
    LAS bf16* xwT = (LAS bf16*)(F.lds + OFF_XWT);
    LAS bf16* Wl = (LAS bf16*)(F.lds + OFF_WL);
    LAS float* cumL = (LAS float*)(F.lds + OFF_SM);
    LAS float* dtL = cumL + 256;
    LAS float* rowss = dtL + 256;
    GAS float* const ytmp = (GAS float*)wsp(F, WS_YTMP) + (size_t)blockIdx.x * (64 * 512);
    float ssum[4] = {0.f, 0.f, 0.f, 0.f};
    if (tid0 < 64) rowss[tid0] = 0.f;
#pragma unroll 1
    for (int g = 0; g < 2; ++g) {
        int tid = tid0, lane = lane0; asm volatile("" : "+v"(tid), "+v"(lane));
        __syncthreads();
        if (MODE == 1) UTS(0);
        if (wave < 4) { const int hh = g * 4 + wave; float dtv = 0.f, a = 0.f;
            { const int tl = lane < L ? lane : L - 1; const float raw = DT[(size_t)(m0 + tl) * 8 + hh] + INP(I_DTB)[l * 8 + hh]; const float dt1 = raw > 20.f ? raw : log1pf(__expf(raw)); const float a1 = -dt1 * __expf(INP(I_ALOG)[l * 8 + hh]);
              dtv = lane < L ? dt1 : 0.f; a = lane < L ? a1 : 0.f; }
#pragma unroll
            for (int o = 1; o < 64; o <<= 1) { const float y = __shfl_up(a, o); if (lane >= o) a += y; }
            cumL[lane * 4 + wave] = a; dtL[lane * 4 + wave] = dtv; }
        {   const int pr = tid & 127, rq = tid >> 7;
            const int isC = pr >> 6, n0 = 2 * (pr & 63), ch = 512 + isC * 256 + g * 128 + n0;
            if (MODE != 0 || !isC) {
                float w[4][2], bia[2];
#pragma unroll
                for (int j = 0; j < 4; ++j) { w[j][0] = cwp[(l * 4 + j) * 1024 + ch]; w[j][1] = cwp[(l * 4 + j) * 1024 + ch + 1]; }
                bia[0] = cbp[l * 1024 + ch]; bia[1] = cbp[l * 1024 + ch + 1];
                constexpr int RQ = T / 4; const int r0 = rq * RQ;
                unsigned ra[RQ + 3];
#pragma unroll
                for (int i = 0; i < RQ + 3; ++i) ra[i] = ssd_raw<MODE>(PROJ, scv, l, b, m0, tseq0, r0 - 3 + i, ch);
#pragma unroll
                for (int i = 0; i < RQ; ++i) { const int r = r0 + i; float c0 = 0.f, c1 = 0.f;
                    if (r < L) { c0 = bia[0] + w[0][0] * bflo(ra[i]) + w[1][0] * bflo(ra[i + 1]) + w[2][0] * bflo(ra[i + 2]) + w[3][0] * bflo(ra[i + 3]); c1 = bia[1] + w[0][1] * bfhi(ra[i]) + w[1][1] * bfhi(ra[i + 1]) + w[2][1] * bfhi(ra[i + 2]) + w[3][1] * bfhi(ra[i + 3]);
                        c0 = c0 * sigm(c0); c1 = c1 * sigm(c1); }
                    if (isC) { if (MODE != 0) *(LAS unsigned*)(Cg + r * LDN + n0) = pk2(c0, c1); }
                    else { if (MODE != 0) *(LAS unsigned*)(Bg + r * LDN + n0) = pk2(c0, c1);
                           if (MODE != 1) { BgT[n0 * LDS_ + r] = tobf(c0); BgT[(n0 + 1) * LDS_ + r] = tobf(c1); } } }
                if (MODE == 2 && !isC) { for (int r = T + rq * 4; r < T + rq * 4 + 4; ++r) { BgT[n0 * LDS_ + r] = 0; BgT[(n0 + 1) * LDS_ + r] = 0; } }
            }
        }
        __syncthreads();
        if (MODE == 1) { UTE(0); UTS(1); }
        { int t_ = tid0, l_ = lane0; asm volatile("" : "+v"(t_), "+v"(l_)); tid = t_; lane = l_; }
        {   const int pr = tid & 127, rq = tid >> 7, r = pr >> 5, pp = pr & 31; const int ch = (g * 4 + r) * 64 + 2 * pp;
            float w[4][2], bia[2];
#pragma unroll
            for (int j = 0; j < 4; ++j) { w[j][0] = cwp[(l * 4 + j) * 1024 + ch]; w[j][1] = cwp[(l * 4 + j) * 1024 + ch + 1]; }
            bia[0] = cbp[l * 1024 + ch]; bia[1] = cbp[l * 1024 + ch + 1];
            constexpr int RS = SK / 4; const int r0 = rq * RS;
            const float cl = cumL[(L - 1) * 4 + r];
            unsigned ra[RS + 3];
#pragma unroll
            for (int i = 0; i < RS + 3; ++i) ra[i] = ssd_raw<MODE>(PROJ, scv, l, b, m0, tseq0, r0 - 3 + i, ch);
            LAS bf16* x0 = xT + (r * 64 + 2 * pp) * LDS_; LAS bf16* xw0 = xwT + (r * 64 + 2 * pp) * LDS_;
#pragma unroll
            for (int i = 0; i < RS; ++i) { const int s = r0 + i; float c0 = 0.f, c1 = 0.f, ws = 0.f;
                if (s < L) { c0 = bia[0] + w[0][0] * bflo(ra[i]) + w[1][0] * bflo(ra[i + 1]) + w[2][0] * bflo(ra[i + 2]) + w[3][0] * bflo(ra[i + 3]); c1 = bia[1] + w[0][1] * bfhi(ra[i]) + w[1][1] * bfhi(ra[i + 1]) + w[2][1] * bfhi(ra[i + 2]) + w[3][1] * bfhi(ra[i + 3]);
                    c0 = c0 * sigm(c0); c1 = c1 * sigm(c1); ws = dtL[s * 4 + r] * __expf(cl - cumL[s * 4 + r]); }
                if (MODE != 0) { x0[s] = tobf(c0); x0[LDS_ + s] = tobf(c1); }
                if (MODE != 1) { xw0[s] = tobf(c0 * ws); xw0[LDS_ + s] = tobf(c1 * ws); } }
        }
        if (MODE != 0) {
#pragma unroll
            for (int j = 0; j < 2; ++j) { const int id = 2 * wave + j; if (id < NT_CB) { const int ti = id / (SK / 16), si = id % (SK / 16); f32x4 cb = (f32x4){0.f, 0.f, 0.f, 0.f};
                if (!(MODE == 2 && si > 0) && si <= ti) cb = mma16(Cg + ti * 16 * LDN, LDN, Bg + si * 16 * LDN, LDN, 128, cb, lane);
#pragma unroll
                for (int r = 0; r < 4; ++r)
#pragma unroll
                    for (int i = 0; i < 4; ++i) { const int t = ti * 16 + 4 * (lane >> 4) + i, s = si * 16 + (lane & 15);
                        float wv = 0.f; if (s <= t && (MODE != 2 || t < L)) wv = cb[i] * __expf(cumL[t * 4 + r] - cumL[s * 4 + r]) * dtL[s * 4 + r];
                        Wl[(r * T + t) * LDS_ + s] = tobf(wv); } } }
        }
        __syncthreads();
        if (MODE == 1) { UTE(1); UTS(2); }
        { int t_ = tid0, l_ = lane0; asm volatile("" : "+v"(t_), "+v"(l_)); tid = t_; lane = l_; }
        if (MODE != 0) {
            LAS bf16* Sl = (LAS bf16*)(F.lds + OFF_S0);
            const bool ywave = 2 * wave < NT_Y; const int ti = (2 * wave) >> 2;
            bf16x8v ca[4];
#pragma unroll
            for (int ks = 0; ks < 4; ++ks) ca[ks] = *(const LAS bf16x8v*)(Cg + (ti * 16 + (lane & 15)) * LDN + ks * 32 + 8 * (lane >> 4));
            const GAS float* dskp = INP(I_DSK) + l * 8 + g * 4; const float dsk4[4] = {dskp[0], dskp[1], dskp[2], dskp[3]};
#pragma unroll
            for (int half = 0; half < 2; ++half) {
                float zv[2][2][4];
                if (ywave) {
#pragma unroll
                    for (int rr = 0; rr < 2; ++rr)
#pragma unroll
                        for (int j = 0; j < 2; ++j)
#pragma unroll
                            for (int i = 0; i < 4; ++i) { const int t = ti * 16 + 4 * (lane >> 4) + i, p = ((2 * wave + j) & 3) * 16 + (lane & 15); const int tc = t < L ? t : L - 1; zv[rr][j][i] = bf2f(PROJ[(size_t)(m0 + tc) * NPROJ + C_CZ + (g * 4 + 2 * half + rr) * 64 + p]); } }
                __syncthreads();
                for (int e = tid; e < 4096; e += NTHR) { const int rr = e >> 11, e2 = e & 2047, hh_ = g * 4 + 2 * half + rr;
                    const f32x4 v = ((const GAS f32x4*)(MODE == 1 ? SDSS + ((size_t)u * 8 + hh_) * 8192 : INP(I_SSSM) + ((size_t)(l * BS + b) * 8 + hh_) * 8192))[e2]; const int p = e2 >> 5, n4 = (e2 & 31) * 4;
                    *(LAS unsigned*)(Sl + (rr * 64 + p) * LDN + n4) = pk2(v.x, v.y); *(LAS unsigned*)(Sl + (rr * 64 + p) * LDN + n4 + 2) = pk2(v.z, v.w); }
                __syncthreads();
                if (ywave) {
#pragma unroll
                    for (int rr = 0; rr < 2; ++rr)
#pragma unroll
                        for (int j = 0; j < 2; ++j) { const int r = 2 * half + rr, hh = g * 4 + r, pj = (2 * wave + j) & 3;
                            f32x4 y1 = (f32x4){0.f, 0.f, 0.f, 0.f}, y2 = y1;
                            y1 = mma16(Wl + (r * T + ti * 16) * LDS_, LDS_, xT + (r * 64 + pj * 16) * LDS_, LDS_, SK, y1, lane);
#pragma unroll
                            for (int ks = 0; ks < 4; ++ks) y2 = __builtin_amdgcn_mfma_f32_16x16x32_bf16(ca[ks], *(const LAS bf16x8v*)(Sl + (rr * 64 + pj * 16 + (lane & 15)) * LDN + ks * 32 + 8 * (lane >> 4)), y2, 0, 0, 0);
                            const int p = pj * 16 + (lane & 15); const float dsk = dsk4[r];
#pragma unroll
                            for (int i = 0; i < 4; ++i) { const int t = ti * 16 + 4 * (lane >> 4) + i;
                                if (MODE != 2 || t < L) { const float xv = bf2f(xT[(r * 64 + p) * LDS_ + t]); const float z = zv[rr][j][i];
                                    const float yy = (y1[i] + __expf(cumL[t * 4 + r]) * y2[i] + dsk * xv) * z * sigm(z); ssum[i] += yy * yy; ytmp[t * 512 + hh * 64 + p] = yy; } } } }
            }
        }
        if (MODE == 1) UTE(2);
        if (MODE != 1) {
            const int r = wave >> 1, hh = g * 4 + r; const float dtot = __expf(cumL[(L - 1) * 4 + r]);
#pragma unroll 1
            for (int pi = 0; pi < 4; ++pi) { f32x4 d[4]; float sv[4][4];
                const size_t sb0 = ((size_t)(l * BS + b) * 8 + hh) * 8192; const GAS float* sin_ = (MODE == 2) ? INP(I_SSSM) + sb0 : nullptr;
                if (MODE == 2) {
#pragma unroll
                    for (int j = 0; j < 4; ++j)
#pragma unroll
                        for (int i = 0; i < 4; ++i) sv[j][i] = sin_[(pi * 16 + 4 * (lane >> 4) + i) * 128 + (4 * (wave & 1) + j) * 16 + (lane & 15)]; }
#pragma unroll
                for (int j = 0; j < 4; ++j) { const int nj = 4 * (wave & 1) + j; d[j] = (f32x4){0.f, 0.f, 0.f, 0.f}; d[j] = mma16(xwT + (r * 64 + pi * 16) * LDS_, LDS_, BgT + nj * 16 * LDS_, LDS_, SK, d[j], lane); }
#pragma unroll
                for (int j = 0; j < 4; ++j) { const int n = (4 * (wave & 1) + j) * 16 + (lane & 15);
#pragma unroll
                    for (int i = 0; i < 4; ++i) { const int p = pi * 16 + 4 * (lane >> 4) + i;
                        if (MODE == 0) SDDS[((size_t)u * 8 + hh) * 8192 + p * 128 + n] = d[j][i]; else F.out[O_SSSM + sb0 + p * 128 + n] = dtot * sv[j][i] + d[j][i]; } } }
            if (MODE == 0 && (lane & 63) == 0 && (wave & 1) == 0) SDDEC[u * 8 + hh] = dtot;
        }
    }
    const int tid = tid0, lane = lane0;
    if (MODE == 1) UTS(3);
    if (MODE != 0) {
#pragma unroll
        for (int i = 0; i < 4; ++i) { float s = ssum[i]; s += __shfl_xor(s, 1); s += __shfl_xor(s, 2); s += __shfl_xor(s, 4); s += __shfl_xor(s, 8);
            const int id = 2 * wave; if (id < NT_Y && (lane & 15) == 0) __hip_atomic_fetch_add(&rowss[(id >> 2) * 16 + 4 * (lane >> 4) + i], s, __ATOMIC_RELAXED, __HIP_MEMORY_SCOPE_WORKGROUP); }
        __syncthreads();
        const GAS float* ngp = INP(I_SNG) + l * 512;
        if (2 * wave < NT_Y) {
            float rinv[4];
#pragma unroll
            for (int i = 0; i < 4; ++i) { const int t = ((2 * wave) >> 2) * 16 + 4 * (lane >> 4) + i; rinv[i] = rsq(rowss[t] * (1.f / 512.f) + EPS); }
#pragma unroll 1
            for (int gh = 0; gh < 2; ++gh) { float yv[4][2][4], ngv[4][2];
#pragma unroll
                for (int g4 = 0; g4 < 4; ++g4)
#pragma unroll
                    for (int j = 0; j < 2; ++j) { const int id = 2 * wave + j, ti = id >> 2, pj = id & 3, chn = (gh * 4 + g4) * 64 + pj * 16 + (lane & 15); ngv[g4][j] = ngp[chn];
#pragma unroll
                        for (int i = 0; i < 4; ++i) { const int t = ti * 16 + 4 * (lane >> 4) + i; yv[g4][j][i] = ytmp[(t < L ? t : 0) * 512 + chn]; } }
#pragma unroll
                for (int g4 = 0; g4 < 4; ++g4)
#pragma unroll
                    for (int j = 0; j < 2; ++j) { const int id = 2 * wave + j, ti = id >> 2, pj = id & 3, chn = (gh * 4 + g4) * 64 + pj * 16 + (lane & 15);
#pragma unroll
                        for (int i = 0; i < 4; ++i) { const int t = ti * 16 + 4 * (lane >> 4) + i; if (MODE != 2 || t < L) MIX[(size_t)(m0 + t) * D + 1024 + chn] = tobf(yv[g4][j][i] * rinv[i] * ngv[g4][j]); } } }
        }
    }
    if (MODE == 1) { __syncthreads(); UTE(3); }
    if (MODE == 0 && (u & 63) == 63) for (int e = tid; e < 3 * 1024; e += NTHR) { const int j = e >> 10, c2 = e & 1023; F.out[O_PCONV + ((size_t)(l * BP + b) * 3 + j) * 1024 + c2] = bf2f(PROJ[(size_t)(m0 + 61 + j) * NPROJ + C_CX + c2]); }
    if (MODE == 2) for (int e = tid; e < 3 * 1024; e += NTHR) { const int j = e >> 10, c2 = e & 1023; F.out[O_SCONV + ((size_t)(l * BS + b) * 3 + j) * 1024 + c2] = bf2f(PROJ[(size_t)(m0 + 5 + j) * NPROJ + C_CX + c2]); }
}
template <int MODE> __device__ __forceinline__ void hgrn_unit(Frame& F, int l, int u) {
    WS_LOCALS
    constexpr int T = (MODE == 2) ? 16 : 64, SK = (MODE == 2) ? 32 : 64, L = (MODE == 2) ? 8 : 64, MID = (MODE == 2) ? 3 : 31, LDN = 136, LDS_ = SK + 8, NI = T / 4;
    constexpr int OFF_QT = T * 512, OFF_KT = OFF_QT + T * 272, OFF_KTT = OFF_KT + T * 272, OFF_VT = OFF_KTT + (MODE == 1 ? 0 : 128 * LDS_ * 2), OFF_S0T = OFF_VT + 128 * LDS_ * 2, OFF_AM = OFF_S0T + (MODE == 0 ? 0 : 128 * 272), OFF_END = OFF_AM + T * LDS_ * 2;
    static_assert(OFF_END <= RING_BYTES, "hgrn LDS map");
    const int tid = F.tid, lane = F.lane, wave = F.wave, d = tid & 127, tq = tid >> 7;
    int h, m0; size_t sidx;
    if (MODE == 2) { const int b = u >> 2; h = u & 3; m0 = MP + b * TS; sidx = ((size_t)(l * BS + b) * 4 + h) * 16384; }
    else { const int bh = u >> 6, c = u & 63, b = bh >> 2; h = bh & 3; m0 = b * TP + c * 64; sidx = (size_t)u * 16384; }
    LAS float* cum = (LAS float*)F.lds;
    LAS bf16* qt = (LAS bf16*)(F.lds + OFF_QT);
    LAS bf16* kt = (LAS bf16*)(F.lds + OFF_KT);
    LAS bf16* ktT = (LAS bf16*)(F.lds + OFF_KTT);
    LAS bf16* vT = (LAS bf16*)(F.lds + OFF_VT);
    LAS bf16* S0T = (LAS bf16*)(F.lds + OFF_S0T);
    LAS bf16* Am = (LAS bf16*)(F.lds + OFF_AM);
    LAS float* refv = (LAS float*)(F.lds + RING_BYTES + 2048);
    LAS float* efin = refv + 128; LAS float* decv = efin + 128; LAS float* erefv = decv + 128; LAS float* rowss = erefv + 128;
    const GAS float* S0g = (MODE == 1 ? HGSS : INP(I_SHG)) + sidx;
    __syncthreads();
    float qv[NI], kv[NI], vv[NI];
    {   const float lbv = LBv[l * 512 + h * 128 + d];
#pragma unroll
        for (int i = 0; i < NI; ++i) { const int t = tq + 4 * i; float lf = 0.f, q = 0.f, k = 0.f, v = 0.f;
            { const int tc = t < L ? t : L - 1; const GAS bf16* row = PROJ + (size_t)(m0 + tc) * NPROJ + h * 128 + d; const float fr = bf2f(row[C_AF]), qr = bf2f(row[C_AQ]), v1 = bf2f(row[C_AI]);
                const float e = __expf(-fr); const float sg = 1.f / (1.f + e); const float fg = lbv + (1.f - lbv) * sg;
                const bool ok = t < L; lf = ok ? __logf(fg) : 0.f; k = ok ? (1.f - lbv) * (e / (1.f + e)) : 0.f; q = ok ? qr * sigm(qr) : 0.f; v = ok ? v1 : 0.f; }
            cum[t * 128 + d] = lf; qv[i] = q; kv[i] = k; vv[i] = v; }
        if (tid < 64) rowss[tid] = 0.f;
    }
    __syncthreads();
    if (tid < 128) { float a = 0.f, rf = 0.f;
#pragma unroll 16
        for (int t = 0; t < L; ++t) { a += cum[t * 128 + tid]; cum[t * 128 + tid] = a; if (t == MID) rf = a; }
        refv[tid] = rf; efin[tid] = __expf(a - rf); decv[tid] = __expf(a); erefv[tid] = __expf(rf); }
    __syncthreads();
    {   const float rf = refv[d];
#pragma unroll
        for (int i = 0; i < NI; ++i) { const int t = tq + 4 * i; const float c = (t < L) ? cum[t * 128 + d] : rf;
            const float qs = qv[i] * __expf(fminf(c - rf, 80.f)), ks = kv[i] * __expf(fminf(rf - c, 80.f));
            if (MODE != 0) { qt[t * LDN + d] = tobf(qs); kt[t * LDN + d] = tobf(ks); }
            if (MODE != 1) ktT[d * LDS_ + t] = tobf(ks);
            vT[d * LDS_ + t] = tobf(vv[i]); }
        if (MODE == 2) {
#pragma unroll
            for (int i = 0; i < NI; ++i) { const int t = 16 + tq + 4 * i; ktT[d * LDS_ + t] = 0; vT[d * LDS_ + t] = 0; } }
    }
    if (MODE == 1) for (int e = tid; e < 4096; e += NTHR) { const f32x4 s = ((const GAS f32x4*)S0g)[e]; const int v = e >> 5, d4 = (e & 31) * 4; const f32x4 er = *(const LAS f32x4*)(erefv + d4);
        *(LAS unsigned*)(S0T + v * LDN + d4) = pk2(s.x * er.x, s.y * er.y); *(LAS unsigned*)(S0T + v * LDN + d4 + 2) = pk2(s.z * er.z, s.w * er.w); }
    if (MODE == 2) for (int e = tid; e < 4096; e += NTHR) { const f32x4 s = ((const GAS f32x4*)S0g)[e]; const int dd = e >> 5, v4 = (e & 31) * 4; const float er = erefv[dd];
        S0T[(v4) * LDN + dd] = tobf(s.x * er); S0T[(v4 + 1) * LDN + dd] = tobf(s.y * er); S0T[(v4 + 2) * LDN + dd] = tobf(s.z * er); S0T[(v4 + 3) * LDN + dd] = tobf(s.w * er); }
    __syncthreads();
    if (MODE != 0) {
#pragma unroll
        for (int j = 0; j < 2; ++j) { const int id = 2 * wave + j; if (id < (T / 16) * (SK / 16)) { const int ti = id / (SK / 16), si = id % (SK / 16);
            f32x4 a = (f32x4){0.f, 0.f, 0.f, 0.f};
            if (si <= ti && si < T / 16) a = mma16(qt + ti * 16 * LDN, LDN, kt + si * 16 * LDN, LDN, 128, a, lane);
#pragma unroll
            for (int i = 0; i < 4; ++i) { const int t = ti * 16 + 4 * (lane >> 4) + i, s = si * 16 + (lane & 15); Am[t * LDS_ + s] = tobf((s <= t && si <= ti && si < T / 16) ? a[i] : 0.f); } } }
        __syncthreads();
        f32x4 o[4]; float ssum[4] = {0.f, 0.f, 0.f, 0.f};
#pragma unroll
        for (int j = 0; j < 4; ++j) { const int id = 4 * wave + j; o[j] = (f32x4){0.f, 0.f, 0.f, 0.f};
            if (id < (T / 16) * 8) { const int ti = id >> 3, vj = id & 7;
                o[j] = mma16(Am + ti * 16 * LDS_, LDS_, vT + vj * 16 * LDS_, LDS_, SK, o[j], lane);
                o[j] = mma16(qt + ti * 16 * LDN, LDN, S0T + vj * 16 * LDN, LDN, 128, o[j], lane);
#pragma unroll
                for (int i = 0; i < 4; ++i) ssum[i] += o[j][i] * o[j][i]; } }
        if (4 * wave < (T / 16) * 8) {
#pragma unroll
            for (int i = 0; i < 4; ++i) { float s = ssum[i]; s += __shfl_xor(s, 1); s += __shfl_xor(s, 2); s += __shfl_xor(s, 4); s += __shfl_xor(s, 8);
                if ((lane & 15) == 0) __hip_atomic_fetch_add(&rowss[((4 * wave) >> 3) * 16 + 4 * (lane >> 4) + i], s, __ATOMIC_RELAXED, __HIP_MEMORY_SCOPE_WORKGROUP); } }
        __syncthreads();
        const GAS float* ngp = INP(I_HNG) + l * 512 + h * 128;
        float grv[4][4], ngv[4];
#pragma unroll
        for (int j = 0; j < 4; ++j) { const int id = 4 * wave + j, ti = (id >> 3) & (T / 16 - 1), vj = id & 7, v = vj * 16 + (lane & 15); ngv[j] = ngp[v];
#pragma unroll
            for (int i = 0; i < 4; ++i) { const int t = ti * 16 + 4 * (lane >> 4) + i; const int tc = t < L ? t : L - 1; grv[j][i] = bf2f(PROJ[(size_t)(m0 + tc) * NPROJ + C_AG + h * 128 + v]); } }
#pragma unroll
        for (int j = 0; j < 4; ++j) { const int id = 4 * wave + j; if (id < (T / 16) * 8) { const int ti = id >> 3, vj = id & 7, v = vj * 16 + (lane & 15);
#pragma unroll
            for (int i = 0; i < 4; ++i) { const int t = ti * 16 + 4 * (lane >> 4) + i;
                if (MODE != 2 || t < L) MIX[(size_t)(m0 + t) * D + h * 128 + v] = tobf(o[j][i] * rsq(rowss[t] * (1.f / 128.f) + EPS) * ngv[j] * sigm(grv[j][i])); } } }
    }
    if (MODE != 1) {
        float sv[8][4];
        if (MODE == 2) {
#pragma unroll
            for (int j = 0; j < 8; ++j)
#pragma unroll
                for (int i = 0; i < 4; ++i) sv[j][i] = S0g[(wave * 16 + 4 * (lane >> 4) + i) * 128 + j * 16 + (lane & 15)]; }
#pragma unroll
        for (int j = 0; j < 8; ++j) { f32x4 a = (f32x4){0.f, 0.f, 0.f, 0.f}; a = mma16(ktT + wave * 16 * LDS_, LDS_, vT + j * 16 * LDS_, LDS_, SK, a, lane);
            const int v = j * 16 + (lane & 15);
            if (MODE == 0) { const int d0 = wave * 16 + 4 * (lane >> 4); const f32x4 ef = *(const LAS f32x4*)(efin + d0);
                *(GAS f32x4*)(HGDS + sidx + v * 128 + d0) = (f32x4){ef.x * a[0], ef.y * a[1], ef.z * a[2], ef.w * a[3]}; }
            else {
#pragma unroll
                for (int i = 0; i < 4; ++i) { const int dd = wave * 16 + 4 * (lane >> 4) + i; F.out[O_SHG + sidx + dd * 128 + v] = decv[dd] * sv[j][i] + efin[dd] * a[i]; } } }
        if (MODE == 0 && tid < 128) HGDEC[u * 128 + tid] = decv[tid];
    }
}
__device__ __forceinline__ void scan_phase(Frame& F, int l) {
    WS_LOCALS
    const int gt = blockIdx.x * NTHR + F.tid, NT = F.G * NTHR;
    for (int e = gt; e < 131072; e += NT) {
        const int bh = e >> 14, vd = e & 16383, d = vd & 127, v = vd >> 7; const int bhh = e >> 13, b = bhh >> 3, hh = bhh & 7, pn = e & 8191;
        float Sh = 0.f, Ss = 0.f;
#pragma unroll 1
        for (int c0 = 0; c0 < 64; c0 += 8) { float dh[8], xh[8], ds[8], xs[8];
#pragma unroll
            for (int k = 0; k < 8; ++k) { const size_t u = (size_t)bh * 64 + c0 + k; const size_t idx = (size_t)(b * 64 + c0 + k) * 8 + hh; dh[k] = HGDEC[u * 128 + d]; xh[k] = HGDS[u * 16384 + vd]; ds[k] = SDDEC[idx]; xs[k] = SDDS[idx * 8192 + pn]; }
#pragma unroll
            for (int k = 0; k < 8; ++k) { const size_t u = (size_t)bh * 64 + c0 + k; const size_t idx = (size_t)(b * 64 + c0 + k) * 8 + hh;
                HGSS[u * 16384 + vd] = Sh; SDSS[idx * 8192 + pn] = Ss; Sh = dh[k] * Sh + xh[k]; Ss = ds[k] * Ss + xs[k]; } }
        F.out[O_PHG + ((size_t)l * 8 + bh) * 16384 + d * 128 + v] = Sh; F.out[O_PSSM + ((size_t)(l * BP + b) * 8 + hh) * 8192 + pn] = Ss; }
}
__device__ __forceinline__ float sq8(v4u w) { const float a0 = bflo(w.x), a1 = bfhi(w.x), a2 = bflo(w.y), a3 = bfhi(w.y), a4 = bflo(w.z), a5 = bfhi(w.z), a6 = bflo(w.w), a7 = bfhi(w.w);
    return ((a0 * a0 + a1 * a1) + (a2 * a2 + a3 * a3)) + ((a4 * a4 + a5 * a5) + (a6 * a6 + a7 * a7)); }
__device__ __forceinline__ float rope1(float x, float rn, float g, float c, float s, int dh) { const float xn = x * rn * g; const float other = __shfl_xor(xn, 1); return dh == 0 ? xn * c - other * s : xn * c + other * s; }
__device__ __forceinline__ v4u rope8(v4u w, float rn, const GAS float* g, const GAS float* rp, int dh) {
    v4u o;
    o.x = pk2(rope1(bflo(w.x), rn, g[0], rp[0], rp[32], dh), rope1(bfhi(w.x), rn, g[1], rp[1], rp[33], dh));
    o.y = pk2(rope1(bflo(w.y), rn, g[2], rp[2], rp[34], dh), rope1(bfhi(w.y), rn, g[3], rp[3], rp[35], dh));
    o.z = pk2(rope1(bflo(w.z), rn, g[4], rp[4], rp[36], dh), rope1(bfhi(w.z), rn, g[5], rp[5], rp[37], dh));
    o.w = pk2(rope1(bflo(w.w), rn, g[6], rp[6], rp[38], dh), rope1(bfhi(w.w), rn, g[7], rp[7], rp[39], dh));
    return o;
}
template <int SAMPLE> __device__ __forceinline__ void attn_unit(Frame& F, int l, int u) {
    WS_LOCALS
    constexpr int LDK = 72, LDV = 200, LDPW = 168;
    const int tid = F.tid, lane = F.lane, wave = F.wave;
    const GAS float* const ckp = INP(I_CK); const GAS float* const cvp = INP(I_CV);
    LAS bf16* Kb = (LAS bf16*)F.lds; LAS bf16* VT = Kb + 192 * LDK; LAS bf16* Qs = VT + 64 * LDV; LAS bf16* Pw = Qs + wave * 16 * LDPW;
    int b, g, q0, row_min; size_t mbase;
    if (SAMPLE) { b = u >> 1; g = u & 1; q0 = 0; row_min = 0; mbase = (size_t)MP + b * TS; }
    else { g = u & 1; const int qt = (u >> 1) & 63; b = u >> 7; q0 = qt * 64; row_min = q0 >= 127 ? 0 : 127 - q0; mbase = (size_t)b * TP; }
    __syncthreads();
    {   const int j8 = tid & 7; const GAS float* kg = INP(I_KNG) + l * 64 + 8 * j8;
        float kgv[8];
#pragma unroll
        for (int e = 0; e < 8; ++e) kgv[e] = kg[e];
        GAS float* const okp = F.out + (SAMPLE ? O_SK : O_PK); GAS float* const ovp = F.out + (SAMPLE ? O_SV : O_PV);
        const size_t ob = SAMPLE ? ((size_t)(l * BS + b) * 128) : ((size_t)(l * BP + b) * 128);
        const int roff = SAMPLE ? 8 : 63; const bool wr_cache = SAMPLE || q0 == TP - 64;
        for (int row = tid >> 3; row < 192; row += 64) {
            float ko[8], vo[8]; bool zero = false;
            if (SAMPLE && row < 128) { const GAS f32x4* kp = (const GAS f32x4*)(ckp + (((size_t)(l * BS + b) * 128 + row) * 2 + g) * 64 + 8 * j8); const GAS f32x4* vp = (const GAS f32x4*)(cvp + (((size_t)(l * BS + b) * 128 + row) * 2 + g) * 64 + 8 * j8);
                const f32x4 k0 = kp[0], k1 = kp[1], v0 = vp[0], v1 = vp[1];
                ko[0] = k0.x; ko[1] = k0.y; ko[2] = k0.z; ko[3] = k0.w; ko[4] = k1.x; ko[5] = k1.y; ko[6] = k1.z; ko[7] = k1.w; vo[0] = v0.x; vo[1] = v0.y; vo[2] = v0.z; vo[3] = v0.w; vo[4] = v1.x; vo[5] = v1.y; vo[6] = v1.z; vo[7] = v1.w; }
            else {
                int t, prow;
                if (SAMPLE) { t = row - 128; prow = 4096 + t; if (row >= 136) zero = true; } else { t = q0 - 127 + row; prow = t; if (t < 0 || row == 191) zero = true; }
                if (zero) {
#pragma unroll
                    for (int e = 0; e < 8; ++e) { ko[e] = 0.f; vo[e] = 0.f; } }
                else {
                    const GAS bf16* pr = PROJ + (mbase + t) * NPROJ;
                    const v4u kw = *(const GAS v4u*)(pr + C_DK + g * 64 + 8 * j8); const v4u vw = *(const GAS v4u*)(pr + C_DV + g * 64 + 8 * j8);
                    float kr[8] = {bflo(kw.x), bfhi(kw.x), bflo(kw.y), bfhi(kw.y), bflo(kw.z), bfhi(kw.z), bflo(kw.w), bfhi(kw.w)};
                    vo[0] = bflo(vw.x); vo[1] = bfhi(vw.x); vo[2] = bflo(vw.y); vo[3] = bfhi(vw.y); vo[4] = bflo(vw.z); vo[5] = bfhi(vw.z); vo[6] = bflo(vw.w); vo[7] = bfhi(vw.w);
                    float ss = 0.f;
#pragma unroll
                    for (int e = 0; e < 8; ++e) ss += kr[e] * kr[e];
                    ss += __shfl_xor(ss, 1); ss += __shfl_xor(ss, 2); ss += __shfl_xor(ss, 4);
                    const float rn = 1.f / sqrtf(ss * (1.f / 64.f) + EPS);
                    const GAS float* rp = ROPE + (size_t)prow * 64 + ((8 * j8) & 31);
#pragma unroll
                    for (int e = 0; e < 8; ++e) { const float kn = kr[e] * rn * kgv[e]; const float other = __shfl_xor(kn, 4); const float c = rp[e], s = rp[32 + e];
                        ko[e] = j8 < 4 ? kn * c - other * s : kn * c + other * s; }
                }
            }
            v4u kp4; kp4.x = pk2(ko[0], ko[1]); kp4.y = pk2(ko[2], ko[3]); kp4.z = pk2(ko[4], ko[5]); kp4.w = pk2(ko[6], ko[7]);
            *(LAS v4u*)(Kb + row * LDK + 8 * j8) = kp4;
#pragma unroll
            for (int e = 0; e < 8; ++e) VT[(8 * j8 + e) * LDV + row] = tobf(vo[e]);
            if (wr_cache && row >= roff && row < roff + 128) { const size_t o = ((ob + (row - roff)) * 2 + g) * 64 + 8 * j8;
                *(GAS f32x4*)(okp + o) = (f32x4){ko[0], ko[1], ko[2], ko[3]}; *(GAS f32x4*)(okp + o + 4) = (f32x4){ko[4], ko[5], ko[6], ko[7]};
                *(GAS f32x4*)(ovp + o) = (f32x4){vo[0], vo[1], vo[2], vo[3]}; *(GAS f32x4*)(ovp + o + 4) = (f32x4){vo[4], vo[5], vo[6], vo[7]}; }
        }
    }
    const bool qwave = !SAMPLE || wave == 0;
    if (qwave) {
        const int dh = lane & 1, qi = (lane >> 1) & 7, r = lane >> 4, head = g * 4 + r;
        const int t = SAMPLE ? qi : q0 + 8 * wave + qi; const int prow = SAMPLE ? 4096 + t : t;
        const GAS v4u* qp = (const GAS v4u*)(PROJ + (mbase + t) * NPROJ + C_DQ + head * 64 + 32 * dh);
        const v4u w0 = qp[0], w1 = qp[1], w2 = qp[2], w3 = qp[3];
        float ss = sq8(w0) + sq8(w1) + sq8(w2) + sq8(w3);
        ss += __shfl_xor(ss, 1);
        const float rn = 0.125f / sqrtf(ss * (1.f / 64.f) + EPS);
        const GAS float* qg = INP(I_QNG) + l * 64 + 32 * dh; const GAS float* rp = ROPE + (size_t)prow * 64;
        LAS v4u* qd = (LAS v4u*)(Qs + (32 * wave + 16 * (r >> 1) + 8 * (r & 1) + qi) * LDK + 32 * dh);
        qd[0] = rope8(w0, rn, qg, rp, dh); qd[1] = rope8(w1, rn, qg + 8, rp + 8, dh); qd[2] = rope8(w2, rn, qg + 16, rp + 16, dh); qd[3] = rope8(w3, rn, qg + 24, rp + 24, dh);
    }
    __syncthreads();
    bf16x8v qf[2][2];
    if (qwave) {
#pragma unroll
        for (int rt = 0; rt < 2; ++rt)
#pragma unroll
            for (int ks = 0; ks < 2; ++ks) qf[rt][ks] = *(const LAS bf16x8v*)(Qs + (32 * wave + 16 * rt + (lane & 15)) * LDK + 32 * ks + 8 * (lane >> 4));
    }
    __syncthreads();
    if (qwave) {
        const int ks0 = SAMPLE ? 0 : (8 * wave < 32 ? 8 * wave : 32);
        const GAS float* skp = INP(I_SINK) + l * 8 + g * 4;
#pragma unroll
        for (int rt = 0; rt < 2; ++rt) {
            f32x4 sc[10]; int kl = ks0 + (lane & 15); asm volatile("" : "+v"(kl));
#pragma unroll
            for (int c = 0; c < 10; ++c) { sc[c] = (f32x4){0.f, 0.f, 0.f, 0.f}; const LAS bf16* kp = Kb + (ks0 + 16 * c + (lane & 15)) * LDK + 8 * (lane >> 4);
                sc[c] = __builtin_amdgcn_mfma_f32_16x16x32_bf16(qf[rt][0], *(const LAS bf16x8v*)kp, sc[c], 0, 0, 0);
                sc[c] = __builtin_amdgcn_mfma_f32_16x16x32_bf16(qf[rt][1], *(const LAS bf16x8v*)(kp + 32), sc[c], 0, 0, 0); }
            float mx[4], sm[4], sinkv[4]; int klo[4]; unsigned span[4];
#pragma unroll
            for (int i = 0; i < 4; ++i) { const int row = 4 * (lane >> 4) + i, qi = row & 7; const int qrow = SAMPLE ? 128 + qi : 127 + 8 * wave + qi;
                sinkv[i] = skp[2 * rt + (row >> 3)]; mx[i] = sinkv[i]; sm[i] = 0.f;
                klo[i] = (qrow - 127) > row_min ? (qrow - 127) : row_min; span[i] = (unsigned)(qrow - klo[i]); }
#pragma unroll
            for (int c = 0; c < 10; ++c) { const int kr = kl + 16 * c;
#pragma unroll
                for (int i = 0; i < 4; ++i) { const float sv = ((unsigned)(kr - klo[i]) <= span[i]) ? sc[c][i] : -INFINITY; sc[c][i] = sv; mx[i] = fmaxf(mx[i], sv); } }
#pragma unroll
            for (int i = 0; i < 4; ++i) { float m = mx[i]; m = fmaxf(m, __shfl_xor(m, 1)); m = fmaxf(m, __shfl_xor(m, 2)); m = fmaxf(m, __shfl_xor(m, 4)); m = fmaxf(m, __shfl_xor(m, 8)); mx[i] = m; }
#pragma unroll
            for (int c = 0; c < 10; ++c) {
#pragma unroll
                for (int i = 0; i < 4; ++i) { const float p = __expf(sc[c][i] - mx[i]); sm[i] += p; Pw[(4 * (lane >> 4) + i) * LDPW + 16 * c + (lane & 15)] = tobf(p); } }
#pragma unroll
            for (int i = 0; i < 4; ++i) { float a = sm[i]; a += __shfl_xor(a, 1); a += __shfl_xor(a, 2); a += __shfl_xor(a, 4); a += __shfl_xor(a, 8); sm[i] = a + __expf(sinkv[i] - mx[i]); }
            asm volatile("s_waitcnt lgkmcnt(0)" ::: "memory");
#pragma unroll
            for (int dj = 0; dj < 4; ++dj) { f32x4 o = (f32x4){0.f, 0.f, 0.f, 0.f};
                o = mma16(Pw, LDPW, VT + dj * 16 * LDV + ks0, LDV, 160, o, lane);
#pragma unroll
                for (int i = 0; i < 4; ++i) { const int row = 4 * (lane >> 4) + i, qi = row & 7, head = g * 4 + 2 * rt + (row >> 3); const int t = SAMPLE ? qi : q0 + 8 * wave + qi;
                    MIX[(mbase + t) * D + 1536 + head * 64 + dj * 16 + (lane & 15)] = tobf(o[i] / sm[i]); } }
            asm volatile("s_waitcnt lgkmcnt(0)" ::: "memory");
        }
    }
}
template <int WIN> __device__ __forceinline__ void pool_rows_prompt(const GAS bf16* base, int ta, LAS bf16* pl, int LDP) {
    unsigned rw[47];
#pragma unroll
    for (int i = 0; i < 47; ++i) { const int t = ta - 15 + i; rw[i] = *(const GAS unsigned*)(base + (size_t)(t >= 0 ? t : 0) * NPROJ); if (t < 0) rw[i] = 0u; }
    float s0 = 0.f, s1 = 0.f;
#pragma unroll
    for (int j = 1; j < WIN; ++j) { s0 += bflo(rw[15 - j]); s1 += bfhi(rw[15 - j]); }
#pragma unroll
    for (int i = 0; i < 32; ++i) { const int t = ta + i; const float a0 = bflo(rw[15 + i]), a1 = bfhi(rw[15 + i]); s0 += a0; s1 += a1;
        const float ic = __builtin_amdgcn_rcpf((float)((t + 1) < WIN ? (t + 1) : WIN));
        *(LAS unsigned*)(pl + i * LDP) = pk2(s0 * ic - a0, s1 * ic - a1);
        s0 -= bflo(rw[15 + i - WIN + 1]); s1 -= bfhi(rw[15 + i - WIN + 1]); }
}
template <int WIN> __device__ __forceinline__ void pool_rows_sample(const GAS bf16* base, const GAS float* buf, LAS bf16* pl, int LDP) {
    float e0[23], e1[23];
#pragma unroll
    for (int i = 0; i < 15; ++i) { e0[i] = buf[(size_t)i * 512]; e1[i] = buf[(size_t)i * 512 + 1]; }
#pragma unroll
    for (int i = 0; i < 8; ++i) { const unsigned w = *(const GAS unsigned*)(base + (size_t)i * NPROJ); e0[15 + i] = bflo(w); e1[15 + i] = bfhi(w); }
    float s0 = 0.f, s1 = 0.f;
#pragma unroll
    for (int j = 1; j < WIN; ++j) { s0 += e0[15 - j]; s1 += e1[15 - j]; }
#pragma unroll
    for (int i = 0; i < 8; ++i) { s0 += e0[15 + i]; s1 += e1[15 + i];
        *(LAS unsigned*)(pl + i * LDP) = pk2(s0 * (1.f / WIN) - e0[15 + i], s1 * (1.f / WIN) - e1[15 + i]);
        s0 -= e0[15 + i - WIN + 1]; s1 -= e1[15 + i - WIN + 1]; }
}
__device__ __forceinline__ void pool_unit(Frame& F, int l, int u) {
    WS_LOCALS
    const int tid = F.tid, lane = F.lane, wave = F.wave;
    const GAS float* const spp = INP(I_SPOOL);
    LAS bf16* pl = (LAS bf16*)F.lds; constexpr int LDP = 520;
    const bool samp = u >= 128; const int b = samp ? 0 : (u >> 6), t0 = samp ? 0 : (u & 63) * 64; const int s8 = samp ? (u - 128) * 8 : 0;
    const size_t m0 = samp ? (size_t)MP + (size_t)s8 * TS : (size_t)b * TP + t0;
    __syncthreads();
    {   const int pr = tid & 255, half = tid >> 8, c0 = 2 * pr, gi = (wave & 3);
        if (!samp) { const GAS bf16* base = PROJ + ((size_t)b * TP) * NPROJ + C_PU + c0; LAS bf16* pp = pl + (half * 32) * LDP + c0; const int ta = t0 + half * 32;
            if (gi == 0) pool_rows_prompt<2>(base, ta, pp, LDP); else if (gi == 1) pool_rows_prompt<4>(base, ta, pp, LDP); else if (gi == 2) pool_rows_prompt<8>(base, ta, pp, LDP); else pool_rows_prompt<16>(base, ta, pp, LDP); }
        else {
#pragma unroll 1
            for (int q = 0; q < 4; ++q) { const int bq = half * 4 + q, bs = s8 + bq; const GAS bf16* base = PROJ + ((size_t)MP + (size_t)bs * TS) * NPROJ + C_PU + c0; const GAS float* buf = spp + ((size_t)(l * BS + bs) * 15) * 512 + c0; LAS bf16* pp = pl + (bq * 8) * LDP + c0;
                if (gi == 0) pool_rows_sample<2>(base, buf, pp, LDP); else if (gi == 1) pool_rows_sample<4>(base, buf, pp, LDP); else if (gi == 2) pool_rows_sample<8>(base, buf, pp, LDP); else pool_rows_sample<16>(base, buf, pp, LDP); } }
    }
    __syncthreads();
    {   const int g = wave >> 1; const GAS float* scp = INP(I_PSC) + l * 512 + g * 128;
        const GAS bf16* wpt = (const GAS bf16*)wsp(F, WS_WPT) + (size_t)(l * 4 + g) * 16384;
#pragma unroll 1
        for (int jj = 0; jj < 4; ++jj) { const int vj = 4 * (wave & 1) + jj;
            bf16x8v bfr[4];
#pragma unroll
            for (int k = 0; k < 4; ++k) bfr[k] = *(const GAS bf16x8v*)(wpt + (size_t)(vj * 16 + (lane & 15)) * 128 + k * 32 + 8 * (lane >> 4));
            const int dd = vj * 16 + (lane & 15); const float sc = scp[dd];
#pragma unroll
            for (int ti = 0; ti < 4; ++ti) { f32x4 acc = (f32x4){0.f, 0.f, 0.f, 0.f};
                const LAS bf16* ap = pl + (ti * 16 + (lane & 15)) * LDP + g * 128 + 8 * (lane >> 4);
#pragma unroll
                for (int k = 0; k < 4; ++k) acc = __builtin_amdgcn_mfma_f32_16x16x32_bf16(*(const LAS bf16x8v*)(ap + k * 32), bfr[k], acc, 0, 0, 0);
#pragma unroll
                for (int i = 0; i < 4; ++i) MIX[(m0 + ti * 16 + 4 * (lane >> 4) + i) * D + 512 + g * 128 + dd] = tobf(acc[i] * sc); } }
    }
    if (!samp && t0 == TP - 64) {
        float tv[15];
#pragma unroll
        for (int j = 0; j < 15; ++j) tv[j] = bf2f(PROJ[((size_t)b * TP + TP - 15 + j) * NPROJ + C_PU + tid]);
#pragma unroll
        for (int j = 0; j < 15; ++j) F.out[O_PPOOL + ((size_t)(l * BP + b) * 15 + j) * 512 + tid] = tv[j]; }
    if (samp) {
#pragma unroll 1
        for (int q = 0; q < 8; ++q) { const int bs = s8 + q; float tv[15];
#pragma unroll
            for (int j = 0; j < 15; ++j) tv[j] = j < 7 ? spp[((size_t)(l * BS + bs) * 15 + 8 + j) * 512 + tid] : bf2f(PROJ[((size_t)MP + (size_t)bs * TS + (j - 7)) * NPROJ + C_PU + tid]);
#pragma unroll
            for (int j = 0; j < 15; ++j) F.out[O_SPOOL + ((size_t)(l * BS + bs) * 15 + j) * 512 + tid] = tv[j]; } }
}
#ifndef TIME_MASK
#define TIME_MASK 0
#endif
#ifndef TIME_BLOCK
#define TIME_BLOCK 0
#endif
#define TSTART(bit) do { if ((TIME_MASK >> (bit)) & 1) tph = __builtin_amdgcn_s_memrealtime(); } while (0)
#define TSTOP(bit) do { if ((TIME_MASK >> (bit)) & 1) tacc += __builtin_amdgcn_s_memrealtime() - tph; } while (0)
#ifndef PROBE_MASK
#define PROBE_MASK 0
#endif
#ifndef PROBE_DUP
#define PROBE_DUP 0
#endif
#ifdef PH_SEL
#define PSEL(k, stmt) do { if ((k) == PH_SEL) { stmt; } } while (0)
#else
#define PSEL(k, stmt) do { stmt; } while (0)
#endif
struct Args { const float* in[N_IN]; float* out; unsigned char* ws; int ph_lo, ph_hi; };
static_assert(sizeof(Args) == (N_IN + 2) * 8 + 8, "Args has no padding");
__global__ void __launch_bounds__(NTHR, 2) hymba_fwd(Args args) {
    extern __shared__ __attribute__((aligned(16))) unsigned char lds[];
    Frame F;
    F.lds = (LAS unsigned char*)lds;
    F.MISC = (volatile LAS unsigned*)(F.lds + MISC_OFF);
    F.tid = threadIdx.x; F.lane = F.tid & 63; F.wave = __builtin_amdgcn_readfirstlane(F.tid >> 6);
    F.G = gridDim.x; F.gw = (int)blockIdx.x * NWAVES + F.wave; F.ngw = F.G * NWAVES;
    GAS unsigned char* ws = (GAS unsigned char*)args.ws; F.ws = ws; F.out = (GAS float*)args.out;
    F.ctl = (gu32*)(ws + WS_CTL);
    for (int u = F.tid; u < (LDS_BYTES - LDSCTL_OFF) / 4; u += NTHR) ((LAS unsigned*)(F.lds + LDSCTL_OFF))[u] = 0u;
    __syncthreads();
    if (F.tid < N_IN) ((LAS unsigned long long*)(F.lds + PTR_OFF))[F.tid] = (unsigned long long)args.in[F.tid];
    __syncthreads();
    const int lo = args.ph_lo, hi = args.ph_hi;
    XcdBarrier bar; bar.bar = (unsigned*)(F.ctl + CW_BAR); bar.x = 0; bar.st = nullptr;
    if (hi - lo > 1) bar = xcd_barrier_post((unsigned*)(F.ctl + CW_BAR), F.MISC + 8);
#define IN(k) (lo <= (k) && (k) < hi)
#define LAUNDER(P) asm volatile("" : "+v"(P.tid), "+v"(P.lane), "+s"(P.wave), "+s"(P.gw))
#define UL_DYN(bit, q, n, k, call) do { const int nrep_ = ((PROBE_MASK >> (bit)) & 1) ? 2 : 1; int nr_ = nrep_; asm volatile("" : "+s"(nr_)); for (int rr = 0; rr < nr_; ++rr) { Frame Q = F; LAUNDER(Q); while ((u = deq(Q, l * 32 + 16 * rr + (q))) < (n)) PSEL(k, call); } } while (0)
#define UL(bit, off, n, k, call) do { const int nrep_ = ((PROBE_MASK >> (bit)) & 1) ? 2 : 1; int nr_ = nrep_; asm volatile("" : "+s"(nr_)); for (int rr = 0; rr < nr_; ++rr) { Frame Q = F; LAUNDER(Q); for (u = ((int)blockIdx.x + F.G - ((off) % F.G)) % F.G; u < (n); u += F.G) { __syncthreads(); PSEL(k, call); } } } while (0)
#define PHASE_LOCALS Frame P = F; LAUNDER(P); WS_LOCALS
#define SEAM(k) do { if (IN(k) && IN((k) + 1)) xcd_barrier(bar); } while (0)
    unsigned long long tacc = 0, tph = 0; (void)tph;
    int rp_pro = (PROBE_DUP == 1) ? 2 : 1, rp_mix = (PROBE_DUP == 2) ? 2 : 1, rp_up = (PROBE_DUP == 3) ? 2 : 1, rp_in = (PROBE_DUP == 4) ? 2 : 1; asm volatile("" : "+s"(rp_pro), "+s"(rp_mix), "+s"(rp_up), "+s"(rp_in));
    TSTART(0); for (int rp = 0; rp < rp_pro; ++rp) { if (IN(0)) { PSEL(0, p0_prologue(F)); } SEAM(0); } TSTOP(0);
    for (int l = 0; l < DEPTH; ++l) {
        const int pb = 1 + l * PH_PER_LAYER;

        TSTART(1); if (IN(pb + 0)) { PHASE_LOCALS  PSEL(1, norm_phase(P, l, 0, l > 0 ? NSL_DN : 0)); } SEAM(pb + 0); TSTOP(1);
        for (int rq = 0; rq < rp_in; ++rq) {
        TSTART(2); if (IN(pb + 1)) { PHASE_LOCALS
            pg8::Gemm g{H, Wi + (size_t)l * NPROJ * D, M, NPROJ, D}; pg8::StaticOrder S; S.init(M, NPROJ, D, F.G, (int)blockIdx.x);
            pg8::EpiStoreBf16 E{PROJ, NPROJ, 0};
            PSEL(2, (pg8::gemm_phase<pg8::EpiStoreBf16, pg8::StaticOrder, true, true>(P.lds, g, S, E)));
            if (l + 1 < DEPTH && F.G == 256) convert_layer(P, l + 1, 115, 141, 0, 560);
            else if (l + 1 < DEPTH) convert_layer(P, l + 1, 0, F.G, 0, 560);
        } SEAM(pb + 1); TSTOP(2);
        }
        for (int rp = 0; rp < rp_mix; ++rp) {
        TSTART(3); if (IN(pb + 2)) { PHASE_LOCALS
            int u;
            TSTART(11); UL(3, 0, 128, 3, ssd_unit<0>(Q, l, u)); TSTOP(11);
            TSTART(12); UL(1, 0, 256, 4, attn_unit<0>(Q, l, u)); TSTOP(12);
            TSTART(13); UL(7, 0, 512, 5, hgrn_unit<0>(Q, l, u)); TSTOP(13);
            TSTART(14); UL(2, 128, 132, 6, pool_unit(Q, l, u)); TSTOP(14);
            TSTART(15); UL(3, 128, 32, 7, ssd_unit<2>(Q, l, u)); TSTOP(15);
            TSTART(16); UL(1, 160, 64, 8, attn_unit<1>(Q, l, u)); TSTOP(16);
            TSTART(17); UL(3, 0, 128, 9, hgrn_unit<2>(Q, l, u)); TSTOP(17);
        } SEAM(pb + 2); TSTOP(3);
        TSTART(4); if (IN(pb + 3)) { PHASE_LOCALS  { int nr_ = ((PROBE_MASK >> 4) & 1) ? 2 : 1; asm volatile("" : "+s"(nr_)); for (int rr = 0; rr < nr_; ++rr) PSEL(10, scan_phase(P, l)); } } SEAM(pb + 3); TSTOP(4);
        TSTART(5); if (IN(pb + 4)) { PHASE_LOCALS
            int u;
            TSTART(18); UL(5, 0, 128, 11, ssd_unit<1>(Q, l, u)); TSTOP(18);
            TSTART(19); { Frame Q = F; LAUNDER(Q); const int bx = (int)blockIdx.x; if (F.G == 256) { if (bx < 128) { __syncthreads(); hgrn_unit<1>(Q, l, 384 + bx); } else { for (u = bx - 128; u < 384; u += 128) { __syncthreads(); hgrn_unit<1>(Q, l, u); } } } else { for (u = bx; u < 512; u += F.G) { __syncthreads(); hgrn_unit<1>(Q, l, u); } } } TSTOP(19);
        } SEAM(pb + 4); TSTOP(5);
        }
        TSTART(6); if (IN(pb + 5)) { PHASE_LOCALS
            pg8::Gemm g{MIX, Wo + (size_t)l * D * D, M, D, D}; pg8::SplitOrder S; S.init(MP, D, D, NSL_OUT, F.G, (int)blockIdx.x);
            pg8::EpiGateRes E{F.out, D, MOD + (size_t)l * NBB * NMOD + 2 * D, NMOD, (GAS float*)wsp(F, WS_PART)};
            PSEL(13, (pg8::gemm_phase<pg8::EpiGateRes, pg8::SplitOrder, true, true>(P.lds, g, S, E)));
        } SEAM(pb + 5); TSTOP(6);
        TSTART(7); if (IN(pb + 6)) { PHASE_LOCALS  PSEL(14, norm_phase(P, l, 1, NSL_OUT)); } SEAM(pb + 6); TSTOP(7);
        for (int rp = 0; rp < rp_up; ++rp) {
        TSTART(8); if (IN(pb + 7)) { PHASE_LOCALS
            pg8::Gemm g{H, Wu + (size_t)l * DFF * D, M, DFF, D}; pg8::StaticOrder S; S.init(M, DFF, D, F.G, (int)blockIdx.x);
            pg8::EpiStoreBf16 E{U, DFF, 1};
            PSEL(15, (pg8::gemm_phase<pg8::EpiStoreBf16, pg8::StaticOrder, true, true>(P.lds, g, S, E)));
            if (l + 1 < DEPTH) convert_layer(P, l + 1, 32, F.G - 32, 560, 1 << 30);
        } SEAM(pb + 7); TSTOP(8);
        }
        TSTART(9); if (IN(pb + 8)) { PHASE_LOCALS
            pg8::Gemm g{U, Wd + (size_t)l * D * DFF, M, D, DFF}; pg8::SplitOrder S; S.init(MP, D, DFF, NSL_DN, F.G, (int)blockIdx.x);
            pg8::EpiGateRes E{F.out, D, MOD + (size_t)l * NBB * NMOD + 5 * D, NMOD, (GAS float*)wsp(F, WS_PART)};
            PSEL(16, (pg8::gemm_phase<pg8::EpiGateRes, pg8::SplitOrder, true, true>(P.lds, g, S, E)));
        } SEAM(pb + 8); TSTOP(9);
    }
    TSTART(10); if (IN(N_PHASES - 1)) { Frame P = F; LAUNDER(P); final_fix_phase(P, NSL_DN); } TSTOP(10);
    if (UT_MASK != 0) tacc += ((unsigned long long)F.MISC[17] << 32) | F.MISC[16];
    if ((TIME_MASK != 0 || UT_MASK != 0) && blockIdx.x == TIME_BLOCK) { const unsigned long long te = __builtin_amdgcn_s_memrealtime() + tacc; while (__builtin_amdgcn_s_memrealtime() < te) __builtin_amdgcn_s_sleep(8); }
#undef IN
#undef SEAM
}

extern "C" void kernel_launch(void* const* d_in, const int* in_sizes, int n_in, void* d_out, int out_size, void* d_ws, size_t ws_size, hipStream_t stream) {
    static int grid = 0;
    if (grid == 0) {
        if (n_in != N_IN || (size_t)out_size != O_END || ws_size < WS_END) { fprintf(stderr, "kernel_launch: unexpected shapes (n_in %d, out %d, ws %zu); nothing launched\n", n_in, out_size, ws_size); grid = -1; return; }
        int dev = 0, cus = 0, per_cu = 0;
        if (hipGetDevice(&dev) != hipSuccess || hipDeviceGetAttribute(&cus, hipDeviceAttributeMultiprocessorCount, dev) != hipSuccess) { grid = -1; return; }
        if (hipFuncSetAttribute((const void*)hymba_fwd, hipFuncAttributeMaxDynamicSharedMemorySize, LDS_BYTES) != hipSuccess) { fprintf(stderr, "kernel_launch: hipFuncSetAttribute failed\n"); grid = -1; return; }
        if (hipOccupancyMaxActiveBlocksPerMultiprocessor(&per_cu, (const void*)hymba_fwd, NTHR, LDS_BYTES) != hipSuccess || per_cu < 1) { fprintf(stderr, "kernel_launch: occupancy query says %d\n", per_cu); }
        (void)hipGetLastError();
        grid = cus < 256 ? cus : 256;
    }
    if (grid < 0) return;
    if (hipMemsetAsync((char*)d_ws + WS_CTL, 0, CTL_ZERO_BYTES, stream) != hipSuccess) return;
    Args a{};
    for (int i = 0; i < N_IN; ++i) a.in[i] = (const float*)d_in[i];
    a.out = (float*)d_out; a.ws = (unsigned char*)d_ws;
#if MK_ONE_LAUNCH
    a.ph_lo = 0; a.ph_hi = N_PHASES;
    hipLaunchKernelGGL(hymba_fwd, dim3(grid), dim3(NTHR), LDS_BYTES, stream, a);
#else
    for (int k = 0; k < N_PHASES; ++k) { a.ph_lo = k; a.ph_hi = k + 1; hipLaunchKernelGGL(hymba_fwd, dim3(grid), dim3(NTHR), LDS_BYTES, stream, a); }
#endif
}
```

```cpp
#include <hip/hip_runtime.h>
#include <cstdio>
#include <cstdint>
namespace pg8 {
#define PG8_LAS __attribute__((address_space(3)))
#define PG8_GAS __attribute__((address_space(1)))
typedef unsigned short bf16_t;
typedef short bf16x8 __attribute__((ext_vector_type(8)));
typedef float f32x4 __attribute__((ext_vector_type(4)));
typedef unsigned u32x4 __attribute__((ext_vector_type(4)));
constexpr int BM = 256, BK = 64, HALF = 128, HTB = HALF * BK * 2  , STAGE_BYTES = 8 * HTB, NXCD = 8, WGM = 8;

__host__ __device__ __forceinline__ int lds_byte(int r, int c) { const int st = (r >> 4) * 2 + (c >> 5), rr = r & 15, cc = c & 31, ob = rr * 64 + cc * 2; return st * 1024 + (ob ^ (((ob >> 9) & 1) << 5)); }
__host__ __device__ __forceinline__ void stage_rc(int b, int& R, int& C) { const int st = b / 1024, sb = b % 1024, swz = sb ^ (((sb >> 9) & 1) << 5); R = (st >> 1) * 16 + swz / 64; C = (st & 1) * 32 + (swz % 64) / 2; }
__host__ __device__ __forceinline__ int perm32(int rho) { const int n = rho >> 4, i = rho & 15; return 8 * (i >> 2) + 4 * n + (i & 3); }

struct Unit { int pm, pn, k0, nt, at; };
struct Gemm { const PG8_GAS bf16_t* A; const PG8_GAS bf16_t* Bt; int M, N, K; };

struct StaticOrder {
    int nM, nN, nwg, G, c, ntK;
    __host__ __device__ void init(int M, int N, int K, int G_, int c_) { nM = M / BM; nN = N / BM; nwg = nM * nN; G = G_; c = c_; ntK = K / BK; }
    __host__ __device__ bool next(int i, Unit& u) const {
        const long L = (long)i * G + c; if (L >= nwg) return false;
        int wgid = (int)L; { const int q = nwg / NXCD, r = nwg % NXCD, xcd = wgid % NXCD, off = wgid / NXCD; wgid = (xcd < r ? xcd * (q + 1) : r * (q + 1) + (xcd - r) * q) + off; }
        const int nig = WGM * nN, gid = wgid / nig, fm = gid * WGM, gsz = (nM - fm) < WGM ? (nM - fm) : WGM;
        u.pm = fm + ((wgid % nig) % gsz); u.pn = (wgid % nig) / gsz; u.k0 = 0; u.nt = ntK; u.at = 0; return true;
    }
    __device__ __forceinline__ void a_ready(const Unit&) const {}
    __device__ __forceinline__ void done(const Unit&) const {}
};

struct SplitOrder {
    StaticOrder so; int nfull, ntot, pmS, nN, ntS;
    __host__ __device__ void init(int Mfull, int N, int K, int nslice, int G_, int c_) { so.init(Mfull, N, K, G_, c_); nfull = so.nwg; pmS = Mfull / BM; nN = N / BM; ntS = K / BK / nslice; ntot = nfull + nN * nslice; }
    __host__ __device__ bool next(int i, Unit& u) const {
        const long L = (long)i * so.G + so.c; if (L >= ntot) return false;
        if (L < nfull) return so.next(i, u);
        const int j = (int)L - nfull; u.pm = pmS; u.pn = j % nN; u.k0 = (j / nN) * ntS * BK; u.nt = ntS; u.at = 1; return true;
    }
    __device__ __forceinline__ void a_ready(const Unit&) const {}
    __device__ __forceinline__ void done(const Unit&) const {}
};

struct SliceOrder {
    int pmS, nN, ntS, ntot, nb, c;
    __host__ __device__ void init(int pmS_, int N, int K, int nslice, int nb_, int c_) { pmS = pmS_; nN = N / BM; ntS = K / BK / nslice; ntot = nN * nslice; nb = nb_; c = c_; }
    __host__ __device__ bool next(int i, Unit& u) const {
        if (c < 0 || c >= nb) return false; const int L = i * nb + c; if (L >= ntot) return false;
        u.pm = pmS; u.pn = L % nN; u.k0 = (L / nN) * ntS * BK; u.nt = ntS; u.at = 1; return true;
    }
    __device__ __forceinline__ void a_ready(const Unit&) const {}
    __device__ __forceinline__ void done(const Unit&) const {}
};

__device__ __forceinline__ unsigned cvt_pk_bf16(float lo, float hi) { unsigned r; asm volatile("v_cvt_pk_bf16_f32 %0, %1, %2" : "=v"(r) : "v"(lo), "v"(hi)); return r; }
typedef float f32x2 __attribute__((ext_vector_type(2)));
struct EpiStoreBf16 {
    static constexpr bool PERM = true, AFTER_DRAIN = false;
    PG8_GAS bf16_t* O; int ldc; int act;
    __device__ __forceinline__ void operator()(const f32x4 (&acc)[2][2][4][2], const Unit& u, int wr, int wc, int fr, int fq) const {
        const int row0 = u.pm * BM + wr * 64 + fr; const int col0 = u.pn * BM + wc * 32 + 8 * fq;
#pragma unroll
        for (int ai = 0; ai < 2; ++ai)
#pragma unroll
            for (int m = 0; m < 4; ++m) { PG8_GAS bf16_t* rowp = O + (size_t)(row0 + ai * HALF + m * 16) * ldc + col0;
#pragma unroll
                for (int bj = 0; bj < 2; ++bj) { f32x4 v0 = acc[ai][bj][m][0], v1 = acc[ai][bj][m][1];
                    if (act) {
#pragma unroll
                        for (int j = 0; j < 4; ++j) { const float a = v0[j] > 0.f ? v0[j] : 0.f, b = v1[j] > 0.f ? v1[j] : 0.f; v0[j] = a * a; v1[j] = b * b; } }
                    u32x4 w; w.x = cvt_pk_bf16(v0[0], v0[1]); w.y = cvt_pk_bf16(v0[2], v0[3]); w.z = cvt_pk_bf16(v1[0], v1[1]); w.w = cvt_pk_bf16(v1[2], v1[3]);
                    *(PG8_GAS u32x4*)(rowp + bj * HALF) = w; } }
    }
};
struct EpiGateRes {
    static constexpr bool PERM = true, AFTER_DRAIN = false;
    PG8_GAS float* X; int ldc; const PG8_GAS float* gate; int gstride; PG8_GAS float* part; const PG8_GAS float* Xin;
    __device__ __forceinline__ void operator()(const f32x4 (&acc)[2][2][4][2], const Unit& u, int wr, int wc, int fr, int fq) const {
        const int row0 = u.pm * BM + wr * 64 + fr, col0 = u.pn * BM + wc * 32 + 8 * fq;
        if (!u.at) {
            const int bb = (u.pm * BM) >> 12; const PG8_GAS float* gp = gate + (size_t)bb * gstride + col0;
            f32x4 gv[2][2];
#pragma unroll
            for (int bj = 0; bj < 2; ++bj)
#pragma unroll
                for (int n = 0; n < 2; ++n) gv[bj][n] = *(const PG8_GAS f32x4*)(gp + bj * HALF + n * 4);
#pragma unroll
            for (int ai = 0; ai < 2; ++ai)
#pragma unroll
                for (int m = 0; m < 4; ++m) { PG8_GAS float* rowp = X + (size_t)(row0 + ai * HALF + m * 16) * ldc + col0; const PG8_GAS float* rowi = Xin + (size_t)(row0 + ai * HALF + m * 16) * ldc + col0;
                    f32x4 xv[2][2];
#pragma unroll
                    for (int bj = 0; bj < 2; ++bj)
#pragma unroll
                        for (int n = 0; n < 2; ++n) xv[bj][n] = *(const PG8_GAS f32x4*)(rowi + bj * HALF + n * 4);
#pragma unroll
                    for (int bj = 0; bj < 2; ++bj)
#pragma unroll
                        for (int n = 0; n < 2; ++n) *(PG8_GAS f32x4*)(rowp + bj * HALF + n * 4) = xv[bj][n] + gv[bj][n] * acc[ai][bj][m][n]; }
        } else {
            const int sl = u.k0 / (u.nt * BK);
#pragma unroll
            for (int ai = 0; ai < 2; ++ai)
#pragma unroll
                for (int m = 0; m < 4; ++m) { const int row = row0 + ai * HALF + m * 16; const int bb = 2 + ((row - 8192) >> 3);
                    const PG8_GAS float* gp = gate + (size_t)bb * gstride + col0; PG8_GAS float* pp = part + ((size_t)(sl * BM + (row - 8192)) * ldc + col0);
                    f32x4 gv[2][2];
#pragma unroll
                    for (int bj = 0; bj < 2; ++bj)
#pragma unroll
                        for (int n = 0; n < 2; ++n) gv[bj][n] = *(const PG8_GAS f32x4*)(gp + bj * HALF + n * 4);
#pragma unroll
                    for (int bj = 0; bj < 2; ++bj)
#pragma unroll
                        for (int n = 0; n < 2; ++n) *(PG8_GAS f32x4*)(pp + bj * HALF + n * 4) = gv[bj][n] * acc[ai][bj][m][n]; }
        }
    }
};
template <class Epi, class Sched, bool ALIGN_EPI = false, bool SP2 = false>
__device__ __forceinline__ void gemm_phase(PG8_LAS unsigned char* lds, const Gemm g, const Sched& S, const Epi& E) {
    int tid_ = threadIdx.x; asm volatile("" : "+v"(tid_));
    const int tid = tid_, wid = __builtin_amdgcn_readfirstlane(tid >> 6), lane = tid & 63, wr = wid >> 2, wc = wid & 3, fr = lane & 15, fq = lane >> 4;
    const int K = g.K;
    unsigned voffA[2], voffB[2];
#pragma unroll
    for (int i = 0; i < 2; ++i) { int R, C; stage_rc(tid * 16 + i * 8192, R, C); const int Rb = Epi::PERM ? ((R & ~31) + perm32(R & 31)) : R;
        voffA[i] = (unsigned)(R * K + C) * 2u; voffB[i] = (unsigned)(Rb * K + C) * 2u; }
    const size_t kstep = (size_t)(BK * 2);
    const size_t hstep = (size_t)HALF * K * 2;
    const size_t tstep = 2 * hstep;
    const unsigned ldsw = (unsigned)wid * 1024u;
    const int aoff = lds_byte(wr * 64 + fr, fq * 8), boff = lds_byte(wc * 32 + fr, fq * 8);
#define PG8_SA(b, h) (((b) * 2 + (h)) * HTB)
#define PG8_SB(b, h) ((4 + (b) * 2 + (h)) * HTB)
#define PG8_STAGE(bufoff, gbase, voff) do { _Pragma("unroll") for (int _i = 0; _i < 2; ++_i) \
        __builtin_amdgcn_global_load_lds((const PG8_GAS unsigned*)((const PG8_GAS char*)(gbase) + (voff)[_i]), (PG8_LAS unsigned*)(lds + (bufoff) + ldsw + _i * 8192), 16, 0, 0); } while (0)
#define PG8_LDA(dst, b, h) do { _Pragma("unroll") for (int m = 0; m < 4; ++m) _Pragma("unroll") for (int k = 0; k < 2; ++k) dst[m][k] = *(const PG8_LAS bf16x8*)(lds + PG8_SA(b, h) + aoff + m * 2048 + k * 1024); } while (0)
#define PG8_LDB(dst, b, h) do { _Pragma("unroll") for (int n = 0; n < 2; ++n) _Pragma("unroll") for (int k = 0; k < 2; ++k) dst[n][k] = *(const PG8_LAS bf16x8*)(lds + PG8_SB(b, h) + boff + n * 2048 + k * 1024); } while (0)
#define PG8_MMA(ai, bj, At, Bt) do { __builtin_amdgcn_s_setprio(1); _Pragma("unroll") for (int m = 0; m < 4; ++m) _Pragma("unroll") for (int n = 0; n < 2; ++n) _Pragma("unroll") for (int k = 0; k < 2; ++k) \
        acc[ai][bj][m][n] = __builtin_amdgcn_mfma_f32_16x16x32_bf16(Bt[n][k], At[m][k], acc[ai][bj][m][n], 0, 0, 0); __builtin_amdgcn_s_setprio(0); } while (0)
#define PG8_WAIT_V(n) asm volatile("s_waitcnt vmcnt(" #n ")" ::: "memory")
#define PG8_WAIT_L(n) asm volatile("s_waitcnt lgkmcnt(" #n ")" ::: "memory")
#define PG8_BAR __builtin_amdgcn_s_barrier()
#define PG8_SCHED __builtin_amdgcn_sched_barrier(0)
    Unit cur, nxt; int ui = 0;
    if (!S.next(0, cur)) return;
    f32x4 acc[2][2][4][2];
#pragma unroll
    for (int a = 0; a < 2; ++a)
#pragma unroll
        for (int b = 0; b < 2; ++b)
#pragma unroll
            for (int m = 0; m < 4; ++m)
#pragma unroll
                for (int n = 0; n < 2; ++n) acc[a][b][m][n] = (f32x4){0.f, 0.f, 0.f, 0.f};
    bf16x8 At[4][2], B0[2][2], B1[2][2];
    const PG8_GAS char* cA = (const PG8_GAS char*)g.A + (size_t)cur.pm * tstep + (size_t)cur.k0 * 2; const PG8_GAS char* cB = (const PG8_GAS char*)g.Bt + (size_t)cur.pn * tstep + (size_t)cur.k0 * 2;
    S.a_ready(cur);
    if constexpr (SP2) {
        PG8_STAGE(PG8_SB(0, 0), cB, voffB); PG8_STAGE(PG8_SB(0, 1), cB + hstep, voffB); PG8_STAGE(PG8_SA(0, 0), cA, voffA); PG8_STAGE(PG8_SA(0, 1), cA + hstep, voffA);
        if (wr == 1) PG8_BAR;
        PG8_WAIT_V(2); PG8_BAR;
        PG8_STAGE(PG8_SB(1, 0), cB + kstep, voffB); PG8_STAGE(PG8_SA(1, 0), cA + kstep, voffA); PG8_STAGE(PG8_SB(1, 1), cB + hstep + kstep, voffB);
        PG8_WAIT_V(6); PG8_BAR;
    } else {
        PG8_STAGE(PG8_SB(0, 0), cB, voffB); PG8_STAGE(PG8_SA(0, 0), cA, voffA); PG8_STAGE(PG8_SB(0, 1), cB + hstep, voffB); PG8_STAGE(PG8_SA(0, 1), cA + hstep, voffA);
        if (wr == 1) PG8_BAR;
        PG8_WAIT_V(4); PG8_BAR;
        PG8_STAGE(PG8_SB(1, 0), cB + kstep, voffB); PG8_STAGE(PG8_SA(1, 0), cA + kstep, voffA); PG8_STAGE(PG8_SB(1, 1), cB + hstep + kstep, voffB);
        PG8_WAIT_V(6); PG8_BAR;
    }
    for (;;) {
        const bool has_next = S.next(ui + 1, nxt);
        const PG8_GAS char* nA = has_next ? (const PG8_GAS char*)g.A + (size_t)nxt.pm * tstep + (size_t)nxt.k0 * 2 : cA; const PG8_GAS char* nB = has_next ? (const PG8_GAS char*)g.Bt + (size_t)nxt.pn * tstep + (size_t)nxt.k0 * 2 : cB;
        const int nt = cur.nt;
        for (int t = 0; t < nt; t += 2) {
            const bool last = (t == nt - 2);
            const PG8_GAS char* a1 = cA + (size_t)(t + 1) * kstep;
            const PG8_GAS char* a2 = last ? nA : cA + (size_t)(t + 2) * kstep; const PG8_GAS char* b2 = last ? nB : cB + (size_t)(t + 2) * kstep;
            const PG8_GAS char* a3 = a2 + kstep; const PG8_GAS char* b3 = b2 + kstep;
            if (last && has_next) S.a_ready(nxt);
            if constexpr (SP2) {
            PG8_LDB(B0, 0, 0); PG8_LDB(B1, 0, 1); PG8_SCHED; PG8_LDA(At, 0, 0); PG8_STAGE(PG8_SA(1, 1), a1 + hstep, voffA);
            PG8_WAIT_V(8); PG8_WAIT_L(0); PG8_BAR; PG8_MMA(0, 0, At, B0); PG8_MMA(0, 1, At, B1); PG8_BAR; PG8_SCHED;
            PG8_LDA(At, 0, 1); PG8_STAGE(PG8_SB(0, 0), b2, voffB); PG8_STAGE(PG8_SB(0, 1), b2 + hstep, voffB); PG8_STAGE(PG8_SA(0, 0), a2, voffA);
            PG8_WAIT_V(8); PG8_WAIT_L(0); PG8_BAR; PG8_MMA(1, 0, At, B0); PG8_MMA(1, 1, At, B1); PG8_BAR; PG8_SCHED;
            PG8_LDB(B0, 1, 0); PG8_LDB(B1, 1, 1); PG8_SCHED; PG8_LDA(At, 1, 0); PG8_STAGE(PG8_SA(0, 1), a2 + hstep, voffA);
            PG8_WAIT_V(8); PG8_WAIT_L(0); PG8_BAR; PG8_MMA(0, 0, At, B0); PG8_MMA(0, 1, At, B1); PG8_BAR; PG8_SCHED;
            PG8_LDA(At, 1, 1); PG8_STAGE(PG8_SB(1, 0), b3, voffB); PG8_STAGE(PG8_SB(1, 1), b3 + hstep, voffB); PG8_STAGE(PG8_SA(1, 0), a3, voffA);
            PG8_WAIT_V(8); PG8_WAIT_L(0); PG8_BAR; PG8_MMA(1, 0, At, B0); PG8_MMA(1, 1, At, B1); PG8_BAR; PG8_SCHED;
            } else {
            PG8_LDB(B0, 0, 0); PG8_SCHED; PG8_LDA(At, 0, 0); PG8_STAGE(PG8_SA(1, 1), a1 + hstep, voffA);
            PG8_WAIT_L(8); PG8_BAR; PG8_WAIT_L(0); PG8_MMA(0, 0, At, B0); PG8_BAR; PG8_SCHED;
            PG8_LDB(B1, 0, 1); PG8_STAGE(PG8_SB(0, 0), b2, voffB);
            PG8_BAR; PG8_WAIT_L(0); PG8_MMA(0, 1, At, B1); PG8_BAR;
            PG8_LDA(At, 0, 1); PG8_STAGE(PG8_SA(0, 0), a2, voffA);
            PG8_BAR; PG8_WAIT_L(0); PG8_MMA(1, 0, At, B0); PG8_BAR; PG8_SCHED;
            PG8_STAGE(PG8_SB(0, 1), b2 + hstep, voffB);
            PG8_WAIT_V(6); PG8_BAR; PG8_MMA(1, 1, At, B1); PG8_BAR;
            PG8_LDB(B0, 1, 0); PG8_SCHED; PG8_LDA(At, 1, 0); PG8_STAGE(PG8_SA(0, 1), a2 + hstep, voffA);
            PG8_WAIT_L(8); PG8_BAR; PG8_WAIT_L(0); PG8_MMA(0, 0, At, B0); PG8_BAR; PG8_SCHED;
            PG8_LDB(B1, 1, 1); PG8_STAGE(PG8_SB(1, 0), b3, voffB);
            PG8_BAR; PG8_WAIT_L(0); PG8_MMA(0, 1, At, B1); PG8_BAR;
            PG8_LDA(At, 1, 1); PG8_STAGE(PG8_SA(1, 0), a3, voffA);
            PG8_BAR; PG8_WAIT_L(0); PG8_MMA(1, 0, At, B0); PG8_BAR; PG8_SCHED;
            PG8_STAGE(PG8_SB(1, 1), b3 + hstep, voffB);
            PG8_WAIT_V(6); PG8_BAR; PG8_MMA(1, 1, At, B1); PG8_BAR;
            }
        }
        if constexpr (ALIGN_EPI) { if (wr == 0) PG8_BAR; }
        if constexpr (!Epi::AFTER_DRAIN) { E(acc, cur, wr, wc, fr, fq); S.done(cur); }
        if (!has_next) break;
#pragma unroll
        for (int a = 0; a < 2; ++a)
#pragma unroll
            for (int b = 0; b < 2; ++b)
#pragma unroll
                for (int m = 0; m < 4; ++m)
#pragma unroll
                    for (int n = 0; n < 2; ++n) acc[a][b][m][n] = (f32x4){0.f, 0.f, 0.f, 0.f};
        cur = nxt; cA = nA; cB = nB; ++ui;
        if constexpr (ALIGN_EPI) { if (wr == 1) PG8_BAR; }
    }
    PG8_WAIT_V(0);
    if constexpr (!ALIGN_EPI) { if (wr == 0) PG8_BAR; }
    PG8_BAR;
    if constexpr (Epi::AFTER_DRAIN) { E.fused(acc, cur, wr, wc, fr, fq, lds, wid, lane); S.done(cur); }
#undef PG8_SA
#undef PG8_SB
#undef PG8_STAGE
#undef PG8_LDA
#undef PG8_LDB
#undef PG8_MMA
#undef PG8_WAIT_V
#undef PG8_WAIT_L
#undef PG8_BAR
#undef PG8_SCHED
}
}
constexpr int NWAVES = 8, NTHR = 512;
constexpr int D = 2048, DEPTH = 4, BP = 2, TP = 4096, BS = 32, TS = 8;
constexpr int MP = BP * TP, MS = BS * TS, M = MP + MS, NBB = BP + BS;
constexpr int NINW = 4872, NPROJ = 4864, DFF = 8192, NMOD = 6 * D, PAST = 16384;
constexpr int C_AQ = 0, C_AF = 512, C_AI = 1024, C_AG = 1536, C_PU = 2048, C_CZ = 2560, C_CX = 3072, C_DQ = 4096, C_DK = 4608, C_DV = 4736;
constexpr float EPS = 1e-6f;
enum { I_XP = 0, I_XS, I_CP, I_CS, I_SHG, I_SPOOL, I_SSSM, I_SCONV, I_CK, I_CV, I_N1G, I_N2G, I_WADA, I_BADA, I_WIN, I_LBL, I_HNG, I_PW, I_PSC, I_CW, I_CB, I_DTB, I_ALOG, I_DSK, I_SNG, I_QNG, I_KNG, I_SINK, I_WOUT, I_WUP, I_WDN, N_IN };
constexpr size_t O_Y = 0, O_PHG = (size_t)M * D, O_PPOOL = O_PHG + 4 * 2 * 4 * 16384, O_PSSM = O_PPOOL + 4 * 2 * 15 * 512, O_PCONV = O_PSSM + 4 * 2 * 8 * 8192, O_PK = O_PCONV + 4 * 2 * 3 * 1024,
    O_PV = O_PK + 4 * 2 * 128 * 128, O_SHG = O_PV + 4 * 2 * 128 * 128, O_SPOOL = O_SHG + (size_t)4 * 32 * 4 * 16384, O_SSSM = O_SPOOL + 4 * 32 * 15 * 512, O_SCONV = O_SSSM + (size_t)4 * 32 * 8 * 8192,
    O_SK = O_SCONV + 4 * 32 * 3 * 1024, O_SV = O_SK + 4 * 32 * 128 * 128, O_END = O_SV + 4 * 32 * 128 * 128;
static_assert(O_END == 41046016, "output size");
constexpr size_t MiB = 1u << 20;
constexpr size_t WS_CTL = 0, CTL_ZERO_BYTES = 1 * MiB;
constexpr size_t WS_MOD = 1 * MiB, WS_LB = 8 * MiB, WS_ROPE = 8 * MiB + 65536, WS_DT = 10 * MiB;
constexpr size_t WS_WIN = 16 * MiB, WS_WOUT = 92 * MiB, WS_WUP = 124 * MiB, WS_WDN = 252 * MiB;
constexpr size_t WS_H = 380 * MiB, WS_PROJ = 413 * MiB, WS_MIX = 492 * MiB, WS_U = 525 * MiB;
constexpr size_t WS_HGDS = 657 * MiB, WS_HGSS = 689 * MiB, WS_SDDS = 721 * MiB, WS_SDSS = 753 * MiB, WS_HGDEC = 785 * MiB, WS_SDDEC = 785 * MiB + 524288, WS_PART = 786 * MiB, WS_YTMP = 818 * MiB, WS_WPT = 850 * MiB, WS_WDT = 850 * MiB + 524288, WS_U2 = 883 * MiB, WS_WDN2 = 1017 * MiB, WS_END = 1147 * MiB;
constexpr int LDU = DFF + 64;
static_assert(WS_U2 + (size_t)M * LDU * 2 <= WS_WDN2 && WS_WDN2 + (size_t)4 * D * LDU * 2 <= WS_END, "ws map 2");
static_assert(WS_WIN + (size_t)4 * NPROJ * D * 2 <= WS_WOUT && WS_PROJ + (size_t)M * NPROJ * 2 <= WS_MIX && WS_U + (size_t)M * DFF * 2 <= WS_HGDS, "ws map");
constexpr int CW_BAR = 4096, CW_Q = 16384, CQ_CONV = 160;
constexpr int RING_BYTES = 131072, LDSCTL_OFF = RING_BYTES, MISC_OFF = LDSCTL_OFF + 320, PTR_OFF = LDSCTL_OFF + 1024, LDS_BYTES = 147456;
constexpr int PH_PER_LAYER = 9, N_PHASES = 2 + DEPTH * PH_PER_LAYER;
constexpr int NSL_OUT = 8, NSL_DN = 16;
#ifndef MK_ONE_LAUNCH
#define MK_ONE_LAUNCH 1
#endif
#define GAS __attribute__((address_space(1)))
#define LAS __attribute__((address_space(3)))
typedef unsigned short bf16;
typedef unsigned v4u __attribute__((ext_vector_type(4)));
typedef float f32x4 __attribute__((ext_vector_type(4)));
typedef short bf16x8 __attribute__((ext_vector_type(8)));
typedef GAS unsigned gu32;
typedef GAS unsigned long long gu64;
#define RLX_AGENT __ATOMIC_RELAXED, __HIP_MEMORY_SCOPE_AGENT
#define LDS_WAIT() asm volatile("s_waitcnt lgkmcnt(0)" ::: "memory")
#define VM_WAIT() asm volatile("s_waitcnt vmcnt(0)" ::: "memory")
__device__ __forceinline__ unsigned long long rt() { return __builtin_amdgcn_s_memrealtime(); }
__device__ __forceinline__ unsigned f2bf(float f) { unsigned u = __builtin_bit_cast(unsigned, f); return (u + 0x7fffu + ((u >> 16) & 1u)) >> 16; }
__device__ __forceinline__ unsigned pk2(float lo, float hi) { return f2bf(lo) | (f2bf(hi) << 16); }

#define XB_TMO      128
#define XB_XCNT(j)  (256  + 64 * (j))
#define XB_XSUB(j)  (1280 + 64 * (j))
#define XB_XGEN(j)  (2304 + 64 * (j))
#define XB_TOP      3328
#define XB_TOPGEN   3392
#define XCD_BAR_WORDS 3456
#define XB_SPIN_CAP (1u << 18)

__device__ __forceinline__ unsigned xb_ld(unsigned* p)              { return __hip_atomic_load(p, __ATOMIC_RELAXED, __HIP_MEMORY_SCOPE_AGENT); }
__device__ __forceinline__ unsigned xb_add(unsigned* p, unsigned v) { return __hip_atomic_fetch_add(p, v, __ATOMIC_RELAXED, __HIP_MEMORY_SCOPE_AGENT); }
__device__ __forceinline__ unsigned xb_xcc_id() { return (unsigned)__builtin_amdgcn_s_getreg((3 << 11) | 20) & 0xFu; }
#define XB_SPIN(cond, bar) do { unsigned _sp = 0; while (cond) { __builtin_amdgcn_s_sleep(1); \
    if ((++_sp & 255u) == 0u) { if (xb_ld(&(bar)[XB_TMO])) break; if (_sp > XB_SPIN_CAP) { atomicAdd(&(bar)[XB_TMO], 1u); break; } } } } while (0)

struct XcdBarrier {
    unsigned* bar; unsigned x;
    volatile LAS unsigned* st;
};

__device__ __forceinline__ XcdBarrier xcd_barrier_post(unsigned* bar, volatile LAS unsigned* st) {
    XcdBarrier b; b.bar = bar; b.x = xb_xcc_id(); b.st = st;
    if (threadIdx.x == 0) (void)xb_add(&bar[XB_XCNT(b.x)], 1u);
    return b;
}
__device__ __forceinline__ void xcd_barrier_complete(unsigned* bar, unsigned x, unsigned& nloc, unsigned& nx) {
    const unsigned G = gridDim.x * gridDim.y * gridDim.z;
    unsigned sum, cnt, mine, sp = 0u;
    for (;;) {
        sum = 0u; cnt = 0u; mine = 0u;
#pragma unroll
        for (unsigned j = 0; j < 16; ++j) { const unsigned c = xb_ld(&bar[XB_XCNT(j)]); sum += c; cnt += (c > 0u) ? 1u : 0u; mine = (j == x) ? c : mine; }
        if (sum == G) break;
        __builtin_amdgcn_s_sleep(1);
        if ((++sp & 255u) == 0u) { if (xb_ld(&bar[XB_TMO])) break; if (sp > XB_SPIN_CAP) { atomicAdd(&bar[XB_TMO], 1u); break; } }
    }
    nloc = mine > 0u ? mine : 1u; nx = cnt > 0u ? cnt : 1u;
}

__device__ __forceinline__ void xcd_barrier(const XcdBarrier& b) {
    asm volatile("s_waitcnt vmcnt(0)" ::: "memory");
    __syncthreads();
    if (threadIdx.x == 0) {
        unsigned* bar = b.bar;
        __builtin_amdgcn_s_waitcnt(0);
        unsigned nloc = b.st[0], nx = b.st[1];
        if (nloc == 0u) { xcd_barrier_complete(bar, b.x, nloc, nx); b.st[0] = nloc; b.st[1] = nx; }
        const unsigned old = xb_add(&bar[XB_XSUB(b.x)], 1u);
        const unsigned gen = old / nloc;
        if (old + 1u == (gen + 1u) * nloc) {
            __builtin_amdgcn_fence(__ATOMIC_RELEASE, "agent");
            asm volatile("s_waitcnt vmcnt(0)" ::: "memory");
            const unsigned og = xb_add(&bar[XB_TOP], 1u);
            const unsigned tg = og / nx;
            if (og + 1u == (tg + 1u) * nx) xb_add(&bar[XB_TOPGEN], 1u);
            else XB_SPIN(xb_ld(&bar[XB_TOPGEN]) == tg, bar);
            __builtin_amdgcn_fence(__ATOMIC_ACQUIRE, "agent");
            xb_add(&bar[XB_XGEN(b.x)], 1u);
            asm volatile("s_waitcnt vmcnt(0)" ::: "memory");
        } else {
            XB_SPIN(xb_ld(&bar[XB_XGEN(b.x)]) == gen, bar);
            __builtin_amdgcn_fence(__ATOMIC_ACQUIRE, "agent");
            asm volatile("s_waitcnt vmcnt(0)" ::: "memory");
        }
    }
    __syncthreads();
}

struct Frame {
    LAS unsigned char* lds;
    volatile LAS unsigned* MISC;
    gu32* ctl;
    int tid, lane, wave, G, gw, ngw;
    GAS float* out; GAS unsigned char* ws;
};
__device__ __forceinline__ const GAS float* inp(const Frame& F, int i) {
    int off = PTR_OFF + 8 * i; asm volatile("" : "+s"(off));
    const unsigned long long v = *(const LAS unsigned long long*)(F.lds + off);
    const unsigned lo = __builtin_amdgcn_readfirstlane((unsigned)v), hi = __builtin_amdgcn_readfirstlane((unsigned)(v >> 32));
    return (const GAS float*)(((unsigned long long)hi << 32) | lo);
}
__device__ __forceinline__ GAS unsigned char* wsp(const Frame& F, size_t off) { GAS unsigned char* p = F.ws; asm volatile("" : "+s"(p)); return p + off; }
#define INP(i) inp(F, i)
#define WS_LOCALS \
    GAS float* const MOD = (GAS float*)wsp(F, WS_MOD); GAS float* const LBv = (GAS float*)wsp(F, WS_LB); GAS float* const ROPE = (GAS float*)wsp(F, WS_ROPE); GAS float* const DT = (GAS float*)wsp(F, WS_DT); \
    GAS bf16* const Wi = (GAS bf16*)wsp(F, WS_WIN); GAS bf16* const Wo = (GAS bf16*)wsp(F, WS_WOUT); GAS bf16* const Wu = (GAS bf16*)wsp(F, WS_WUP); GAS bf16* const Wd = (GAS bf16*)wsp(F, WS_WDN2); \
    GAS bf16* const H = (GAS bf16*)wsp(F, WS_H); GAS bf16* const PROJ = (GAS bf16*)wsp(F, WS_PROJ); GAS bf16* const MIX = (GAS bf16*)wsp(F, WS_MIX); GAS bf16* const U = (GAS bf16*)wsp(F, WS_U2); \
    GAS float* const HGDS = (GAS float*)wsp(F, WS_HGDS); GAS float* const HGSS = (GAS float*)wsp(F, WS_HGSS); GAS float* const SDDS = (GAS float*)wsp(F, WS_SDDS); GAS float* const SDSS = (GAS float*)wsp(F, WS_SDSS); \
    GAS float* const HGDEC = (GAS float*)wsp(F, WS_HGDEC); GAS float* const SDDEC = (GAS float*)wsp(F, WS_SDDEC); \
    (void)MOD; (void)LBv; (void)ROPE; (void)DT; (void)Wi; (void)Wo; (void)Wu; (void)Wd; (void)H; (void)PROJ; (void)MIX; (void)U; (void)HGDS; (void)HGSS; (void)SDDS; (void)SDSS; (void)HGDEC; (void)SDDEC;
__device__ __forceinline__ float wave_sum(float v) {
#pragma unroll
    for (int o = 1; o < 64; o <<= 1) v += __shfl_xor(v, o);
    return v;
}
__device__ __forceinline__ float bf2f(bf16 b) { return __builtin_bit_cast(float, (unsigned)b << 16); }
__device__ __forceinline__ float bflo(unsigned w) { return __builtin_bit_cast(float, w << 16); }
__device__ __forceinline__ float bfhi(unsigned w) { return __builtin_bit_cast(float, w & 0xffff0000u); }
__device__ __forceinline__ float sigm(float x) { return __builtin_amdgcn_rcpf(1.f + __expf(-x)); }
__device__ __forceinline__ float rsq(float x) { return __builtin_amdgcn_rsqf(x); }
__device__ __forceinline__ int row_bb(int m) { return m < MP ? (m >> 12) : BP + ((m - MP) >> 3); }
typedef short bf16x8v __attribute__((ext_vector_type(8)));
__device__ __forceinline__ f32x4 mma16(const LAS bf16* A, int lda, const LAS bf16* B, int ldb, int K, f32x4 acc, int lane) {
    const LAS bf16* ap = A + (lane & 15) * lda + 8 * (lane >> 4); const LAS bf16* bp = B + (lane & 15) * ldb + 8 * (lane >> 4);
    for (int k = 0; k < K; k += 32) { const bf16x8v a = *(const LAS bf16x8v*)(ap + k); const bf16x8v b = *(const LAS bf16x8v*)(bp + k); acc = __builtin_amdgcn_mfma_f32_16x16x32_bf16(a, b, acc, 0, 0, 0); }
    return acc;
}
__device__ __forceinline__ bf16 tobf(float f) { return (bf16)f2bf(f); }

#ifndef UT_MASK
#define UT_MASK 0
#endif
#define UTS(bit) do { if ((UT_MASK >> (bit)) & 1) { if (F.tid == 0) { const unsigned long long t_ = __builtin_amdgcn_s_memrealtime(); F.MISC[18] = (unsigned)t_; F.MISC[19] = (unsigned)(t_ >> 32); } } } while (0)
#define UTE(bit) do { if ((UT_MASK >> (bit)) & 1) { if (F.tid == 0) { const unsigned long long t0_ = ((unsigned long long)F.MISC[19] << 32) | F.MISC[18]; const unsigned long long a_ = (((unsigned long long)F.MISC[17] << 32) | F.MISC[16]) + (__builtin_amdgcn_s_memrealtime() - t0_); F.MISC[16] = (unsigned)a_; F.MISC[17] = (unsigned)(a_ >> 32); } } } while (0)
__device__ __forceinline__ int deq(Frame& F, int q) {
    __syncthreads();
    if (F.tid == 0) F.MISC[0] = __hip_atomic_fetch_add(F.ctl + CW_Q + 64 * q, 1u, RLX_AGENT);
    __syncthreads();
    return (int)F.MISC[0];
}

__device__ __forceinline__ void p0_transpose_item(const GAS float* W, int K, int ldw, GAS bf16* WT, int k0, int src_n0, int dst_n0, LAS float* scr, int lane) {
    float tv[32];
#pragma unroll
    for (int i = 0; i < 32; ++i) { const int kk = 2 * i + (lane >> 5); tv[i] = W[(size_t)(k0 + kk) * ldw + src_n0 + (lane & 31)]; }
#pragma unroll
    for (int i = 0; i < 32; ++i) { const int kk = 2 * i + (lane >> 5); scr[kk * 33 + (lane & 31)] = tv[i]; }
    LDS_WAIT(); asm volatile("" ::: "memory");
    const int c = lane & 7;
#pragma unroll
    for (int j = 0; j < 4; ++j) { const int n = (lane >> 3) + 8 * j; const LAS float* s = scr + (8 * c) * 33 + n;
        v4u o; o.x = pk2(s[0 * 33], s[1 * 33]); o.y = pk2(s[2 * 33], s[3 * 33]); o.z = pk2(s[4 * 33], s[5 * 33]); o.w = pk2(s[6 * 33], s[7 * 33]);
        *(GAS v4u*)(WT + (size_t)(dst_n0 + n) * K + k0 + 8 * c) = o; }
    LDS_WAIT(); asm volatile("" ::: "memory");
}
__device__ __forceinline__ void p0_adaln(Frame& F) {
    WS_LOCALS
    constexpr int LDC = 520, NITEM = DEPTH * NMOD / 32;
    LAS bf16* cs = (LAS bf16*)F.lds;
    const GAS float* const cpp = INP(I_CP); const GAS float* const csp = INP(I_CS); const GAS float* const wada = INP(I_WADA); const GAS float* const bada = INP(I_BADA);
    const int lane = F.lane, item = (int)blockIdx.x + F.G * F.wave; const bool act = item < NITEM;
    const int l = act ? item / (NMOD / 32) : 0, n0 = act ? (item % (NMOD / 32)) * 32 : 0;
    f32x4 acc[2][3];
#pragma unroll
    for (int a = 0; a < 2; ++a)
#pragma unroll
        for (int r = 0; r < 3; ++r) acc[a][r] = (f32x4){0.f, 0.f, 0.f, 0.f};
    const GAS float* wl = wada + (size_t)l * D * NMOD + n0 + (lane & 15);
    for (int kc = 0; kc < 4; ++kc) {
        __syncthreads();
        for (int e = F.tid; e < 48 * 512; e += NTHR) { const int bb = e >> 9, kk = e & 511; float v = 0.f;
            if (bb < NBB) { const float c = bb < BP ? cpp[bb * D + kc * 512 + kk] : csp[(bb - BP) * D + kc * 512 + kk]; v = c * sigm(c); }
            cs[bb * LDC + kk] = tobf(v); }
        __syncthreads();
        if (act) {
#pragma unroll 2
            for (int ks = 0; ks < 16; ++ks) { const int kg = kc * 512 + ks * 32 + 8 * (lane >> 4);
                float w0[8], w1[8];
#pragma unroll
                for (int j = 0; j < 8; ++j) { w0[j] = wl[(size_t)(kg + j) * NMOD]; w1[j] = wl[(size_t)(kg + j) * NMOD + 16]; }
                v4u b0, b1; b0.x = pg8::cvt_pk_bf16(w0[0], w0[1]); b0.y = pg8::cvt_pk_bf16(w0[2], w0[3]); b0.z = pg8::cvt_pk_bf16(w0[4], w0[5]); b0.w = pg8::cvt_pk_bf16(w0[6], w0[7]);
                b1.x = pg8::cvt_pk_bf16(w1[0], w1[1]); b1.y = pg8::cvt_pk_bf16(w1[2], w1[3]); b1.z = pg8::cvt_pk_bf16(w1[4], w1[5]); b1.w = pg8::cvt_pk_bf16(w1[6], w1[7]);
                const bf16x8v bf0 = __builtin_bit_cast(bf16x8v, b0), bf1 = __builtin_bit_cast(bf16x8v, b1);
#pragma unroll
                for (int r = 0; r < 3; ++r) { const bf16x8v a = *(const LAS bf16x8v*)(cs + (16 * r + (lane & 15)) * LDC + ks * 32 + 8 * (lane >> 4));
                    acc[0][r] = __builtin_amdgcn_mfma_f32_16x16x32_bf16(a, bf0, acc[0][r], 0, 0, 0); acc[1][r] = __builtin_amdgcn_mfma_f32_16x16x32_bf16(a, bf1, acc[1][r], 0, 0, 0); } }
        }
    }
    if (act) {
#pragma unroll
        for (int a = 0; a < 2; ++a) { const int n = n0 + 16 * a + (lane & 15); const float bias = bada[l * NMOD + n];
#pragma unroll
            for (int r = 0; r < 3; ++r)
#pragma unroll
                for (int i = 0; i < 4; ++i) { const int bb = 16 * r + 4 * (lane >> 4) + i; if (bb < NBB) MOD[((size_t)l * NBB + bb) * NMOD + n] = acc[a][r][i] + bias; } }
    }
    __syncthreads();
}
__device__ __forceinline__ void convert_layer(Frame& F, int l, int first, int nblk_, int bt0, int bt1) {
    WS_LOCALS
    LAS float* scr = (LAS float*)(F.lds + F.wave * 16384);
    constexpr int IT_IN = (D / 64) * (NPROJ / 32), IT_OUT = (D / 64) * (D / 32), IT_UP = (D / 64) * (DFF / 32), IT_DN = (DFF / 64) * (D / 32), IT_L = IT_IN + IT_OUT + IT_UP + IT_DN, NBATCH = (IT_L + 15) / 16;
    const GAS float* const win = INP(I_WIN) + (size_t)l * D * NINW; const GAS float* const wout = INP(I_WOUT) + (size_t)l * D * D; const GAS float* const wup = INP(I_WUP) + (size_t)l * D * DFF; const GAS float* const wdn = INP(I_WDN) + (size_t)l * DFF * D;
    const int me = (int)blockIdx.x - first; if (me < 0 || me >= nblk_) return;
    const int bte = bt1 < NBATCH ? bt1 : NBATCH;
    for (int bt = bt0 + me; bt < bte; bt += nblk_) {
#pragma unroll 1
        for (int s = 0; s < 2; ++s) { int r = bt * 16 + s * 8 + F.wave; if (r >= IT_L) continue;
            if (r < IT_IN) { const int nblk = NPROJ / 32, kb = r / nblk, nb = r % nblk, dn0 = 32 * nb, sn0 = dn0 + (dn0 >= 4096 ? 8 : 0);
                p0_transpose_item(win, D, NINW, Wi + (size_t)l * NPROJ * D, 64 * kb, sn0, dn0, scr, F.lane); continue; } r -= IT_IN;
            if (r < IT_OUT) { const int nblk = D / 32, kb = r / nblk, nb = r % nblk;
                p0_transpose_item(wout, D, D, Wo + (size_t)l * D * D, 64 * kb, 32 * nb, 32 * nb, scr, F.lane); continue; } r -= IT_OUT;
            if (r < IT_UP) { const int nblk = DFF / 32, kb = r / nblk, nb = r % nblk;
                p0_transpose_item(wup, D, DFF, Wu + (size_t)l * DFF * D, 64 * kb, 32 * nb, 32 * nb, scr, F.lane); continue; } r -= IT_UP;
            { const int nblk = D / 32, kb = r / nblk, nb = r % nblk;
                p0_transpose_item(wdn, LDU, D, Wd + (size_t)l * D * LDU, 64 * kb, 32 * nb, 32 * nb, scr, F.lane); } }
    }
}
__device__ __forceinline__ void p0_prologue(Frame& F) {
    WS_LOCALS
    const int gt = blockIdx.x * NTHR + F.tid, NT = F.G * NTHR;
    if (gt < 512) { const GAS float* lg = INP(I_LBL); const float a0 = lg[gt], a1 = lg[512 + gt], a2 = lg[1024 + gt], a3 = lg[1536 + gt];
        const float mx = fmaxf(fmaxf(a0, a1), fmaxf(a2, a3)); const float e0 = expf(a0 - mx), e1 = expf(a1 - mx), e2 = expf(a2 - mx), e3 = expf(a3 - mx); const float inv = 1.f / (e0 + e1 + e2 + e3);
        LBv[gt] = 0.f; LBv[512 + gt] = e1 * inv; LBv[1024 + gt] = (e1 + e2) * inv; LBv[1536 + gt] = (e1 + e2 + e3) * inv; }
    for (int e = gt; e < 4104 * 32; e += NT) { const int r = e >> 5, i = e & 31; const int pos = r < 4096 ? r : PAST + (r - 4096);
        const double inv = exp2(-(double)i * (13.287712379549449 / 32.0)); const double rev = (double)pos * inv * 0.15915494309189535;
        const float fr = (float)(rev - floor(rev));
        ROPE[r * 64 + i] = __builtin_amdgcn_cosf(fr); ROPE[r * 64 + 32 + i] = __builtin_amdgcn_sinf(fr); }
    { const GAS float* wi = INP(I_WIN); GAS float* wdtg = (GAS float*)wsp(F, WS_WDT);
      for (int e = gt; e < DEPTH * D * 8; e += NT) { const int ll = e >> 14, d2 = (e >> 3) & 2047, j = e & 7; wdtg[(ll * 8 + j) * D + d2] = wi[((size_t)ll * D + d2) * NINW + 4096 + j]; } }
    { const GAS float* pw = INP(I_PW); GAS bf16* wpt = (GAS bf16*)wsp(F, WS_WPT);
      for (int e = gt; e < 16 * 16384; e += NT) { const int lg = e >> 14, dd = (e >> 7) & 127, c = e & 127; wpt[e] = (bf16)f2bf(pw[(size_t)lg * 16384 + c * 128 + dd]); } }
    p0_adaln(F);
    convert_layer(F, 0, 0, F.G, 0, 1 << 30);
}

template <int NR> __device__ __forceinline__ void norm_rows(Frame& F, int l, int which, const int (&mr)[NR], f32x4 (&v)[NR][8], const GAS f32x4* g4, const GAS float* MOD, GAS bf16* H, GAS float* DT, const LAS float* wdt) {
    const int bb = row_bb(mr[0]);
    const GAS float* modp = MOD + ((size_t)l * NBB + bb) * NMOD + (which ? 3 * D : 0);
    const GAS f32x4* sh4 = (const GAS f32x4*)modp; const GAS f32x4* sc4 = (const GAS f32x4*)(modp + D);
    f32x4 gs[8], shv[8];
#pragma unroll
    for (int j = 0; j < 8; ++j) { const int q = 64 * j + F.lane; const f32x4 g = g4[q], sc = sc4[q]; shv[j] = sh4[q]; gs[j] = g * (sc + 1.f); }
    float ss[NR];
#pragma unroll
    for (int n = 0; n < NR; ++n) { float s = 0.f;
#pragma unroll
        for (int j = 0; j < 8; ++j) s += (v[n][j].x * v[n][j].x + v[n][j].y * v[n][j].y) + (v[n][j].z * v[n][j].z + v[n][j].w * v[n][j].w);
        ss[n] = s; }
#pragma unroll
    for (int o = 1; o < 64; o <<= 1) {
#pragma unroll
        for (int n = 0; n < NR; ++n) ss[n] += __shfl_xor(ss[n], o); }
#pragma unroll
    for (int n = 0; n < NR; ++n) { const float r = rsq(ss[n] * (1.f / D) + EPS); GAS unsigned long long* o8 = (GAS unsigned long long*)(H + (size_t)mr[n] * D);
#pragma unroll
        for (int j = 0; j < 8; ++j) { const int q = 64 * j + F.lane;
            f32x4 h; h.x = v[n][j].x * r * gs[j].x + shv[j].x; h.y = v[n][j].y * r * gs[j].y + shv[j].y; h.z = v[n][j].z * r * gs[j].z + shv[j].z; h.w = v[n][j].w * r * gs[j].w + shv[j].w;
            o8[q] = (unsigned long long)pk2(h.x, h.y) | ((unsigned long long)pk2(h.z, h.w) << 32);
            v[n][j] = h; } }
    if (which == 0) { float dta[NR][8];
#pragma unroll
        for (int jj = 0; jj < 8; ++jj) { float a[NR];
#pragma unroll
            for (int n = 0; n < NR; ++n) a[n] = 0.f;
#pragma unroll
            for (int j = 0; j < 8; ++j) { const f32x4 w = ((const LAS f32x4*)wdt)[jj * (D / 4) + 64 * j + F.lane];
#pragma unroll
                for (int n = 0; n < NR; ++n) a[n] += (v[n][j].x * w.x + v[n][j].y * w.y) + (v[n][j].z * w.z + v[n][j].w * w.w); }
#pragma unroll
            for (int n = 0; n < NR; ++n) dta[n][jj] = a[n];
            __builtin_amdgcn_sched_barrier(0); }
#pragma unroll
        for (int o = 1; o < 64; o <<= 1) {
#pragma unroll
            for (int n = 0; n < NR; ++n)
#pragma unroll
                for (int jj = 0; jj < 8; ++jj) dta[n][jj] += __shfl_xor(dta[n][jj], o); }
        if (F.lane == 0) {
#pragma unroll
            for (int n = 0; n < NR; ++n) { GAS f32x4* dp = (GAS f32x4*)(DT + (size_t)mr[n] * 8); dp[0] = (f32x4){dta[n][0], dta[n][1], dta[n][2], dta[n][3]}; dp[1] = (f32x4){dta[n][4], dta[n][5], dta[n][6], dta[n][7]}; } } }
}
__device__ __forceinline__ void sample_row_reduce(Frame& F, int ms, int nsl, f32x4 (&v)[8], LAS float* partl) {
    const GAS f32x4* pp = (const GAS f32x4*)wsp(F, WS_PART) + (size_t)ms * (D / 4); GAS f32x4* xw = (GAS f32x4*)(F.out + (size_t)(MP + ms) * D);
#pragma unroll
    for (int j = 0; j < 8; ++j) v[j] = (F.wave == 0) ? xw[64 * j + F.lane] : (f32x4){0.f, 0.f, 0.f, 0.f};
#pragma unroll 1
    for (int s = F.wave; s < nsl; s += 8) {
#pragma unroll
        for (int j = 0; j < 8; ++j) v[j] = v[j] + pp[(size_t)s * (MS * D / 4) + 64 * j + F.lane]; }
    if (F.wave != 0) {
#pragma unroll
        for (int j = 0; j < 8; ++j) ((LAS f32x4*)partl)[(F.wave - 1) * (D / 4) + 64 * j + F.lane] = v[j]; }
    __syncthreads();
    if (F.wave == 0) {
#pragma unroll 1
        for (int w = 0; w < 7; ++w) {
#pragma unroll
            for (int j = 0; j < 8; ++j) v[j] = v[j] + ((const LAS f32x4*)partl)[w * (D / 4) + 64 * j + F.lane]; }
#pragma unroll
        for (int j = 0; j < 8; ++j) xw[64 * j + F.lane] = v[j]; }
}
__device__ __forceinline__ void norm_phase(Frame& F, int l, int which, int nsl) {
    WS_LOCALS
    LAS float* wdt = (LAS float*)F.lds;
    LAS float* partl = (LAS float*)(F.lds + 65536);
    if (which == 0) { const GAS f32x4* wsrc = (const GAS f32x4*)((const GAS float*)wsp(F, WS_WDT) + (size_t)l * 8 * D);
        for (int e = F.tid; e < D * 8 / 4; e += NTHR) ((LAS f32x4*)wdt)[e] = wsrc[e]; }
    __syncthreads();
    const GAS f32x4* g4 = (const GAS f32x4*)(INP(which ? I_N2G : I_N1G) + l * D);
    if (nsl > 0) for (int ms = (int)blockIdx.x; ms < MS; ms += F.G) { f32x4 v1[1][8]; if (ms != (int)blockIdx.x) __syncthreads(); sample_row_reduce(F, ms, nsl, v1[0], partl); const int mr[1] = {MP + ms}; if (F.wave == 0) norm_rows<1>(F, l, which, mr, v1, g4, MOD, H, DT, wdt); }
    const int mend = nsl > 0 ? MP : M;
    const bool first = (l == 0 && which == 0);
    const GAS float* const xpp = INP(I_XP); const GAS float* const xsp = INP(I_XS);
    int m = F.gw;
    while (m < mend) { const int m2 = m + F.ngw;
        if (m2 < mend && row_bb(m) == row_bb(m2)) { f32x4 v2[2][8]; const int mr[2] = {m, m2};
            const GAS f32x4* xa = (const GAS f32x4*)((first ? (m < MP ? xpp + (size_t)m * D : xsp + (size_t)(m - MP) * D) : F.out + (size_t)m * D)); const GAS f32x4* xb = (const GAS f32x4*)((first ? (m2 < MP ? xpp + (size_t)m2 * D : xsp + (size_t)(m2 - MP) * D) : F.out + (size_t)m2 * D));
#pragma unroll
            for (int j = 0; j < 8; ++j) { v2[0][j] = xa[64 * j + F.lane]; v2[1][j] = xb[64 * j + F.lane]; }
            if (first && m >= MP) {
#pragma unroll
                for (int j = 0; j < 8; ++j) { ((GAS f32x4*)(F.out + (size_t)m * D))[64 * j + F.lane] = v2[0][j]; ((GAS f32x4*)(F.out + (size_t)m2 * D))[64 * j + F.lane] = v2[1][j]; } }
            norm_rows<2>(F, l, which, mr, v2, g4, MOD, H, DT, wdt); m += 2 * F.ngw; }
        else { f32x4 v1[1][8]; const int mr[1] = {m}; const GAS f32x4* xa = (const GAS f32x4*)((first ? (m < MP ? xpp + (size_t)m * D : xsp + (size_t)(m - MP) * D) : F.out + (size_t)m * D));
#pragma unroll
            for (int j = 0; j < 8; ++j) v1[0][j] = xa[64 * j + F.lane];
            if (first && m >= MP) {
#pragma unroll
                for (int j = 0; j < 8; ++j) ((GAS f32x4*)(F.out + (size_t)m * D))[64 * j + F.lane] = v1[0][j]; }
            norm_rows<1>(F, l, which, mr, v1, g4, MOD, H, DT, wdt); m += F.ngw; } }
}
__device__ __forceinline__ void final_fix_phase(Frame& F, int nsl) {
    LAS float* partl = (LAS float*)(F.lds + 65536); f32x4 v[8];
    __syncthreads();
    for (int ms = (int)blockIdx.x; ms < MS; ms += F.G) { sample_row_reduce(F, ms, nsl, v, partl); __syncthreads(); }
}
template <int MODE> __device__ __forceinline__ unsigned ssd_raw(const GAS bf16* PROJ, const GAS float* scv, int l, int b, int m0, int tseq0, int r, int ch) {
    if (MODE == 2) { const int rp = r < 0 ? 0 : (r > 7 ? 7 : r), rs = r < 0 ? 3 + r : 0;
        const unsigned a = *(const GAS unsigned*)(PROJ + (size_t)(m0 + rp) * NPROJ + C_CX + ch); const GAS float* sc = scv + ((size_t)(l * BS + b) * 3 + rs) * 1024 + ch; const unsigned c = pk2(sc[0], sc[1]);
        return r < 0 ? c : (r > 7 ? 0u : a); }
    const int rc = (tseq0 + r >= 0) ? r : -tseq0; const unsigned a = *(const GAS unsigned*)(PROJ + (size_t)(m0 + rc) * NPROJ + C_CX + ch);
    return (tseq0 + r >= 0) ? a : 0u;
}
template <int MODE> __device__ __forceinline__ void ssd_unit(Frame& F, int l, int u) {
    WS_LOCALS
    constexpr int T = (MODE == 2) ? 16 : 64, SK = (MODE == 2) ? 32 : 64, L = (MODE == 2) ? 8 : 64, LDN = 136, LDS_ = SK + 8;
    constexpr int NT_CB = (T / 16) * (SK / 16), NT_Y = (T / 16) * 4;
    constexpr int OFF_BG = (MODE == 0 ? 0 : T * LDN * 2), OFF_BGT = OFF_BG + (MODE == 0 ? 0 : T * LDN * 2), OFF_XT = OFF_BGT + (MODE == 1 ? 0 : 128 * LDS_ * 2), OFF_XWT = OFF_XT + (MODE == 0 ? 0 : 4 * 64 * LDS_ * 2),
                  OFF_WL = OFF_XWT + (MODE == 1 ? 0 : 4 * 64 * LDS_ * 2), OFF_SM = OFF_WL + (MODE == 0 ? 0 : 4 * T * LDS_ * 2);
    constexpr int OFF_S0 = (MODE == 2) ? OFF_SM + 2304 : 0;
    static_assert(OFF_SM + 2304 <= RING_BYTES && (MODE != 2 || OFF_S0 + 2 * 64 * 136 * 2 <= RING_BYTES) && (MODE != 1 || 2 * 64 * 136 * 2 <= OFF_XT), "ssd LDS map");
    const int tid0 = F.tid, lane0 = F.lane, wave = F.wave;
    const GAS float* const cwp = INP(I_CW); const GAS float* const cbp = INP(I_CB); const GAS float* const scv = INP(I_SCONV);
    int b, m0, tseq0;
    if (MODE == 2) { b = u; m0 = MP + b * TS; tseq0 = 0; } else { b = u >> 6; m0 = b * TP + (u & 63) * 64; tseq0 = (u & 63) * 64; }
    LAS bf16* Cg = (LAS bf16*)F.lds;
    LAS bf16* Bg = (LAS bf16*)(F.lds + OFF_BG);
    LAS bf16* BgT = (LAS bf16*)(F.lds + OFF_BGT);
    LAS bf16* xT = (LAS bf16*)(F.lds + OFF_XT);
    LAS bf16* xwT = (LAS bf16*)(F.lds + OFF_XWT);
    LAS bf16* Wl = (LAS bf16*)(F.lds + OFF_WL);
    LAS float* cumL = (LAS float*)(F.lds + OFF_SM);
    LAS float* dtL = cumL + 256;
    LAS float* rowss = dtL + 256;
    GAS float* const ytmp = (GAS float*)wsp(F, WS_YTMP) + (size_t)blockIdx.x * (64 * 512);
    float ssum[4] = {0.f, 0.f, 0.f, 0.f};
    if (tid0 < 64) rowss[tid0] = 0.f;
#pragma unroll 1
    for (int g = 0; g < 2; ++g) {
        int tid = tid0, lane = lane0; asm volatile("" : "+v"(tid), "+v"(lane));
        __syncthreads();
        if (MODE == 1) UTS(0);
        if (wave < 4) { const int hh = g * 4 + wave; float dtv = 0.f, a = 0.f;
            { const int tl = lane < L ? lane : L - 1; const float raw = DT[(size_t)(m0 + tl) * 8 + hh] + INP(I_DTB)[l * 8 + hh]; const float dt1 = raw > 20.f ? raw : log1pf(__expf(raw)); const float a1 = -dt1 * __expf(INP(I_ALOG)[l * 8 + hh]);
              dtv = lane < L ? dt1 : 0.f; a = lane < L ? a1 : 0.f; }
#pragma unroll
            for (int o = 1; o < 64; o <<= 1) { const float y = __shfl_up(a, o); if (lane >= o) a += y; }
            cumL[lane * 4 + wave] = a; dtL[lane * 4 + wave] = dtv; }
        {   const int pr = tid & 127, rq = tid >> 7;
            const int isC = pr >> 6, n0 = 2 * (pr & 63), ch = 512 + isC * 256 + g * 128 + n0;
            if (MODE != 0 || !isC) {
                float w[4][2], bia[2];
#pragma unroll
                for (int j = 0; j < 4; ++j) { w[j][0] = cwp[(l * 4 + j) * 1024 + ch]; w[j][1] = cwp[(l * 4 + j) * 1024 + ch + 1]; }
                bia[0] = cbp[l * 1024 + ch]; bia[1] = cbp[l * 1024 + ch + 1];
                constexpr int RQ = T / 4; const int r0 = rq * RQ;
                unsigned ra[RQ + 3];
#pragma unroll
                for (int i = 0; i < RQ + 3; ++i) ra[i] = ssd_raw<MODE>(PROJ, scv, l, b, m0, tseq0, r0 - 3 + i, ch);
#pragma unroll
                for (int i = 0; i < RQ; ++i) { const int r = r0 + i; float c0 = 0.f, c1 = 0.f;
                    if (r < L) { c0 = bia[0] + w[0][0] * bflo(ra[i]) + w[1][0] * bflo(ra[i + 1]) + w[2][0] * bflo(ra[i + 2]) + w[3][0] * bflo(ra[i + 3]); c1 = bia[1] + w[0][1] * bfhi(ra[i]) + w[1][1] * bfhi(ra[i + 1]) + w[2][1] * bfhi(ra[i + 2]) + w[3][1] * bfhi(ra[i + 3]);
                        c0 = c0 * sigm(c0); c1 = c1 * sigm(c1); }
                    if (isC) { if (MODE != 0) *(LAS unsigned*)(Cg + r * LDN + n0) = pk2(c0, c1); }
                    else { if (MODE != 0) *(LAS unsigned*)(Bg + r * LDN + n0) = pk2(c0, c1);
                           if (MODE != 1) { BgT[n0 * LDS_ + r] = tobf(c0); BgT[(n0 + 1) * LDS_ + r] = tobf(c1); } } }
                if (MODE == 2 && !isC) { for (int r = T + rq * 4; r < T + rq * 4 + 4; ++r) { BgT[n0 * LDS_ + r] = 0; BgT[(n0 + 1) * LDS_ + r] = 0; } }
            }
        }
        __syncthreads();
        if (MODE == 1) { UTE(0); UTS(1); }
        { int t_ = tid0, l_ = lane0; asm volatile("" : "+v"(t_), "+v"(l_)); tid = t_; lane = l_; }
        {   const int pr = tid & 127, rq = tid >> 7, r = pr >> 5, pp = pr & 31; const int ch = (g * 4 + r) * 64 + 2 * pp;
            float w[4][2], bia[2];
#pragma unroll
            for (int j = 0; j < 4; ++j) { w[j][0] = cwp[(l * 4 + j) * 1024 + ch]; w[j][1] = cwp[(l * 4 + j) * 1024 + ch + 1]; }
            bia[0] = cbp[l * 1024 + ch]; bia[1] = cbp[l * 1024 + ch + 1];
            constexpr int RS = SK / 4; const int r0 = rq * RS;
            const float cl = cumL[(L - 1) * 4 + r];
            unsigned ra[RS + 3];
#pragma unroll
            for (int i = 0; i < RS + 3; ++i) ra[i] = ssd_raw<MODE>(PROJ, scv, l, b, m0, tseq0, r0 - 3 + i, ch);
            LAS bf16* x0 = xT + (r * 64 + 2 * pp) * LDS_; LAS bf16* xw0 = xwT + (r * 64 + 2 * pp) * LDS_;
#pragma unroll
            for (int i = 0; i < RS; ++i) { const int s = r0 + i; float c0 = 0.f, c1 = 0.f, ws = 0.f;
                if (s < L) { c0 = bia[0] + w[0][0] * bflo(ra[i]) + w[1][0] * bflo(ra[i + 1]) + w[2][0] * bflo(ra[i + 2]) + w[3][0] * bflo(ra[i + 3]); c1 = bia[1] + w[0][1] * bfhi(ra[i]) + w[1][1] * bfhi(ra[i + 1]) + w[2][1] * bfhi(ra[i + 2]) + w[3][1] * bfhi(ra[i + 3]);
                    c0 = c0 * sigm(c0); c1 = c1 * sigm(c1); ws = dtL[s * 4 + r] * __expf(cl - cumL[s * 4 + r]); }
                if (MODE != 0) { x0[s] = tobf(c0); x0[LDS_ + s] = tobf(c1); }
                if (MODE != 1) { xw0[s] = tobf(c0 * ws); xw0[LDS_ + s] = tobf(c1 * ws); } }
        }
        if (MODE != 0) {
#pragma unroll
            for (int j = 0; j < 2; ++j) { const int id = 2 * wave + j; if (id < NT_CB) { const int ti = id / (SK / 16), si = id % (SK / 16); f32x4 cb = (f32x4){0.f, 0.f, 0.f, 0.f};
                if (!(MODE == 2 && si > 0) && si <= ti) cb = mma16(Cg + ti * 16 * LDN, LDN, Bg + si * 16 * LDN, LDN, 128, cb, lane);
#pragma unroll
                for (int r = 0; r < 4; ++r)
#pragma unroll
                    for (int i = 0; i < 4; ++i) { const int t = ti * 16 + 4 * (lane >> 4) + i, s = si * 16 + (lane & 15);
                        float wv = 0.f; if (s <= t && (MODE != 2 || t < L)) wv = cb[i] * __expf(cumL[t * 4 + r] - cumL[s * 4 + r]) * dtL[s * 4 + r];
                        Wl[(r * T + t) * LDS_ + s] = tobf(wv); } } }
        }
        __syncthreads();
        if (MODE == 1) { UTE(1); UTS(2); }
        { int t_ = tid0, l_ = lane0; asm volatile("" : "+v"(t_), "+v"(l_)); tid = t_; lane = l_; }
        if (MODE != 0) {
            LAS bf16* Sl = (LAS bf16*)(F.lds + OFF_S0);
            const bool ywave = 2 * wave < NT_Y; const int ti = (2 * wave) >> 2;
            bf16x8v ca[4];
#pragma unroll
            for (int ks = 0; ks < 4; ++ks) ca[ks] = *(const LAS bf16x8v*)(Cg + (ti * 16 + (lane & 15)) * LDN + ks * 32 + 8 * (lane >> 4));
            const GAS float* dskp = INP(I_DSK) + l * 8 + g * 4; const float dsk4[4] = {dskp[0], dskp[1], dskp[2], dskp[3]};
#pragma unroll
            for (int half = 0; half < 2; ++half) {
                float zv[2][2][4];
                if (ywave) {
#pragma unroll
                    for (int rr = 0; rr < 2; ++rr)
#pragma unroll
                        for (int j = 0; j < 2; ++j)
#pragma unroll
                            for (int i = 0; i < 4; ++i) { const int t = ti * 16 + 4 * (lane >> 4) + i, p = ((2 * wave + j) & 3) * 16 + (lane & 15); const int tc = t < L ? t : L - 1; zv[rr][j][i] = bf2f(PROJ[(size_t)(m0 + tc) * NPROJ + C_CZ + (g * 4 + 2 * half + rr) * 64 + p]); } }
                __syncthreads();
                for (int e = tid; e < 4096; e += NTHR) { const int rr = e >> 11, e2 = e & 2047, hh_ = g * 4 + 2 * half + rr;
                    const f32x4 v = ((const GAS f32x4*)(MODE == 1 ? SDSS + ((size_t)u * 8 + hh_) * 8192 : INP(I_SSSM) + ((size_t)(l * BS + b) * 8 + hh_) * 8192))[e2]; const int p = e2 >> 5, n4 = (e2 & 31) * 4;
                    *(LAS unsigned*)(Sl + (rr * 64 + p) * LDN + n4) = pk2(v.x, v.y); *(LAS unsigned*)(Sl + (rr * 64 + p) * LDN + n4 + 2) = pk2(v.z, v.w); }
                __syncthreads();
                if (ywave) {
#pragma unroll
                    for (int rr = 0; rr < 2; ++rr)
#pragma unroll
                        for (int j = 0; j < 2; ++j) { const int r = 2 * half + rr, hh = g * 4 + r, pj = (2 * wave + j) & 3;
                            f32x4 y1 = (f32x4){0.f, 0.f, 0.f, 0.f}, y2 = y1;
                            y1 = mma16(Wl + (r * T + ti * 16) * LDS_, LDS_, xT + (r * 64 + pj * 16) * LDS_, LDS_, SK, y1, lane);
#pragma unroll
                            for (int ks = 0; ks < 4; ++ks) y2 = __builtin_amdgcn_mfma_f32_16x16x32_bf16(ca[ks], *(const LAS bf16x8v*)(Sl + (rr * 64 + pj * 16 + (lane & 15)) * LDN + ks * 32 + 8 * (lane >> 4)), y2, 0, 0, 0);
                            const int p = pj * 16 + (lane & 15); const float dsk = dsk4[r];
#pragma unroll
                            for (int i = 0; i < 4; ++i) { const int t = ti * 16 + 4 * (lane >> 4) + i;
                                if (MODE != 2 || t < L) { const float xv = bf2f(xT[(r * 64 + p) * LDS_ + t]); const float z = zv[rr][j][i];
                                    const float yy = (y1[i] + __expf(cumL[t * 4 + r]) * y2[i] + dsk * xv) * z * sigm(z); ssum[i] += yy * yy; ytmp[t * 512 + hh * 64 + p] = yy; } } } }
            }
        }
        if (MODE == 1) UTE(2);
        if (MODE != 1) {
            const int r = wave >> 1, hh = g * 4 + r; const float dtot = __expf(cumL[(L - 1) * 4 + r]);
#pragma unroll 1
            for (int pi = 0; pi < 4; ++pi) { f32x4 d[4]; float sv[4][4];
                const size_t sb0 = ((size_t)(l * BS + b) * 8 + hh) * 8192; const GAS float* sin_ = (MODE == 2) ? INP(I_SSSM) + sb0 : nullptr;
                if (MODE == 2) {
#pragma unroll
                    for (int j = 0; j < 4; ++j)
#pragma unroll
                        for (int i = 0; i < 4; ++i) sv[j][i] = sin_[(pi * 16 + 4 * (lane >> 4) + i) * 128 + (4 * (wave & 1) + j) * 16 + (lane & 15)]; }
#pragma unroll
                for (int j = 0; j < 4; ++j) { const int nj = 4 * (wave & 1) + j; d[j] = (f32x4){0.f, 0.f, 0.f, 0.f}; d[j] = mma16(xwT + (r * 64 + pi * 16) * LDS_, LDS_, BgT + nj * 16 * LDS_, LDS_, SK, d[j], lane); }
#pragma unroll
                for (int j = 0; j < 4; ++j) { const int n = (4 * (wave & 1) + j) * 16 + (lane & 15);
#pragma unroll
                    for (int i = 0; i < 4; ++i) { const int p = pi * 16 + 4 * (lane >> 4) + i;
                        if (MODE == 0) SDDS[((size_t)u * 8 + hh) * 8192 + p * 128 + n] = d[j][i]; else F.out[O_SSSM + sb0 + p * 128 + n] = dtot * sv[j][i] + d[j][i]; } } }
            if (MODE == 0 && (lane & 63) == 0 && (wave & 1) == 0) SDDEC[u * 8 + hh] = dtot;
        }
    }
    const int tid = tid0, lane = lane0;
    if (MODE == 1) UTS(3);
    if (MODE != 0) {
#pragma unroll
        for (int i = 0; i < 4; ++i) { float s = ssum[i]; s += __shfl_xor(s, 1); s += __shfl_xor(s, 2); s += __shfl_xor(s, 4); s += __shfl_xor(s, 8);
            const int id = 2 * wave; if (id < NT_Y && (lane & 15) == 0) __hip_atomic_fetch_add(&rowss[(id >> 2) * 16 + 4 * (lane >> 4) + i], s, __ATOMIC_RELAXED, __HIP_MEMORY_SCOPE_WORKGROUP); }
        __syncthreads();
        const GAS float* ngp = INP(I_SNG) + l * 512;
        if (2 * wave < NT_Y) {
            float rinv[4];
#pragma unroll
            for (int i = 0; i < 4; ++i) { const int t = ((2 * wave) >> 2) * 16 + 4 * (lane >> 4) + i; rinv[i] = rsq(rowss[t] * (1.f / 512.f) + EPS); }
#pragma unroll 1
            for (int gh = 0; gh < 2; ++gh) { float yv[4][2][4], ngv[4][2];
#pragma unroll
                for (int g4 = 0; g4 < 4; ++g4)
#pragma unroll
                    for (int j = 0; j < 2; ++j) { const int id = 2 * wave + j, ti = id >> 2, pj = id & 3, chn = (gh * 4 + g4) * 64 + pj * 16 + (lane & 15); ngv[g4][j] = ngp[chn];
#pragma unroll
                        for (int i = 0; i < 4; ++i) { const int t = ti * 16 + 4 * (lane >> 4) + i; yv[g4][j][i] = ytmp[(t < L ? t : 0) * 512 + chn]; } }
#pragma unroll
                for (int g4 = 0; g4 < 4; ++g4)
#pragma unroll
                    for (int j = 0; j < 2; ++j) { const int id = 2 * wave + j, ti = id >> 2, pj = id & 3, chn = (gh * 4 + g4) * 64 + pj * 16 + (lane & 15);
#pragma unroll
                        for (int i = 0; i < 4; ++i) { const int t = ti * 16 + 4 * (lane >> 4) + i; if (MODE != 2 || t < L) MIX[(size_t)(m0 + t) * D + 1024 + chn] = tobf(yv[g4][j][i] * rinv[i] * ngv[g4][j]); } } }
        }
    }
    if (MODE == 1) { __syncthreads(); UTE(3); }
    if (MODE == 0 && (u & 63) == 63) for (int e = tid; e < 3 * 1024; e += NTHR) { const int j = e >> 10, c2 = e & 1023; F.out[O_PCONV + ((size_t)(l * BP + b) * 3 + j) * 1024 + c2] = bf2f(PROJ[(size_t)(m0 + 61 + j) * NPROJ + C_CX + c2]); }
    if (MODE == 2) for (int e = tid; e < 3 * 1024; e += NTHR) { const int j = e >> 10, c2 = e & 1023; F.out[O_SCONV + ((size_t)(l * BS + b) * 3 + j) * 1024 + c2] = bf2f(PROJ[(size_t)(m0 + 5 + j) * NPROJ + C_CX + c2]); }
}
template <int MODE> __device__ __forceinline__ void hgrn_unit(Frame& F, int l, int u) {
    WS_LOCALS
    constexpr int T = (MODE == 2) ? 16 : 64, SK = (MODE == 2) ? 32 : 64, L = (MODE == 2) ? 8 : 64, MID = (MODE == 2) ? 3 : 31, LDN = 136, LDS_ = SK + 8, NI = T / 4;
    constexpr int OFF_QT = T * 512, OFF_KT = OFF_QT + T * 272, OFF_KTT = OFF_KT + T * 272, OFF_VT = OFF_KTT + (MODE == 1 ? 0 : 128 * LDS_ * 2), OFF_S0T = OFF_VT + 128 * LDS_ * 2, OFF_AM = OFF_S0T + (MODE == 0 ? 0 : 128 * 272), OFF_END = OFF_AM + T * LDS_ * 2;
    static_assert(OFF_END <= RING_BYTES, "hgrn LDS map");
    const int tid = F.tid, lane = F.lane, wave = F.wave, d = tid & 127, tq = tid >> 7;
    int h, m0; size_t sidx;
    if (MODE == 2) { const int b = u >> 2; h = u & 3; m0 = MP + b * TS; sidx = ((size_t)(l * BS + b) * 4 + h) * 16384; }
    else { const int bh = u >> 6, c = u & 63, b = bh >> 2; h = bh & 3; m0 = b * TP + c * 64; sidx = (size_t)u * 16384; }
    LAS float* cum = (LAS float*)F.lds;
    LAS bf16* qt = (LAS bf16*)(F.lds + OFF_QT);
    LAS bf16* kt = (LAS bf16*)(F.lds + OFF_KT);
    LAS bf16* ktT = (LAS bf16*)(F.lds + OFF_KTT);
    LAS bf16* vT = (LAS bf16*)(F.lds + OFF_VT);
    LAS bf16* S0T = (LAS bf16*)(F.lds + OFF_S0T);
    LAS bf16* Am = (LAS bf16*)(F.lds + OFF_AM);
    LAS float* refv = (LAS float*)(F.lds + RING_BYTES + 2048);
    LAS float* efin = refv + 128; LAS float* decv = efin + 128; LAS float* erefv = decv + 128; LAS float* rowss = erefv + 128;
    const GAS float* S0g = (MODE == 1 ? HGSS : INP(I_SHG)) + sidx;
    __syncthreads();
    float qv[NI], kv[NI], vv[NI];
    {   const float lbv = LBv[l * 512 + h * 128 + d];
#pragma unroll
        for (int i = 0; i < NI; ++i) { const int t = tq + 4 * i; float lf = 0.f, q = 0.f, k = 0.f, v = 0.f;
            { const int tc = t < L ? t : L - 1; const GAS bf16* row = PROJ + (size_t)(m0 + tc) * NPROJ + h * 128 + d; const float fr = bf2f(row[C_AF]), qr = bf2f(row[C_AQ]), v1 = bf2f(row[C_AI]);
                const float e = __expf(-fr); const float sg = 1.f / (1.f + e); const float fg = lbv + (1.f - lbv) * sg;
                const bool ok = t < L; lf = ok ? __logf(fg) : 0.f; k = ok ? (1.f - lbv) * (e / (1.f + e)) : 0.f; q = ok ? qr * sigm(qr) : 0.f; v = ok ? v1 : 0.f; }
            cum[t * 128 + d] = lf; qv[i] = q; kv[i] = k; vv[i] = v; }
        if (tid < 64) rowss[tid] = 0.f;
    }
    __syncthreads();
    if (tid < 128) { float a = 0.f, rf = 0.f;
#pragma unroll 16
        for (int t = 0; t < L; ++t) { a += cum[t * 128 + tid]; cum[t * 128 + tid] = a; if (t == MID) rf = a; }
        refv[tid] = rf; efin[tid] = __expf(a - rf); decv[tid] = __expf(a); erefv[tid] = __expf(rf); }
    __syncthreads();
    {   const float rf = refv[d];
#pragma unroll
        for (int i = 0; i < NI; ++i) { const int t = tq + 4 * i; const float c = (t < L) ? cum[t * 128 + d] : rf;
            const float qs = qv[i] * __expf(fminf(c - rf, 80.f)), ks = kv[i] * __expf(fminf(rf - c, 80.f));
            if (MODE != 0) { qt[t * LDN + d] = tobf(qs); kt[t * LDN + d] = tobf(ks); }
            if (MODE != 1) ktT[d * LDS_ + t] = tobf(ks);
            vT[d * LDS_ + t] = tobf(vv[i]); }
        if (MODE == 2) {
#pragma unroll
            for (int i = 0; i < NI; ++i) { const int t = 16 + tq + 4 * i; ktT[d * LDS_ + t] = 0; vT[d * LDS_ + t] = 0; } }
    }
    if (MODE == 1) for (int e = tid; e < 4096; e += NTHR) { const f32x4 s = ((const GAS f32x4*)S0g)[e]; const int v = e >> 5, d4 = (e & 31) * 4; const f32x4 er = *(const LAS f32x4*)(erefv + d4);
        *(LAS unsigned*)(S0T + v * LDN + d4) = pk2(s.x * er.x, s.y * er.y); *(LAS unsigned*)(S0T + v * LDN + d4 + 2) = pk2(s.z * er.z, s.w * er.w); }
    if (MODE == 2) for (int e = tid; e < 4096; e += NTHR) { const f32x4 s = ((const GAS f32x4*)S0g)[e]; const int dd = e >> 5, v4 = (e & 31) * 4; const float er = erefv[dd];
        S0T[(v4) * LDN + dd] = tobf(s.x * er); S0T[(v4 + 1) * LDN + dd] = tobf(s.y * er); S0T[(v4 + 2) * LDN + dd] = tobf(s.z * er); S0T[(v4 + 3) * LDN + dd] = tobf(s.w * er); }
    __syncthreads();
    if (MODE != 0) {
#pragma unroll
        for (int j = 0; j < 2; ++j) { const int id = 2 * wave + j; if (id < (T / 16) * (SK / 16)) { const int ti = id / (SK / 16), si = id % (SK / 16);
            f32x4 a = (f32x4){0.f, 0.f, 0.f, 0.f};
            if (si <= ti && si < T / 16) a = mma16(qt + ti * 16 * LDN, LDN, kt + si * 16 * LDN, LDN, 128, a, lane);
#pragma unroll
            for (int i = 0; i < 4; ++i) { const int t = ti * 16 + 4 * (lane >> 4) + i, s = si * 16 + (lane & 15); Am[t * LDS_ + s] = tobf((s <= t && si <= ti && si < T / 16) ? a[i] : 0.f); } } }
        __syncthreads();
        f32x4 o[4]; float ssum[4] = {0.f, 0.f, 0.f, 0.f};
#pragma unroll
        for (int j = 0; j < 4; ++j) { const int id = 4 * wave + j; o[j] = (f32x4){0.f, 0.f, 0.f, 0.f};
            if (id < (T / 16) * 8) { const int ti = id >> 3, vj = id & 7;
                o[j] = mma16(Am + ti * 16 * LDS_, LDS_, vT + vj * 16 * LDS_, LDS_, SK, o[j], lane);
                o[j] = mma16(qt + ti * 16 * LDN, LDN, S0T + vj * 16 * LDN, LDN, 128, o[j], lane);
#pragma unroll
                for (int i = 0; i < 4; ++i) ssum[i] += o[j][i] * o[j][i]; } }
        if (4 * wave < (T / 16) * 8) {
#pragma unroll
            for (int i = 0; i < 4; ++i) { float s = ssum[i]; s += __shfl_xor(s, 1); s += __shfl_xor(s, 2); s += __shfl_xor(s, 4); s += __shfl_xor(s, 8);
                if ((lane & 15) == 0) __hip_atomic_fetch_add(&rowss[((4 * wave) >> 3) * 16 + 4 * (lane >> 4) + i], s, __ATOMIC_RELAXED, __HIP_MEMORY_SCOPE_WORKGROUP); } }
        __syncthreads();
        const GAS float* ngp = INP(I_HNG) + l * 512 + h * 128;
        float grv[4][4], ngv[4];
#pragma unroll
        for (int j = 0; j < 4; ++j) { const int id = 4 * wave + j, ti = (id >> 3) & (T / 16 - 1), vj = id & 7, v = vj * 16 + (lane & 15); ngv[j] = ngp[v];
#pragma unroll
            for (int i = 0; i < 4; ++i) { const int t = ti * 16 + 4 * (lane >> 4) + i; const int tc = t < L ? t : L - 1; grv[j][i] = bf2f(PROJ[(size_t)(m0 + tc) * NPROJ + C_AG + h * 128 + v]); } }
#pragma unroll
        for (int j = 0; j < 4; ++j) { const int id = 4 * wave + j; if (id < (T / 16) * 8) { const int ti = id >> 3, vj = id & 7, v = vj * 16 + (lane & 15);
#pragma unroll
            for (int i = 0; i < 4; ++i) { const int t = ti * 16 + 4 * (lane >> 4) + i;
                if (MODE != 2 || t < L) MIX[(size_t)(m0 + t) * D + h * 128 + v] = tobf(o[j][i] * rsq(rowss[t] * (1.f / 128.f) + EPS) * ngv[j] * sigm(grv[j][i])); } } }
    }
    if (MODE != 1) {
        float sv[8][4];
        if (MODE == 2) {
#pragma unroll
            for (int j = 0; j < 8; ++j)
#pragma unroll
                for (int i = 0; i < 4; ++i) sv[j][i] = S0g[(wave * 16 + 4 * (lane >> 4) + i) * 128 + j * 16 + (lane & 15)]; }
#pragma unroll
        for (int j = 0; j < 8; ++j) { f32x4 a = (f32x4){0.f, 0.f, 0.f, 0.f}; a = mma16(ktT + wave * 16 * LDS_, LDS_, vT + j * 16 * LDS_, LDS_, SK, a, lane);
            const int v = j * 16 + (lane & 15);
            if (MODE == 0) { const int d0 = wave * 16 + 4 * (lane >> 4); const f32x4 ef = *(const LAS f32x4*)(efin + d0);
                *(GAS f32x4*)(HGDS + sidx + v * 128 + d0) = (f32x4){ef.x * a[0], ef.y * a[1], ef.z * a[2], ef.w * a[3]}; }
            else {
#pragma unroll
                for (int i = 0; i < 4; ++i) { const int dd = wave * 16 + 4 * (lane >> 4) + i; F.out[O_SHG + sidx + dd * 128 + v] = decv[dd] * sv[j][i] + efin[dd] * a[i]; } } }
        if (MODE == 0 && tid < 128) HGDEC[u * 128 + tid] = decv[tid];
    }
}
__device__ __forceinline__ void scan_phase(Frame& F, int l) {
    WS_LOCALS
    const int gt = blockIdx.x * NTHR + F.tid, NT = F.G * NTHR;
    for (int e = gt; e < 131072; e += NT) {
        const int bh = e >> 14, vd = e & 16383, d = vd & 127, v = vd >> 7; const int bhh = e >> 13, b = bhh >> 3, hh = bhh & 7, pn = e & 8191;
        float Sh = 0.f, Ss = 0.f;
#pragma unroll 1
        for (int c0 = 0; c0 < 64; c0 += 8) { float dh[8], xh[8], ds[8], xs[8];
#pragma unroll
            for (int k = 0; k < 8; ++k) { const size_t u = (size_t)bh * 64 + c0 + k; const size_t idx = (size_t)(b * 64 + c0 + k) * 8 + hh; dh[k] = HGDEC[u * 128 + d]; xh[k] = HGDS[u * 16384 + vd]; ds[k] = SDDEC[idx]; xs[k] = SDDS[idx * 8192 + pn]; }
#pragma unroll
            for (int k = 0; k < 8; ++k) { const size_t u = (size_t)bh * 64 + c0 + k; const size_t idx = (size_t)(b * 64 + c0 + k) * 8 + hh;
                HGSS[u * 16384 + vd] = Sh; SDSS[idx * 8192 + pn] = Ss; Sh = dh[k] * Sh + xh[k]; Ss = ds[k] * Ss + xs[k]; } }
        F.out[O_PHG + ((size_t)l * 8 + bh) * 16384 + d * 128 + v] = Sh; F.out[O_PSSM + ((size_t)(l * BP + b) * 8 + hh) * 8192 + pn] = Ss; }
}
__device__ __forceinline__ float sq8(v4u w) { const float a0 = bflo(w.x), a1 = bfhi(w.x), a2 = bflo(w.y), a3 = bfhi(w.y), a4 = bflo(w.z), a5 = bfhi(w.z), a6 = bflo(w.w), a7 = bfhi(w.w);
    return ((a0 * a0 + a1 * a1) + (a2 * a2 + a3 * a3)) + ((a4 * a4 + a5 * a5) + (a6 * a6 + a7 * a7)); }
__device__ __forceinline__ float rope1(float x, float rn, float g, float c, float s, int dh) { const float xn = x * rn * g; const float other = __shfl_xor(xn, 1); return dh == 0 ? xn * c - other * s : xn * c + other * s; }
__device__ __forceinline__ v4u rope8(v4u w, float rn, const GAS float* g, const GAS float* rp, int dh) {
    v4u o;
    o.x = pk2(rope1(bflo(w.x), rn, g[0], rp[0], rp[32], dh), rope1(bfhi(w.x), rn, g[1], rp[1], rp[33], dh));
    o.y = pk2(rope1(bflo(w.y), rn, g[2], rp[2], rp[34], dh), rope1(bfhi(w.y), rn, g[3], rp[3], rp[35], dh));
    o.z = pk2(rope1(bflo(w.z), rn, g[4], rp[4], rp[36], dh), rope1(bfhi(w.z), rn, g[5], rp[5], rp[37], dh));
    o.w = pk2(rope1(bflo(w.w), rn, g[6], rp[6], rp[38], dh), rope1(bfhi(w.w), rn, g[7], rp[7], rp[39], dh));
    return o;
}
template <int SAMPLE> __device__ __forceinline__ void attn_unit(Frame& F, int l, int u) {
    WS_LOCALS
    constexpr int LDK = 72, LDV = 200, LDPW = 168;
    const int tid = F.tid, lane = F.lane, wave = F.wave;
    const GAS float* const ckp = INP(I_CK); const GAS float* const cvp = INP(I_CV);
    LAS bf16* Kb = (LAS bf16*)F.lds; LAS bf16* VT = Kb + 192 * LDK; LAS bf16* Qs = VT + 64 * LDV; LAS bf16* Pw = Qs + wave * 16 * LDPW;
    int b, g, q0, row_min; size_t mbase;
    if (SAMPLE) { b = u >> 1; g = u & 1; q0 = 0; row_min = 0; mbase = (size_t)MP + b * TS; }
    else { g = u & 1; const int qt = (u >> 1) & 63; b = u >> 7; q0 = qt * 64; row_min = q0 >= 127 ? 0 : 127 - q0; mbase = (size_t)b * TP; }
    __syncthreads();
    {   const int j8 = tid & 7; const GAS float* kg = INP(I_KNG) + l * 64 + 8 * j8;
        float kgv[8];
#pragma unroll
        for (int e = 0; e < 8; ++e) kgv[e] = kg[e];
        GAS float* const okp = F.out + (SAMPLE ? O_SK : O_PK); GAS float* const ovp = F.out + (SAMPLE ? O_SV : O_PV);
        const size_t ob = SAMPLE ? ((size_t)(l * BS + b) * 128) : ((size_t)(l * BP + b) * 128);
        const int roff = SAMPLE ? 8 : 63; const bool wr_cache = SAMPLE || q0 == TP - 64;
        for (int row = tid >> 3; row < 192; row += 64) {
            float ko[8], vo[8]; bool zero = false;
            if (SAMPLE && row < 128) { const GAS f32x4* kp = (const GAS f32x4*)(ckp + (((size_t)(l * BS + b) * 128 + row) * 2 + g) * 64 + 8 * j8); const GAS f32x4* vp = (const GAS f32x4*)(cvp + (((size_t)(l * BS + b) * 128 + row) * 2 + g) * 64 + 8 * j8);
                const f32x4 k0 = kp[0], k1 = kp[1], v0 = vp[0], v1 = vp[1];
                ko[0] = k0.x; ko[1] = k0.y; ko[2] = k0.z; ko[3] = k0.w; ko[4] = k1.x; ko[5] = k1.y; ko[6] = k1.z; ko[7] = k1.w; vo[0] = v0.x; vo[1] = v0.y; vo[2] = v0.z; vo[3] = v0.w; vo[4] = v1.x; vo[5] = v1.y; vo[6] = v1.z; vo[7] = v1.w; }
            else {
                int t, prow;
                if (SAMPLE) { t = row - 128; prow = 4096 + t; if (row >= 136) zero = true; } else { t = q0 - 127 + row; prow = t; if (t < 0 || row == 191) zero = true; }
                if (zero) {
#pragma unroll
                    for (int e = 0; e < 8; ++e) { ko[e] = 0.f; vo[e] = 0.f; } }
                else {
                    const GAS bf16* pr = PROJ + (mbase + t) * NPROJ;
                    const v4u kw = *(const GAS v4u*)(pr + C_DK + g * 64 + 8 * j8); const v4u vw = *(const GAS v4u*)(pr + C_DV + g * 64 + 8 * j8);
                    float kr[8] = {bflo(kw.x), bfhi(kw.x), bflo(kw.y), bfhi(kw.y), bflo(kw.z), bfhi(kw.z), bflo(kw.w), bfhi(kw.w)};
                    vo[0] = bflo(vw.x); vo[1] = bfhi(vw.x); vo[2] = bflo(vw.y); vo[3] = bfhi(vw.y); vo[4] = bflo(vw.z); vo[5] = bfhi(vw.z); vo[6] = bflo(vw.w); vo[7] = bfhi(vw.w);
                    float ss = 0.f;
#pragma unroll
                    for (int e = 0; e < 8; ++e) ss += kr[e] * kr[e];
                    ss += __shfl_xor(ss, 1); ss += __shfl_xor(ss, 2); ss += __shfl_xor(ss, 4);
                    const float rn = 1.f / sqrtf(ss * (1.f / 64.f) + EPS);
                    const GAS float* rp = ROPE + (size_t)prow * 64 + ((8 * j8) & 31);
#pragma unroll
                    for (int e = 0; e < 8; ++e) { const float kn = kr[e] * rn * kgv[e]; const float other = __shfl_xor(kn, 4); const float c = rp[e], s = rp[32 + e];
                        ko[e] = j8 < 4 ? kn * c - other * s : kn * c + other * s; }
                }
            }
            v4u kp4; kp4.x = pk2(ko[0], ko[1]); kp4.y = pk2(ko[2], ko[3]); kp4.z = pk2(ko[4], ko[5]); kp4.w = pk2(ko[6], ko[7]);
            *(LAS v4u*)(Kb + row * LDK + 8 * j8) = kp4;
#pragma unroll
            for (int e = 0; e < 8; ++e) VT[(8 * j8 + e) * LDV + row] = tobf(vo[e]);
            if (wr_cache && row >= roff && row < roff + 128) { const size_t o = ((ob + (row - roff)) * 2 + g) * 64 + 8 * j8;
                *(GAS f32x4*)(okp + o) = (f32x4){ko[0], ko[1], ko[2], ko[3]}; *(GAS f32x4*)(okp + o + 4) = (f32x4){ko[4], ko[5], ko[6], ko[7]};
                *(GAS f32x4*)(ovp + o) = (f32x4){vo[0], vo[1], vo[2], vo[3]}; *(GAS f32x4*)(ovp + o + 4) = (f32x4){vo[4], vo[5], vo[6], vo[7]}; }
        }
    }
    const bool qwave = !SAMPLE || wave == 0;
    if (qwave) {
        const int dh = lane & 1, qi = (lane >> 1) & 7, r = lane >> 4, head = g * 4 + r;
        const int t = SAMPLE ? qi : q0 + 8 * wave + qi; const int prow = SAMPLE ? 4096 + t : t;
        const GAS v4u* qp = (const GAS v4u*)(PROJ + (mbase + t) * NPROJ + C_DQ + head * 64 + 32 * dh);
        const v4u w0 = qp[0], w1 = qp[1], w2 = qp[2], w3 = qp[3];
        float ss = sq8(w0) + sq8(w1) + sq8(w2) + sq8(w3);
        ss += __shfl_xor(ss, 1);
        const float rn = 0.125f / sqrtf(ss * (1.f / 64.f) + EPS);
        const GAS float* qg = INP(I_QNG) + l * 64 + 32 * dh; const GAS float* rp = ROPE + (size_t)prow * 64;
        LAS v4u* qd = (LAS v4u*)(Qs + (32 * wave + 16 * (r >> 1) + 8 * (r & 1) + qi) * LDK + 32 * dh);
        qd[0] = rope8(w0, rn, qg, rp, dh); qd[1] = rope8(w1, rn, qg + 8, rp + 8, dh); qd[2] = rope8(w2, rn, qg + 16, rp + 16, dh); qd[3] = rope8(w3, rn, qg + 24, rp + 24, dh);
    }
    __syncthreads();
    bf16x8v qf[2][2];
    if (qwave) {
#pragma unroll
        for (int rt = 0; rt < 2; ++rt)
#pragma unroll
            for (int ks = 0; ks < 2; ++ks) qf[rt][ks] = *(const LAS bf16x8v*)(Qs + (32 * wave + 16 * rt + (lane & 15)) * LDK + 32 * ks + 8 * (lane >> 4));
    }
    __syncthreads();
    if (qwave) {
        const int ks0 = SAMPLE ? 0 : (8 * wave < 32 ? 8 * wave : 32);
        const GAS float* skp = INP(I_SINK) + l * 8 + g * 4;
#pragma unroll
        for (int rt = 0; rt < 2; ++rt) {
            f32x4 sc[10]; int kl = ks0 + (lane & 15); asm volatile("" : "+v"(kl));
#pragma unroll
            for (int c = 0; c < 10; ++c) { sc[c] = (f32x4){0.f, 0.f, 0.f, 0.f}; const LAS bf16* kp = Kb + (ks0 + 16 * c + (lane & 15)) * LDK + 8 * (lane >> 4);
                sc[c] = __builtin_amdgcn_mfma_f32_16x16x32_bf16(qf[rt][0], *(const LAS bf16x8v*)kp, sc[c], 0, 0, 0);
                sc[c] = __builtin_amdgcn_mfma_f32_16x16x32_bf16(qf[rt][1], *(const LAS bf16x8v*)(kp + 32), sc[c], 0, 0, 0); }
            float mx[4], sm[4], sinkv[4]; int klo[4]; unsigned span[4];
#pragma unroll
            for (int i = 0; i < 4; ++i) { const int row = 4 * (lane >> 4) + i, qi = row & 7; const int qrow = SAMPLE ? 128 + qi : 127 + 8 * wave + qi;
                sinkv[i] = skp[2 * rt + (row >> 3)]; mx[i] = sinkv[i]; sm[i] = 0.f;
                klo[i] = (qrow - 127) > row_min ? (qrow - 127) : row_min; span[i] = (unsigned)(qrow - klo[i]); }
#pragma unroll
            for (int c = 0; c < 10; ++c) { const int kr = kl + 16 * c;
#pragma unroll
                for (int i = 0; i < 4; ++i) { const float sv = ((unsigned)(kr - klo[i]) <= span[i]) ? sc[c][i] : -INFINITY; sc[c][i] = sv; mx[i] = fmaxf(mx[i], sv); } }
#pragma unroll
            for (int i = 0; i < 4; ++i) { float m = mx[i]; m = fmaxf(m, __shfl_xor(m, 1)); m = fmaxf(m, __shfl_xor(m, 2)); m = fmaxf(m, __shfl_xor(m, 4)); m = fmaxf(m, __shfl_xor(m, 8)); mx[i] = m; }
#pragma unroll
            for (int c = 0; c < 10; ++c) {
#pragma unroll
                for (int i = 0; i < 4; ++i) { const float p = __expf(sc[c][i] - mx[i]); sm[i] += p; Pw[(4 * (lane >> 4) + i) * LDPW + 16 * c + (lane & 15)] = tobf(p); } }
#pragma unroll
            for (int i = 0; i < 4; ++i) { float a = sm[i]; a += __shfl_xor(a, 1); a += __shfl_xor(a, 2); a += __shfl_xor(a, 4); a += __shfl_xor(a, 8); sm[i] = a + __expf(sinkv[i] - mx[i]); }
            asm volatile("s_waitcnt lgkmcnt(0)" ::: "memory");
#pragma unroll
            for (int dj = 0; dj < 4; ++dj) { f32x4 o = (f32x4){0.f, 0.f, 0.f, 0.f};
                o = mma16(Pw, LDPW, VT + dj * 16 * LDV + ks0, LDV, 160, o, lane);
#pragma unroll
                for (int i = 0; i < 4; ++i) { const int row = 4 * (lane >> 4) + i, qi = row & 7, head = g * 4 + 2 * rt + (row >> 3); const int t = SAMPLE ? qi : q0 + 8 * wave + qi;
                    MIX[(mbase + t) * D + 1536 + head * 64 + dj * 16 + (lane & 15)] = tobf(o[i] / sm[i]); } }
            asm volatile("s_waitcnt lgkmcnt(0)" ::: "memory");
        }
    }
}
template <int WIN> __device__ __forceinline__ void pool_rows_prompt(const GAS bf16* base, int ta, LAS bf16* pl, int LDP) {
    unsigned rw[47];
#pragma unroll
    for (int i = 0; i < 47; ++i) { const int t = ta - 15 + i; rw[i] = *(const GAS unsigned*)(base + (size_t)(t >= 0 ? t : 0) * NPROJ); if (t < 0) rw[i] = 0u; }
    float s0 = 0.f, s1 = 0.f;
#pragma unroll
    for (int j = 1; j < WIN; ++j) { s0 += bflo(rw[15 - j]); s1 += bfhi(rw[15 - j]); }
#pragma unroll
    for (int i = 0; i < 32; ++i) { const int t = ta + i; const float a0 = bflo(rw[15 + i]), a1 = bfhi(rw[15 + i]); s0 += a0; s1 += a1;
        const float ic = __builtin_amdgcn_rcpf((float)((t + 1) < WIN ? (t + 1) : WIN));
        *(LAS unsigned*)(pl + i * LDP) = pk2(s0 * ic - a0, s1 * ic - a1);
        s0 -= bflo(rw[15 + i - WIN + 1]); s1 -= bfhi(rw[15 + i - WIN + 1]); }
}
template <int WIN> __device__ __forceinline__ void pool_rows_sample(const GAS bf16* base, const GAS float* buf, LAS bf16* pl, int LDP) {
    float e0[23], e1[23];
#pragma unroll
    for (int i = 0; i < 15; ++i) { e0[i] = buf[(size_t)i * 512]; e1[i] = buf[(size_t)i * 512 + 1]; }
#pragma unroll
    for (int i = 0; i < 8; ++i) { const unsigned w = *(const GAS unsigned*)(base + (size_t)i * NPROJ); e0[15 + i] = bflo(w); e1[15 + i] = bfhi(w); }
    float s0 = 0.f, s1 = 0.f;
#pragma unroll
    for (int j = 1; j < WIN; ++j) { s0 += e0[15 - j]; s1 += e1[15 - j]; }
#pragma unroll
    for (int i = 0; i < 8; ++i) { s0 += e0[15 + i]; s1 += e1[15 + i];
        *(LAS unsigned*)(pl + i * LDP) = pk2(s0 * (1.f / WIN) - e0[15 + i], s1 * (1.f / WIN) - e1[15 + i]);
        s0 -= e0[15 + i - WIN + 1]; s1 -= e1[15 + i - WIN + 1]; }
}
__device__ __forceinline__ void pool_unit(Frame& F, int l, int u) {
    WS_LOCALS
    const int tid = F.tid, lane = F.lane, wave = F.wave;
    const GAS float* const spp = INP(I_SPOOL);
    LAS bf16* pl = (LAS bf16*)F.lds; constexpr int LDP = 520;
    const bool samp = u >= 128; const int b = samp ? 0 : (u >> 6), t0 = samp ? 0 : (u & 63) * 64; const int s8 = samp ? (u - 128) * 8 : 0;
    const size_t m0 = samp ? (size_t)MP + (size_t)s8 * TS : (size_t)b * TP + t0;
    __syncthreads();
    {   const int pr = tid & 255, half = tid >> 8, c0 = 2 * pr, gi = (wave & 3);
        if (!samp) { const GAS bf16* base = PROJ + ((size_t)b * TP) * NPROJ + C_PU + c0; LAS bf16* pp = pl + (half * 32) * LDP + c0; const int ta = t0 + half * 32;
            if (gi == 0) pool_rows_prompt<2>(base, ta, pp, LDP); else if (gi == 1) pool_rows_prompt<4>(base, ta, pp, LDP); else if (gi == 2) pool_rows_prompt<8>(base, ta, pp, LDP); else pool_rows_prompt<16>(base, ta, pp, LDP); }
        else {
#pragma unroll 1
            for (int q = 0; q < 4; ++q) { const int bq = half * 4 + q, bs = s8 + bq; const GAS bf16* base = PROJ + ((size_t)MP + (size_t)bs * TS) * NPROJ + C_PU + c0; const GAS float* buf = spp + ((size_t)(l * BS + bs) * 15) * 512 + c0; LAS bf16* pp = pl + (bq * 8) * LDP + c0;
                if (gi == 0) pool_rows_sample<2>(base, buf, pp, LDP); else if (gi == 1) pool_rows_sample<4>(base, buf, pp, LDP); else if (gi == 2) pool_rows_sample<8>(base, buf, pp, LDP); else pool_rows_sample<16>(base, buf, pp, LDP); } }
    }
    __syncthreads();
    {   const int g = wave >> 1; const GAS float* scp = INP(I_PSC) + l * 512 + g * 128;
        const GAS bf16* wpt = (const GAS bf16*)wsp(F, WS_WPT) + (size_t)(l * 4 + g) * 16384;
#pragma unroll 1
        for (int jj = 0; jj < 4; ++jj) { const int vj = 4 * (wave & 1) + jj;
            bf16x8v bfr[4];
#pragma unroll
            for (int k = 0; k < 4; ++k) bfr[k] = *(const GAS bf16x8v*)(wpt + (size_t)(vj * 16 + (lane & 15)) * 128 + k * 32 + 8 * (lane >> 4));
            const int dd = vj * 16 + (lane & 15); const float sc = scp[dd];
#pragma unroll
            for (int ti = 0; ti < 4; ++ti) { f32x4 acc = (f32x4){0.f, 0.f, 0.f, 0.f};
                const LAS bf16* ap = pl + (ti * 16 + (lane & 15)) * LDP + g * 128 + 8 * (lane >> 4);
#pragma unroll
                for (int k = 0; k < 4; ++k) acc = __builtin_amdgcn_mfma_f32_16x16x32_bf16(*(const LAS bf16x8v*)(ap + k * 32), bfr[k], acc, 0, 0, 0);
#pragma unroll
                for (int i = 0; i < 4; ++i) MIX[(m0 + ti * 16 + 4 * (lane >> 4) + i) * D + 512 + g * 128 + dd] = tobf(acc[i] * sc); } }
    }
    if (!samp && t0 == TP - 64) {
        float tv[15];
#pragma unroll
        for (int j = 0; j < 15; ++j) tv[j] = bf2f(PROJ[((size_t)b * TP + TP - 15 + j) * NPROJ + C_PU + tid]);
#pragma unroll
        for (int j = 0; j < 15; ++j) F.out[O_PPOOL + ((size_t)(l * BP + b) * 15 + j) * 512 + tid] = tv[j]; }
    if (samp) {
#pragma unroll 1
        for (int q = 0; q < 8; ++q) { const int bs = s8 + q; float tv[15];
#pragma unroll
            for (int j = 0; j < 15; ++j) tv[j] = j < 7 ? spp[((size_t)(l * BS + bs) * 15 + 8 + j) * 512 + tid] : bf2f(PROJ[((size_t)MP + (size_t)bs * TS + (j - 7)) * NPROJ + C_PU + tid]);
#pragma unroll
            for (int j = 0; j < 15; ++j) F.out[O_SPOOL + ((size_t)(l * BS + bs) * 15 + j) * 512 + tid] = tv[j]; } }
}
#ifndef TIME_MASK
#define TIME_MASK 0
#endif
#ifndef TIME_BLOCK
#define TIME_BLOCK 0
#endif
#define TSTART(bit) do { if ((TIME_MASK >> (bit)) & 1) tph = __builtin_amdgcn_s_memrealtime(); } while (0)
#define TSTOP(bit) do { if ((TIME_MASK >> (bit)) & 1) tacc += __builtin_amdgcn_s_memrealtime() - tph; } while (0)
#ifndef PROBE_MASK
#define PROBE_MASK 0
#endif
#ifndef PROBE_DUP
#define PROBE_DUP 0
#endif
#ifdef PH_SEL
#define PSEL(k, stmt) do { if ((k) == PH_SEL) { stmt; } } while (0)
#else
#define PSEL(k, stmt) do { stmt; } while (0)
#endif
struct Args { const float* in[N_IN]; float* out; unsigned char* ws; int ph_lo, ph_hi; };
static_assert(sizeof(Args) == (N_IN + 2) * 8 + 8, "Args has no padding");
__global__ void __launch_bounds__(NTHR, 2) hymba_fwd(Args args) {
    extern __shared__ __attribute__((aligned(16))) unsigned char lds[];
    Frame F;
    F.lds = (LAS unsigned char*)lds;
    F.MISC = (volatile LAS unsigned*)(F.lds + MISC_OFF);
    F.tid = threadIdx.x; F.lane = F.tid & 63; F.wave = __builtin_amdgcn_readfirstlane(F.tid >> 6);
    F.G = gridDim.x; F.gw = (int)blockIdx.x * NWAVES + F.wave; F.ngw = F.G * NWAVES;
    GAS unsigned char* ws = (GAS unsigned char*)args.ws; F.ws = ws; F.out = (GAS float*)args.out;
    F.ctl = (gu32*)(ws + WS_CTL);
    for (int u = F.tid; u < (LDS_BYTES - LDSCTL_OFF) / 4; u += NTHR) ((LAS unsigned*)(F.lds + LDSCTL_OFF))[u] = 0u;
    __syncthreads();
    if (F.tid < N_IN) ((LAS unsigned long long*)(F.lds + PTR_OFF))[F.tid] = (unsigned long long)args.in[F.tid];
    __syncthreads();
    const int lo = args.ph_lo, hi = args.ph_hi;
    XcdBarrier bar; bar.bar = (unsigned*)(F.ctl + CW_BAR); bar.x = 0; bar.st = nullptr;
    if (hi - lo > 1) bar = xcd_barrier_post((unsigned*)(F.ctl + CW_BAR), F.MISC + 8);
#define IN(k) (lo <= (k) && (k) < hi)
#define LAUNDER(P) asm volatile("" : "+v"(P.tid), "+v"(P.lane), "+s"(P.wave), "+s"(P.gw))
#define UL_DYN(bit, q, n, k, call) do { const int nrep_ = ((PROBE_MASK >> (bit)) & 1) ? 2 : 1; int nr_ = nrep_; asm volatile("" : "+s"(nr_)); for (int rr = 0; rr < nr_; ++rr) { Frame Q = F; LAUNDER(Q); while ((u = deq(Q, l * 32 + 16 * rr + (q))) < (n)) PSEL(k, call); } } while (0)
#define UL(bit, off, n, k, call) do { const int nrep_ = ((PROBE_MASK >> (bit)) & 1) ? 2 : 1; int nr_ = nrep_; asm volatile("" : "+s"(nr_)); for (int rr = 0; rr < nr_; ++rr) { Frame Q = F; LAUNDER(Q); for (u = ((int)blockIdx.x + F.G - ((off) % F.G)) % F.G; u < (n); u += F.G) { __syncthreads(); PSEL(k, call); } } } while (0)
#define PHASE_LOCALS Frame P = F; LAUNDER(P); WS_LOCALS
#define SEAM(k) do { if (IN(k) && IN((k) + 1)) xcd_barrier(bar); } while (0)
    unsigned long long tacc = 0, tph = 0; (void)tph;
    int rp_pro = (PROBE_DUP == 1) ? 2 : 1, rp_mix = (PROBE_DUP == 2) ? 2 : 1, rp_up = (PROBE_DUP == 3) ? 2 : 1, rp_in = (PROBE_DUP == 4) ? 2 : 1; asm volatile("" : "+s"(rp_pro), "+s"(rp_mix), "+s"(rp_up), "+s"(rp_in));
    TSTART(0); for (int rp = 0; rp < rp_pro; ++rp) { if (IN(0)) { PSEL(0, p0_prologue(F)); } SEAM(0); } TSTOP(0);
    for (int l = 0; l < DEPTH; ++l) {
        const int pb = 1 + l * PH_PER_LAYER;

        TSTART(1); if (IN(pb + 0)) { PHASE_LOCALS  PSEL(1, norm_phase(P, l, 0, l > 0 ? NSL_DN : 0)); } SEAM(pb + 0); TSTOP(1);
        for (int rq = 0; rq < rp_in; ++rq) {
        TSTART(2); if (IN(pb + 1)) { PHASE_LOCALS
            pg8::Gemm g{H, Wi + (size_t)l * NPROJ * D, M, NPROJ, D}; pg8::StaticOrder S; S.init(M, NPROJ, D, F.G, (int)blockIdx.x);
            pg8::EpiStoreBf16 E{PROJ, NPROJ, 0};
            PSEL(2, (pg8::gemm_phase<pg8::EpiStoreBf16, pg8::StaticOrder, true, true>(P.lds, g, S, E)));
            if (l + 1 < DEPTH && F.G == 256) convert_layer(P, l + 1, 115, 141, 0, 560);
            else if (l + 1 < DEPTH) convert_layer(P, l + 1, 0, F.G, 0, 560);
        } SEAM(pb + 1); TSTOP(2);
        }
        for (int rp = 0; rp < rp_mix; ++rp) {
        TSTART(3); if (IN(pb + 2)) { PHASE_LOCALS
            int u;
            TSTART(11); UL(3, 0, 128, 3, ssd_unit<0>(Q, l, u)); TSTOP(11);
            TSTART(12); UL(1, 0, 256, 4, attn_unit<0>(Q, l, u)); TSTOP(12);
            TSTART(13); UL(7, 0, 512, 5, hgrn_unit<0>(Q, l, u)); TSTOP(13);
            TSTART(14); UL(2, 128, 132, 6, pool_unit(Q, l, u)); TSTOP(14);
            TSTART(15); UL(3, 128, 32, 7, ssd_unit<2>(Q, l, u)); TSTOP(15);
            TSTART(16); UL(1, 160, 64, 8, attn_unit<1>(Q, l, u)); TSTOP(16);
            TSTART(17); UL(3, 0, 128, 9, hgrn_unit<2>(Q, l, u)); TSTOP(17);
        } SEAM(pb + 2); TSTOP(3);
        TSTART(4); if (IN(pb + 3)) { PHASE_LOCALS  { int nr_ = ((PROBE_MASK >> 4) & 1) ? 2 : 1; asm volatile("" : "+s"(nr_)); for (int rr = 0; rr < nr_; ++rr) PSEL(10, scan_phase(P, l)); } } SEAM(pb + 3); TSTOP(4);
        TSTART(5); if (IN(pb + 4)) { PHASE_LOCALS
            int u;
            TSTART(18); UL(5, 0, 128, 11, ssd_unit<1>(Q, l, u)); TSTOP(18);
            TSTART(19); { Frame Q = F; LAUNDER(Q); const int bx = (int)blockIdx.x; if (F.G == 256) { if (bx < 128) { __syncthreads(); hgrn_unit<1>(Q, l, 384 + bx); } else { for (u = bx - 128; u < 384; u += 128) { __syncthreads(); hgrn_unit<1>(Q, l, u); } } } else { for (u = bx; u < 512; u += F.G) { __syncthreads(); hgrn_unit<1>(Q, l, u); } } } TSTOP(19);
            {
                __syncthreads();
                pg8::Gemm g{MIX, Wo + (size_t)l * D * D, M, D, D}; pg8::SliceOrder S; S.init(MP / 256, D, D, NSL_OUT, 64, (int)blockIdx.x - 128);
                pg8::EpiGateRes E{F.out, D, MOD + (size_t)l * NBB * NMOD + 2 * D, NMOD, (GAS float*)wsp(F, WS_PART), (l == 0 ? INP(I_XP) : (const GAS float*)F.out)};
                pg8::gemm_phase<pg8::EpiGateRes, pg8::SliceOrder, true, true>(P.lds, g, S, E); }
        } SEAM(pb + 4); TSTOP(5);
        }
        TSTART(6); if (IN(pb + 5)) { PHASE_LOCALS
            pg8::Gemm g{MIX, Wo + (size_t)l * D * D, M, D, D}; pg8::StaticOrder S; S.init(MP, D, D, F.G, (int)blockIdx.x);
            pg8::EpiGateRes E{F.out, D, MOD + (size_t)l * NBB * NMOD + 2 * D, NMOD, (GAS float*)wsp(F, WS_PART), (l == 0 ? INP(I_XP) : (const GAS float*)F.out)};
            PSEL(13, (pg8::gemm_phase<pg8::EpiGateRes, pg8::StaticOrder, true, true>(P.lds, g, S, E)));
        } SEAM(pb + 5); TSTOP(6);
        TSTART(7); if (IN(pb + 6)) { PHASE_LOCALS  PSEL(14, norm_phase(P, l, 1, NSL_OUT)); } SEAM(pb + 6); TSTOP(7);
        for (int rp = 0; rp < rp_up; ++rp) {
        TSTART(8); if (IN(pb + 7)) { PHASE_LOCALS
            pg8::Gemm g{H, Wu + (size_t)l * DFF * D, M, DFF, D}; pg8::StaticOrder S; S.init(M, DFF, D, F.G, (int)blockIdx.x);
            pg8::EpiStoreBf16 E{U, LDU, 1};
            PSEL(15, (pg8::gemm_phase<pg8::EpiStoreBf16, pg8::StaticOrder, true, true>(P.lds, g, S, E)));
            if (l + 1 < DEPTH) convert_layer(P, l + 1, 32, F.G - 32, 560, 1 << 30);
        } SEAM(pb + 7); TSTOP(8);
        }
        TSTART(9); if (IN(pb + 8)) { PHASE_LOCALS
            pg8::Gemm g{U, Wd + (size_t)l * D * LDU, M, D, LDU}; pg8::SplitOrder S; S.init(MP, D, DFF, NSL_DN, F.G, (int)blockIdx.x);
            pg8::EpiGateRes E{F.out, D, MOD + (size_t)l * NBB * NMOD + 5 * D, NMOD, (GAS float*)wsp(F, WS_PART), (const GAS float*)F.out};
            PSEL(16, (pg8::gemm_phase<pg8::EpiGateRes, pg8::SplitOrder, true, true>(P.lds, g, S, E)));
        } SEAM(pb + 8); TSTOP(9);
    }
    TSTART(10); if (IN(N_PHASES - 1)) { Frame P = F; LAUNDER(P); final_fix_phase(P, NSL_DN); } TSTOP(10);
    if (UT_MASK != 0) tacc += ((unsigned long long)F.MISC[17] << 32) | F.MISC[16];
    if ((TIME_MASK != 0 || UT_MASK != 0) && blockIdx.x == TIME_BLOCK) { const unsigned long long te = __builtin_amdgcn_s_memrealtime() + tacc; while (__builtin_amdgcn_s_memrealtime() < te) __builtin_amdgcn_s_sleep(8); }
#undef IN
#undef SEAM
}

extern "C" void kernel_launch(void* const* d_in, const int* in_sizes, int n_in, void* d_out, int out_size, void* d_ws, size_t ws_size, hipStream_t stream) {
    static int grid = 0;
    if (grid == 0) {
        if (n_in != N_IN || (size_t)out_size != O_END || ws_size < WS_END) { fprintf(stderr, "kernel_launch: unexpected shapes (n_in %d, out %d, ws %zu); nothing launched\n", n_in, out_size, ws_size); grid = -1; return; }
        int dev = 0, cus = 0, per_cu = 0;
        if (hipGetDevice(&dev) != hipSuccess || hipDeviceGetAttribute(&cus, hipDeviceAttributeMultiprocessorCount, dev) != hipSuccess) { grid = -1; return; }
        if (hipFuncSetAttribute((const void*)hymba_fwd, hipFuncAttributeMaxDynamicSharedMemorySize, LDS_BYTES) != hipSuccess) { fprintf(stderr, "kernel_launch: hipFuncSetAttribute failed\n"); grid = -1; return; }
        if (hipOccupancyMaxActiveBlocksPerMultiprocessor(&per_cu, (const void*)hymba_fwd, NTHR, LDS_BYTES) != hipSuccess || per_cu < 1) { fprintf(stderr, "kernel_launch: occupancy query says %d\n", per_cu); }
        (void)hipGetLastError();
        grid = cus < 256 ? cus : 256;
    }
    if (grid < 0) return;
    if (hipMemsetAsync((char*)d_ws + WS_CTL, 0, CTL_ZERO_BYTES, stream) != hipSuccess) return;
    Args a{};
    for (int i = 0; i < N_IN; ++i) a.in[i] = (const float*)d_in[i];
    a.out = (float*)d_out; a.ws = (unsigned char*)d_ws;
#if MK_ONE_LAUNCH
    a.ph_lo = 0; a.ph_hi = N_PHASES;
    hipLaunchKernelGGL(hymba_fwd, dim3(grid), dim3(NTHR), LDS_BYTES, stream, a);
#else
    for (int k = 0; k < N_PHASES; ++k) { a.ph_lo = k; a.ph_hi = k + 1; hipLaunchKernelGGL(hymba_fwd, dim3(grid), dim3(NTHR), LDS_BYTES, stream, a); }
#endif
}
```

```cpp
#include <hip/hip_runtime.h>
#include <cstdio>
#include <cstdint>
namespace pg8 {
#define PG8_LAS __attribute__((address_space(3)))
#define PG8_GAS __attribute__((address_space(1)))
typedef unsigned short bf16_t;
typedef short bf16x8 __attribute__((ext_vector_type(8)));
typedef float f32x4 __attribute__((ext_vector_type(4)));
typedef unsigned u32x4 __attribute__((ext_vector_type(4)));
constexpr int BM = 256, BK = 64, HALF = 128, HTB = HALF * BK * 2  , STAGE_BYTES = 8 * HTB, NXCD = 8, WGM = 8;

__host__ __device__ __forceinline__ int lds_byte(int r, int c) { const int st = (r >> 4) * 2 + (c >> 5), rr = r & 15, cc = c & 31, ob = rr * 64 + cc * 2; return st * 1024 + (ob ^ (((ob >> 9) & 1) << 5)); }
__host__ __device__ __forceinline__ void stage_rc(int b, int& R, int& C) { const int st = b / 1024, sb = b % 1024, swz = sb ^ (((sb >> 9) & 1) << 5); R = (st >> 1) * 16 + swz / 64; C = (st & 1) * 32 + (swz % 64) / 2; }
__host__ __device__ __forceinline__ int perm32(int rho) { const int n = rho >> 4, i = rho & 15; return 8 * (i >> 2) + 4 * n + (i & 3); }

struct Unit { int pm, pn, k0, nt, at; };
struct Gemm { const PG8_GAS bf16_t* A; const PG8_GAS bf16_t* Bt; int M, N, K; };

struct StaticOrder {
    int nM, nN, nwg, G, c, ntK;
    __host__ __device__ void init(int M, int N, int K, int G_, int c_) { nM = M / BM; nN = N / BM; nwg = nM * nN; G = G_; c = c_; ntK = K / BK; }
    __host__ __device__ bool next(int i, Unit& u) const {
        const long L = (long)i * G + c; if (L >= nwg) return false;
        int wgid = (int)L; { const int q = nwg / NXCD, r = nwg % NXCD, xcd = wgid % NXCD, off = wgid / NXCD; wgid = (xcd < r ? xcd * (q + 1) : r * (q + 1) + (xcd - r) * q) + off; }
        const int nig = WGM * nN, gid = wgid / nig, fm = gid * WGM, gsz = (nM - fm) < WGM ? (nM - fm) : WGM;
        u.pm = fm + ((wgid % nig) % gsz); u.pn = (wgid % nig) / gsz; u.k0 = 0; u.nt = ntK; u.at = 0; return true;
    }
    __device__ __forceinline__ void a_ready(const Unit&) const {}
    __device__ __forceinline__ void done(const Unit&) const {}
};

struct SplitOrder {
    StaticOrder so; int nfull, ntot, pmS, nN, ntS;
    __host__ __device__ void init(int Mfull, int N, int K, int nslice, int G_, int c_) { so.init(Mfull, N, K, G_, c_); nfull = so.nwg; pmS = Mfull / BM; nN = N / BM; ntS = K / BK / nslice; ntot = nfull + nN * nslice; }
    __host__ __device__ bool next(int i, Unit& u) const {
        const long L = (long)i * so.G + so.c; if (L >= ntot) return false;
        if (L < nfull) return so.next(i, u);
        const int j = (int)L - nfull; u.pm = pmS; u.pn = j % nN; u.k0 = (j / nN) * ntS * BK; u.nt = ntS; u.at = 1; return true;
    }
    __device__ __forceinline__ void a_ready(const Unit&) const {}
    __device__ __forceinline__ void done(const Unit&) const {}
};

struct SliceOrder {
    int pmS, nN, ntS, ntot, nb, c;
    __host__ __device__ void init(int pmS_, int N, int K, int nslice, int nb_, int c_) { pmS = pmS_; nN = N / BM; ntS = K / BK / nslice; ntot = nN * nslice; nb = nb_; c = c_; }
    __host__ __device__ bool next(int i, Unit& u) const {
        if (c < 0 || c >= nb) return false; const int L = i * nb + c; if (L >= ntot) return false;
        u.pm = pmS; u.pn = L % nN; u.k0 = (L / nN) * ntS * BK; u.nt = ntS; u.at = 1; return true;
    }
    __device__ __forceinline__ void a_ready(const Unit&) const {}
    __device__ __forceinline__ void done(const Unit&) const {}
};

__device__ __forceinline__ unsigned cvt_pk_bf16(float lo, float hi) { unsigned r; asm volatile("v_cvt_pk_bf16_f32 %0, %1, %2" : "=v"(r) : "v"(lo), "v"(hi)); return r; }
typedef float f32x2 __attribute__((ext_vector_type(2)));
struct EpiStoreBf16 {
    static constexpr bool PERM = true, AFTER_DRAIN = false;
    PG8_GAS bf16_t* O; int ldc; int act;
    __device__ __forceinline__ void operator()(const f32x4 (&acc)[2][2][4][2], const Unit& u, int wr, int wc, int fr, int fq) const {
        const int row0 = u.pm * BM + wr * 64 + fr; const int col0 = u.pn * BM + wc * 32 + 8 * fq;
#pragma unroll
        for (int ai = 0; ai < 2; ++ai)
#pragma unroll
            for (int m = 0; m < 4; ++m) { PG8_GAS bf16_t* rowp = O + (size_t)(row0 + ai * HALF + m * 16) * ldc + col0;
#pragma unroll
                for (int bj = 0; bj < 2; ++bj) { f32x4 v0 = acc[ai][bj][m][0], v1 = acc[ai][bj][m][1];
                    if (act) {
#pragma unroll
                        for (int j = 0; j < 4; ++j) { const float a = v0[j] > 0.f ? v0[j] : 0.f, b = v1[j] > 0.f ? v1[j] : 0.f; v0[j] = a * a; v1[j] = b * b; } }
                    u32x4 w; w.x = cvt_pk_bf16(v0[0], v0[1]); w.y = cvt_pk_bf16(v0[2], v0[3]); w.z = cvt_pk_bf16(v1[0], v1[1]); w.w = cvt_pk_bf16(v1[2], v1[3]);
                    *(PG8_GAS u32x4*)(rowp + bj * HALF) = w; } }
    }
};
struct EpiGateRes {
    static constexpr bool PERM = true, AFTER_DRAIN = false;
    PG8_GAS float* X; int ldc; const PG8_GAS float* gate; int gstride; PG8_GAS float* part; const PG8_GAS float* Xin;
    __device__ __forceinline__ void operator()(const f32x4 (&acc)[2][2][4][2], const Unit& u, int wr, int wc, int fr, int fq) const {
        const int row0 = u.pm * BM + wr * 64 + fr, col0 = u.pn * BM + wc * 32 + 8 * fq;
        if (!u.at) {
            const int bb = (u.pm * BM) >> 12; const PG8_GAS float* gp = gate + (size_t)bb * gstride + col0;
            f32x4 gv[2][2];
#pragma unroll
            for (int bj = 0; bj < 2; ++bj)
#pragma unroll
                for (int n = 0; n < 2; ++n) gv[bj][n] = *(const PG8_GAS f32x4*)(gp + bj * HALF + n * 4);
#pragma unroll
            for (int ai = 0; ai < 2; ++ai)
#pragma unroll
                for (int m = 0; m < 4; ++m) { PG8_GAS float* rowp = X + (size_t)(row0 + ai * HALF + m * 16) * ldc + col0; const PG8_GAS float* rowi = Xin + (size_t)(row0 + ai * HALF + m * 16) * ldc + col0;
                    f32x4 xv[2][2];
#pragma unroll
                    for (int bj = 0; bj < 2; ++bj)
#pragma unroll
                        for (int n = 0; n < 2; ++n) xv[bj][n] = *(const PG8_GAS f32x4*)(rowi + bj * HALF + n * 4);
#pragma unroll
                    for (int bj = 0; bj < 2; ++bj)
#pragma unroll
                        for (int n = 0; n < 2; ++n) *(PG8_GAS f32x4*)(rowp + bj * HALF + n * 4) = xv[bj][n] + gv[bj][n] * acc[ai][bj][m][n]; }
        } else {
            const int sl = u.k0 / (u.nt * BK);
#pragma unroll
            for (int ai = 0; ai < 2; ++ai)
#pragma unroll
                for (int m = 0; m < 4; ++m) { const int row = row0 + ai * HALF + m * 16; const int bb = 2 + ((row - 8192) >> 3);
                    const PG8_GAS float* gp = gate + (size_t)bb * gstride + col0; PG8_GAS float* pp = part + ((size_t)(sl * BM + (row - 8192)) * ldc + col0);
                    f32x4 gv[2][2];
#pragma unroll
                    for (int bj = 0; bj < 2; ++bj)
#pragma unroll
                        for (int n = 0; n < 2; ++n) gv[bj][n] = *(const PG8_GAS f32x4*)(gp + bj * HALF + n * 4);
#pragma unroll
                    for (int bj = 0; bj < 2; ++bj)
#pragma unroll
                        for (int n = 0; n < 2; ++n) *(PG8_GAS f32x4*)(pp + bj * HALF + n * 4) = gv[bj][n] * acc[ai][bj][m][n]; }
        }
    }
};
template <class Epi, class Sched, bool ALIGN_EPI = false, bool SP2 = false>
__device__ __forceinline__ void gemm_phase(PG8_LAS unsigned char* lds, const Gemm g, const Sched& S, const Epi& E) {
    int tid_ = threadIdx.x; asm volatile("" : "+v"(tid_));
    const int tid = tid_, wid = __builtin_amdgcn_readfirstlane(tid >> 6), lane = tid & 63, wr = wid >> 2, wc = wid & 3, fr = lane & 15, fq = lane >> 4;
    const int K = g.K;
    unsigned voffA[2], voffB[2];
#pragma unroll
    for (int i = 0; i < 2; ++i) { int R, C; stage_rc(tid * 16 + i * 8192, R, C); const int Rb = Epi::PERM ? ((R & ~31) + perm32(R & 31)) : R;
        voffA[i] = (unsigned)(R * K + C) * 2u; voffB[i] = (unsigned)(Rb * K + C) * 2u; }
    const size_t kstep = (size_t)(BK * 2);
    const size_t hstep = (size_t)HALF * K * 2;
    const size_t tstep = 2 * hstep;
    const unsigned ldsw = (unsigned)wid * 1024u;
    const int aoff = lds_byte(wr * 64 + fr, fq * 8), boff = lds_byte(wc * 32 + fr, fq * 8);
#define PG8_SA(b, h) (((b) * 2 + (h)) * HTB)
#define PG8_SB(b, h) ((4 + (b) * 2 + (h)) * HTB)
#define PG8_STAGE(bufoff, gbase, voff) do { _Pragma("unroll") for (int _i = 0; _i < 2; ++_i) \
        __builtin_amdgcn_global_load_lds((const PG8_GAS unsigned*)((const PG8_GAS char*)(gbase) + (voff)[_i]), (PG8_LAS unsigned*)(lds + (bufoff) + ldsw + _i * 8192), 16, 0, 0); } while (0)
#define PG8_LDA(dst, b, h) do { _Pragma("unroll") for (int m = 0; m < 4; ++m) _Pragma("unroll") for (int k = 0; k < 2; ++k) dst[m][k] = *(const PG8_LAS bf16x8*)(lds + PG8_SA(b, h) + aoff + m * 2048 + k * 1024); } while (0)
#define PG8_LDB(dst, b, h) do { _Pragma("unroll") for (int n = 0; n < 2; ++n) _Pragma("unroll") for (int k = 0; k < 2; ++k) dst[n][k] = *(const PG8_LAS bf16x8*)(lds + PG8_SB(b, h) + boff + n * 2048 + k * 1024); } while (0)
#define PG8_MMA(ai, bj, At, Bt) do { __builtin_amdgcn_s_setprio(1); _Pragma("unroll") for (int m = 0; m < 4; ++m) _Pragma("unroll") for (int n = 0; n < 2; ++n) _Pragma("unroll") for (int k = 0; k < 2; ++k) \
        acc[ai][bj][m][n] = __builtin_amdgcn_mfma_f32_16x16x32_bf16(Bt[n][k], At[m][k], acc[ai][bj][m][n], 0, 0, 0); __builtin_amdgcn_s_setprio(0); } while (0)
#define PG8_WAIT_V(n) asm volatile("s_waitcnt vmcnt(" #n ")" ::: "memory")
#define PG8_WAIT_L(n) asm volatile("s_waitcnt lgkmcnt(" #n ")" ::: "memory")
#define PG8_BAR __builtin_amdgcn_s_barrier()
#define PG8_SCHED __builtin_amdgcn_sched_barrier(0)
    Unit cur, nxt; int ui = 0;
    if (!S.next(0, cur)) return;
    f32x4 acc[2][2][4][2];
#pragma unroll
    for (int a = 0; a < 2; ++a)
#pragma unroll
        for (int b = 0; b < 2; ++b)
#pragma unroll
            for (int m = 0; m < 4; ++m)
#pragma unroll
                for (int n = 0; n < 2; ++n) acc[a][b][m][n] = (f32x4){0.f, 0.f, 0.f, 0.f};
    bf16x8 At[4][2], B0[2][2], B1[2][2];
    const PG8_GAS char* cA = (const PG8_GAS char*)g.A + (size_t)cur.pm * tstep + (size_t)cur.k0 * 2; const PG8_GAS char* cB = (const PG8_GAS char*)g.Bt + (size_t)cur.pn * tstep + (size_t)cur.k0 * 2;
    S.a_ready(cur);
    if constexpr (SP2) {
        PG8_STAGE(PG8_SB(0, 0), cB, voffB); PG8_STAGE(PG8_SB(0, 1), cB + hstep, voffB); PG8_STAGE(PG8_SA(0, 0), cA, voffA); PG8_STAGE(PG8_SA(0, 1), cA + hstep, voffA);
        if (wr == 1) PG8_BAR;
        PG8_WAIT_V(2); PG8_BAR;
        PG8_STAGE(PG8_SB(1, 0), cB + kstep, voffB); PG8_STAGE(PG8_SA(1, 0), cA + kstep, voffA); PG8_STAGE(PG8_SB(1, 1), cB + hstep + kstep, voffB);
        PG8_WAIT_V(6); PG8_BAR;
    } else {
        PG8_STAGE(PG8_SB(0, 0), cB, voffB); PG8_STAGE(PG8_SA(0, 0), cA, voffA); PG8_STAGE(PG8_SB(0, 1), cB + hstep, voffB); PG8_STAGE(PG8_SA(0, 1), cA + hstep, voffA);
        if (wr == 1) PG8_BAR;
        PG8_WAIT_V(4); PG8_BAR;
        PG8_STAGE(PG8_SB(1, 0), cB + kstep, voffB); PG8_STAGE(PG8_SA(1, 0), cA + kstep, voffA); PG8_STAGE(PG8_SB(1, 1), cB + hstep + kstep, voffB);
        PG8_WAIT_V(6); PG8_BAR;
    }
    for (;;) {
        const bool has_next = S.next(ui + 1, nxt);
        const PG8_GAS char* nA = has_next ? (const PG8_GAS char*)g.A + (size_t)nxt.pm * tstep + (size_t)nxt.k0 * 2 : cA; const PG8_GAS char* nB = has_next ? (const PG8_GAS char*)g.Bt + (size_t)nxt.pn * tstep + (size_t)nxt.k0 * 2 : cB;
        const int nt = cur.nt;
        for (int t = 0; t < nt; t += 2) {
            const bool last = (t == nt - 2);
            const PG8_GAS char* a1 = cA + (size_t)(t + 1) * kstep;
            const PG8_GAS char* a2 = last ? nA : cA + (size_t)(t + 2) * kstep; const PG8_GAS char* b2 = last ? nB : cB + (size_t)(t + 2) * kstep;
            const PG8_GAS char* a3 = a2 + kstep; const PG8_GAS char* b3 = b2 + kstep;
            if (last && has_next) S.a_ready(nxt);
            if constexpr (SP2) {
            PG8_LDB(B0, 0, 0); PG8_LDB(B1, 0, 1); PG8_SCHED; PG8_LDA(At, 0, 0); PG8_STAGE(PG8_SA(1, 1), a1 + hstep, voffA);
            PG8_WAIT_V(8); PG8_WAIT_L(0); PG8_BAR; PG8_MMA(0, 0, At, B0); PG8_MMA(0, 1, At, B1); PG8_BAR; PG8_SCHED;
            PG8_LDA(At, 0, 1); PG8_STAGE(PG8_SB(0, 0), b2, voffB); PG8_STAGE(PG8_SB(0, 1), b2 + hstep, voffB); PG8_STAGE(PG8_SA(0, 0), a2, voffA);
            PG8_WAIT_V(8); PG8_WAIT_L(0); PG8_BAR; PG8_MMA(1, 0, At, B0); PG8_MMA(1, 1, At, B1); PG8_BAR; PG8_SCHED;
            PG8_LDB(B0, 1, 0); PG8_LDB(B1, 1, 1); PG8_SCHED; PG8_LDA(At, 1, 0); PG8_STAGE(PG8_SA(0, 1), a2 + hstep, voffA);
            PG8_WAIT_V(8); PG8_WAIT_L(0); PG8_BAR; PG8_MMA(0, 0, At, B0); PG8_MMA(0, 1, At, B1); PG8_BAR; PG8_SCHED;
            PG8_LDA(At, 1, 1); PG8_STAGE(PG8_SB(1, 0), b3, voffB); PG8_STAGE(PG8_SB(1, 1), b3 + hstep, voffB); PG8_STAGE(PG8_SA(1, 0), a3, voffA);
            PG8_WAIT_V(8); PG8_WAIT_L(0); PG8_BAR; PG8_MMA(1, 0, At, B0); PG8_MMA(1, 1, At, B1); PG8_BAR; PG8_SCHED;
            } else {
            PG8_LDB(B0, 0, 0); PG8_SCHED; PG8_LDA(At, 0, 0); PG8_STAGE(PG8_SA(1, 1), a1 + hstep, voffA);
            PG8_WAIT_L(8); PG8_BAR; PG8_WAIT_L(0); PG8_MMA(0, 0, At, B0); PG8_BAR; PG8_SCHED;
            PG8_LDB(B1, 0, 1); PG8_STAGE(PG8_SB(0, 0), b2, voffB);
            PG8_BAR; PG8_WAIT_L(0); PG8_MMA(0, 1, At, B1); PG8_BAR;
            PG8_LDA(At, 0, 1); PG8_STAGE(PG8_SA(0, 0), a2, voffA);
            PG8_BAR; PG8_WAIT_L(0); PG8_MMA(1, 0, At, B0); PG8_BAR; PG8_SCHED;
            PG8_STAGE(PG8_SB(0, 1), b2 + hstep, voffB);
            PG8_WAIT_V(6); PG8_BAR; PG8_MMA(1, 1, At, B1); PG8_BAR;
            PG8_LDB(B0, 1, 0); PG8_SCHED; PG8_LDA(At, 1, 0); PG8_STAGE(PG8_SA(0, 1), a2 + hstep, voffA);
            PG8_WAIT_L(8); PG8_BAR; PG8_WAIT_L(0); PG8_MMA(0, 0, At, B0); PG8_BAR; PG8_SCHED;
            PG8_LDB(B1, 1, 1); PG8_STAGE(PG8_SB(1, 0), b3, voffB);
            PG8_BAR; PG8_WAIT_L(0); PG8_MMA(0, 1, At, B1); PG8_BAR;
            PG8_LDA(At, 1, 1); PG8_STAGE(PG8_SA(1, 0), a3, voffA);
            PG8_BAR; PG8_WAIT_L(0); PG8_MMA(1, 0, At, B0); PG8_BAR; PG8_SCHED;
            PG8_STAGE(PG8_SB(1, 1), b3 + hstep, voffB);
            PG8_WAIT_V(6); PG8_BAR; PG8_MMA(1, 1, At, B1); PG8_BAR;
            }
        }
        if constexpr (ALIGN_EPI) { if (wr == 0) PG8_BAR; }
        if constexpr (!Epi::AFTER_DRAIN) { E(acc, cur, wr, wc, fr, fq); S.done(cur); }
        if (!has_next) break;
#pragma unroll
        for (int a = 0; a < 2; ++a)
#pragma unroll
            for (int b = 0; b < 2; ++b)
#pragma unroll
                for (int m = 0; m < 4; ++m)
#pragma unroll
                    for (int n = 0; n < 2; ++n) acc[a][b][m][n] = (f32x4){0.f, 0.f, 0.f, 0.f};
        cur = nxt; cA = nA; cB = nB; ++ui;
        if constexpr (ALIGN_EPI) { if (wr == 1) PG8_BAR; }
    }
    PG8_WAIT_V(0);
    if constexpr (!ALIGN_EPI) { if (wr == 0) PG8_BAR; }
    PG8_BAR;
    if constexpr (Epi::AFTER_DRAIN) { E.fused(acc, cur, wr, wc, fr, fq, lds, wid, lane); S.done(cur); }
#undef PG8_SA
#undef PG8_SB
#undef PG8_STAGE
#undef PG8_LDA
#undef PG8_LDB
#undef PG8_MMA
#undef PG8_WAIT_V
#undef PG8_WAIT_L
#undef PG8_BAR
#undef PG8_SCHED
}
}
constexpr int NWAVES = 8, NTHR = 512;
constexpr int D = 2048, DEPTH = 4, BP = 2, TP = 4096, BS = 32, TS = 8;
constexpr int MP = BP * TP, MS = BS * TS, M = MP + MS, NBB = BP + BS;
constexpr int NINW = 4872, NPROJ = 4864, DFF = 8192, NMOD = 6 * D, PAST = 16384;
constexpr int C_AQ = 0, C_AF = 512, C_AI = 1024, C_AG = 1536, C_PU = 2048, C_CZ = 2560, C_CX = 3072, C_DQ = 4096, C_DK = 4608, C_DV = 4736;
constexpr float EPS = 1e-6f;
enum { I_XP = 0, I_XS, I_CP, I_CS, I_SHG, I_SPOOL, I_SSSM, I_SCONV, I_CK, I_CV, I_N1G, I_N2G, I_WADA, I_BADA, I_WIN, I_LBL, I_HNG, I_PW, I_PSC, I_CW, I_CB, I_DTB, I_ALOG, I_DSK, I_SNG, I_QNG, I_KNG, I_SINK, I_WOUT, I_WUP, I_WDN, N_IN };
constexpr size_t O_Y = 0, O_PHG = (size_t)M * D, O_PPOOL = O_PHG + 4 * 2 * 4 * 16384, O_PSSM = O_PPOOL + 4 * 2 * 15 * 512, O_PCONV = O_PSSM + 4 * 2 * 8 * 8192, O_PK = O_PCONV + 4 * 2 * 3 * 1024,
    O_PV = O_PK + 4 * 2 * 128 * 128, O_SHG = O_PV + 4 * 2 * 128 * 128, O_SPOOL = O_SHG + (size_t)4 * 32 * 4 * 16384, O_SSSM = O_SPOOL + 4 * 32 * 15 * 512, O_SCONV = O_SSSM + (size_t)4 * 32 * 8 * 8192,
    O_SK = O_SCONV + 4 * 32 * 3 * 1024, O_SV = O_SK + 4 * 32 * 128 * 128, O_END = O_SV + 4 * 32 * 128 * 128;
static_assert(O_END == 41046016, "output size");
constexpr size_t MiB = 1u << 20;
constexpr size_t WS_CTL = 0, CTL_ZERO_BYTES = 1 * MiB;
constexpr size_t WS_MOD = 1 * MiB, WS_LB = 8 * MiB, WS_ROPE = 8 * MiB + 65536, WS_DT = 10 * MiB;
constexpr size_t WS_WIN = 16 * MiB, WS_WOUT = 92 * MiB, WS_WUP = 124 * MiB, WS_WDN = 252 * MiB;
constexpr size_t WS_H = 380 * MiB, WS_PROJ = 413 * MiB, WS_MIX = 492 * MiB, WS_U = 525 * MiB;
constexpr size_t WS_HGDS = 657 * MiB, WS_HGSS = 689 * MiB, WS_SDDS = 721 * MiB, WS_SDSS = 753 * MiB, WS_HGDEC = 785 * MiB, WS_SDDEC = 785 * MiB + 524288, WS_PART = 786 * MiB, WS_YTMP = 818 * MiB, WS_WPT = 850 * MiB, WS_WDT = 850 * MiB + 524288, WS_U2 = 883 * MiB, WS_WDN2 = 1017 * MiB, WS_END = 1147 * MiB;
constexpr int LDU = DFF + 64;
static_assert(WS_U2 + (size_t)M * LDU * 2 <= WS_WDN2 && WS_WDN2 + (size_t)4 * D * LDU * 2 <= WS_END, "ws map 2");
static_assert(WS_WIN + (size_t)4 * NPROJ * D * 2 <= WS_WOUT && WS_PROJ + (size_t)M * NPROJ * 2 <= WS_MIX && WS_U + (size_t)M * DFF * 2 <= WS_HGDS, "ws map");
constexpr int CW_BAR = 4096, CW_Q = 16384, CQ_CONV = 160;
constexpr int RING_BYTES = 131072, LDSCTL_OFF = RING_BYTES, MISC_OFF = LDSCTL_OFF + 320, PTR_OFF = LDSCTL_OFF + 1024, LDS_BYTES = 147456;
constexpr int PH_PER_LAYER = 9, N_PHASES = 2 + DEPTH * PH_PER_LAYER;
constexpr int NSL_OUT = 8, NSL_DN = 16;
#ifndef MK_ONE_LAUNCH
#define MK_ONE_LAUNCH 1
#endif
#define GAS __attribute__((address_space(1)))
#define LAS __attribute__((address_space(3)))
typedef unsigned short bf16;
typedef unsigned v4u __attribute__((ext_vector_type(4)));
typedef float f32x4 __attribute__((ext_vector_type(4)));
typedef short bf16x8 __attribute__((ext_vector_type(8)));
typedef GAS unsigned gu32;
typedef GAS unsigned long long gu64;
#define RLX_AGENT __ATOMIC_RELAXED, __HIP_MEMORY_SCOPE_AGENT
#define LDS_WAIT() asm volatile("s_waitcnt lgkmcnt(0)" ::: "memory")
#define VM_WAIT() asm volatile("s_waitcnt vmcnt(0)" ::: "memory")
__device__ __forceinline__ unsigned long long rt() { return __builtin_amdgcn_s_memrealtime(); }
__device__ __forceinline__ unsigned f2bf(float f) { unsigned u = __builtin_bit_cast(unsigned, f); return (u + 0x7fffu + ((u >> 16) & 1u)) >> 16; }
__device__ __forceinline__ unsigned pk2(float lo, float hi) { return f2bf(lo) | (f2bf(hi) << 16); }

#define XB_TMO      128
#define XB_XCNT(j)  (256  + 64 * (j))
#define XB_XSUB(j)  (1280 + 64 * (j))
#define XB_XGEN(j)  (2304 + 64 * (j))
#define XB_TOP      3328
#define XB_TOPGEN   3392
#define XCD_BAR_WORDS 3456
#define XB_SPIN_CAP (1u << 18)

__device__ __forceinline__ unsigned xb_ld(unsigned* p)              { return __hip_atomic_load(p, __ATOMIC_RELAXED, __HIP_MEMORY_SCOPE_AGENT); }
__device__ __forceinline__ unsigned xb_add(unsigned* p, unsigned v) { return __hip_atomic_fetch_add(p, v, __ATOMIC_RELAXED, __HIP_MEMORY_SCOPE_AGENT); }
__device__ __forceinline__ unsigned xb_xcc_id() { return (unsigned)__builtin_amdgcn_s_getreg((3 << 11) | 20) & 0xFu; }
#define XB_SPIN(cond, bar) do { unsigned _sp = 0; while (cond) { __builtin_amdgcn_s_sleep(1); \
    if ((++_sp & 255u) == 0u) { if (xb_ld(&(bar)[XB_TMO])) break; if (_sp > XB_SPIN_CAP) { atomicAdd(&(bar)[XB_TMO], 1u); break; } } } } while (0)

struct XcdBarrier {
    unsigned* bar; unsigned x;
    volatile LAS unsigned* st;
};

__device__ __forceinline__ XcdBarrier xcd_barrier_post(unsigned* bar, volatile LAS unsigned* st) {
    XcdBarrier b; b.bar = bar; b.x = xb_xcc_id(); b.st = st;
    if (threadIdx.x == 0) (void)xb_add(&bar[XB_XCNT(b.x)], 1u);
    return b;
}
__device__ __forceinline__ void xcd_barrier_complete(unsigned* bar, unsigned x, unsigned& nloc, unsigned& nx) {
    const unsigned G = gridDim.x * gridDim.y * gridDim.z;
    unsigned sum, cnt, mine, sp = 0u;
    for (;;) {
        sum = 0u; cnt = 0u; mine = 0u;
#pragma unroll
        for (unsigned j = 0; j < 16; ++j) { const unsigned c = xb_ld(&bar[XB_XCNT(j)]); sum += c; cnt += (c > 0u) ? 1u : 0u; mine = (j == x) ? c : mine; }
        if (sum == G) break;
        __builtin_amdgcn_s_sleep(1);
        if ((++sp & 255u) == 0u) { if (xb_ld(&bar[XB_TMO])) break; if (sp > XB_SPIN_CAP) { atomicAdd(&bar[XB_TMO], 1u); break; } }
    }
    nloc = mine > 0u ? mine : 1u; nx = cnt > 0u ? cnt : 1u;
}

__device__ __forceinline__ void xcd_barrier(const XcdBarrier& b) {
    asm volatile("s_waitcnt vmcnt(0)" ::: "memory");
    __syncthreads();
    if (threadIdx.x == 0) {
        unsigned* bar = b.bar;
        __builtin_amdgcn_s_waitcnt(0);
        unsigned nloc = b.st[0], nx = b.st[1];
        if (nloc == 0u) { xcd_barrier_complete(bar, b.x, nloc, nx); b.st[0] = nloc; b.st[1] = nx; }
        const unsigned old = xb_add(&bar[XB_XSUB(b.x)], 1u);
        const unsigned gen = old / nloc;
        if (old + 1u == (gen + 1u) * nloc) {
            __builtin_amdgcn_fence(__ATOMIC_RELEASE, "agent");
            asm volatile("s_waitcnt vmcnt(0)" ::: "memory");
            const unsigned og = xb_add(&bar[XB_TOP], 1u);
            const unsigned tg = og / nx;
            if (og + 1u == (tg + 1u) * nx) xb_add(&bar[XB_TOPGEN], 1u);
            else XB_SPIN(xb_ld(&bar[XB_TOPGEN]) == tg, bar);
            __builtin_amdgcn_fence(__ATOMIC_ACQUIRE, "agent");
            xb_add(&bar[XB_XGEN(b.x)], 1u);
            asm volatile("s_waitcnt vmcnt(0)" ::: "memory");
        } else {
            XB_SPIN(xb_ld(&bar[XB_XGEN(b.x)]) == gen, bar);
            __builtin_amdgcn_fence(__ATOMIC_ACQUIRE, "agent");
            asm volatile("s_waitcnt vmcnt(0)" ::: "memory");
        }
    }
    __syncthreads();
}

struct Frame {
    LAS unsigned char* lds;
    volatile LAS unsigned* MISC;
    gu32* ctl;
    int tid, lane, wave, G, gw, ngw;
    GAS float* out; GAS unsigned char* ws;
};
__device__ __forceinline__ const GAS float* inp(const Frame& F, int i) {
    int off = PTR_OFF + 8 * i; asm volatile("" : "+s"(off));
    const unsigned long long v = *(const LAS unsigned long long*)(F.lds + off);
    const unsigned lo = __builtin_amdgcn_readfirstlane((unsigned)v), hi = __builtin_amdgcn_readfirstlane((unsigned)(v >> 32));
    return (const GAS float*)(((unsigned long long)hi << 32) | lo);
}
__device__ __forceinline__ GAS unsigned char* wsp(const Frame& F, size_t off) { GAS unsigned char* p = F.ws; asm volatile("" : "+s"(p)); return p + off; }
#define INP(i) inp(F, i)
#define WS_LOCALS \
    GAS float* const MOD = (GAS float*)wsp(F, WS_MOD); GAS float* const LBv = (GAS float*)wsp(F, WS_LB); GAS float* const ROPE = (GAS float*)wsp(F, WS_ROPE); GAS float* const DT = (GAS float*)wsp(F, WS_DT); \
    GAS bf16* const Wi = (GAS bf16*)wsp(F, WS_WIN); GAS bf16* const Wo = (GAS bf16*)wsp(F, WS_WOUT); GAS bf16* const Wu = (GAS bf16*)wsp(F, WS_WUP); GAS bf16* const Wd = (GAS bf16*)wsp(F, WS_WDN2); \
    GAS bf16* const H = (GAS bf16*)wsp(F, WS_H); GAS bf16* const PROJ = (GAS bf16*)wsp(F, WS_PROJ); GAS bf16* const MIX = (GAS bf16*)wsp(F, WS_MIX); GAS bf16* const U = (GAS bf16*)wsp(F, WS_U2); \
    GAS float* const HGDS = (GAS float*)wsp(F, WS_HGDS); GAS float* const HGSS = (GAS float*)wsp(F, WS_HGSS); GAS float* const SDDS = (GAS float*)wsp(F, WS_SDDS); GAS float* const SDSS = (GAS float*)wsp(F, WS_SDSS); \
    GAS float* const HGDEC = (GAS float*)wsp(F, WS_HGDEC); GAS float* const SDDEC = (GAS float*)wsp(F, WS_SDDEC); \
    (void)MOD; (void)LBv; (void)ROPE; (void)DT; (void)Wi; (void)Wo; (void)Wu; (void)Wd; (void)H; (void)PROJ; (void)MIX; (void)U; (void)HGDS; (void)HGSS; (void)SDDS; (void)SDSS; (void)HGDEC; (void)SDDEC;
__device__ __forceinline__ float wave_sum(float v) {
#pragma unroll
    for (int o = 1; o < 64; o <<= 1) v += __shfl_xor(v, o);
    return v;
}
__device__ __forceinline__ float bf2f(bf16 b) { return __builtin_bit_cast(float, (unsigned)b << 16); }
__device__ __forceinline__ float bflo(unsigned w) { return __builtin_bit_cast(float, w << 16); }
__device__ __forceinline__ float bfhi(unsigned w) { return __builtin_bit_cast(float, w & 0xffff0000u); }
__device__ __forceinline__ float sigm(float x) { return __builtin_amdgcn_rcpf(1.f + __expf(-x)); }
__device__ __forceinline__ float rsq(float x) { return __builtin_amdgcn_rsqf(x); }
__device__ __forceinline__ int row_bb(int m) { return m < MP ? (m >> 12) : BP + ((m - MP) >> 3); }
typedef short bf16x8v __attribute__((ext_vector_type(8)));
__device__ __forceinline__ f32x4 mma16(const LAS bf16* A, int lda, const LAS bf16* B, int ldb, int K, f32x4 acc, int lane) {
    const LAS bf16* ap = A + (lane & 15) * lda + 8 * (lane >> 4); const LAS bf16* bp = B + (lane & 15) * ldb + 8 * (lane >> 4);
    for (int k = 0; k < K; k += 32) { const bf16x8v a = *(const LAS bf16x8v*)(ap + k); const bf16x8v b = *(const LAS bf16x8v*)(bp + k); acc = __builtin_amdgcn_mfma_f32_16x16x32_bf16(a, b, acc, 0, 0, 0); }
    return acc;
}
__device__ __forceinline__ bf16 tobf(float f) { return (bf16)f2bf(f); }

#ifndef UT_MASK
#define UT_MASK 0
#endif
#define UTS(bit) do { if ((UT_MASK >> (bit)) & 1) { if (F.tid == 0) { const unsigned long long t_ = __builtin_amdgcn_s_memrealtime(); F.MISC[18] = (unsigned)t_; F.MISC[19] = (unsigned)(t_ >> 32); } } } while (0)
#define UTE(bit) do { if ((UT_MASK >> (bit)) & 1) { if (F.tid == 0) { const unsigned long long t0_ = ((unsigned long long)F.MISC[19] << 32) | F.MISC[18]; const unsigned long long a_ = (((unsigned long long)F.MISC[17] << 32) | F.MISC[16]) + (__builtin_amdgcn_s_memrealtime() - t0_); F.MISC[16] = (unsigned)a_; F.MISC[17] = (unsigned)(a_ >> 32); } } } while (0)
__device__ __forceinline__ int deq(Frame& F, int q) {
    __syncthreads();
    if (F.tid == 0) F.MISC[0] = __hip_atomic_fetch_add(F.ctl + CW_Q + 64 * q, 1u, RLX_AGENT);
    __syncthreads();
    return (int)F.MISC[0];
}

__device__ __forceinline__ void p0_transpose_item(const GAS float* W, int K, int ldw, GAS bf16* WT, int k0, int src_n0, int dst_n0, LAS float* scr, int lane) {
    float tv[32];
#pragma unroll
    for (int i = 0; i < 32; ++i) { const int kk = 2 * i + (lane >> 5); tv[i] = W[(size_t)(k0 + kk) * ldw + src_n0 + (lane & 31)]; }
#pragma unroll
    for (int i = 0; i < 32; ++i) { const int kk = 2 * i + (lane >> 5); scr[kk * 33 + (lane & 31)] = tv[i]; }
    LDS_WAIT(); asm volatile("" ::: "memory");
    const int c = lane & 7;
#pragma unroll
    for (int j = 0; j < 4; ++j) { const int n = (lane >> 3) + 8 * j; const LAS float* s = scr + (8 * c) * 33 + n;
        v4u o; o.x = pk2(s[0 * 33], s[1 * 33]); o.y = pk2(s[2 * 33], s[3 * 33]); o.z = pk2(s[4 * 33], s[5 * 33]); o.w = pk2(s[6 * 33], s[7 * 33]);
        *(GAS v4u*)(WT + (size_t)(dst_n0 + n) * K + k0 + 8 * c) = o; }
    LDS_WAIT(); asm volatile("" ::: "memory");
}
__device__ __forceinline__ void p0_adaln(Frame& F) {
    WS_LOCALS
    constexpr int LDC = 520, NITEM = DEPTH * NMOD / 32;
    LAS bf16* cs = (LAS bf16*)F.lds;
    const GAS float* const cpp = INP(I_CP); const GAS float* const csp = INP(I_CS); const GAS float* const wada = INP(I_WADA); const GAS float* const bada = INP(I_BADA);
    const int lane = F.lane, item = (int)blockIdx.x + F.G * F.wave; const bool act = item < NITEM;
    const int l = act ? item / (NMOD / 32) : 0, n0 = act ? (item % (NMOD / 32)) * 32 : 0;
    f32x4 acc[2][3];
#pragma unroll
    for (int a = 0; a < 2; ++a)
#pragma unroll
        for (int r = 0; r < 3; ++r) acc[a][r] = (f32x4){0.f, 0.f, 0.f, 0.f};
    const GAS float* wl = wada + (size_t)l * D * NMOD + n0 + (lane & 15);
    for (int kc = 0; kc < 4; ++kc) {
        __syncthreads();
        for (int e = F.tid; e < 48 * 512; e += NTHR) { const int bb = e >> 9, kk = e & 511; float v = 0.f;
            if (bb < NBB) { const float c = bb < BP ? cpp[bb * D + kc * 512 + kk] : csp[(bb - BP) * D + kc * 512 + kk]; v = c * sigm(c); }
            cs[bb * LDC + kk] = tobf(v); }
        __syncthreads();
        if (act) {
#pragma unroll 2
            for (int ks = 0; ks < 16; ++ks) { const int kg = kc * 512 + ks * 32 + 8 * (lane >> 4);
                float w0[8], w1[8];
#pragma unroll
                for (int j = 0; j < 8; ++j) { w0[j] = wl[(size_t)(kg + j) * NMOD]; w1[j] = wl[(size_t)(kg + j) * NMOD + 16]; }
                v4u b0, b1; b0.x = pg8::cvt_pk_bf16(w0[0], w0[1]); b0.y = pg8::cvt_pk_bf16(w0[2], w0[3]); b0.z = pg8::cvt_pk_bf16(w0[4], w0[5]); b0.w = pg8::cvt_pk_bf16(w0[6], w0[7]);
                b1.x = pg8::cvt_pk_bf16(w1[0], w1[1]); b1.y = pg8::cvt_pk_bf16(w1[2], w1[3]); b1.z = pg8::cvt_pk_bf16(w1[4], w1[5]); b1.w = pg8::cvt_pk_bf16(w1[6], w1[7]);
                const bf16x8v bf0 = __builtin_bit_cast(bf16x8v, b0), bf1 = __builtin_bit_cast(bf16x8v, b1);
#pragma unroll
                for (int r = 0; r < 3; ++r) { const bf16x8v a = *(const LAS bf16x8v*)(cs + (16 * r + (lane & 15)) * LDC + ks * 32 + 8 * (lane >> 4));
                    acc[0][r] = __builtin_amdgcn_mfma_f32_16x16x32_bf16(a, bf0, acc[0][r], 0, 0, 0); acc[1][r] = __builtin_amdgcn_mfma_f32_16x16x32_bf16(a, bf1, acc[1][r], 0, 0, 0); } }
        }
    }
    if (act) {
#pragma unroll
        for (int a = 0; a < 2; ++a) { const int n = n0 + 16 * a + (lane & 15); const float bias = bada[l * NMOD + n];
#pragma unroll
            for (int r = 0; r < 3; ++r)
#pragma unroll
                for (int i = 0; i < 4; ++i) { const int bb = 16 * r + 4 * (lane >> 4) + i; if (bb < NBB) MOD[((size_t)l * NBB + bb) * NMOD + n] = acc[a][r][i] + bias; } }
    }
    __syncthreads();
}
__device__ __forceinline__ void convert_layer(Frame& F, int l, int first, int nblk_, int bt0, int bt1) {
    WS_LOCALS
    LAS float* scr = (LAS float*)(F.lds + F.wave * 16384);
    constexpr int IT_IN = (D / 64) * (NPROJ / 32), IT_OUT = (D / 64) * (D / 32), IT_UP = (D / 64) * (DFF / 32), IT_DN = (DFF / 64) * (D / 32), IT_L = IT_IN + IT_OUT + IT_UP + IT_DN, NBATCH = (IT_L + 15) / 16;
    const GAS float* const win = INP(I_WIN) + (size_t)l * D * NINW; const GAS float* const wout = INP(I_WOUT) + (size_t)l * D * D; const GAS float* const wup = INP(I_WUP) + (size_t)l * D * DFF; const GAS float* const wdn = INP(I_WDN) + (size_t)l * DFF * D;
    const int me = (int)blockIdx.x - first; if (me < 0 || me >= nblk_) return;
    const int bte = bt1 < NBATCH ? bt1 : NBATCH;
    for (int bt = bt0 + me; bt < bte; bt += nblk_) {
#pragma unroll 1
        for (int s = 0; s < 2; ++s) { int r = bt * 16 + s * 8 + F.wave; if (r >= IT_L) continue;
            if (r < IT_IN) { const int nblk = NPROJ / 32, kb = r / nblk, nb = r % nblk, dn0 = 32 * nb, sn0 = dn0 + (dn0 >= 4096 ? 8 : 0);
                p0_transpose_item(win, D, NINW, Wi + (size_t)l * NPROJ * D, 64 * kb, sn0, dn0, scr, F.lane); continue; } r -= IT_IN;
            if (r < IT_OUT) { const int nblk = D / 32, kb = r / nblk, nb = r % nblk;
                p0_transpose_item(wout, D, D, Wo + (size_t)l * D * D, 64 * kb, 32 * nb, 32 * nb, scr, F.lane); continue; } r -= IT_OUT;
            if (r < IT_UP) { const int nblk = DFF / 32, kb = r / nblk, nb = r % nblk;
                p0_transpose_item(wup, D, DFF, Wu + (size_t)l * DFF * D, 64 * kb, 32 * nb, 32 * nb, scr, F.lane); continue; } r -= IT_UP;
            { const int nblk = D / 32, kb = r / nblk, nb = r % nblk;
                p0_transpose_item(wdn, LDU, D, Wd + (size_t)l * D * LDU, 64 * kb, 32 * nb, 32 * nb, scr, F.lane); } }
    }
}
__device__ __forceinline__ void p0_prologue(Frame& F) {
    WS_LOCALS
    const int gt = blockIdx.x * NTHR + F.tid, NT = F.G * NTHR;
    if (gt < 512) { const GAS float* lg = INP(I_LBL); const float a0 = lg[gt], a1 = lg[512 + gt], a2 = lg[1024 + gt], a3 = lg[1536 + gt];
        const float mx = fmaxf(fmaxf(a0, a1), fmaxf(a2, a3)); const float e0 = expf(a0 - mx), e1 = expf(a1 - mx), e2 = expf(a2 - mx), e3 = expf(a3 - mx); const float inv = 1.f / (e0 + e1 + e2 + e3);
        LBv[gt] = 0.f; LBv[512 + gt] = e1 * inv; LBv[1024 + gt] = (e1 + e2) * inv; LBv[1536 + gt] = (e1 + e2 + e3) * inv; }
    for (int e = gt; e < 4104 * 32; e += NT) { const int r = e >> 5, i = e & 31; const int pos = r < 4096 ? r : PAST + (r - 4096);
        const double inv = exp2(-(double)i * (13.287712379549449 / 32.0)); const double rev = (double)pos * inv * 0.15915494309189535;
        const float fr = (float)(rev - floor(rev));
        ROPE[r * 64 + i] = __builtin_amdgcn_cosf(fr); ROPE[r * 64 + 32 + i] = __builtin_amdgcn_sinf(fr); }
    { const GAS float* wi = INP(I_WIN); GAS float* wdtg = (GAS float*)wsp(F, WS_WDT);
      for (int e = gt; e < DEPTH * D * 8; e += NT) { const int ll = e >> 14, d2 = (e >> 3) & 2047, j = e & 7; wdtg[(ll * 8 + j) * D + d2] = wi[((size_t)ll * D + d2) * NINW + 4096 + j]; } }
    { const GAS float* pw = INP(I_PW); GAS bf16* wpt = (GAS bf16*)wsp(F, WS_WPT);
      for (int e = gt; e < 16 * 16384; e += NT) { const int lg = e >> 14, dd = (e >> 7) & 127, c = e & 127; wpt[e] = (bf16)f2bf(pw[(size_t)lg * 16384 + c * 128 + dd]); } }
    p0_adaln(F);
    convert_layer(F, 0, 0, F.G, 0, 1 << 30);
}

template <int NR> __device__ __forceinline__ void norm_rows(Frame& F, int l, int which, const int (&mr)[NR], f32x4 (&v)[NR][8], const GAS f32x4* g4, const GAS float* MOD, GAS bf16* H, GAS float* DT, const LAS float* wdt) {
    const int bb = row_bb(mr[0]);
    const GAS float* modp = MOD + ((size_t)l * NBB + bb) * NMOD + (which ? 3 * D : 0);
    const GAS f32x4* sh4 = (const GAS f32x4*)modp; const GAS f32x4* sc4 = (const GAS f32x4*)(modp + D);
    f32x4 gs[8], shv[8];
#pragma unroll
    for (int j = 0; j < 8; ++j) { const int q = 64 * j + F.lane; const f32x4 g = g4[q], sc = sc4[q]; shv[j] = sh4[q]; gs[j] = g * (sc + 1.f); }
    float ss[NR];
#pragma unroll
    for (int n = 0; n < NR; ++n) { float s = 0.f;
#pragma unroll
        for (int j = 0; j < 8; ++j) s += (v[n][j].x * v[n][j].x + v[n][j].y * v[n][j].y) + (v[n][j].z * v[n][j].z + v[n][j].w * v[n][j].w);
        ss[n] = s; }
#pragma unroll
    for (int o = 1; o < 64; o <<= 1) {
#pragma unroll
        for (int n = 0; n < NR; ++n) ss[n] += __shfl_xor(ss[n], o); }
#pragma unroll
    for (int n = 0; n < NR; ++n) { const float r = rsq(ss[n] * (1.f / D) + EPS); GAS unsigned long long* o8 = (GAS unsigned long long*)(H + (size_t)mr[n] * D);
#pragma unroll
        for (int j = 0; j < 8; ++j) { const int q = 64 * j + F.lane;
            f32x4 h; h.x = v[n][j].x * r * gs[j].x + shv[j].x; h.y = v[n][j].y * r * gs[j].y + shv[j].y; h.z = v[n][j].z * r * gs[j].z + shv[j].z; h.w = v[n][j].w * r * gs[j].w + shv[j].w;
            o8[q] = (unsigned long long)pk2(h.x, h.y) | ((unsigned long long)pk2(h.z, h.w) << 32);
            v[n][j] = h; } }
    if (which == 0) { float dta[NR][8];
#pragma unroll
        for (int jj = 0; jj < 8; ++jj) { float a[NR];
#pragma unroll
            for (int n = 0; n < NR; ++n) a[n] = 0.f;
#pragma unroll
            for (int j = 0; j < 8; ++j) { const f32x4 w = ((const LAS f32x4*)wdt)[jj * (D / 4) + 64 * j + F.lane];
#pragma unroll
                for (int n = 0; n < NR; ++n) a[n] += (v[n][j].x * w.x + v[n][j].y * w.y) + (v[n][j].z * w.z + v[n][j].w * w.w); }
#pragma unroll
            for (int n = 0; n < NR; ++n) dta[n][jj] = a[n];
            __builtin_amdgcn_sched_barrier(0); }
#pragma unroll
        for (int o = 1; o < 64; o <<= 1) {
#pragma unroll
            for (int n = 0; n < NR; ++n)
#pragma unroll
                for (int jj = 0; jj < 8; ++jj) dta[n][jj] += __shfl_xor(dta[n][jj], o); }
        if (F.lane == 0) {
#pragma unroll
            for (int n = 0; n < NR; ++n) { GAS f32x4* dp = (GAS f32x4*)(DT + (size_t)mr[n] * 8); dp[0] = (f32x4){dta[n][0], dta[n][1], dta[n][2], dta[n][3]}; dp[1] = (f32x4){dta[n][4], dta[n][5], dta[n][6], dta[n][7]}; } } }
}
__device__ __forceinline__ void sample_row_reduce(Frame& F, int ms, int nsl, f32x4 (&v)[8], LAS float* partl) {
    const GAS f32x4* pp = (const GAS f32x4*)wsp(F, WS_PART) + (size_t)ms * (D / 4); GAS f32x4* xw = (GAS f32x4*)(F.out + (size_t)(MP + ms) * D);
#pragma unroll
    for (int j = 0; j < 8; ++j) v[j] = (F.wave == 0) ? xw[64 * j + F.lane] : (f32x4){0.f, 0.f, 0.f, 0.f};
#pragma unroll 1
    for (int s = F.wave; s < nsl; s += 8) {
#pragma unroll
        for (int j = 0; j < 8; ++j) v[j] = v[j] + pp[(size_t)s * (MS * D / 4) + 64 * j + F.lane]; }
    if (F.wave != 0) {
#pragma unroll
        for (int j = 0; j < 8; ++j) ((LAS f32x4*)partl)[(F.wave - 1) * (D / 4) + 64 * j + F.lane] = v[j]; }
    __syncthreads();
    if (F.wave == 0) {
#pragma unroll 1
        for (int w = 0; w < 7; ++w) {
#pragma unroll
            for (int j = 0; j < 8; ++j) v[j] = v[j] + ((const LAS f32x4*)partl)[w * (D / 4) + 64 * j + F.lane]; }
#pragma unroll
        for (int j = 0; j < 8; ++j) xw[64 * j + F.lane] = v[j]; }
}
__device__ __forceinline__ void norm_phase(Frame& F, int l, int which, int nsl) {
    WS_LOCALS
    LAS float* wdt = (LAS float*)F.lds;
    LAS float* partl = (LAS float*)(F.lds + 65536);
    if (which == 0) { const GAS f32x4* wsrc = (const GAS f32x4*)((const GAS float*)wsp(F, WS_WDT) + (size_t)l * 8 * D);
        for (int e = F.tid; e < D * 8 / 4; e += NTHR) ((LAS f32x4*)wdt)[e] = wsrc[e]; }
    __syncthreads();
    const GAS f32x4* g4 = (const GAS f32x4*)(INP(which ? I_N2G : I_N1G) + l * D);
    if (nsl > 0) for (int ms = (int)blockIdx.x; ms < MS; ms += F.G) { f32x4 v1[1][8]; if (ms != (int)blockIdx.x) __syncthreads(); sample_row_reduce(F, ms, nsl, v1[0], partl); const int mr[1] = {MP + ms}; if (F.wave == 0) norm_rows<1>(F, l, which, mr, v1, g4, MOD, H, DT, wdt); }
    const int mend = nsl > 0 ? MP : M;
    const bool first = (l == 0 && which == 0);
    const GAS float* const xpp = INP(I_XP); const GAS float* const xsp = INP(I_XS);
    int m = F.gw;
    while (m < mend) { const int m2 = m + F.ngw;
        if (m2 < mend && row_bb(m) == row_bb(m2)) { f32x4 v2[2][8]; const int mr[2] = {m, m2};
            const GAS f32x4* xa = (const GAS f32x4*)((first ? (m < MP ? xpp + (size_t)m * D : xsp + (size_t)(m - MP) * D) : F.out + (size_t)m * D)); const GAS f32x4* xb = (const GAS f32x4*)((first ? (m2 < MP ? xpp + (size_t)m2 * D : xsp + (size_t)(m2 - MP) * D) : F.out + (size_t)m2 * D));
#pragma unroll
            for (int j = 0; j < 8; ++j) { v2[0][j] = xa[64 * j + F.lane]; v2[1][j] = xb[64 * j + F.lane]; }
            if (first && m >= MP) {
#pragma unroll
                for (int j = 0; j < 8; ++j) { ((GAS f32x4*)(F.out + (size_t)m * D))[64 * j + F.lane] = v2[0][j]; ((GAS f32x4*)(F.out + (size_t)m2 * D))[64 * j + F.lane] = v2[1][j]; } }
            norm_rows<2>(F, l, which, mr, v2, g4, MOD, H, DT, wdt); m += 2 * F.ngw; }
        else { f32x4 v1[1][8]; const int mr[1] = {m}; const GAS f32x4* xa = (const GAS f32x4*)((first ? (m < MP ? xpp + (size_t)m * D : xsp + (size_t)(m - MP) * D) : F.out + (size_t)m * D));
#pragma unroll
            for (int j = 0; j < 8; ++j) v1[0][j] = xa[64 * j + F.lane];
            if (first && m >= MP) {
#pragma unroll
                for (int j = 0; j < 8; ++j) ((GAS f32x4*)(F.out + (size_t)m * D))[64 * j + F.lane] = v1[0][j]; }
            norm_rows<1>(F, l, which, mr, v1, g4, MOD, H, DT, wdt); m += F.ngw; } }
}
__device__ __forceinline__ void final_fix_phase(Frame& F, int nsl) {
    LAS float* partl = (LAS float*)(F.lds + 65536); f32x4 v[8];
    __syncthreads();
    for (int ms = (int)blockIdx.x; ms < MS; ms += F.G) { sample_row_reduce(F, ms, nsl, v, partl); __syncthreads(); }
}
template <int MODE> __device__ __forceinline__ unsigned ssd_raw(const GAS bf16* PROJ, const GAS float* scv, int l, int b, int m0, int tseq0, int r, int ch) {
    if (MODE == 2) { const int rp = r < 0 ? 0 : (r > 7 ? 7 : r), rs = r < 0 ? 3 + r : 0;
        const unsigned a = *(const GAS unsigned*)(PROJ + (size_t)(m0 + rp) * NPROJ + C_CX + ch); const GAS float* sc = scv + ((size_t)(l * BS + b) * 3 + rs) * 1024 + ch; const unsigned c = pk2(sc[0], sc[1]);
        return r < 0 ? c : (r > 7 ? 0u : a); }
    const int rc = (tseq0 + r >= 0) ? r : -tseq0; const unsigned a = *(const GAS unsigned*)(PROJ + (size_t)(m0 + rc) * NPROJ + C_CX + ch);
    return (tseq0 + r >= 0) ? a : 0u;
}
template <int MODE> __device__ __forceinline__ void ssd_unit(Frame& F, int l, int u) {
    WS_LOCALS
    constexpr int T = (MODE == 2) ? 16 : 64, SK = (MODE == 2) ? 32 : 64, L = (MODE == 2) ? 8 : 64, LDN = 136, LDS_ = SK + 8;
    constexpr int NT_CB = (T / 16) * (SK / 16), NT_Y = (T / 16) * 4;
    constexpr int OFF_BG = (MODE == 0 ? 0 : T * LDN * 2), OFF_BGT = OFF_BG + (MODE == 0 ? 0 : T * LDN * 2), OFF_XT = OFF_BGT + (MODE == 1 ? 0 : 128 * LDS_ * 2), OFF_XWT = OFF_XT + (MODE == 0 ? 0 : 4 * 64 * LDS_ * 2),
                  OFF_WL = OFF_XWT + (MODE == 1 ? 0 : 4 * 64 * LDS_ * 2), OFF_SM = OFF_WL + (MODE == 0 ? 0 : 4 * T * LDS_ * 2);
    constexpr int OFF_S0 = (MODE == 2) ? OFF_SM + 2304 : 0;
    static_assert(OFF_SM + 2304 <= RING_BYTES && (MODE != 2 || OFF_S0 + 2 * 64 * 136 * 2 <= RING_BYTES) && (MODE != 1 || 2 * 64 * 136 * 2 <= OFF_XT), "ssd LDS map");
    const int tid0 = F.tid, lane0 = F.lane, wave = F.wave;
    const GAS float* const cwp = INP(I_CW); const GAS float* const cbp = INP(I_CB); const GAS float* const scv = INP(I_SCONV);
    int b, m0, tseq0;
    if (MODE == 2) { b = u; m0 = MP + b * TS; tseq0 = 0; } else { b = u >> 6; m0 = b * TP + (u & 63) * 64; tseq0 = (u & 63) * 64; }
    LAS bf16* Cg = (LAS bf16*)F.lds;
    LAS bf16* Bg = (LAS bf16*)(F.lds + OFF_BG);
    LAS bf16* BgT = (LAS bf16*)(F.lds + OFF_BGT);
    LAS bf16* xT = (LAS bf16*)(F.lds + OFF_XT);
    LAS bf16* xwT = (LAS bf16*)(F.lds + OFF_XWT);
    LAS bf16* Wl = (LAS bf16*)(F.lds + OFF_WL);
    LAS float* cumL = (LAS float*)(F.lds + OFF_SM);
    LAS float* dtL = cumL + 256;
    LAS float* rowss = dtL + 256;
    GAS float* const ytmp = (GAS float*)wsp(F, WS_YTMP) + (size_t)blockIdx.x * (64 * 512);
    float ssum[4] = {0.f, 0.f, 0.f, 0.f};
    if (tid0 < 64) rowss[tid0] = 0.f;
#pragma unroll 1
    for (int g = 0; g < 2; ++g) {
        int tid = tid0, lane = lane0; asm volatile("" : "+v"(tid), "+v"(lane));
        __syncthreads();
        if (MODE == 1) UTS(0);
        if (wave < 4) { const int hh = g * 4 + wave; float dtv = 0.f, a = 0.f;
            { const int tl = lane < L ? lane : L - 1; const float raw = DT[(size_t)(m0 + tl) * 8 + hh] + INP(I_DTB)[l * 8 + hh]; const float dt1 = raw > 20.f ? raw : log1pf(__expf(raw)); const float a1 = -dt1 * __expf(INP(I_ALOG)[l * 8 + hh]);
              dtv = lane < L ? dt1 : 0.f; a = lane < L ? a1 : 0.f; }
#pragma unroll
            for (int o = 1; o < 64; o <<= 1) { const float y = __shfl_up(a, o); if (lane >= o) a += y; }
            cumL[lane * 4 + wave] = a; dtL[lane * 4 + wave] = dtv; }
        {   const int pr = tid & 127, rq = tid >> 7;
            const int isC = pr >> 6, n0 = 2 * (pr & 63), ch = 512 + isC * 256 + g * 128 + n0;
            if (MODE != 0 || !isC) {
                float w[4][2], bia[2];
#pragma unroll
                for (int j = 0; j < 4; ++j) { w[j][0] = cwp[(l * 4 + j) * 1024 + ch]; w[j][1] = cwp[(l * 4 + j) * 1024 + ch + 1]; }
                bia[0] = cbp[l * 1024 + ch]; bia[1] = cbp[l * 1024 + ch + 1];
                constexpr int RQ = T / 4; const int r0 = rq * RQ;
                unsigned ra[RQ + 3];
#pragma unroll
                for (int i = 0; i < RQ + 3; ++i) ra[i] = ssd_raw<MODE>(PROJ, scv, l, b, m0, tseq0, r0 - 3 + i, ch);
#pragma unroll
                for (int i = 0; i < RQ; ++i) { const int r = r0 + i; float c0 = 0.f, c1 = 0.f;
                    if (r < L) { c0 = bia[0] + w[0][0] * bflo(ra[i]) + w[1][0] * bflo(ra[i + 1]) + w[2][0] * bflo(ra[i + 2]) + w[3][0] * bflo(ra[i + 3]); c1 = bia[1] + w[0][1] * bfhi(ra[i]) + w[1][1] * bfhi(ra[i + 1]) + w[2][1] * bfhi(ra[i + 2]) + w[3][1] * bfhi(ra[i + 3]);
                        c0 = c0 * sigm(c0); c1 = c1 * sigm(c1); }
                    if (isC) { if (MODE != 0) *(LAS unsigned*)(Cg + r * LDN + n0) = pk2(c0, c1); }
                    else { if (MODE != 0) *(LAS unsigned*)(Bg + r * LDN + n0) = pk2(c0, c1);
                           if (MODE != 1) { BgT[n0 * LDS_ + r] = tobf(c0); BgT[(n0 + 1) * LDS_ + r] = tobf(c1); } } }
                if (MODE == 2 && !isC) { for (int r = T + rq * 4; r < T + rq * 4 + 4; ++r) { BgT[n0 * LDS_ + r] = 0; BgT[(n0 + 1) * LDS_ + r] = 0; } }
            }
        }
        __syncthreads();
        if (MODE == 1) { UTE(0); UTS(1); }
        { int t_ = tid0, l_ = lane0; asm volatile("" : "+v"(t_), "+v"(l_)); tid = t_; lane = l_; }
        {   const int pr = tid & 127, rq = tid >> 7, r = pr >> 5, pp = pr & 31; const int ch = (g * 4 + r) * 64 + 2 * pp;
            float w[4][2], bia[2];
#pragma unroll
            for (int j = 0; j < 4; ++j) { w[j][0] = cwp[(l * 4 + j) * 1024 + ch]; w[j][1] = cwp[(l * 4 + j) * 1024 + ch + 1]; }
            bia[0] = cbp[l * 1024 + ch]; bia[1] = cbp[l * 1024 + ch + 1];
            constexpr int RS = SK / 4; const int r0 = rq * RS;
            const float cl = cumL[(L - 1) * 4 + r];
            unsigned ra[RS + 3];
#pragma unroll
            for (int i = 0; i < RS + 3; ++i) ra[i] = ssd_raw<MODE>(PROJ, scv, l, b, m0, tseq0, r0 - 3 + i, ch);
            LAS bf16* x0 = xT + (r * 64 + 2 * pp) * LDS_; LAS bf16* xw0 = xwT + (r * 64 + 2 * pp) * LDS_;
#pragma unroll
            for (int i = 0; i < RS; ++i) { const int s = r0 + i; float c0 = 0.f, c1 = 0.f, ws = 0.f;
                if (s < L) { c0 = bia[0] + w[0][0] * bflo(ra[i]) + w[1][0] * bflo(ra[i + 1]) + w[2][0] * bflo(ra[i + 2]) + w[3][0] * bflo(ra[i + 3]); c1 = bia[1] + w[0][1] * bfhi(ra[i]) + w[1][1] * bfhi(ra[i + 1]) + w[2][1] * bfhi(ra[i + 2]) + w[3][1] * bfhi(ra[i + 3]);
                    c0 = c0 * sigm(c0); c1 = c1 * sigm(c1); ws = dtL[s * 4 + r] * __expf(cl - cumL[s * 4 + r]); }
                if (MODE != 0) { x0[s] = tobf(c0); x0[LDS_ + s] = tobf(c1); }
                if (MODE != 1) { xw0[s] = tobf(c0 * ws); xw0[LDS_ + s] = tobf(c1 * ws); } }
        }
        if (MODE != 0) {
#pragma unroll
            for (int j = 0; j < 2; ++j) { const int id = 2 * wave + j; if (id < NT_CB) { const int ti = id / (SK / 16), si = id % (SK / 16); f32x4 cb = (f32x4){0.f, 0.f, 0.f, 0.f};
                if (!(MODE == 2 && si > 0) && si <= ti) cb = mma16(Cg + ti * 16 * LDN, LDN, Bg + si * 16 * LDN, LDN, 128, cb, lane);
#pragma unroll
                for (int r = 0; r < 4; ++r)
#pragma unroll
                    for (int i = 0; i < 4; ++i) { const int t = ti * 16 + 4 * (lane >> 4) + i, s = si * 16 + (lane & 15);
                        float wv = 0.f; if (s <= t && (MODE != 2 || t < L)) wv = cb[i] * __expf(cumL[t * 4 + r] - cumL[s * 4 + r]) * dtL[s * 4 + r];
                        Wl[(r * T + t) * LDS_ + s] = tobf(wv); } } }
        }
        __syncthreads();
        if (MODE == 1) { UTE(1); UTS(2); }
        { int t_ = tid0, l_ = lane0; asm volatile("" : "+v"(t_), "+v"(l_)); tid = t_; lane = l_; }
        if (MODE != 0) {
            LAS bf16* Sl = (LAS bf16*)(F.lds + OFF_S0);
            const bool ywave = 2 * wave < NT_Y; const int ti = (2 * wave) >> 2;
            bf16x8v ca[4];
#pragma unroll
            for (int ks = 0; ks < 4; ++ks) ca[ks] = *(const LAS bf16x8v*)(Cg + (ti * 16 + (lane & 15)) * LDN + ks * 32 + 8 * (lane >> 4));
            const GAS float* dskp = INP(I_DSK) + l * 8 + g * 4; const float dsk4[4] = {dskp[0], dskp[1], dskp[2], dskp[3]};
#pragma unroll
            for (int half = 0; half < 2; ++half) {
                float zv[2][2][4];
                if (ywave) {
#pragma unroll
                    for (int rr = 0; rr < 2; ++rr)
#pragma unroll
                        for (int j = 0; j < 2; ++j)
#pragma unroll
                            for (int i = 0; i < 4; ++i) { const int t = ti * 16 + 4 * (lane >> 4) + i, p = ((2 * wave + j) & 3) * 16 + (lane & 15); const int tc = t < L ? t : L - 1; zv[rr][j][i] = bf2f(PROJ[(size_t)(m0 + tc) * NPROJ + C_CZ + (g * 4 + 2 * half + rr) * 64 + p]); } }
                __syncthreads();
                for (int e = tid; e < 4096; e += NTHR) { const int rr = e >> 11, e2 = e & 2047, hh_ = g * 4 + 2 * half + rr;
                    const f32x4 v = ((const GAS f32x4*)(MODE == 1 ? SDSS + ((size_t)u * 8 + hh_) * 8192 : INP(I_SSSM) + ((size_t)(l * BS + b) * 8 + hh_) * 8192))[e2]; const int p = e2 >> 5, n4 = (e2 & 31) * 4;
                    *(LAS unsigned*)(Sl + (rr * 64 + p) * LDN + n4) = pk2(v.x, v.y); *(LAS unsigned*)(Sl + (rr * 64 + p) * LDN + n4 + 2) = pk2(v.z, v.w); }
                __syncthreads();
                if (ywave) {
#pragma unroll
                    for (int rr = 0; rr < 2; ++rr)
#pragma unroll
                        for (int j = 0; j < 2; ++j) { const int r = 2 * half + rr, hh = g * 4 + r, pj = (2 * wave + j) & 3;
                            f32x4 y1 = (f32x4){0.f, 0.f, 0.f, 0.f}, y2 = y1;
                            y1 = mma16(Wl + (r * T + ti * 16) * LDS_, LDS_, xT + (r * 64 + pj * 16) * LDS_, LDS_, SK, y1, lane);
#pragma unroll
                            for (int ks = 0; ks < 4; ++ks) y2 = __builtin_amdgcn_mfma_f32_16x16x32_bf16(ca[ks], *(const LAS bf16x8v*)(Sl + (rr * 64 + pj * 16 + (lane & 15)) * LDN + ks * 32 + 8 * (lane >> 4)), y2, 0, 0, 0);
                            const int p = pj * 16 + (lane & 15); const float dsk = dsk4[r];
#pragma unroll
                            for (int i = 0; i < 4; ++i) { const int t = ti * 16 + 4 * (lane >> 4) + i;
                                if (MODE != 2 || t < L) { const float xv = bf2f(xT[(r * 64 + p) * LDS_ + t]); const float z = zv[rr][j][i];
                                    const float yy = (y1[i] + __expf(cumL[t * 4 + r]) * y2[i] + dsk * xv) * z * sigm(z); ssum[i] += yy * yy; ytmp[t * 512 + hh * 64 + p] = yy; } } } }
            }
        }
        if (MODE == 1) UTE(2);
        if (MODE != 1) {
            const int r = wave >> 1, hh = g * 4 + r; const float dtot = __expf(cumL[(L - 1) * 4 + r]);
#pragma unroll 1
            for (int pi = 0; pi < 4; ++pi) { f32x4 d[4]; float sv[4][4];
                const size_t sb0 = ((size_t)(l * BS + b) * 8 + hh) * 8192; const GAS float* sin_ = (MODE == 2) ? INP(I_SSSM) + sb0 : nullptr;
                if (MODE == 2) {
#pragma unroll
                    for (int j = 0; j < 4; ++j)
#pragma unroll
                        for (int i = 0; i < 4; ++i) sv[j][i] = sin_[(pi * 16 + 4 * (lane >> 4) + i) * 128 + (4 * (wave & 1) + j) * 16 + (lane & 15)]; }
#pragma unroll
                for (int j = 0; j < 4; ++j) { const int nj = 4 * (wave & 1) + j; d[j] = (f32x4){0.f, 0.f, 0.f, 0.f}; d[j] = mma16(xwT + (r * 64 + pi * 16) * LDS_, LDS_, BgT + nj * 16 * LDS_, LDS_, SK, d[j], lane); }
#pragma unroll
                for (int j = 0; j < 4; ++j) { const int n = (4 * (wave & 1) + j) * 16 + (lane & 15);
#pragma unroll
                    for (int i = 0; i < 4; ++i) { const int p = pi * 16 + 4 * (lane >> 4) + i;
                        if (MODE == 0) SDDS[((size_t)u * 8 + hh) * 8192 + p * 128 + n] = d[j][i]; else F.out[O_SSSM + sb0 + p * 128 + n] = dtot * sv[j][i] + d[j][i]; } } }
            if (MODE == 0 && (lane & 63) == 0 && (wave & 1) == 0) SDDEC[u * 8 + hh] = dtot;
        }
    }
    const int tid = tid0, lane = lane0;
    if (MODE == 1) UTS(3);
    if (MODE != 0) {
#pragma unroll
        for (int i = 0; i < 4; ++i) { float s = ssum[i]; s += __shfl_xor(s, 1); s += __shfl_xor(s, 2); s += __shfl_xor(s, 4); s += __shfl_xor(s, 8);
            const int id = 2 * wave; if (id < NT_Y && (lane & 15) == 0) __hip_atomic_fetch_add(&rowss[(id >> 2) * 16 + 4 * (lane >> 4) + i], s, __ATOMIC_RELAXED, __HIP_MEMORY_SCOPE_WORKGROUP); }
        __syncthreads();
        const GAS float* ngp = INP(I_SNG) + l * 512;
        if (2 * wave < NT_Y) {
            float rinv[4];
#pragma unroll
            for (int i = 0; i < 4; ++i) { const int t = ((2 * wave) >> 2) * 16 + 4 * (lane >> 4) + i; rinv[i] = rsq(rowss[t] * (1.f / 512.f) + EPS); }
#pragma unroll 1
            for (int gh = 0; gh < 2; ++gh) { float yv[4][2][4], ngv[4][2];
#pragma unroll
                for (int g4 = 0; g4 < 4; ++g4)
#pragma unroll
                    for (int j = 0; j < 2; ++j) { const int id = 2 * wave + j, ti = id >> 2, pj = id & 3, chn = (gh * 4 + g4) * 64 + pj * 16 + (lane & 15); ngv[g4][j] = ngp[chn];
#pragma unroll
                        for (int i = 0; i < 4; ++i) { const int t = ti * 16 + 4 * (lane >> 4) + i; yv[g4][j][i] = ytmp[(t < L ? t : 0) * 512 + chn]; } }
#pragma unroll
                for (int g4 = 0; g4 < 4; ++g4)
#pragma unroll
                    for (int j = 0; j < 2; ++j) { const int id = 2 * wave + j, ti = id >> 2, pj = id & 3, chn = (gh * 4 + g4) * 64 + pj * 16 + (lane & 15);
#pragma unroll
                        for (int i = 0; i < 4; ++i) { const int t = ti * 16 + 4 * (lane >> 4) + i; if (MODE != 2 || t < L) MIX[(size_t)(m0 + t) * D + 1024 + chn] = tobf(yv[g4][j][i] * rinv[i] * ngv[g4][j]); } } }
        }
    }
    if (MODE == 1) { __syncthreads(); UTE(3); }
    if (MODE == 0 && (u & 63) == 63) for (int e = tid; e < 3 * 1024; e += NTHR) { const int j = e >> 10, c2 = e & 1023; F.out[O_PCONV + ((size_t)(l * BP + b) * 3 + j) * 1024 + c2] = bf2f(PROJ[(size_t)(m0 + 61 + j) * NPROJ + C_CX + c2]); }
    if (MODE == 2) for (int e = tid; e < 3 * 1024; e += NTHR) { const int j = e >> 10, c2 = e & 1023; F.out[O_SCONV + ((size_t)(l * BS + b) * 3 + j) * 1024 + c2] = bf2f(PROJ[(size_t)(m0 + 5 + j) * NPROJ + C_CX + c2]); }
}
template <int MODE> __device__ __forceinline__ void hgrn_unit(Frame& F, int l, int u) {
    WS_LOCALS
    constexpr int T = (MODE == 2) ? 16 : 64, SK = (MODE == 2) ? 32 : 64, L = (MODE == 2) ? 8 : 64, MID = (MODE == 2) ? 3 : 31, LDN = 136, LDS_ = SK + 8, NI = T / 4;
    constexpr int OFF_QT = T * 512, OFF_KT = OFF_QT + T * 272, OFF_KTT = OFF_KT + T * 272, OFF_VT = OFF_KTT + (MODE == 1 ? 0 : 128 * LDS_ * 2), OFF_S0T = OFF_VT + 128 * LDS_ * 2, OFF_AM = OFF_S0T + (MODE == 0 ? 0 : 128 * 272), OFF_END = OFF_AM + T * LDS_ * 2;
    static_assert(OFF_END <= RING_BYTES, "hgrn LDS map");
    const int tid = F.tid, lane = F.lane, wave = F.wave, d = tid & 127, tq = tid >> 7;
    int h, m0; size_t sidx;
    if (MODE == 2) { const int b = u >> 2; h = u & 3; m0 = MP + b * TS; sidx = ((size_t)(l * BS + b) * 4 + h) * 16384; }
    else { const int bh = u >> 6, c = u & 63, b = bh >> 2; h = bh & 3; m0 = b * TP + c * 64; sidx = (size_t)u * 16384; }
    LAS float* cum = (LAS float*)F.lds;
    LAS bf16* qt = (LAS bf16*)(F.lds + OFF_QT);
    LAS bf16* kt = (LAS bf16*)(F.lds + OFF_KT);
    LAS bf16* ktT = (LAS bf16*)(F.lds + OFF_KTT);
    LAS bf16* vT = (LAS bf16*)(F.lds + OFF_VT);
    LAS bf16* S0T = (LAS bf16*)(F.lds + OFF_S0T);
    LAS bf16* Am = (LAS bf16*)(F.lds + OFF_AM);
    LAS float* refv = (LAS float*)(F.lds + RING_BYTES + 2048);
    LAS float* efin = refv + 128; LAS float* decv = efin + 128; LAS float* erefv = decv + 128; LAS float* rowss = erefv + 128;
    const GAS float* S0g = (MODE == 1 ? HGSS : INP(I_SHG)) + sidx;
    __syncthreads();
    float qv[NI], kv[NI], vv[NI];
    {   const float lbv = LBv[l * 512 + h * 128 + d];
#pragma unroll
        for (int i = 0; i < NI; ++i) { const int t = tq + 4 * i; float lf = 0.f, q = 0.f, k = 0.f, v = 0.f;
            { const int tc = t < L ? t : L - 1; const GAS bf16* row = PROJ + (size_t)(m0 + tc) * NPROJ + h * 128 + d; const float fr = bf2f(row[C_AF]), qr = bf2f(row[C_AQ]), v1 = bf2f(row[C_AI]);
                const float e = __expf(-fr); const float sg = 1.f / (1.f + e); const float fg = lbv + (1.f - lbv) * sg;
                const bool ok = t < L; lf = ok ? __logf(fg) : 0.f; k = ok ? (1.f - lbv) * (e / (1.f + e)) : 0.f; q = ok ? qr * sigm(qr) : 0.f; v = ok ? v1 : 0.f; }
            cum[t * 128 + d] = lf; qv[i] = q; kv[i] = k; vv[i] = v; }
        if (tid < 64) rowss[tid] = 0.f;
    }
    __syncthreads();
    if (tid < 128) { float a = 0.f, rf = 0.f;
#pragma unroll 16
        for (int t = 0; t < L; ++t) { a += cum[t * 128 + tid]; cum[t * 128 + tid] = a; if (t == MID) rf = a; }
        refv[tid] = rf; efin[tid] = __expf(a - rf); decv[tid] = __expf(a); erefv[tid] = __expf(rf); }
    __syncthreads();
    {   const float rf = refv[d];
#pragma unroll
        for (int i = 0; i < NI; ++i) { const int t = tq + 4 * i; const float c = (t < L) ? cum[t * 128 + d] : rf;
            const float qs = qv[i] * __expf(fminf(c - rf, 80.f)), ks = kv[i] * __expf(fminf(rf - c, 80.f));
            if (MODE != 0) { qt[t * LDN + d] = tobf(qs); kt[t * LDN + d] = tobf(ks); }
            if (MODE != 1) ktT[d * LDS_ + t] = tobf(ks);
            vT[d * LDS_ + t] = tobf(vv[i]); }
        if (MODE == 2) {
#pragma unroll
            for (int i = 0; i < NI; ++i) { const int t = 16 + tq + 4 * i; ktT[d * LDS_ + t] = 0; vT[d * LDS_ + t] = 0; } }
    }
    if (MODE == 1) for (int e = tid; e < 4096; e += NTHR) { const f32x4 s = ((const GAS f32x4*)S0g)[e]; const int v = e >> 5, d4 = (e & 31) * 4; const f32x4 er = *(const LAS f32x4*)(erefv + d4);
        *(LAS unsigned*)(S0T + v * LDN + d4) = pk2(s.x * er.x, s.y * er.y); *(LAS unsigned*)(S0T + v * LDN + d4 + 2) = pk2(s.z * er.z, s.w * er.w); }
    if (MODE == 2) for (int e = tid; e < 4096; e += NTHR) { const f32x4 s = ((const GAS f32x4*)S0g)[e]; const int dd = e >> 5, v4 = (e & 31) * 4; const float er = erefv[dd];
        S0T[(v4) * LDN + dd] = tobf(s.x * er); S0T[(v4 + 1) * LDN + dd] = tobf(s.y * er); S0T[(v4 + 2) * LDN + dd] = tobf(s.z * er); S0T[(v4 + 3) * LDN + dd] = tobf(s.w * er); }
    __syncthreads();
    if (MODE != 0) {
#pragma unroll
        for (int j = 0; j < 2; ++j) { const int id = 2 * wave + j; if (id < (T / 16) * (SK / 16)) { const int ti = id / (SK / 16), si = id % (SK / 16);
            f32x4 a = (f32x4){0.f, 0.f, 0.f, 0.f};
            if (si <= ti && si < T / 16) a = mma16(qt + ti * 16 * LDN, LDN, kt + si * 16 * LDN, LDN, 128, a, lane);
#pragma unroll
            for (int i = 0; i < 4; ++i) { const int t = ti * 16 + 4 * (lane >> 4) + i, s = si * 16 + (lane & 15); Am[t * LDS_ + s] = tobf((s <= t && si <= ti && si < T / 16) ? a[i] : 0.f); } } }
        __syncthreads();
        f32x4 o[4]; float ssum[4] = {0.f, 0.f, 0.f, 0.f};
#pragma unroll
        for (int j = 0; j < 4; ++j) { const int id = 4 * wave + j; o[j] = (f32x4){0.f, 0.f, 0.f, 0.f};
            if (id < (T / 16) * 8) { const int ti = id >> 3, vj = id & 7;
                o[j] = mma16(Am + ti * 16 * LDS_, LDS_, vT + vj * 16 * LDS_, LDS_, SK, o[j], lane);
                o[j] = mma16(qt + ti * 16 * LDN, LDN, S0T + vj * 16 * LDN, LDN, 128, o[j], lane);
#pragma unroll
                for (int i = 0; i < 4; ++i) ssum[i] += o[j][i] * o[j][i]; } }
        if (4 * wave < (T / 16) * 8) {
#pragma unroll
            for (int i = 0; i < 4; ++i) { float s = ssum[i]; s += __shfl_xor(s, 1); s += __shfl_xor(s, 2); s += __shfl_xor(s, 4); s += __shfl_xor(s, 8);
                if ((lane & 15) == 0) __hip_atomic_fetch_add(&rowss[((4 * wave) >> 3) * 16 + 4 * (lane >> 4) + i], s, __ATOMIC_RELAXED, __HIP_MEMORY_SCOPE_WORKGROUP); } }
        __syncthreads();
        const GAS float* ngp = INP(I_HNG) + l * 512 + h * 128;
        float grv[4][4], ngv[4];
#pragma unroll
        for (int j = 0; j < 4; ++j) { const int id = 4 * wave + j, ti = (id >> 3) & (T / 16 - 1), vj = id & 7, v = vj * 16 + (lane & 15); ngv[j] = ngp[v];
#pragma unroll
            for (int i = 0; i < 4; ++i) { const int t = ti * 16 + 4 * (lane >> 4) + i; const int tc = t < L ? t : L - 1; grv[j][i] = bf2f(PROJ[(size_t)(m0 + tc) * NPROJ + C_AG + h * 128 + v]); } }
#pragma unroll
        for (int j = 0; j < 4; ++j) { const int id = 4 * wave + j; if (id < (T / 16) * 8) { const int ti = id >> 3, vj = id & 7, v = vj * 16 + (lane & 15);
#pragma unroll
            for (int i = 0; i < 4; ++i) { const int t = ti * 16 + 4 * (lane >> 4) + i;
                if (MODE != 2 || t < L) MIX[(size_t)(m0 + t) * D + h * 128 + v] = tobf(o[j][i] * rsq(rowss[t] * (1.f / 128.f) + EPS) * ngv[j] * sigm(grv[j][i])); } } }
    }
    if (MODE != 1) {
        float sv[8][4];
        if (MODE == 2) {
#pragma unroll
            for (int j = 0; j < 8; ++j)
#pragma unroll
                for (int i = 0; i < 4; ++i) sv[j][i] = S0g[(wave * 16 + 4 * (lane >> 4) + i) * 128 + j * 16 + (lane & 15)]; }
#pragma unroll
        for (int j = 0; j < 8; ++j) { f32x4 a = (f32x4){0.f, 0.f, 0.f, 0.f}; a = mma16(ktT + wave * 16 * LDS_, LDS_, vT + j * 16 * LDS_, LDS_, SK, a, lane);
            const int v = j * 16 + (lane & 15);
            if (MODE == 0) { const int d0 = wave * 16 + 4 * (lane >> 4); const f32x4 ef = *(const LAS f32x4*)(efin + d0);
                *(GAS f32x4*)(HGDS + sidx + v * 128 + d0) = (f32x4){ef.x * a[0], ef.y * a[1], ef.z * a[2], ef.w * a[3]}; }
            else {
#pragma unroll
                for (int i = 0; i < 4; ++i) { const int dd = wave * 16 + 4 * (lane >> 4) + i; F.out[O_SHG + sidx + dd * 128 + v] = decv[dd] * sv[j][i] + efin[dd] * a[i]; } } }
        if (MODE == 0 && tid < 128) HGDEC[u * 128 + tid] = decv[tid];
    }
}
__device__ __forceinline__ void scan_phase(Frame& F, int l) {
    WS_LOCALS
    const int gt = blockIdx.x * NTHR + F.tid, NT = F.G * NTHR;
    for (int e = gt; e < 131072; e += NT) {
        const int bh = e >> 14, vd = e & 16383, d = vd & 127, v = vd >> 7; const int bhh = e >> 13, b = bhh >> 3, hh = bhh & 7, pn = e & 8191;
        float Sh = 0.f, Ss = 0.f;
#pragma unroll 1
        for (int c0 = 0; c0 < 64; c0 += 8) { float dh[8], xh[8], ds[8], xs[8];
#pragma unroll
            for (int k = 0; k < 8; ++k) { const size_t u = (size_t)bh * 64 + c0 + k; const size_t idx = (size_t)(b * 64 + c0 + k) * 8 + hh; dh[k] = HGDEC[u * 128 + d]; xh[k] = HGDS[u * 16384 + vd]; ds[k] = SDDEC[idx]; xs[k] = SDDS[idx * 8192 + pn]; }
#pragma unroll
            for (int k = 0; k < 8; ++k) { const size_t u = (size_t)bh * 64 + c0 + k; const size_t idx = (size_t)(b * 64 + c0 + k) * 8 + hh;
                HGSS[u * 16384 + vd] = Sh; SDSS[idx * 8192 + pn] = Ss; Sh = dh[k] * Sh + xh[k]; Ss = ds[k] * Ss + xs[k]; } }
        F.out[O_PHG + ((size_t)l * 8 + bh) * 16384 + d * 128 + v] = Sh; F.out[O_PSSM + ((size_t)(l * BP + b) * 8 + hh) * 8192 + pn] = Ss; }
}
__device__ __forceinline__ float sq8(v4u w) { const float a0 = bflo(w.x), a1 = bfhi(w.x), a2 = bflo(w.y), a3 = bfhi(w.y), a4 = bflo(w.z), a5 = bfhi(w.z), a6 = bflo(w.w), a7 = bfhi(w.w);
    return ((a0 * a0 + a1 * a1) + (a2 * a2 + a3 * a3)) + ((a4 * a4 + a5 * a5) + (a6 * a6 + a7 * a7)); }
__device__ __forceinline__ float rope1(float x, float rn, float g, float c, float s, int dh) { const float xn = x * rn * g; const float other = __shfl_xor(xn, 1); return dh == 0 ? xn * c - other * s : xn * c + other * s; }
__device__ __forceinline__ v4u rope8(v4u w, float rn, const GAS float* g, const GAS float* rp, int dh) {
    v4u o;
    o.x = pk2(rope1(bflo(w.x), rn, g[0], rp[0], rp[32], dh), rope1(bfhi(w.x), rn, g[1], rp[1], rp[33], dh));
    o.y = pk2(rope1(bflo(w.y), rn, g[2], rp[2], rp[34], dh), rope1(bfhi(w.y), rn, g[3], rp[3], rp[35], dh));
    o.z = pk2(rope1(bflo(w.z), rn, g[4], rp[4], rp[36], dh), rope1(bfhi(w.z), rn, g[5], rp[5], rp[37], dh));
    o.w = pk2(rope1(bflo(w.w), rn, g[6], rp[6], rp[38], dh), rope1(bfhi(w.w), rn, g[7], rp[7], rp[39], dh));
    return o;
}
template <int SAMPLE> __device__ __forceinline__ void attn_unit(Frame& F, int l, int u) {
    WS_LOCALS
    constexpr int LDK = 72, LDV = 200, LDPW = 168;
    const int tid = F.tid, lane = F.lane, wave = F.wave;
    const GAS float* const ckp = INP(I_CK); const GAS float* const cvp = INP(I_CV);
    LAS bf16* Kb = (LAS bf16*)F.lds; LAS bf16* VT = Kb + 192 * LDK; LAS bf16* Qs = VT + 64 * LDV; LAS bf16* Pw = Qs + wave * 16 * LDPW;
    int b, g, q0, row_min; size_t mbase;
    if (SAMPLE) { b = u >> 1; g = u & 1; q0 = 0; row_min = 0; mbase = (size_t)MP + b * TS; }
    else { g = u & 1; const int qt = (u >> 1) & 63; b = u >> 7; q0 = qt * 64; row_min = q0 >= 127 ? 0 : 127 - q0; mbase = (size_t)b * TP; }
    __syncthreads();
    {   const int j8 = tid & 7; const GAS float* kg = INP(I_KNG) + l * 64 + 8 * j8;
        float kgv[8];
#pragma unroll
        for (int e = 0; e < 8; ++e) kgv[e] = kg[e];
        GAS float* const okp = F.out + (SAMPLE ? O_SK : O_PK); GAS float* const ovp = F.out + (SAMPLE ? O_SV : O_PV);
        const size_t ob = SAMPLE ? ((size_t)(l * BS + b) * 128) : ((size_t)(l * BP + b) * 128);
        const int roff = SAMPLE ? 8 : 63; const bool wr_cache = SAMPLE || q0 == TP - 64;
        for (int row = tid >> 3; row < 192; row += 64) {
            float ko[8], vo[8]; bool zero = false;
            if (SAMPLE && row < 128) { const GAS f32x4* kp = (const GAS f32x4*)(ckp + (((size_t)(l * BS + b) * 128 + row) * 2 + g) * 64 + 8 * j8); const GAS f32x4* vp = (const GAS f32x4*)(cvp + (((size_t)(l * BS + b) * 128 + row) * 2 + g) * 64 + 8 * j8);
                const f32x4 k0 = kp[0], k1 = kp[1], v0 = vp[0], v1 = vp[1];
                ko[0] = k0.x; ko[1] = k0.y; ko[2] = k0.z; ko[3] = k0.w; ko[4] = k1.x; ko[5] = k1.y; ko[6] = k1.z; ko[7] = k1.w; vo[0] = v0.x; vo[1] = v0.y; vo[2] = v0.z; vo[3] = v0.w; vo[4] = v1.x; vo[5] = v1.y; vo[6] = v1.z; vo[7] = v1.w; }
            else {
                int t, prow;
                if (SAMPLE) { t = row - 128; prow = 4096 + t; if (row >= 136) zero = true; } else { t = q0 - 127 + row; prow = t; if (t < 0 || row == 191) zero = true; }
                if (zero) {
#pragma unroll
                    for (int e = 0; e < 8; ++e) { ko[e] = 0.f; vo[e] = 0.f; } }
                else {
                    const GAS bf16* pr = PROJ + (mbase + t) * NPROJ;
                    const v4u kw = *(const GAS v4u*)(pr + C_DK + g * 64 + 8 * j8); const v4u vw = *(const GAS v4u*)(pr + C_DV + g * 64 + 8 * j8);
                    float kr[8] = {bflo(kw.x), bfhi(kw.x), bflo(kw.y), bfhi(kw.y), bflo(kw.z), bfhi(kw.z), bflo(kw.w), bfhi(kw.w)};
                    vo[0] = bflo(vw.x); vo[1] = bfhi(vw.x); vo[2] = bflo(vw.y); vo[3] = bfhi(vw.y); vo[4] = bflo(vw.z); vo[5] = bfhi(vw.z); vo[6] = bflo(vw.w); vo[7] = bfhi(vw.w);
                    float ss = 0.f;
#pragma unroll
                    for (int e = 0; e < 8; ++e) ss += kr[e] * kr[e];
                    ss += __shfl_xor(ss, 1); ss += __shfl_xor(ss, 2); ss += __shfl_xor(ss, 4);
                    const float rn = 1.f / sqrtf(ss * (1.f / 64.f) + EPS);
                    const GAS float* rp = ROPE + (size_t)prow * 64 + ((8 * j8) & 31);
#pragma unroll
                    for (int e = 0; e < 8; ++e) { const float kn = kr[e] * rn * kgv[e]; const float other = __shfl_xor(kn, 4); const float c = rp[e], s = rp[32 + e];
                        ko[e] = j8 < 4 ? kn * c - other * s : kn * c + other * s; }
                }
            }
            v4u kp4; kp4.x = pk2(ko[0], ko[1]); kp4.y = pk2(ko[2], ko[3]); kp4.z = pk2(ko[4], ko[5]); kp4.w = pk2(ko[6], ko[7]);
            *(LAS v4u*)(Kb + row * LDK + 8 * j8) = kp4;
#pragma unroll
            for (int e = 0; e < 8; ++e) VT[(8 * j8 + e) * LDV + row] = tobf(vo[e]);
            if (wr_cache && row >= roff && row < roff + 128) { const size_t o = ((ob + (row - roff)) * 2 + g) * 64 + 8 * j8;
                *(GAS f32x4*)(okp + o) = (f32x4){ko[0], ko[1], ko[2], ko[3]}; *(GAS f32x4*)(okp + o + 4) = (f32x4){ko[4], ko[5], ko[6], ko[7]};
                *(GAS f32x4*)(ovp + o) = (f32x4){vo[0], vo[1], vo[2], vo[3]}; *(GAS f32x4*)(ovp + o + 4) = (f32x4){vo[4], vo[5], vo[6], vo[7]}; }
        }
    }
    const bool qwave = !SAMPLE || wave == 0;
    if (qwave) {
        const int dh = lane & 1, qi = (lane >> 1) & 7, r = lane >> 4, head = g * 4 + r;
        const int t = SAMPLE ? qi : q0 + 8 * wave + qi; const int prow = SAMPLE ? 4096 + t : t;
        const GAS v4u* qp = (const GAS v4u*)(PROJ + (mbase + t) * NPROJ + C_DQ + head * 64 + 32 * dh);
        const v4u w0 = qp[0], w1 = qp[1], w2 = qp[2], w3 = qp[3];
        float ss = sq8(w0) + sq8(w1) + sq8(w2) + sq8(w3);
        ss += __shfl_xor(ss, 1);
        const float rn = 0.125f / sqrtf(ss * (1.f / 64.f) + EPS);
        const GAS float* qg = INP(I_QNG) + l * 64 + 32 * dh; const GAS float* rp = ROPE + (size_t)prow * 64;
        LAS v4u* qd = (LAS v4u*)(Qs + (32 * wave + 16 * (r >> 1) + 8 * (r & 1) + qi) * LDK + 32 * dh);
        qd[0] = rope8(w0, rn, qg, rp, dh); qd[1] = rope8(w1, rn, qg + 8, rp + 8, dh); qd[2] = rope8(w2, rn, qg + 16, rp + 16, dh); qd[3] = rope8(w3, rn, qg + 24, rp + 24, dh);
    }
    __syncthreads();
    bf16x8v qf[2][2];
    if (qwave) {
#pragma unroll
        for (int rt = 0; rt < 2; ++rt)
#pragma unroll
            for (int ks = 0; ks < 2; ++ks) qf[rt][ks] = *(const LAS bf16x8v*)(Qs + (32 * wave + 16 * rt + (lane & 15)) * LDK + 32 * ks + 8 * (lane >> 4));
    }
    __syncthreads();
    if (qwave) {
        const int ks0 = SAMPLE ? 0 : (8 * wave < 32 ? 8 * wave : 32);
        const GAS float* skp = INP(I_SINK) + l * 8 + g * 4;
#pragma unroll
        for (int rt = 0; rt < 2; ++rt) {
            f32x4 sc[10]; int kl = ks0 + (lane & 15); asm volatile("" : "+v"(kl));
#pragma unroll
            for (int c = 0; c < 10; ++c) { sc[c] = (f32x4){0.f, 0.f, 0.f, 0.f}; const LAS bf16* kp = Kb + (ks0 + 16 * c + (lane & 15)) * LDK + 8 * (lane >> 4);
                sc[c] = __builtin_amdgcn_mfma_f32_16x16x32_bf16(qf[rt][0], *(const LAS bf16x8v*)kp, sc[c], 0, 0, 0);
                sc[c] = __builtin_amdgcn_mfma_f32_16x16x32_bf16(qf[rt][1], *(const LAS bf16x8v*)(kp + 32), sc[c], 0, 0, 0); }
            float mx[4], sm[4], sinkv[4]; int klo[4]; unsigned span[4];
#pragma unroll
            for (int i = 0; i < 4; ++i) { const int row = 4 * (lane >> 4) + i, qi = row & 7; const int qrow = SAMPLE ? 128 + qi : 127 + 8 * wave + qi;
                sinkv[i] = skp[2 * rt + (row >> 3)]; mx[i] = sinkv[i]; sm[i] = 0.f;
                klo[i] = (qrow - 127) > row_min ? (qrow - 127) : row_min; span[i] = (unsigned)(qrow - klo[i]); }
#pragma unroll
            for (int c = 0; c < 10; ++c) { const int kr = kl + 16 * c;
#pragma unroll
                for (int i = 0; i < 4; ++i) { const float sv = ((unsigned)(kr - klo[i]) <= span[i]) ? sc[c][i] : -INFINITY; sc[c][i] = sv; mx[i] = fmaxf(mx[i], sv); } }
#pragma unroll
            for (int i = 0; i < 4; ++i) { float m = mx[i]; m = fmaxf(m, __shfl_xor(m, 1)); m = fmaxf(m, __shfl_xor(m, 2)); m = fmaxf(m, __shfl_xor(m, 4)); m = fmaxf(m, __shfl_xor(m, 8)); mx[i] = m; }
#pragma unroll
            for (int c = 0; c < 10; ++c) {
#pragma unroll
                for (int i = 0; i < 4; ++i) { const float p = __expf(sc[c][i] - mx[i]); sm[i] += p; Pw[(4 * (lane >> 4) + i) * LDPW + 16 * c + (lane & 15)] = tobf(p); } }
#pragma unroll
            for (int i = 0; i < 4; ++i) { float a = sm[i]; a += __shfl_xor(a, 1); a += __shfl_xor(a, 2); a += __shfl_xor(a, 4); a += __shfl_xor(a, 8); sm[i] = a + __expf(sinkv[i] - mx[i]); }
            asm volatile("s_waitcnt lgkmcnt(0)" ::: "memory");
#pragma unroll
            for (int dj = 0; dj < 4; ++dj) { f32x4 o = (f32x4){0.f, 0.f, 0.f, 0.f};
                o = mma16(Pw, LDPW, VT + dj * 16 * LDV + ks0, LDV, 160, o, lane);
#pragma unroll
                for (int i = 0; i < 4; ++i) { const int row = 4 * (lane >> 4) + i, qi = row & 7, head = g * 4 + 2 * rt + (row >> 3); const int t = SAMPLE ? qi : q0 + 8 * wave + qi;
                    MIX[(mbase + t) * D + 1536 + head * 64 + dj * 16 + (lane & 15)] = tobf(o[i] / sm[i]); } }
            asm volatile("s_waitcnt lgkmcnt(0)" ::: "memory");
        }
    }
}
template <int WIN> __device__ __forceinline__ void pool_rows_prompt(const GAS bf16* base, int ta, LAS bf16* pl, int LDP) {
    unsigned rw[47];
#pragma unroll
    for (int i = 0; i < 47; ++i) { const int t = ta - 15 + i; rw[i] = *(const GAS unsigned*)(base + (size_t)(t >= 0 ? t : 0) * NPROJ); if (t < 0) rw[i] = 0u; }
    float s0 = 0.f, s1 = 0.f;
#pragma unroll
    for (int j = 1; j < WIN; ++j) { s0 += bflo(rw[15 - j]); s1 += bfhi(rw[15 - j]); }
#pragma unroll
    for (int i = 0; i < 32; ++i) { const int t = ta + i; const float a0 = bflo(rw[15 + i]), a1 = bfhi(rw[15 + i]); s0 += a0; s1 += a1;
        const float ic = __builtin_amdgcn_rcpf((float)((t + 1) < WIN ? (t + 1) : WIN));
        *(LAS unsigned*)(pl + i * LDP) = pk2(s0 * ic - a0, s1 * ic - a1);
        s0 -= bflo(rw[15 + i - WIN + 1]); s1 -= bfhi(rw[15 + i - WIN + 1]); }
}
template <int WIN> __device__ __forceinline__ void pool_rows_sample(const GAS bf16* base, const GAS float* buf, LAS bf16* pl, int LDP) {
    float e0[23], e1[23];
#pragma unroll
    for (int i = 0; i < 15; ++i) { e0[i] = buf[(size_t)i * 512]; e1[i] = buf[(size_t)i * 512 + 1]; }
#pragma unroll
    for (int i = 0; i < 8; ++i) { const unsigned w = *(const GAS unsigned*)(base + (size_t)i * NPROJ); e0[15 + i] = bflo(w); e1[15 + i] = bfhi(w); }
    float s0 = 0.f, s1 = 0.f;
#pragma unroll
    for (int j = 1; j < WIN; ++j) { s0 += e0[15 - j]; s1 += e1[15 - j]; }
#pragma unroll
    for (int i = 0; i < 8; ++i) { s0 += e0[15 + i]; s1 += e1[15 + i];
        *(LAS unsigned*)(pl + i * LDP) = pk2(s0 * (1.f / WIN) - e0[15 + i], s1 * (1.f / WIN) - e1[15 + i]);
        s0 -= e0[15 + i - WIN + 1]; s1 -= e1[15 + i - WIN + 1]; }
}
__device__ __forceinline__ void pool_unit(Frame& F, int l, int u) {
    WS_LOCALS
    const int tid = F.tid, lane = F.lane, wave = F.wave;
    const GAS float* const spp = INP(I_SPOOL);
    LAS bf16* pl = (LAS bf16*)F.lds; constexpr int LDP = 520;
    const bool samp = u >= 128; const int b = samp ? 0 : (u >> 6), t0 = samp ? 0 : (u & 63) * 64; const int s8 = samp ? (u - 128) * 8 : 0;
    const size_t m0 = samp ? (size_t)MP + (size_t)s8 * TS : (size_t)b * TP + t0;
    __syncthreads();
    {   const int pr = tid & 255, half = tid >> 8, c0 = 2 * pr, gi = (wave & 3);
        if (!samp) { const GAS bf16* base = PROJ + ((size_t)b * TP) * NPROJ + C_PU + c0; LAS bf16* pp = pl + (half * 32) * LDP + c0; const int ta = t0 + half * 32;
            if (gi == 0) pool_rows_prompt<2>(base, ta, pp, LDP); else if (gi == 1) pool_rows_prompt<4>(base, ta, pp, LDP); else if (gi == 2) pool_rows_prompt<8>(base, ta, pp, LDP); else pool_rows_prompt<16>(base, ta, pp, LDP); }
        else {
#pragma unroll 1
            for (int q = 0; q < 4; ++q) { const int bq = half * 4 + q, bs = s8 + bq; const GAS bf16* base = PROJ + ((size_t)MP + (size_t)bs * TS) * NPROJ + C_PU + c0; const GAS float* buf = spp + ((size_t)(l * BS + bs) * 15) * 512 + c0; LAS bf16* pp = pl + (bq * 8) * LDP + c0;
                if (gi == 0) pool_rows_sample<2>(base, buf, pp, LDP); else if (gi == 1) pool_rows_sample<4>(base, buf, pp, LDP); else if (gi == 2) pool_rows_sample<8>(base, buf, pp, LDP); else pool_rows_sample<16>(base, buf, pp, LDP); } }
    }
    __syncthreads();
    {   const int g = wave >> 1; const GAS float* scp = INP(I_PSC) + l * 512 + g * 128;
        const GAS bf16* wpt = (const GAS bf16*)wsp(F, WS_WPT) + (size_t)(l * 4 + g) * 16384;
#pragma unroll 1
        for (int jj = 0; jj < 4; ++jj) { const int vj = 4 * (wave & 1) + jj;
            bf16x8v bfr[4];
#pragma unroll
            for (int k = 0; k < 4; ++k) bfr[k] = *(const GAS bf16x8v*)(wpt + (size_t)(vj * 16 + (lane & 15)) * 128 + k * 32 + 8 * (lane >> 4));
            const int dd = vj * 16 + (lane & 15); const float sc = scp[dd];
#pragma unroll
            for (int ti = 0; ti < 4; ++ti) { f32x4 acc = (f32x4){0.f, 0.f, 0.f, 0.f};
                const LAS bf16* ap = pl + (ti * 16 + (lane & 15)) * LDP + g * 128 + 8 * (lane >> 4);
#pragma unroll
                for (int k = 0; k < 4; ++k) acc = __builtin_amdgcn_mfma_f32_16x16x32_bf16(*(const LAS bf16x8v*)(ap + k * 32), bfr[k], acc, 0, 0, 0);
#pragma unroll
                for (int i = 0; i < 4; ++i) MIX[(m0 + ti * 16 + 4 * (lane >> 4) + i) * D + 512 + g * 128 + dd] = tobf(acc[i] * sc); } }
    }
    if (!samp && t0 == TP - 64) {
        float tv[15];
#pragma unroll
        for (int j = 0; j < 15; ++j) tv[j] = bf2f(PROJ[((size_t)b * TP + TP - 15 + j) * NPROJ + C_PU + tid]);
#pragma unroll
        for (int j = 0; j < 15; ++j) F.out[O_PPOOL + ((size_t)(l * BP + b) * 15 + j) * 512 + tid] = tv[j]; }
    if (samp) {
#pragma unroll 1
        for (int q = 0; q < 8; ++q) { const int bs = s8 + q; float tv[15];
#pragma unroll
            for (int j = 0; j < 15; ++j) tv[j] = j < 7 ? spp[((size_t)(l * BS + bs) * 15 + 8 + j) * 512 + tid] : bf2f(PROJ[((size_t)MP + (size_t)bs * TS + (j - 7)) * NPROJ + C_PU + tid]);
#pragma unroll
            for (int j = 0; j < 15; ++j) F.out[O_SPOOL + ((size_t)(l * BS + bs) * 15 + j) * 512 + tid] = tv[j]; } }
}
#ifndef TIME_MASK
#define TIME_MASK 0
#endif
#ifndef TIME_BLOCK
#define TIME_BLOCK 0
#endif
#define TSTART(bit) do { if ((TIME_MASK >> (bit)) & 1) tph = __builtin_amdgcn_s_memrealtime(); } while (0)
#define TSTOP(bit) do { if ((TIME_MASK >> (bit)) & 1) tacc += __builtin_amdgcn_s_memrealtime() - tph; } while (0)
#ifndef PROBE_MASK
#define PROBE_MASK 0
#endif
#ifndef PROBE_DUP
#define PROBE_DUP 0
#endif
#ifdef PH_SEL
#define PSEL(k, stmt) do { if ((k) == PH_SEL) { stmt; } } while (0)
#else
#define PSEL(k, stmt) do { stmt; } while (0)
#endif
struct Args { const float* in[N_IN]; float* out; unsigned char* ws; int ph_lo, ph_hi; };
static_assert(sizeof(Args) == (N_IN + 2) * 8 + 8, "Args has no padding");
__global__ void __launch_bounds__(NTHR, 2) hymba_fwd(Args args) {
    extern __shared__ __attribute__((aligned(16))) unsigned char lds[];
    Frame F;
    F.lds = (LAS unsigned char*)lds;
    F.MISC = (volatile LAS unsigned*)(F.lds + MISC_OFF);
    F.tid = threadIdx.x; F.lane = F.tid & 63; F.wave = __builtin_amdgcn_readfirstlane(F.tid >> 6);
    F.G = gridDim.x; F.gw = (int)blockIdx.x * NWAVES + F.wave; F.ngw = F.G * NWAVES;
    GAS unsigned char* ws = (GAS unsigned char*)args.ws; F.ws = ws; F.out = (GAS float*)args.out;
    F.ctl = (gu32*)(ws + WS_CTL);
    for (int u = F.tid; u < (LDS_BYTES - LDSCTL_OFF) / 4; u += NTHR) ((LAS unsigned*)(F.lds + LDSCTL_OFF))[u] = 0u;
    __syncthreads();
    if (F.tid < N_IN) ((LAS unsigned long long*)(F.lds + PTR_OFF))[F.tid] = (unsigned long long)args.in[F.tid];
    __syncthreads();
    const int lo = args.ph_lo, hi = args.ph_hi;
    XcdBarrier bar; bar.bar = (unsigned*)(F.ctl + CW_BAR); bar.x = 0; bar.st = nullptr;
    if (hi - lo > 1) bar = xcd_barrier_post((unsigned*)(F.ctl + CW_BAR), F.MISC + 8);
#define IN(k) (lo <= (k) && (k) < hi)
#define LAUNDER(P) asm volatile("" : "+v"(P.tid), "+v"(P.lane), "+s"(P.wave), "+s"(P.gw))
#define UL_DYN(bit, q, n, k, call) do { const int nrep_ = ((PROBE_MASK >> (bit)) & 1) ? 2 : 1; int nr_ = nrep_; asm volatile("" : "+s"(nr_)); for (int rr = 0; rr < nr_; ++rr) { Frame Q = F; LAUNDER(Q); while ((u = deq(Q, l * 32 + 16 * rr + (q))) < (n)) PSEL(k, call); } } while (0)
#define UL(bit, off, n, k, call) do { const int nrep_ = ((PROBE_MASK >> (bit)) & 1) ? 2 : 1; int nr_ = nrep_; asm volatile("" : "+s"(nr_)); for (int rr = 0; rr < nr_; ++rr) { Frame Q = F; LAUNDER(Q); for (u = ((int)blockIdx.x + F.G - ((off) % F.G)) % F.G; u < (n); u += F.G) { __syncthreads(); PSEL(k, call); } } } while (0)
#define PHASE_LOCALS Frame P = F; LAUNDER(P); WS_LOCALS
#define SEAM(k) do { if (IN(k) && IN((k) + 1)) xcd_barrier(bar); } while (0)
    unsigned long long tacc = 0, tph = 0; (void)tph;
    int rp_pro = (PROBE_DUP == 1) ? 2 : 1, rp_mix = (PROBE_DUP == 2) ? 2 : 1, rp_up = (PROBE_DUP == 3) ? 2 : 1, rp_in = (PROBE_DUP == 4) ? 2 : 1; asm volatile("" : "+s"(rp_pro), "+s"(rp_mix), "+s"(rp_up), "+s"(rp_in));
    TSTART(0); for (int rp = 0; rp < rp_pro; ++rp) { if (IN(0)) { PSEL(0, p0_prologue(F)); } SEAM(0); } TSTOP(0);
    for (int l = 0; l < DEPTH; ++l) {
        const int pb = 1 + l * PH_PER_LAYER;

        TSTART(1); if (IN(pb + 0)) { PHASE_LOCALS  PSEL(1, norm_phase(P, l, 0, l > 0 ? NSL_DN : 0)); } SEAM(pb + 0); TSTOP(1);
        for (int rq = 0; rq < rp_in; ++rq) {
        TSTART(2); if (IN(pb + 1)) { PHASE_LOCALS
            pg8::Gemm g{H, Wi + (size_t)l * NPROJ * D, M, NPROJ, D}; pg8::StaticOrder S; S.init(M, NPROJ, D, F.G, (int)blockIdx.x);
            pg8::EpiStoreBf16 E{PROJ, NPROJ, 0};
            PSEL(2, (pg8::gemm_phase<pg8::EpiStoreBf16, pg8::StaticOrder, true, true>(P.lds, g, S, E)));
            if (l + 1 < DEPTH && F.G == 256) convert_layer(P, l + 1, 115, 141, 0, 560);
            else if (l + 1 < DEPTH) convert_layer(P, l + 1, 0, F.G, 0, 560);
        } SEAM(pb + 1); TSTOP(2);
        }
        for (int rp = 0; rp < rp_mix; ++rp) {
        TSTART(3); if (IN(pb + 2)) { PHASE_LOCALS
            int u;
            TSTART(11); UL(3, 0, 128, 3, ssd_unit<0>(Q, l, u)); TSTOP(11);
            TSTART(12); UL(1, 0, 256, 4, attn_unit<0>(Q, l, u)); TSTOP(12);
            TSTART(13); UL(7, 0, 512, 5, hgrn_unit<0>(Q, l, u)); TSTOP(13);
            TSTART(14); UL(2, 128, 132, 6, pool_unit(Q, l, u)); TSTOP(14);
            TSTART(15); UL(3, 128, 32, 7, ssd_unit<2>(Q, l, u)); TSTOP(15);
            TSTART(16); UL(1, 160, 64, 8, attn_unit<1>(Q, l, u)); TSTOP(16);
            TSTART(17); UL(3, 0, 128, 9, hgrn_unit<2>(Q, l, u)); TSTOP(17);
        } SEAM(pb + 2); TSTOP(3);
        TSTART(4); if (IN(pb + 3)) { PHASE_LOCALS  { int nr_ = ((PROBE_MASK >> 4) & 1) ? 2 : 1; asm volatile("" : "+s"(nr_)); for (int rr = 0; rr < nr_; ++rr) PSEL(10, scan_phase(P, l)); } } SEAM(pb + 3); TSTOP(4);
        TSTART(5); if (IN(pb + 4)) { PHASE_LOCALS
            int u;
            TSTART(18); UL(5, 0, 128, 11, ssd_unit<1>(Q, l, u)); TSTOP(18);
            TSTART(19); { Frame Q = F; LAUNDER(Q); const int bx = (int)blockIdx.x; if (F.G == 256) { if (bx < 128) { __syncthreads(); hgrn_unit<1>(Q, l, 384 + bx); } else { for (u = bx - 128; u < 384; u += 128) { __syncthreads(); hgrn_unit<1>(Q, l, u); } } } else { for (u = bx; u < 512; u += F.G) { __syncthreads(); hgrn_unit<1>(Q, l, u); } } } TSTOP(19);
            {
                __syncthreads();
                pg8::Gemm g{MIX, Wo + (size_t)l * D * D, M, D, D}; pg8::SliceOrder S; S.init(MP / 256, D, D, NSL_OUT, F.G < 64 ? F.G : 64, ((int)blockIdx.x + F.G - (128 % F.G)) % F.G);
                pg8::EpiGateRes E{F.out, D, MOD + (size_t)l * NBB * NMOD + 2 * D, NMOD, (GAS float*)wsp(F, WS_PART), (l == 0 ? INP(I_XP) : (const GAS float*)F.out)};
                pg8::gemm_phase<pg8::EpiGateRes, pg8::SliceOrder, true, true>(P.lds, g, S, E); }
        } SEAM(pb + 4); TSTOP(5);
        }
        TSTART(6); if (IN(pb + 5)) { PHASE_LOCALS
            pg8::Gemm g{MIX, Wo + (size_t)l * D * D, M, D, D}; pg8::StaticOrder S; S.init(MP, D, D, F.G, (int)blockIdx.x);
            pg8::EpiGateRes E{F.out, D, MOD + (size_t)l * NBB * NMOD + 2 * D, NMOD, (GAS float*)wsp(F, WS_PART), (l == 0 ? INP(I_XP) : (const GAS float*)F.out)};
            PSEL(13, (pg8::gemm_phase<pg8::EpiGateRes, pg8::StaticOrder, true, true>(P.lds, g, S, E)));
        } SEAM(pb + 5); TSTOP(6);
        TSTART(7); if (IN(pb + 6)) { PHASE_LOCALS  PSEL(14, norm_phase(P, l, 1, NSL_OUT)); } SEAM(pb + 6); TSTOP(7);
        for (int rp = 0; rp < rp_up; ++rp) {
        TSTART(8); if (IN(pb + 7)) { PHASE_LOCALS
            pg8::Gemm g{H, Wu + (size_t)l * DFF * D, M, DFF, D}; pg8::StaticOrder S; S.init(M, DFF, D, F.G, (int)blockIdx.x);
            pg8::EpiStoreBf16 E{U, LDU, 1};
            PSEL(15, (pg8::gemm_phase<pg8::EpiStoreBf16, pg8::StaticOrder, true, true>(P.lds, g, S, E)));
            if (l + 1 < DEPTH) convert_layer(P, l + 1, 32, F.G - 32, 560, 1 << 30);
        } SEAM(pb + 7); TSTOP(8);
        }
        TSTART(9); if (IN(pb + 8)) { PHASE_LOCALS
            pg8::Gemm g{U, Wd + (size_t)l * D * LDU, M, D, LDU}; pg8::SplitOrder S; S.init(MP, D, DFF, NSL_DN, F.G, (int)blockIdx.x);
            pg8::EpiGateRes E{F.out, D, MOD + (size_t)l * NBB * NMOD + 5 * D, NMOD, (GAS float*)wsp(F, WS_PART), (const GAS float*)F.out};
            PSEL(16, (pg8::gemm_phase<pg8::EpiGateRes, pg8::SplitOrder, true, true>(P.lds, g, S, E)));
        } SEAM(pb + 8); TSTOP(9);
    }
    TSTART(10); if (IN(N_PHASES - 1)) { Frame P = F; LAUNDER(P); final_fix_phase(P, NSL_DN); } TSTOP(10);
    if (UT_MASK != 0) tacc += ((unsigned long long)F.MISC[17] << 32) | F.MISC[16];
    if ((TIME_MASK != 0 || UT_MASK != 0) && blockIdx.x == TIME_BLOCK) { const unsigned long long te = __builtin_amdgcn_s_memrealtime() + tacc; while (__builtin_amdgcn_s_memrealtime() < te) __builtin_amdgcn_s_sleep(8); }
#undef IN
#undef SEAM
}

extern "C" void kernel_launch(void* const* d_in, const int* in_sizes, int n_in, void* d_out, int out_size, void* d_ws, size_t ws_size, hipStream_t stream) {
    static int grid = 0;
    if (grid == 0) {
        if (n_in != N_IN || (size_t)out_size != O_END || ws_size < WS_END) { fprintf(stderr, "kernel_launch: unexpected shapes (n_in %d, out %d, ws %zu); nothing launched\n", n_in, out_size, ws_size); grid = -1; return; }
        int dev = 0, cus = 0, per_cu = 0;
        if (hipGetDevice(&dev) != hipSuccess || hipDeviceGetAttribute(&cus, hipDeviceAttributeMultiprocessorCount, dev) != hipSuccess) { grid = -1; return; }
        if (hipFuncSetAttribute((const void*)hymba_fwd, hipFuncAttributeMaxDynamicSharedMemorySize, LDS_BYTES) != hipSuccess) { fprintf(stderr, "kernel_launch: hipFuncSetAttribute failed\n"); grid = -1; return; }
        if (hipOccupancyMaxActiveBlocksPerMultiprocessor(&per_cu, (const void*)hymba_fwd, NTHR, LDS_BYTES) != hipSuccess || per_cu < 1) { fprintf(stderr, "kernel_launch: occupancy query says %d\n", per_cu); }
        (void)hipGetLastError();
        grid = cus < 256 ? cus : 256;
    }
    if (grid < 0) return;
    if (hipMemsetAsync((char*)d_ws + WS_CTL, 0, CTL_ZERO_BYTES, stream) != hipSuccess) return;
    Args a{};
    for (int i = 0; i < N_IN; ++i) a.in[i] = (const float*)d_in[i];
    a.out = (float*)d_out; a.ws = (unsigned char*)d_ws;
#if MK_ONE_LAUNCH
    a.ph_lo = 0; a.ph_hi = N_PHASES;
    hipLaunchKernelGGL(hymba_fwd, dim3(grid), dim3(NTHR), LDS_BYTES, stream, a);
#else
    for (int k = 0; k < N_PHASES; ++k) { a.ph_lo = k; a.ph_hi = k + 1; hipLaunchKernelGGL(hymba_fwd, dim3(grid), dim3(NTHR), LDS_BYTES, stream, a); }
#endif
}
```

```cpp
#include <hip/hip_runtime.h>
#include <cstdio>
#include <cstdint>
namespace pg8 {
#define PG8_LAS __attribute__((address_space(3)))
#define PG8_GAS __attribute__((address_space(1)))
typedef unsigned short bf16_t;
typedef short bf16x8 __attribute__((ext_vector_type(8)));
typedef float f32x4 __attribute__((ext_vector_type(4)));
typedef unsigned u32x4 __attribute__((ext_vector_type(4)));
constexpr int BM = 256, BK = 64, HALF = 128, HTB = HALF * BK * 2  , STAGE_BYTES = 8 * HTB, NXCD = 8, WGM = 8;

__host__ __device__ __forceinline__ int lds_byte(int r, int c) { const int st = (r >> 4) * 2 + (c >> 5), rr = r & 15, cc = c & 31, ob = rr * 64 + cc * 2; return st * 1024 + (ob ^ (((ob >> 9) & 1) << 5)); }
__host__ __device__ __forceinline__ void stage_rc(int b, int& R, int& C) { const int st = b / 1024, sb = b % 1024, swz = sb ^ (((sb >> 9) & 1) << 5); R = (st >> 1) * 16 + swz / 64; C = (st & 1) * 32 + (swz % 64) / 2; }
__host__ __device__ __forceinline__ int perm32(int rho) { const int n = rho >> 4, i = rho & 15; return 8 * (i >> 2) + 4 * n + (i & 3); }

struct Unit { int pm, pn, k0, nt, at; };
struct Gemm { const PG8_GAS bf16_t* A; const PG8_GAS bf16_t* Bt; int M, N, K; };

struct StaticOrder {
    int nM, nN, nwg, G, c, ntK;
    __host__ __device__ void init(int M, int N, int K, int G_, int c_) { nM = M / BM; nN = N / BM; nwg = nM * nN; G = G_; c = c_; ntK = K / BK; }
    __host__ __device__ bool next(int i, Unit& u) const {
        const long L = (long)i * G + c; if (L >= nwg) return false;
        int wgid = (int)L; { const int q = nwg / NXCD, r = nwg % NXCD, xcd = wgid % NXCD, off = wgid / NXCD; wgid = (xcd < r ? xcd * (q + 1) : r * (q + 1) + (xcd - r) * q) + off; }
        const int nig = WGM * nN, gid = wgid / nig, fm = gid * WGM, gsz = (nM - fm) < WGM ? (nM - fm) : WGM;
        u.pm = fm + ((wgid % nig) % gsz); u.pn = (wgid % nig) / gsz; u.k0 = 0; u.nt = ntK; u.at = 0; return true;
    }
    __device__ __forceinline__ void a_ready(const Unit&) const {}
    __device__ __forceinline__ void done(const Unit&) const {}
};

struct SplitOrder {
    StaticOrder so; int nfull, ntot, pmS, nN, ntS;
    __host__ __device__ void init(int Mfull, int N, int K, int nslice, int G_, int c_) { so.init(Mfull, N, K, G_, c_); nfull = so.nwg; pmS = Mfull / BM; nN = N / BM; ntS = K / BK / nslice; ntot = nfull + nN * nslice; }
    __host__ __device__ bool next(int i, Unit& u) const {
        const long L = (long)i * so.G + so.c; if (L >= ntot) return false;
        if (L < nfull) return so.next(i, u);
        const int j = (int)L - nfull; u.pm = pmS; u.pn = j % nN; u.k0 = (j / nN) * ntS * BK; u.nt = ntS; u.at = 1; return true;
    }
    __device__ __forceinline__ void a_ready(const Unit&) const {}
    __device__ __forceinline__ void done(const Unit&) const {}
};

struct SliceOrder {
    int pmS, nN, ntS, ntot, nb, c;
    __host__ __device__ void init(int pmS_, int N, int K, int nslice, int nb_, int c_) { pmS = pmS_; nN = N / BM; ntS = K / BK / nslice; ntot = nN * nslice; nb = nb_; c = c_; }
    __host__ __device__ bool next(int i, Unit& u) const {
        if (c < 0 || c >= nb) return false; const int L = i * nb + c; if (L >= ntot) return false;
        u.pm = pmS; u.pn = L % nN; u.k0 = (L / nN) * ntS * BK; u.nt = ntS; u.at = 1; return true;
    }
    __device__ __forceinline__ void a_ready(const Unit&) const {}
    __device__ __forceinline__ void done(const Unit&) const {}
};

__device__ __forceinline__ unsigned cvt_pk_bf16(float lo, float hi) { unsigned r; asm volatile("v_cvt_pk_bf16_f32 %0, %1, %2" : "=v"(r) : "v"(lo), "v"(hi)); return r; }
typedef float f32x2 __attribute__((ext_vector_type(2)));
struct EpiStoreBf16 {
    static constexpr bool PERM = true, AFTER_DRAIN = false;
    PG8_GAS bf16_t* O; int ldc; int act; int blk;
    __device__ __forceinline__ void operator()(const f32x4 (&acc)[2][2][4][2], const Unit& u, int wr, int wc, int fr, int fq) const {
        const int row0 = u.pm * BM + wr * 64 + fr; const int col0 = u.pn * BM + wc * 32 + 8 * fq;
#pragma unroll
        for (int ai = 0; ai < 2; ++ai)
#pragma unroll
            for (int m = 0; m < 4; ++m) { const int row = row0 + ai * HALF + m * 16;
                PG8_GAS bf16_t* rowp = blk ? O + (((size_t)(row >> 8) * (ldc / BK) + (col0 >> 6)) * BM + (row & 255)) * BK + (col0 & 63) : O + (size_t)row * ldc + col0;
#pragma unroll
                for (int bj = 0; bj < 2; ++bj) { f32x4 v0 = acc[ai][bj][m][0], v1 = acc[ai][bj][m][1];
                    if (act) {
#pragma unroll
                        for (int j = 0; j < 4; ++j) { const float a = v0[j] > 0.f ? v0[j] : 0.f, b = v1[j] > 0.f ? v1[j] : 0.f; v0[j] = a * a; v1[j] = b * b; } }
                    u32x4 w; w.x = cvt_pk_bf16(v0[0], v0[1]); w.y = cvt_pk_bf16(v0[2], v0[3]); w.z = cvt_pk_bf16(v1[0], v1[1]); w.w = cvt_pk_bf16(v1[2], v1[3]);
                    *(PG8_GAS u32x4*)(rowp + (blk ? bj * 2 * BM * BK : bj * HALF)) = w; } }
    }
};
struct EpiGateRes {
    static constexpr bool PERM = true, AFTER_DRAIN = false;
    PG8_GAS float* X; int ldc; const PG8_GAS float* gate; int gstride; PG8_GAS float* part; const PG8_GAS float* Xin;
    __device__ __forceinline__ void operator()(const f32x4 (&acc)[2][2][4][2], const Unit& u, int wr, int wc, int fr, int fq) const {
        const int row0 = u.pm * BM + wr * 64 + fr, col0 = u.pn * BM + wc * 32 + 8 * fq;
        if (!u.at) {
            const int bb = (u.pm * BM) >> 12; const PG8_GAS float* gp = gate + (size_t)bb * gstride + col0;
            f32x4 gv[2][2];
#pragma unroll
            for (int bj = 0; bj < 2; ++bj)
#pragma unroll
                for (int n = 0; n < 2; ++n) gv[bj][n] = *(const PG8_GAS f32x4*)(gp + bj * HALF + n * 4);
#pragma unroll
            for (int ai = 0; ai < 2; ++ai)
#pragma unroll
                for (int m = 0; m < 4; ++m) { PG8_GAS float* rowp = X + (size_t)(row0 + ai * HALF + m * 16) * ldc + col0; const PG8_GAS float* rowi = Xin + (size_t)(row0 + ai * HALF + m * 16) * ldc + col0;
                    f32x4 xv[2][2];
#pragma unroll
                    for (int bj = 0; bj < 2; ++bj)
#pragma unroll
                        for (int n = 0; n < 2; ++n) xv[bj][n] = *(const PG8_GAS f32x4*)(rowi + bj * HALF + n * 4);
#pragma unroll
                    for (int bj = 0; bj < 2; ++bj)
#pragma unroll
                        for (int n = 0; n < 2; ++n) *(PG8_GAS f32x4*)(rowp + bj * HALF + n * 4) = xv[bj][n] + gv[bj][n] * acc[ai][bj][m][n]; }
        } else {
            const int sl = u.k0 / (u.nt * BK);
#pragma unroll
            for (int ai = 0; ai < 2; ++ai)
#pragma unroll
                for (int m = 0; m < 4; ++m) { const int row = row0 + ai * HALF + m * 16; const int bb = 2 + ((row - 8192) >> 3);
                    const PG8_GAS float* gp = gate + (size_t)bb * gstride + col0; PG8_GAS float* pp = part + ((size_t)(sl * BM + (row - 8192)) * ldc + col0);
                    f32x4 gv[2][2];
#pragma unroll
                    for (int bj = 0; bj < 2; ++bj)
#pragma unroll
                        for (int n = 0; n < 2; ++n) gv[bj][n] = *(const PG8_GAS f32x4*)(gp + bj * HALF + n * 4);
#pragma unroll
                    for (int bj = 0; bj < 2; ++bj)
#pragma unroll
                        for (int n = 0; n < 2; ++n) *(PG8_GAS f32x4*)(pp + bj * HALF + n * 4) = gv[bj][n] * acc[ai][bj][m][n]; }
        }
    }
};
template <class Epi, class Sched, bool ALIGN_EPI = false, bool SP2 = false, bool BLK = false>
__device__ __forceinline__ void gemm_phase(PG8_LAS unsigned char* lds, const Gemm g, const Sched& S, const Epi& E) {
    int tid_ = threadIdx.x; asm volatile("" : "+v"(tid_));
    const int tid = tid_, wid = __builtin_amdgcn_readfirstlane(tid >> 6), lane = tid & 63, wr = wid >> 2, wc = wid & 3, fr = lane & 15, fq = lane >> 4;
    const int K = g.K;
    unsigned voffA[2], voffB[2];
#pragma unroll
    for (int i = 0; i < 2; ++i) { int R, C; stage_rc(tid * 16 + i * 8192, R, C); const int Rb = Epi::PERM ? ((R & ~31) + perm32(R & 31)) : R;
        voffA[i] = (unsigned)(R * (BLK ? BK : K) + C) * 2u; voffB[i] = (unsigned)(Rb * (BLK ? BK : K) + C) * 2u; }
    const size_t kstep = BLK ? (size_t)BM * BK * 2 : (size_t)(BK * 2);
    const size_t hstep = BLK ? (size_t)HALF * BK * 2 : (size_t)HALF * K * 2;
    const size_t tstep = BLK ? (size_t)(K / BK) * BM * BK * 2 : 2 * hstep;
    const unsigned ldsw = (unsigned)wid * 1024u;
    const int aoff = lds_byte(wr * 64 + fr, fq * 8), boff = lds_byte(wc * 32 + fr, fq * 8);
#define PG8_SA(b, h) (((b) * 2 + (h)) * HTB)
#define PG8_SB(b, h) ((4 + (b) * 2 + (h)) * HTB)
#define PG8_STAGE(bufoff, gbase, voff) do { _Pragma("unroll") for (int _i = 0; _i < 2; ++_i) \
        __builtin_amdgcn_global_load_lds((const PG8_GAS unsigned*)((const PG8_GAS char*)(gbase) + (voff)[_i]), (PG8_LAS unsigned*)(lds + (bufoff) + ldsw + _i * 8192), 16, 0, 0); } while (0)
#define PG8_LDA(dst, b, h) do { _Pragma("unroll") for (int m = 0; m < 4; ++m) _Pragma("unroll") for (int k = 0; k < 2; ++k) dst[m][k] = *(const PG8_LAS bf16x8*)(lds + PG8_SA(b, h) + aoff + m * 2048 + k * 1024); } while (0)
#define PG8_LDB(dst, b, h) do { _Pragma("unroll") for (int n = 0; n < 2; ++n) _Pragma("unroll") for (int k = 0; k < 2; ++k) dst[n][k] = *(const PG8_LAS bf16x8*)(lds + PG8_SB(b, h) + boff + n * 2048 + k * 1024); } while (0)
#define PG8_MMA(ai, bj, At, Bt) do { __builtin_amdgcn_s_setprio(1); _Pragma("unroll") for (int m = 0; m < 4; ++m) _Pragma("unroll") for (int n = 0; n < 2; ++n) _Pragma("unroll") for (int k = 0; k < 2; ++k) \
        acc[ai][bj][m][n] = __builtin_amdgcn_mfma_f32_16x16x32_bf16(Bt[n][k], At[m][k], acc[ai][bj][m][n], 0, 0, 0); __builtin_amdgcn_s_setprio(0); } while (0)
#define PG8_WAIT_V(n) asm volatile("s_waitcnt vmcnt(" #n ")" ::: "memory")
#define PG8_WAIT_L(n) asm volatile("s_waitcnt lgkmcnt(" #n ")" ::: "memory")
#define PG8_BAR __builtin_amdgcn_s_barrier()
#define PG8_SCHED __builtin_amdgcn_sched_barrier(0)
#ifndef GT_MASK
#define GT_MASK 0
#endif
    const bool gt_on = (GT_MASK != 0) && g.N == 2048 && g.K == 2048;
#define GTS(bit) do { if (((GT_MASK >> (bit)) & 1) && gt_on && tid == 0) { const unsigned long long t_ = __builtin_amdgcn_s_memrealtime(); *(volatile PG8_LAS unsigned*)(lds + 131072 + 320 + 72) = (unsigned)t_; *(volatile PG8_LAS unsigned*)(lds + 131072 + 320 + 76) = (unsigned)(t_ >> 32); } } while (0)
#define GTE(bit) do { if (((GT_MASK >> (bit)) & 1) && gt_on && tid == 0) { volatile PG8_LAS unsigned* m_ = (volatile PG8_LAS unsigned*)(lds + 131072 + 320); const unsigned long long t0_ = ((unsigned long long)m_[19] << 32) | m_[18]; const unsigned long long a_ = (((unsigned long long)m_[17] << 32) | m_[16]) + (__builtin_amdgcn_s_memrealtime() - t0_); m_[16] = (unsigned)a_; m_[17] = (unsigned)(a_ >> 32); } } while (0)
    Unit cur, nxt; int ui = 0;
    if (!S.next(0, cur)) return;
    GTS(0);
    f32x4 acc[2][2][4][2];
#pragma unroll
    for (int a = 0; a < 2; ++a)
#pragma unroll
        for (int b = 0; b < 2; ++b)
#pragma unroll
            for (int m = 0; m < 4; ++m)
#pragma unroll
                for (int n = 0; n < 2; ++n) acc[a][b][m][n] = (f32x4){0.f, 0.f, 0.f, 0.f};
    bf16x8 At[4][2], B0[2][2], B1[2][2];
    const PG8_GAS char* cA = (const PG8_GAS char*)g.A + (size_t)cur.pm * tstep + (BLK ? (size_t)(cur.k0 / BK) * kstep : (size_t)cur.k0 * 2); const PG8_GAS char* cB = (const PG8_GAS char*)g.Bt + (size_t)cur.pn * tstep + (BLK ? (size_t)(cur.k0 / BK) * kstep : (size_t)cur.k0 * 2);
    S.a_ready(cur);
    if constexpr (SP2) {
        PG8_STAGE(PG8_SB(0, 0), cB, voffB); PG8_STAGE(PG8_SB(0, 1), cB + hstep, voffB); PG8_STAGE(PG8_SA(0, 0), cA, voffA); PG8_STAGE(PG8_SA(0, 1), cA + hstep, voffA);
        if (wr == 1) PG8_BAR;
        PG8_WAIT_V(2); PG8_BAR;
        PG8_STAGE(PG8_SB(1, 0), cB + kstep, voffB); PG8_STAGE(PG8_SA(1, 0), cA + kstep, voffA); PG8_STAGE(PG8_SB(1, 1), cB + hstep + kstep, voffB);
        PG8_WAIT_V(6); PG8_BAR;
    } else {
        PG8_STAGE(PG8_SB(0, 0), cB, voffB); PG8_STAGE(PG8_SA(0, 0), cA, voffA); PG8_STAGE(PG8_SB(0, 1), cB + hstep, voffB); PG8_STAGE(PG8_SA(0, 1), cA + hstep, voffA);
        if (wr == 1) PG8_BAR;
        PG8_WAIT_V(4); PG8_BAR;
        PG8_STAGE(PG8_SB(1, 0), cB + kstep, voffB); PG8_STAGE(PG8_SA(1, 0), cA + kstep, voffA); PG8_STAGE(PG8_SB(1, 1), cB + hstep + kstep, voffB);
        PG8_WAIT_V(6); PG8_BAR;
    }
    GTE(0);
    for (;;) {
        const bool has_next = S.next(ui + 1, nxt);
        GTS(1);
        const PG8_GAS char* nA = has_next ? (const PG8_GAS char*)g.A + (size_t)nxt.pm * tstep + (BLK ? (size_t)(nxt.k0 / BK) * kstep : (size_t)nxt.k0 * 2) : cA; const PG8_GAS char* nB = has_next ? (const PG8_GAS char*)g.Bt + (size_t)nxt.pn * tstep + (BLK ? (size_t)(nxt.k0 / BK) * kstep : (size_t)nxt.k0 * 2) : cB;
        const int nt = cur.nt;
        for (int t = 0; t < nt; t += 2) {
            const bool last = (t == nt - 2);
            const PG8_GAS char* a1 = cA + (size_t)(t + 1) * kstep;
            const PG8_GAS char* a2 = last ? nA : cA + (size_t)(t + 2) * kstep; const PG8_GAS char* b2 = last ? nB : cB + (size_t)(t + 2) * kstep;
            const PG8_GAS char* a3 = a2 + kstep; const PG8_GAS char* b3 = b2 + kstep;
            if (last && has_next) S.a_ready(nxt);
            if constexpr (SP2) {
            PG8_LDB(B0, 0, 0); PG8_LDB(B1, 0, 1); PG8_SCHED; PG8_LDA(At, 0, 0); PG8_STAGE(PG8_SA(1, 1), a1 + hstep, voffA);
            PG8_WAIT_V(8); PG8_WAIT_L(0); PG8_BAR; PG8_MMA(0, 0, At, B0); PG8_MMA(0, 1, At, B1); PG8_BAR; PG8_SCHED;
            PG8_LDA(At, 0, 1); PG8_STAGE(PG8_SB(0, 0), b2, voffB); PG8_STAGE(PG8_SB(0, 1), b2 + hstep, voffB); PG8_STAGE(PG8_SA(0, 0), a2, voffA);
            PG8_WAIT_V(8); PG8_WAIT_L(0); PG8_BAR; PG8_MMA(1, 0, At, B0); PG8_MMA(1, 1, At, B1); PG8_BAR; PG8_SCHED;
            PG8_LDB(B0, 1, 0); PG8_LDB(B1, 1, 1); PG8_SCHED; PG8_LDA(At, 1, 0); PG8_STAGE(PG8_SA(0, 1), a2 + hstep, voffA);
            PG8_WAIT_V(8); PG8_WAIT_L(0); PG8_BAR; PG8_MMA(0, 0, At, B0); PG8_MMA(0, 1, At, B1); PG8_BAR; PG8_SCHED;
            PG8_LDA(At, 1, 1); PG8_STAGE(PG8_SB(1, 0), b3, voffB); PG8_STAGE(PG8_SB(1, 1), b3 + hstep, voffB); PG8_STAGE(PG8_SA(1, 0), a3, voffA);
            PG8_WAIT_V(8); PG8_WAIT_L(0); PG8_BAR; PG8_MMA(1, 0, At, B0); PG8_MMA(1, 1, At, B1); PG8_BAR; PG8_SCHED;
            } else {
            PG8_LDB(B0, 0, 0); PG8_SCHED; PG8_LDA(At, 0, 0); PG8_STAGE(PG8_SA(1, 1), a1 + hstep, voffA);
            PG8_WAIT_L(8); PG8_BAR; PG8_WAIT_L(0); PG8_MMA(0, 0, At, B0); PG8_BAR; PG8_SCHED;
            PG8_LDB(B1, 0, 1); PG8_STAGE(PG8_SB(0, 0), b2, voffB);
            PG8_BAR; PG8_WAIT_L(0); PG8_MMA(0, 1, At, B1); PG8_BAR;
            PG8_LDA(At, 0, 1); PG8_STAGE(PG8_SA(0, 0), a2, voffA);
            PG8_BAR; PG8_WAIT_L(0); PG8_MMA(1, 0, At, B0); PG8_BAR; PG8_SCHED;
            PG8_STAGE(PG8_SB(0, 1), b2 + hstep, voffB);
            PG8_WAIT_V(6); PG8_BAR; PG8_MMA(1, 1, At, B1); PG8_BAR;
            PG8_LDB(B0, 1, 0); PG8_SCHED; PG8_LDA(At, 1, 0); PG8_STAGE(PG8_SA(0, 1), a2 + hstep, voffA);
            PG8_WAIT_L(8); PG8_BAR; PG8_WAIT_L(0); PG8_MMA(0, 0, At, B0); PG8_BAR; PG8_SCHED;
            PG8_LDB(B1, 1, 1); PG8_STAGE(PG8_SB(1, 0), b3, voffB);
            PG8_BAR; PG8_WAIT_L(0); PG8_MMA(0, 1, At, B1); PG8_BAR;
            PG8_LDA(At, 1, 1); PG8_STAGE(PG8_SA(1, 0), a3, voffA);
            PG8_BAR; PG8_WAIT_L(0); PG8_MMA(1, 0, At, B0); PG8_BAR; PG8_SCHED;
            PG8_STAGE(PG8_SB(1, 1), b3 + hstep, voffB);
            PG8_WAIT_V(6); PG8_BAR; PG8_MMA(1, 1, At, B1); PG8_BAR;
            }
        }
        GTE(1); GTS(2);
        if constexpr (ALIGN_EPI) { if (wr == 0) PG8_BAR; }
        if constexpr (!Epi::AFTER_DRAIN) { E(acc, cur, wr, wc, fr, fq); S.done(cur); }
        GTE(2);
        if (!has_next) break;
#pragma unroll
        for (int a = 0; a < 2; ++a)
#pragma unroll
            for (int b = 0; b < 2; ++b)
#pragma unroll
                for (int m = 0; m < 4; ++m)
#pragma unroll
                    for (int n = 0; n < 2; ++n) acc[a][b][m][n] = (f32x4){0.f, 0.f, 0.f, 0.f};
        cur = nxt; cA = nA; cB = nB; ++ui;
        if constexpr (ALIGN_EPI) { if (wr == 1) PG8_BAR; }
    }
    GTS(3);
    PG8_WAIT_V(0);
    if constexpr (!ALIGN_EPI) { if (wr == 0) PG8_BAR; }
    PG8_BAR;
    if constexpr (Epi::AFTER_DRAIN) { E.fused(acc, cur, wr, wc, fr, fq, lds, wid, lane); S.done(cur); }
    GTE(3);
#undef PG8_SA
#undef PG8_SB
#undef PG8_STAGE
#undef PG8_LDA
#undef PG8_LDB
#undef PG8_MMA
#undef PG8_WAIT_V
#undef PG8_WAIT_L
#undef PG8_BAR
#undef PG8_SCHED
}
}
constexpr int NWAVES = 8, NTHR = 512;
constexpr int D = 2048, DEPTH = 4, BP = 2, TP = 4096, BS = 32, TS = 8;
constexpr int MP = BP * TP, MS = BS * TS, M = MP + MS, NBB = BP + BS;
constexpr int NINW = 4872, NPROJ = 4864, DFF = 8192, NMOD = 6 * D, PAST = 16384;
constexpr int C_AQ = 0, C_AF = 512, C_AI = 1024, C_AG = 1536, C_PU = 2048, C_CZ = 2560, C_CX = 3072, C_DQ = 4096, C_DK = 4608, C_DV = 4736;
constexpr float EPS = 1e-6f;
enum { I_XP = 0, I_XS, I_CP, I_CS, I_SHG, I_SPOOL, I_SSSM, I_SCONV, I_CK, I_CV, I_N1G, I_N2G, I_WADA, I_BADA, I_WIN, I_LBL, I_HNG, I_PW, I_PSC, I_CW, I_CB, I_DTB, I_ALOG, I_DSK, I_SNG, I_QNG, I_KNG, I_SINK, I_WOUT, I_WUP, I_WDN, N_IN };
constexpr size_t O_Y = 0, O_PHG = (size_t)M * D, O_PPOOL = O_PHG + 4 * 2 * 4 * 16384, O_PSSM = O_PPOOL + 4 * 2 * 15 * 512, O_PCONV = O_PSSM + 4 * 2 * 8 * 8192, O_PK = O_PCONV + 4 * 2 * 3 * 1024,
    O_PV = O_PK + 4 * 2 * 128 * 128, O_SHG = O_PV + 4 * 2 * 128 * 128, O_SPOOL = O_SHG + (size_t)4 * 32 * 4 * 16384, O_SSSM = O_SPOOL + 4 * 32 * 15 * 512, O_SCONV = O_SSSM + (size_t)4 * 32 * 8 * 8192,
    O_SK = O_SCONV + 4 * 32 * 3 * 1024, O_SV = O_SK + 4 * 32 * 128 * 128, O_END = O_SV + 4 * 32 * 128 * 128;
static_assert(O_END == 41046016, "output size");
constexpr size_t MiB = 1u << 20;
constexpr size_t WS_CTL = 0, CTL_ZERO_BYTES = 65536;
constexpr size_t WS_MOD = 1 * MiB, WS_LB = 8 * MiB, WS_ROPE = 8 * MiB + 65536, WS_DT = 10 * MiB;
constexpr size_t WS_WIN = 16 * MiB, WS_WOUT = 92 * MiB, WS_WUP = 124 * MiB, WS_WDN = 252 * MiB;
constexpr size_t WS_H = 380 * MiB, WS_PROJ = 413 * MiB, WS_MIX = 492 * MiB, WS_U = 525 * MiB;
constexpr size_t WS_HGDS = 657 * MiB, WS_HGSS = 689 * MiB, WS_SDDS = 721 * MiB, WS_SDSS = 753 * MiB, WS_HGDEC = 785 * MiB, WS_SDDEC = 785 * MiB + 524288, WS_PART = 786 * MiB, WS_YTMP = 818 * MiB, WS_WPT = 850 * MiB, WS_WDT = 850 * MiB + 524288, WS_U2 = 883 * MiB, WS_WDN2 = 1017 * MiB, WS_HQ = 1147 * MiB, WS_HK = 1155 * MiB, WS_HV = 1163 * MiB, WS_HEREF = 1171 * MiB, WS_SSDH = 1172 * MiB, WS_SSDCD = 1189 * MiB, WS_END = 1190 * MiB;
constexpr int LDU = DFF + 64;
static_assert(WS_U2 + (size_t)M * LDU * 2 <= WS_WDN2 && WS_WDN2 + (size_t)4 * D * LDU * 2 <= WS_END, "ws map 2");
static_assert(WS_WIN + (size_t)4 * NPROJ * D * 2 <= WS_WOUT && WS_PROJ + (size_t)M * NPROJ * 2 <= WS_MIX && WS_U + (size_t)M * DFF * 2 <= WS_HGDS, "ws map");
constexpr int CW_BAR = 4096, CW_Q = 16384, CQ_CONV = 160;
constexpr int RING_BYTES = 131072, LDSCTL_OFF = RING_BYTES, MISC_OFF = LDSCTL_OFF + 320, PTR_OFF = LDSCTL_OFF + 1024, LDS_BYTES = 147456;
constexpr int PH_PER_LAYER = 9, N_PHASES = 2 + DEPTH * PH_PER_LAYER;
constexpr int NSL_OUT = 8, NSL_DN = 16;
#ifndef MK_ONE_LAUNCH
#define MK_ONE_LAUNCH 1
#endif
#define GAS __attribute__((address_space(1)))
#define LAS __attribute__((address_space(3)))
typedef unsigned short bf16;
typedef unsigned v4u __attribute__((ext_vector_type(4)));
typedef float f32x4 __attribute__((ext_vector_type(4)));
typedef short bf16x8 __attribute__((ext_vector_type(8)));
typedef GAS unsigned gu32;
typedef GAS unsigned long long gu64;
#define RLX_AGENT __ATOMIC_RELAXED, __HIP_MEMORY_SCOPE_AGENT
#define LDS_WAIT() asm volatile("s_waitcnt lgkmcnt(0)" ::: "memory")
#define VM_WAIT() asm volatile("s_waitcnt vmcnt(0)" ::: "memory")
__device__ __forceinline__ unsigned long long rt() { return __builtin_amdgcn_s_memrealtime(); }
__device__ __forceinline__ unsigned f2bf(float f) { unsigned u = __builtin_bit_cast(unsigned, f); return (u + 0x7fffu + ((u >> 16) & 1u)) >> 16; }
__device__ __forceinline__ unsigned pk2(float lo, float hi) { return f2bf(lo) | (f2bf(hi) << 16); }

#define XB_TMO      128
#define XB_XCNT(j)  (256  + 64 * (j))
#define XB_XSUB(j)  (1280 + 64 * (j))
#define XB_XGEN(j)  (2304 + 64 * (j))
#define XB_TOP      3328
#define XB_TOPGEN   3392
#define XCD_BAR_WORDS 3456
#define XB_SPIN_CAP (1u << 18)

__device__ __forceinline__ unsigned xb_ld(unsigned* p)              { return __hip_atomic_load(p, __ATOMIC_RELAXED, __HIP_MEMORY_SCOPE_AGENT); }
__device__ __forceinline__ unsigned xb_add(unsigned* p, unsigned v) { return __hip_atomic_fetch_add(p, v, __ATOMIC_RELAXED, __HIP_MEMORY_SCOPE_AGENT); }
__device__ __forceinline__ unsigned xb_xcc_id() { return (unsigned)__builtin_amdgcn_s_getreg((3 << 11) | 20) & 0xFu; }
#define XB_SPIN(cond, bar) do { unsigned _sp = 0; while (cond) { __builtin_amdgcn_s_sleep(1); \
    if ((++_sp & 255u) == 0u) { if (xb_ld(&(bar)[XB_TMO])) break; if (_sp > XB_SPIN_CAP) { atomicAdd(&(bar)[XB_TMO], 1u); break; } } } } while (0)

struct XcdBarrier {
    unsigned* bar; unsigned x;
    volatile LAS unsigned* st;
};

__device__ __forceinline__ XcdBarrier xcd_barrier_post(unsigned* bar, volatile LAS unsigned* st) {
    XcdBarrier b; b.bar = bar; b.x = xb_xcc_id(); b.st = st;
    if (threadIdx.x == 0) (void)xb_add(&bar[XB_XCNT(b.x)], 1u);
    return b;
}
__device__ __forceinline__ void xcd_barrier_complete(unsigned* bar, unsigned x, unsigned& nloc, unsigned& nx) {
    const unsigned G = gridDim.x * gridDim.y * gridDim.z;
    unsigned sum, cnt, mine, sp = 0u;
    for (;;) {
        sum = 0u; cnt = 0u; mine = 0u;
#pragma unroll
        for (unsigned j = 0; j < 16; ++j) { const unsigned c = xb_ld(&bar[XB_XCNT(j)]); sum += c; cnt += (c > 0u) ? 1u : 0u; mine = (j == x) ? c : mine; }
        if (sum == G) break;
        __builtin_amdgcn_s_sleep(1);
        if ((++sp & 255u) == 0u) { if (xb_ld(&bar[XB_TMO])) break; if (sp > XB_SPIN_CAP) { atomicAdd(&bar[XB_TMO], 1u); break; } }
    }
    nloc = mine > 0u ? mine : 1u; nx = cnt > 0u ? cnt : 1u;
}

__device__ __forceinline__ void xcd_barrier(const XcdBarrier& b) {
    asm volatile("s_waitcnt vmcnt(0)" ::: "memory");
    __syncthreads();
    if (threadIdx.x == 0) {
        unsigned* bar = b.bar;
        __builtin_amdgcn_s_waitcnt(0);
        unsigned nloc = b.st[0], nx = b.st[1];
        if (nloc == 0u) { xcd_barrier_complete(bar, b.x, nloc, nx); b.st[0] = nloc; b.st[1] = nx; }
        const unsigned old = xb_add(&bar[XB_XSUB(b.x)], 1u);
        const unsigned gen = old / nloc;
        if (old + 1u == (gen + 1u) * nloc) {
            __builtin_amdgcn_fence(__ATOMIC_RELEASE, "agent");
            asm volatile("s_waitcnt vmcnt(0)" ::: "memory");
            const unsigned og = xb_add(&bar[XB_TOP], 1u);
            const unsigned tg = og / nx;
            if (og + 1u == (tg + 1u) * nx) xb_add(&bar[XB_TOPGEN], 1u);
            else XB_SPIN(xb_ld(&bar[XB_TOPGEN]) == tg, bar);
            __builtin_amdgcn_fence(__ATOMIC_ACQUIRE, "agent");
            xb_add(&bar[XB_XGEN(b.x)], 1u);
            asm volatile("s_waitcnt vmcnt(0)" ::: "memory");
        } else {
            XB_SPIN(xb_ld(&bar[XB_XGEN(b.x)]) == gen, bar);
            __builtin_amdgcn_fence(__ATOMIC_ACQUIRE, "agent");
            asm volatile("s_waitcnt vmcnt(0)" ::: "memory");
        }
    }
    __syncthreads();
}

struct Frame {
    LAS unsigned char* lds;
    volatile LAS unsigned* MISC;
    gu32* ctl;
    int tid, lane, wave, G, gw, ngw;
    GAS float* out; GAS unsigned char* ws;
};
__device__ __forceinline__ const GAS float* inp(const Frame& F, int i) {
    int off = PTR_OFF + 8 * i; asm volatile("" : "+s"(off));
    const unsigned long long v = *(const LAS unsigned long long*)(F.lds + off);
    const unsigned lo = __builtin_amdgcn_readfirstlane((unsigned)v), hi = __builtin_amdgcn_readfirstlane((unsigned)(v >> 32));
    return (const GAS float*)(((unsigned long long)hi << 32) | lo);
}
__device__ __forceinline__ GAS unsigned char* wsp(const Frame& F, size_t off) { GAS unsigned char* p = F.ws; asm volatile("" : "+s"(p)); return p + off; }
#define INP(i) inp(F, i)
#define WS_LOCALS \
    GAS float* const MOD = (GAS float*)wsp(F, WS_MOD); GAS float* const LBv = (GAS float*)wsp(F, WS_LB); GAS float* const ROPE = (GAS float*)wsp(F, WS_ROPE); GAS float* const DT = (GAS float*)wsp(F, WS_DT); \
    GAS bf16* const Wi = (GAS bf16*)wsp(F, WS_WIN); GAS bf16* const Wo = (GAS bf16*)wsp(F, WS_WOUT); GAS bf16* const Wu = (GAS bf16*)wsp(F, WS_WUP); GAS bf16* const Wd = (GAS bf16*)wsp(F, WS_WDN2); \
    GAS bf16* const H = (GAS bf16*)wsp(F, WS_H); GAS bf16* const PROJ = (GAS bf16*)wsp(F, WS_PROJ); GAS bf16* const MIX = (GAS bf16*)wsp(F, WS_MIX); GAS bf16* const U = (GAS bf16*)wsp(F, WS_U2); \
    GAS float* const HGDS = (GAS float*)wsp(F, WS_HGDS); GAS float* const HGSS = (GAS float*)wsp(F, WS_HGSS); GAS float* const SDDS = (GAS float*)wsp(F, WS_SDDS); GAS float* const SDSS = (GAS float*)wsp(F, WS_SDSS); \
    GAS float* const HGDEC = (GAS float*)wsp(F, WS_HGDEC); GAS float* const SDDEC = (GAS float*)wsp(F, WS_SDDEC); \
    (void)MOD; (void)LBv; (void)ROPE; (void)DT; (void)Wi; (void)Wo; (void)Wu; (void)Wd; (void)H; (void)PROJ; (void)MIX; (void)U; (void)HGDS; (void)HGSS; (void)SDDS; (void)SDSS; (void)HGDEC; (void)SDDEC;
__device__ __forceinline__ float wave_sum(float v) {
#pragma unroll
    for (int o = 1; o < 64; o <<= 1) v += __shfl_xor(v, o);
    return v;
}
__device__ __forceinline__ float bf2f(bf16 b) { return __builtin_bit_cast(float, (unsigned)b << 16); }
__device__ __forceinline__ float bflo(unsigned w) { return __builtin_bit_cast(float, w << 16); }
__device__ __forceinline__ float bfhi(unsigned w) { return __builtin_bit_cast(float, w & 0xffff0000u); }
__device__ __forceinline__ float sigm(float x) { return __builtin_amdgcn_rcpf(1.f + __expf(-x)); }
__device__ __forceinline__ float rsq(float x) { return __builtin_amdgcn_rsqf(x); }
__device__ __forceinline__ int row_bb(int m) { return m < MP ? (m >> 12) : BP + ((m - MP) >> 3); }
typedef short bf16x8v __attribute__((ext_vector_type(8)));
__device__ __forceinline__ f32x4 mma16(const LAS bf16* A, int lda, const LAS bf16* B, int ldb, int K, f32x4 acc, int lane) {
    const LAS bf16* ap = A + (lane & 15) * lda + 8 * (lane >> 4); const LAS bf16* bp = B + (lane & 15) * ldb + 8 * (lane >> 4);
    for (int k = 0; k < K; k += 32) { const bf16x8v a = *(const LAS bf16x8v*)(ap + k); const bf16x8v b = *(const LAS bf16x8v*)(bp + k); acc = __builtin_amdgcn_mfma_f32_16x16x32_bf16(a, b, acc, 0, 0, 0); }
    return acc;
}
__device__ __forceinline__ bf16 tobf(float f) { return (bf16)f2bf(f); }

#ifndef UT_MASK
#define UT_MASK 0
#endif
#define UTS(bit) do { if ((UT_MASK >> (bit)) & 1) { if (F.tid == 0) { const unsigned long long t_ = __builtin_amdgcn_s_memrealtime(); F.MISC[18] = (unsigned)t_; F.MISC[19] = (unsigned)(t_ >> 32); } } } while (0)
#define UTE(bit) do { if ((UT_MASK >> (bit)) & 1) { if (F.tid == 0) { const unsigned long long t0_ = ((unsigned long long)F.MISC[19] << 32) | F.MISC[18]; const unsigned long long a_ = (((unsigned long long)F.MISC[17] << 32) | F.MISC[16]) + (__builtin_amdgcn_s_memrealtime() - t0_); F.MISC[16] = (unsigned)a_; F.MISC[17] = (unsigned)(a_ >> 32); } } } while (0)
__device__ __forceinline__ int deq(Frame& F, int q) {
    __syncthreads();
    if (F.tid == 0) F.MISC[0] = __hip_atomic_fetch_add(F.ctl + CW_Q + 64 * q, 1u, RLX_AGENT);
    __syncthreads();
    return (int)F.MISC[0];
}

__device__ __forceinline__ void p0_transpose_item(const GAS float* W, int K, int ldw, GAS bf16* WT, int k0, int src_n0, int dst_n0, LAS float* scr, int lane, bool blk = false) {
    float tv[32];
#pragma unroll
    for (int i = 0; i < 32; ++i) { const int kk = 2 * i + (lane >> 5); tv[i] = __builtin_nontemporal_load(W + (size_t)(k0 + kk) * ldw + src_n0 + (lane & 31)); }
#pragma unroll
    for (int i = 0; i < 32; ++i) { const int kk = 2 * i + (lane >> 5); scr[kk * 33 + (lane & 31)] = tv[i]; }
    LDS_WAIT(); asm volatile("" ::: "memory");
    const int c = lane & 7;
#pragma unroll
    for (int j = 0; j < 4; ++j) { const int n = (lane >> 3) + 8 * j; const LAS float* s = scr + (8 * c) * 33 + n;
        v4u o; o.x = pk2(s[0 * 33], s[1 * 33]); o.y = pk2(s[2 * 33], s[3 * 33]); o.z = pk2(s[4 * 33], s[5 * 33]); o.w = pk2(s[6 * 33], s[7 * 33]);
        const int nn = dst_n0 + n;
        if (blk) __builtin_nontemporal_store(o, (GAS v4u*)(WT + (((size_t)(nn >> 8) * (K / 64) + (k0 >> 6)) * 256 + (nn & 255)) * 64 + 8 * c)); else __builtin_nontemporal_store(o, (GAS v4u*)(WT + (size_t)nn * K + k0 + 8 * c)); }
    LDS_WAIT(); asm volatile("" ::: "memory");
}
typedef float f32x2g __attribute__((ext_vector_type(2)));
__device__ __forceinline__ void p0_adaln(Frame& F) {
    WS_LOCALS
    constexpr int LDC = 520, NITEM = DEPTH * NMOD / 32;
    LAS bf16* cs = (LAS bf16*)F.lds;
    const GAS float* const cpp = INP(I_CP); const GAS float* const csp = INP(I_CS); const GAS float* const wada = INP(I_WADA); const GAS float* const bada = INP(I_BADA);
    const int per = (NITEM + F.G - 1) / F.G;
    const int lane = F.lane, item = per <= 8 ? (int)blockIdx.x * per + F.wave : (int)blockIdx.x + F.G * F.wave; const bool act = item < NITEM && (per > 8 || F.wave < per);
    const int l = act ? item / (NMOD / 32) : 0, n0 = act ? (item % (NMOD / 32)) * 32 : 0;
    f32x4 acc[2][3];
#pragma unroll
    for (int a = 0; a < 2; ++a)
#pragma unroll
        for (int r = 0; r < 3; ++r) acc[a][r] = (f32x4){0.f, 0.f, 0.f, 0.f};
    const GAS float* wl = wada + (size_t)l * D * NMOD + n0 + 2 * (lane & 15) + (size_t)(8 * (lane >> 4)) * NMOD;
    f32x2g wb[4][8];
#define ADA_LOAD(buf, step) do { _Pragma("unroll") for (int j = 0; j < 8; ++j) wb[(buf) & 3][j] = __builtin_nontemporal_load((const GAS f32x2g*)(wl + (size_t)((step) * 32 + j) * NMOD)); } while (0)
    if (act) { ADA_LOAD(0, 0); ADA_LOAD(1, 1); ADA_LOAD(2, 2); }
    for (int kc = 0; kc < 4; ++kc) {
        __syncthreads();
        {   f32x4 cv[12];
#pragma unroll
            for (int i = 0; i < 12; ++i) { const int e = F.tid + i * NTHR, bb = e >> 7, k4 = (e & 127) * 4; const int bc = bb < NBB ? bb : 0;
                cv[i] = *(const GAS f32x4*)((bc < BP ? cpp + bc * D : csp + (bc - BP) * D) + kc * 512 + k4); }
#pragma unroll
            for (int i = 0; i < 12; ++i) { const int e = F.tid + i * NTHR, bb = e >> 7, k4 = (e & 127) * 4; const bool ok = bb < NBB; const f32x4 c = cv[i];
                *(LAS unsigned*)(cs + bb * LDC + k4) = ok ? pk2(c.x * sigm(c.x), c.y * sigm(c.y)) : 0u; *(LAS unsigned*)(cs + bb * LDC + k4 + 2) = ok ? pk2(c.z * sigm(c.z), c.w * sigm(c.w)) : 0u; } }
        __syncthreads();
        if (act) {
#pragma unroll
            for (int ks = 0; ks < 16; ++ks) { const int s = kc * 16 + ks;
                if (s + 3 < 64) ADA_LOAD(ks + 3, s + 3);
                v4u b0, b1;
                b0.x = pg8::cvt_pk_bf16(wb[ks & 3][0].x, wb[ks & 3][1].x); b0.y = pg8::cvt_pk_bf16(wb[ks & 3][2].x, wb[ks & 3][3].x); b0.z = pg8::cvt_pk_bf16(wb[ks & 3][4].x, wb[ks & 3][5].x); b0.w = pg8::cvt_pk_bf16(wb[ks & 3][6].x, wb[ks & 3][7].x);
                b1.x = pg8::cvt_pk_bf16(wb[ks & 3][0].y, wb[ks & 3][1].y); b1.y = pg8::cvt_pk_bf16(wb[ks & 3][2].y, wb[ks & 3][3].y); b1.z = pg8::cvt_pk_bf16(wb[ks & 3][4].y, wb[ks & 3][5].y); b1.w = pg8::cvt_pk_bf16(wb[ks & 3][6].y, wb[ks & 3][7].y);
                const bf16x8v bf0 = __builtin_bit_cast(bf16x8v, b0), bf1 = __builtin_bit_cast(bf16x8v, b1);
#pragma unroll
                for (int r = 0; r < 3; ++r) { const bf16x8v a = *(const LAS bf16x8v*)(cs + (16 * r + (lane & 15)) * LDC + ks * 32 + 8 * (lane >> 4));
                    acc[0][r] = __builtin_amdgcn_mfma_f32_16x16x32_bf16(a, bf0, acc[0][r], 0, 0, 0); acc[1][r] = __builtin_amdgcn_mfma_f32_16x16x32_bf16(a, bf1, acc[1][r], 0, 0, 0); } }
        }
    }
#undef ADA_LOAD
    if (act) {
#pragma unroll
        for (int a = 0; a < 2; ++a) { const int n = n0 + 2 * (lane & 15) + a; const float bias = bada[l * NMOD + n];
#pragma unroll
            for (int r = 0; r < 3; ++r)
#pragma unroll
                for (int i = 0; i < 4; ++i) { const int bb = 16 * r + 4 * (lane >> 4) + i; if (bb < NBB) MOD[((size_t)l * NBB + bb) * NMOD + n] = acc[a][r][i] + bias; } }
    }
    __syncthreads();
}
__device__ __forceinline__ void convert_layer(Frame& F, int l, int first, int nblk_, int bt0, int bt1, int rot = 0) {
    WS_LOCALS
    LAS float* scr = (LAS float*)(F.lds + F.wave * 16384);
    constexpr int IT_IN = (D / 64) * (NPROJ / 32), IT_OUT = (D / 64) * (D / 32), IT_UP = (D / 64) * (DFF / 32), IT_DN = (DFF / 64) * (D / 32), IT_L = IT_IN + IT_OUT + IT_UP + IT_DN, NBATCH = (IT_L + 15) / 16;
    const GAS float* const win = INP(I_WIN) + (size_t)l * D * NINW; const GAS float* const wout = INP(I_WOUT) + (size_t)l * D * D; const GAS float* const wup = INP(I_WUP) + (size_t)l * D * DFF; const GAS float* const wdn = INP(I_WDN) + (size_t)l * DFF * D;
    int me = (int)blockIdx.x - first; if (me < 0 || me >= nblk_) return;
    me = (me + rot) % nblk_;
    const int bte = bt1 < NBATCH ? bt1 : NBATCH;
    for (int bt = bt0 + me; bt < bte; bt += nblk_) {
#pragma unroll 1
        for (int s = 0; s < 2; ++s) { int r = bt * 16 + s * 8 + F.wave; if (r >= IT_L) continue;
            if (r < IT_IN) { const int nblk = NPROJ / 32, kb = r / nblk, nb = r % nblk, dn0 = 32 * nb, sn0 = dn0 + (dn0 >= 4096 ? 8 : 0);
                p0_transpose_item(win, D, NINW, Wi + (size_t)l * NPROJ * D, 64 * kb, sn0, dn0, scr, F.lane); continue; } r -= IT_IN;
            if (r < IT_OUT) { const int nblk = D / 32, kb = r / nblk, nb = r % nblk;
                p0_transpose_item(wout, D, D, Wo + (size_t)l * D * D, 64 * kb, 32 * nb, 32 * nb, scr, F.lane); continue; } r -= IT_OUT;
            if (r < IT_UP) { const int nblk = DFF / 32, kb = r / nblk, nb = r % nblk;
                p0_transpose_item(wup, D, DFF, Wu + (size_t)l * DFF * D, 64 * kb, 32 * nb, 32 * nb, scr, F.lane); continue; } r -= IT_UP;
            { const int nblk = D / 32, kb = r / nblk, nb = r % nblk;
                p0_transpose_item(wdn, DFF, D, Wd + (size_t)l * D * DFF, 64 * kb, 32 * nb, 32 * nb, scr, F.lane, true); } }
    }
}
__device__ __forceinline__ void convert_multi(Frame& F, int first, int nblk_, int nseg, int l0, int a0, int b0, int r0, int l1, int a1, int b1, int r1, int l2, int a2, int b2, int r2) {
#pragma unroll 1
    for (int sg = 0; sg < nseg; ++sg) {
        const int l = sg == 0 ? l0 : (sg == 1 ? l1 : l2), a = sg == 0 ? a0 : (sg == 1 ? a1 : a2), b = sg == 0 ? b0 : (sg == 1 ? b1 : b2), r = sg == 0 ? r0 : (sg == 1 ? r1 : r2);
        convert_layer(F, l, first, nblk_, a, b, r); }
}
__device__ __forceinline__ void p0_prologue(Frame& F) {
    WS_LOCALS
    const int gt = blockIdx.x * NTHR + F.tid, NT = F.G * NTHR;
    if (gt < 512) { const GAS float* lg = INP(I_LBL); const float a0 = lg[gt], a1 = lg[512 + gt], a2 = lg[1024 + gt], a3 = lg[1536 + gt];
        const float mx = fmaxf(fmaxf(a0, a1), fmaxf(a2, a3)); const float e0 = expf(a0 - mx), e1 = expf(a1 - mx), e2 = expf(a2 - mx), e3 = expf(a3 - mx); const float inv = 1.f / (e0 + e1 + e2 + e3);
        LBv[gt] = 0.f; LBv[512 + gt] = e1 * inv; LBv[1024 + gt] = (e1 + e2) * inv; LBv[1536 + gt] = (e1 + e2 + e3) * inv; }
    for (int e = gt; e < 4104 * 32; e += NT) { const int r = e >> 5, i = e & 31; const int pos = r < 4096 ? r : PAST + (r - 4096);
        const double inv = exp2(-(double)i * (13.287712379549449 / 32.0)); const double rev = (double)pos * inv * 0.15915494309189535;
        const float fr = (float)(rev - floor(rev));
        ROPE[r * 64 + i] = __builtin_amdgcn_cosf(fr); ROPE[r * 64 + 32 + i] = __builtin_amdgcn_sinf(fr); }
    { const GAS float* wi = INP(I_WIN); GAS float* wdtg = (GAS float*)wsp(F, WS_WDT);
      for (int e = gt; e < DEPTH * D * 8; e += NT) { const int ll = e >> 14, d2 = (e >> 3) & 2047, j = e & 7; wdtg[(ll * 8 + j) * D + d2] = wi[((size_t)ll * D + d2) * NINW + 4096 + j]; } }
    { const GAS float* pw = INP(I_PW); GAS bf16* wpt = (GAS bf16*)wsp(F, WS_WPT);
      for (int e = gt; e < 16 * 16384; e += NT) { const int lg = e >> 14, dd = (e >> 7) & 127, c = e & 127; wpt[e] = (bf16)f2bf(pw[(size_t)lg * 16384 + c * 128 + dd]); } }
    __syncthreads(); UTS(8); p0_adaln(F); __syncthreads(); UTE(8); UTS(9);
    convert_multi(F, 0, F.G, 2, 0, 0, 304, 0, 0, 864, 944, (F.G == 256 ? 208 : 0), 0, 0, 0, 0); __syncthreads(); UTE(9);
}

template <int NR> __device__ __forceinline__ void norm_rows(Frame& F, int l, int which, const int (&mr)[NR], f32x4 (&v)[NR][8], const GAS f32x4* g4, const GAS float* MOD, GAS bf16* H, GAS float* DT, const LAS float* wdt) {
    const int bb = row_bb(mr[0]);
    const GAS float* modp = MOD + ((size_t)l * NBB + bb) * NMOD + (which ? 3 * D : 0);
    const GAS f32x4* sh4 = (const GAS f32x4*)modp; const GAS f32x4* sc4 = (const GAS f32x4*)(modp + D);
    f32x4 gs[8], shv[8];
#pragma unroll
    for (int j = 0; j < 8; ++j) { const int q = 64 * j + F.lane; const f32x4 g = g4[q], sc = sc4[q]; shv[j] = sh4[q]; gs[j] = g * (sc + 1.f); }
    float ss[NR];
#pragma unroll
    for (int n = 0; n < NR; ++n) { float s = 0.f;
#pragma unroll
        for (int j = 0; j < 8; ++j) s += (v[n][j].x * v[n][j].x + v[n][j].y * v[n][j].y) + (v[n][j].z * v[n][j].z + v[n][j].w * v[n][j].w);
        ss[n] = s; }
#pragma unroll
    for (int o = 1; o < 64; o <<= 1) {
#pragma unroll
        for (int n = 0; n < NR; ++n) ss[n] += __shfl_xor(ss[n], o); }
#pragma unroll
    for (int n = 0; n < NR; ++n) { const float r = rsq(ss[n] * (1.f / D) + EPS); GAS unsigned long long* o8 = (GAS unsigned long long*)(H + (size_t)mr[n] * D);
#pragma unroll
        for (int j = 0; j < 8; ++j) { const int q = 64 * j + F.lane;
            f32x4 h; h.x = v[n][j].x * r * gs[j].x + shv[j].x; h.y = v[n][j].y * r * gs[j].y + shv[j].y; h.z = v[n][j].z * r * gs[j].z + shv[j].z; h.w = v[n][j].w * r * gs[j].w + shv[j].w;
            o8[q] = (unsigned long long)pk2(h.x, h.y) | ((unsigned long long)pk2(h.z, h.w) << 32);
            v[n][j] = h; } }
    if (which == 0) { float dta[NR][8];
#pragma unroll
        for (int jj = 0; jj < 8; ++jj) { float a[NR];
#pragma unroll
            for (int n = 0; n < NR; ++n) a[n] = 0.f;
#pragma unroll
            for (int j = 0; j < 8; ++j) { const f32x4 w = ((const LAS f32x4*)wdt)[jj * (D / 4) + 64 * j + F.lane];
#pragma unroll
                for (int n = 0; n < NR; ++n) a[n] += (v[n][j].x * w.x + v[n][j].y * w.y) + (v[n][j].z * w.z + v[n][j].w * w.w); }
#pragma unroll
            for (int n = 0; n < NR; ++n) dta[n][jj] = a[n];
            __builtin_amdgcn_sched_barrier(0); }
#pragma unroll
        for (int o = 1; o < 64; o <<= 1) {
#pragma unroll
            for (int n = 0; n < NR; ++n)
#pragma unroll
                for (int jj = 0; jj < 8; ++jj) dta[n][jj] += __shfl_xor(dta[n][jj], o); }
        if (F.lane == 0) {
#pragma unroll
            for (int n = 0; n < NR; ++n) { GAS f32x4* dp = (GAS f32x4*)(DT + (size_t)mr[n] * 8); dp[0] = (f32x4){dta[n][0], dta[n][1], dta[n][2], dta[n][3]}; dp[1] = (f32x4){dta[n][4], dta[n][5], dta[n][6], dta[n][7]}; } } }
}
__device__ __forceinline__ void sample_row_reduce(Frame& F, int ms, int nsl, f32x4 (&v)[8], LAS float* partl) {
    const GAS f32x4* pp = (const GAS f32x4*)wsp(F, WS_PART) + (size_t)ms * (D / 4); GAS f32x4* xw = (GAS f32x4*)(F.out + (size_t)(MP + ms) * D);
#pragma unroll
    for (int j = 0; j < 8; ++j) v[j] = (F.wave == 0) ? xw[64 * j + F.lane] : (f32x4){0.f, 0.f, 0.f, 0.f};
#pragma unroll 1
    for (int s = F.wave; s < nsl; s += 8) {
#pragma unroll
        for (int j = 0; j < 8; ++j) v[j] = v[j] + pp[(size_t)s * (MS * D / 4) + 64 * j + F.lane]; }
    if (F.wave != 0) {
#pragma unroll
        for (int j = 0; j < 8; ++j) ((LAS f32x4*)partl)[(F.wave - 1) * (D / 4) + 64 * j + F.lane] = v[j]; }
    __syncthreads();
    if (F.wave == 0) {
#pragma unroll 1
        for (int w = 0; w < 7; ++w) {
#pragma unroll
            for (int j = 0; j < 8; ++j) v[j] = v[j] + ((const LAS f32x4*)partl)[w * (D / 4) + 64 * j + F.lane]; }
#pragma unroll
        for (int j = 0; j < 8; ++j) xw[64 * j + F.lane] = v[j]; }
}
__device__ __forceinline__ void norm_phase(Frame& F, int l, int which, int nsl) {
    WS_LOCALS
    LAS float* wdt = (LAS float*)F.lds;
    LAS float* partl = (LAS float*)(F.lds + 65536);
    if (which == 0) { const GAS f32x4* wsrc = (const GAS f32x4*)((const GAS float*)wsp(F, WS_WDT) + (size_t)l * 8 * D);
        f32x4 tw[8];
#pragma unroll
        for (int i = 0; i < 8; ++i) tw[i] = wsrc[F.tid + i * NTHR];
#pragma unroll
        for (int i = 0; i < 8; ++i) ((LAS f32x4*)wdt)[F.tid + i * NTHR] = tw[i]; }
    __syncthreads();
    const GAS f32x4* g4 = (const GAS f32x4*)(INP(which ? I_N2G : I_N1G) + l * D);
    if (nsl > 0) for (int ms = (int)blockIdx.x; ms < MS; ms += F.G) { f32x4 v1[1][8]; if (ms != (int)blockIdx.x) __syncthreads(); sample_row_reduce(F, ms, nsl, v1[0], partl); const int mr[1] = {MP + ms}; if (F.wave == 0) norm_rows<1>(F, l, which, mr, v1, g4, MOD, H, DT, wdt); }
    const int mend = nsl > 0 ? MP : M;
    const bool first = (l == 0 && which == 0);
    const GAS float* const xpp = INP(I_XP); const GAS float* const xsp = INP(I_XS);
    int m = F.gw;
    if (which == 1 && m + 3 * F.ngw < MP && m + 3 * F.ngw < mend && row_bb(m) == row_bb(m + F.ngw) && row_bb(m + 2 * F.ngw) == row_bb(m + 3 * F.ngw)) {
        f32x4 va[2][8], vb[2][8]; const int ma[2] = {m, m + F.ngw}; const int mb[2] = {m + 2 * F.ngw, m + 3 * F.ngw};
        const GAS float* const xb0 = first ? xpp : (const GAS float*)F.out;
        const GAS f32x4* x0 = (const GAS f32x4*)(xb0 + (size_t)ma[0] * D); const GAS f32x4* x1 = (const GAS f32x4*)(xb0 + (size_t)ma[1] * D);
        const GAS f32x4* x2 = (const GAS f32x4*)(xb0 + (size_t)mb[0] * D); const GAS f32x4* x3 = (const GAS f32x4*)(xb0 + (size_t)mb[1] * D);
#pragma unroll
        for (int j = 0; j < 8; ++j) { va[0][j] = x0[64 * j + F.lane]; va[1][j] = x1[64 * j + F.lane]; }
#pragma unroll
        for (int j = 0; j < 8; ++j) { vb[0][j] = x2[64 * j + F.lane]; vb[1][j] = x3[64 * j + F.lane]; }
        norm_rows<2>(F, l, which, ma, va, g4, MOD, H, DT, wdt);
        norm_rows<2>(F, l, which, mb, vb, g4, MOD, H, DT, wdt);
        m += 4 * F.ngw; }
    while (m < mend) { const int m2 = m + F.ngw;
        if (m2 < mend && row_bb(m) == row_bb(m2)) { f32x4 v2[2][8]; const int mr[2] = {m, m2};
            const GAS f32x4* xa = (const GAS f32x4*)((first ? (m < MP ? xpp + (size_t)m * D : xsp + (size_t)(m - MP) * D) : F.out + (size_t)m * D)); const GAS f32x4* xb = (const GAS f32x4*)((first ? (m2 < MP ? xpp + (size_t)m2 * D : xsp + (size_t)(m2 - MP) * D) : F.out + (size_t)m2 * D));
#pragma unroll
            for (int j = 0; j < 8; ++j) { v2[0][j] = xa[64 * j + F.lane]; v2[1][j] = xb[64 * j + F.lane]; }
            if (first && m >= MP) {
#pragma unroll
                for (int j = 0; j < 8; ++j) { ((GAS f32x4*)(F.out + (size_t)m * D))[64 * j + F.lane] = v2[0][j]; ((GAS f32x4*)(F.out + (size_t)m2 * D))[64 * j + F.lane] = v2[1][j]; } }
            norm_rows<2>(F, l, which, mr, v2, g4, MOD, H, DT, wdt); m += 2 * F.ngw; }
        else { f32x4 v1[1][8]; const int mr[1] = {m}; const GAS f32x4* xa = (const GAS f32x4*)((first ? (m < MP ? xpp + (size_t)m * D : xsp + (size_t)(m - MP) * D) : F.out + (size_t)m * D));
#pragma unroll
            for (int j = 0; j < 8; ++j) v1[0][j] = xa[64 * j + F.lane];
            if (first && m >= MP) {
#pragma unroll
                for (int j = 0; j < 8; ++j) ((GAS f32x4*)(F.out + (size_t)m * D))[64 * j + F.lane] = v1[0][j]; }
            norm_rows<1>(F, l, which, mr, v1, g4, MOD, H, DT, wdt); m += F.ngw; } }
}
__device__ __forceinline__ void final_fix_phase(Frame& F, int nsl) {
    LAS float* partl = (LAS float*)(F.lds + 65536); f32x4 v[8];
    __syncthreads();
    for (int ms = (int)blockIdx.x; ms < MS; ms += F.G) { sample_row_reduce(F, ms, nsl, v, partl); __syncthreads(); }
}
template <int MODE> __device__ __forceinline__ unsigned ssd_raw(const GAS bf16* PROJ, const GAS float* scv, int l, int b, int m0, int tseq0, int r, int ch) {
    if (MODE == 2) { const int rp = r < 0 ? 0 : (r > 7 ? 7 : r), rs = r < 0 ? 3 + r : 0;
        const unsigned a = *(const GAS unsigned*)(PROJ + (size_t)(m0 + rp) * NPROJ + C_CX + ch); const GAS float* sc = scv + ((size_t)(l * BS + b) * 3 + rs) * 1024 + ch; const unsigned c = pk2(sc[0], sc[1]);
        return r < 0 ? c : (r > 7 ? 0u : a); }
    const int rc = (tseq0 + r >= 0) ? r : -tseq0; const unsigned a = *(const GAS unsigned*)(PROJ + (size_t)(m0 + rc) * NPROJ + C_CX + ch);
    return (tseq0 + r >= 0) ? a : 0u;
}
template <int MODE> __device__ __forceinline__ void ssd_unit(Frame& F, int l, int u) {
    WS_LOCALS
    constexpr int T = (MODE == 2) ? 16 : 64, SK = (MODE == 2) ? 32 : 64, L = (MODE == 2) ? 8 : 64, LDN = 136, LDS_ = SK + 8;
    constexpr int NT_CB = (T / 16) * (SK / 16), NT_Y = (T / 16) * 4;
    constexpr int OFF_BG = (MODE == 0 ? 0 : T * LDN * 2), OFF_BGT = OFF_BG + (MODE == 0 ? 0 : T * LDN * 2), OFF_XT = OFF_BGT + (MODE == 1 ? 0 : 128 * LDS_ * 2), OFF_XWT = OFF_XT + (MODE == 0 ? 0 : 4 * 64 * LDS_ * 2),
                  OFF_WL = OFF_XWT + (MODE == 1 ? 0 : 4 * 64 * LDS_ * 2), OFF_SM = OFF_WL + (MODE == 0 ? 0 : 4 * T * LDS_ * 2);
    constexpr int OFF_S0 = (MODE == 2) ? OFF_SM + 2304 : 0;
    static_assert(OFF_SM + 2304 <= RING_BYTES && (MODE != 2 || OFF_S0 + 2 * 64 * 136 * 2 <= RING_BYTES) && (MODE != 1 || 2 * 64 * 136 * 2 <= OFF_XT), "ssd LDS map");
    const int tid0 = F.tid, lane0 = F.lane, wave = F.wave;
    const GAS float* const cwp = INP(I_CW); const GAS float* const cbp = INP(I_CB); const GAS float* const scv = INP(I_SCONV);
    int b, m0, tseq0;
    if (MODE == 2) { b = u; m0 = MP + b * TS; tseq0 = 0; } else { b = u >> 6; m0 = b * TP + (u & 63) * 64; tseq0 = (u & 63) * 64; }
    LAS bf16* Cg = (LAS bf16*)F.lds;
    LAS bf16* Bg = (LAS bf16*)(F.lds + OFF_BG);
    LAS bf16* BgT = (LAS bf16*)(F.lds + OFF_BGT);
    LAS bf16* xT = (LAS bf16*)(F.lds + OFF_XT);
    LAS bf16* xwT = (LAS bf16*)(F.lds + OFF_XWT);
    LAS bf16* Wl = (LAS bf16*)(F.lds + OFF_WL);
    LAS float* cumL = (LAS float*)(F.lds + OFF_SM);
    LAS float* dtL = cumL + 256;
    LAS float* rowss = dtL + 256;
    GAS float* const ytmp = (GAS float*)wsp(F, WS_YTMP) + (size_t)blockIdx.x * (64 * 512);
    float ssum[4] = {0.f, 0.f, 0.f, 0.f};
    if (tid0 < 64) rowss[tid0] = 0.f;
#pragma unroll 1
    for (int g = 0; g < 2; ++g) {
        int tid = tid0, lane = lane0; asm volatile("" : "+v"(tid), "+v"(lane));
        __syncthreads();
        if (MODE == 1) UTS(0);
        GAS bf16* const SHb = (GAS bf16*)wsp(F, WS_SSDH) + (size_t)((MODE == 2 ? 0 : u) * 2 + g) * 32768; GAS float* const SCD = (GAS float*)wsp(F, WS_SSDCD) + (size_t)((MODE == 2 ? 0 : u) * 2 + g) * 512;
        if (MODE == 1) {
            v4u lc[2], lb[2], lx[4];
#pragma unroll
            for (int i = 0; i < 2; ++i) { const int e = tid + i * NTHR; lc[i] = *(const GAS v4u*)(SHb + (size_t)e * 8); lb[i] = *(const GAS v4u*)(SHb + 8192 + (size_t)e * 8); }
#pragma unroll
            for (int i = 0; i < 4; ++i) lx[i] = *(const GAS v4u*)(SHb + 16384 + (size_t)(tid + i * NTHR) * 8);
            const float cdv = SCD[tid];
#pragma unroll
            for (int i = 0; i < 2; ++i) { const int e = tid + i * NTHR, t = e >> 4, n8 = (e & 15) * 8; *(LAS v4u*)(Cg + t * LDN + n8) = lc[i]; *(LAS v4u*)(Bg + t * LDN + n8) = lb[i]; }
#pragma unroll
            for (int i = 0; i < 4; ++i) { const int e = tid + i * NTHR, rp = e >> 3, s8 = (e & 7) * 8; *(LAS v4u*)(xT + rp * LDS_ + s8) = lx[i]; }
            cumL[tid] = cdv;
        } else {
        if (wave < 4) { const int hh = g * 4 + wave; float dtv = 0.f, a = 0.f;
            { const int tl = lane < L ? lane : L - 1; const float raw = DT[(size_t)(m0 + tl) * 8 + hh] + INP(I_DTB)[l * 8 + hh]; const float dt1 = raw > 20.f ? raw : log1pf(__expf(raw)); const float a1 = -dt1 * __expf(INP(I_ALOG)[l * 8 + hh]);
              dtv = lane < L ? dt1 : 0.f; a = lane < L ? a1 : 0.f; }
#pragma unroll
            for (int o = 1; o < 64; o <<= 1) { const float y = __shfl_up(a, o); if (lane >= o) a += y; }
            cumL[lane * 4 + wave] = a; dtL[lane * 4 + wave] = dtv;
            if (MODE == 0) { SCD[lane * 4 + wave] = a; SCD[256 + lane * 4 + wave] = dtv; } }
        {   const int pr = tid & 127, rq = tid >> 7;
            const int isC = pr >> 6, n0 = 2 * (pr & 63), ch = 512 + isC * 256 + g * 128 + n0;
            {
                float w[4][2], bia[2];
#pragma unroll
                for (int j = 0; j < 4; ++j) { w[j][0] = cwp[(l * 4 + j) * 1024 + ch]; w[j][1] = cwp[(l * 4 + j) * 1024 + ch + 1]; }
                bia[0] = cbp[l * 1024 + ch]; bia[1] = cbp[l * 1024 + ch + 1];
                constexpr int RQ = T / 4; const int r0 = rq * RQ;
                unsigned ra[RQ + 3];
#pragma unroll
                for (int i = 0; i < RQ + 3; ++i) ra[i] = ssd_raw<MODE>(PROJ, scv, l, b, m0, tseq0, r0 - 3 + i, ch);
#pragma unroll
                for (int i = 0; i < RQ; ++i) { const int r = r0 + i; float c0 = 0.f, c1 = 0.f;
                    if (r < L) { c0 = bia[0] + w[0][0] * bflo(ra[i]) + w[1][0] * bflo(ra[i + 1]) + w[2][0] * bflo(ra[i + 2]) + w[3][0] * bflo(ra[i + 3]); c1 = bia[1] + w[0][1] * bfhi(ra[i]) + w[1][1] * bfhi(ra[i + 1]) + w[2][1] * bfhi(ra[i + 2]) + w[3][1] * bfhi(ra[i + 3]);
                        c0 = c0 * sigm(c0); c1 = c1 * sigm(c1); }
                    if (MODE == 0) *(GAS unsigned*)(SHb + (isC ? 0 : 8192) + r * 128 + n0) = pk2(c0, c1);
                    if (isC) { if (MODE != 0) *(LAS unsigned*)(Cg + r * LDN + n0) = pk2(c0, c1); }
                    else { if (MODE != 0) *(LAS unsigned*)(Bg + r * LDN + n0) = pk2(c0, c1);
                           if (MODE != 1) { BgT[n0 * LDS_ + r] = tobf(c0); BgT[(n0 + 1) * LDS_ + r] = tobf(c1); } } }
                if (MODE == 2 && !isC) { for (int r = T + rq * 4; r < T + rq * 4 + 4; ++r) { BgT[n0 * LDS_ + r] = 0; BgT[(n0 + 1) * LDS_ + r] = 0; } }
            }
        }
        }
        __syncthreads();
        if (MODE == 1) { UTE(0); UTS(1); }
        { int t_ = tid0, l_ = lane0; asm volatile("" : "+v"(t_), "+v"(l_)); tid = t_; lane = l_; }
        if (MODE != 1)
        {   const int pr = tid & 127, rq = tid >> 7, r = pr >> 5, pp = pr & 31; const int ch = (g * 4 + r) * 64 + 2 * pp;
            float w[4][2], bia[2];
#pragma unroll
            for (int j = 0; j < 4; ++j) { w[j][0] = cwp[(l * 4 + j) * 1024 + ch]; w[j][1] = cwp[(l * 4 + j) * 1024 + ch + 1]; }
            bia[0] = cbp[l * 1024 + ch]; bia[1] = cbp[l * 1024 + ch + 1];
            constexpr int RS = SK / 4; const int r0 = rq * RS;
            const float cl = cumL[(L - 1) * 4 + r];
            unsigned ra[RS + 3];
#pragma unroll
            for (int i = 0; i < RS + 3; ++i) ra[i] = ssd_raw<MODE>(PROJ, scv, l, b, m0, tseq0, r0 - 3 + i, ch);
            LAS bf16* x0 = xT + (r * 64 + 2 * pp) * LDS_; LAS bf16* xw0 = xwT + (r * 64 + 2 * pp) * LDS_;
            float pc0[RS], pc1[RS];
#pragma unroll
            for (int i = 0; i < RS; ++i) { const int s = r0 + i; float c0 = 0.f, c1 = 0.f, ws = 0.f;
                if (s < L) { c0 = bia[0] + w[0][0] * bflo(ra[i]) + w[1][0] * bflo(ra[i + 1]) + w[2][0] * bflo(ra[i + 2]) + w[3][0] * bflo(ra[i + 3]); c1 = bia[1] + w[0][1] * bfhi(ra[i]) + w[1][1] * bfhi(ra[i + 1]) + w[2][1] * bfhi(ra[i + 2]) + w[3][1] * bfhi(ra[i + 3]);
                    c0 = c0 * sigm(c0); c1 = c1 * sigm(c1); ws = dtL[s * 4 + r] * __expf(cl - cumL[s * 4 + r]); }
                pc0[i] = c0; pc1[i] = c1;
                if (MODE != 0) { x0[s] = tobf(c0); x0[LDS_ + s] = tobf(c1); }
                if (MODE != 1) { xw0[s] = tobf(c0 * ws); xw0[LDS_ + s] = tobf(c1 * ws); } }
            if (MODE == 0) {
#pragma unroll
                for (int hlf = 0; hlf < 2; ++hlf) { v4u a, c;
                    a.x = pk2(pc0[8 * hlf], pc0[8 * hlf + 1]); a.y = pk2(pc0[8 * hlf + 2], pc0[8 * hlf + 3]); a.z = pk2(pc0[8 * hlf + 4], pc0[8 * hlf + 5]); a.w = pk2(pc0[8 * hlf + 6], pc0[8 * hlf + 7]);
                    c.x = pk2(pc1[8 * hlf], pc1[8 * hlf + 1]); c.y = pk2(pc1[8 * hlf + 2], pc1[8 * hlf + 3]); c.z = pk2(pc1[8 * hlf + 4], pc1[8 * hlf + 5]); c.w = pk2(pc1[8 * hlf + 6], pc1[8 * hlf + 7]);
                    *(GAS v4u*)(SHb + 16384 + (size_t)(r * 64 + 2 * pp) * 64 + r0 + 8 * hlf) = a; *(GAS v4u*)(SHb + 16384 + (size_t)(r * 64 + 2 * pp + 1) * 64 + r0 + 8 * hlf) = c; } }
        }
        if (MODE != 0) {
#pragma unroll
            for (int j = 0; j < 2; ++j) { const int id = 2 * wave + j; if (id < NT_CB) { const int ti = id / (SK / 16), si = id % (SK / 16); f32x4 cb = (f32x4){0.f, 0.f, 0.f, 0.f};
                if (!(MODE == 2 && si > 0) && si <= ti) cb = mma16(Cg + ti * 16 * LDN, LDN, Bg + si * 16 * LDN, LDN, 128, cb, lane);
#pragma unroll
                for (int r = 0; r < 4; ++r)
#pragma unroll
                    for (int i = 0; i < 4; ++i) { const int t = ti * 16 + 4 * (lane >> 4) + i, s = si * 16 + (lane & 15);
                        float wv = 0.f; if (s <= t && (MODE != 2 || t < L)) wv = cb[i] * __expf(cumL[t * 4 + r] - cumL[s * 4 + r]) * dtL[s * 4 + r];
                        Wl[(r * T + t) * LDS_ + s] = tobf(wv); } } }
        }
        __syncthreads();
        if (MODE == 1) { UTE(1); UTS(2); }
        { int t_ = tid0, l_ = lane0; asm volatile("" : "+v"(t_), "+v"(l_)); tid = t_; lane = l_; }
        if (MODE != 0) {
            LAS bf16* Sl = (LAS bf16*)(F.lds + OFF_S0);
            const bool ywave = 2 * wave < NT_Y; const int ti = (2 * wave) >> 2;
            bf16x8v ca[4];
#pragma unroll
            for (int ks = 0; ks < 4; ++ks) ca[ks] = *(const LAS bf16x8v*)(Cg + (ti * 16 + (lane & 15)) * LDN + ks * 32 + 8 * (lane >> 4));
            const GAS float* dskp = INP(I_DSK) + l * 8 + g * 4; const float dsk4[4] = {dskp[0], dskp[1], dskp[2], dskp[3]};
#pragma unroll
            for (int half = 0; half < 2; ++half) {
                float zv[2][2][4];
                if (ywave) {
#pragma unroll
                    for (int rr = 0; rr < 2; ++rr)
#pragma unroll
                        for (int j = 0; j < 2; ++j)
#pragma unroll
                            for (int i = 0; i < 4; ++i) { const int t = ti * 16 + 4 * (lane >> 4) + i, p = ((2 * wave + j) & 3) * 16 + (lane & 15); const int tc = t < L ? t : L - 1; zv[rr][j][i] = bf2f(PROJ[(size_t)(m0 + tc) * NPROJ + C_CZ + (g * 4 + 2 * half + rr) * 64 + p]); } }
                __syncthreads();
                if (MODE == 1) { v4u sb4[4]; const GAS v4u* sbp = (const GAS v4u*)((const GAS bf16*)SDSS + ((size_t)u * 8 + g * 4 + 2 * half) * 8192);
#pragma unroll
                    for (int i = 0; i < 4; ++i) sb4[i] = sbp[tid + i * NTHR];
#pragma unroll
                    for (int i = 0; i < 4; ++i) { const int e = tid + i * NTHR, rr = e >> 10, e2 = e & 1023, p = e2 >> 4, n8 = (e2 & 15) * 8; *(LAS v4u*)(Sl + (rr * 64 + p) * LDN + n8) = sb4[i]; } }
                else { f32x4 sv8[8]; const GAS float* sbase = INP(I_SSSM) + ((size_t)(l * BS + b) * 8 + g * 4 + 2 * half) * 8192;
#pragma unroll
                    for (int i = 0; i < 8; ++i) sv8[i] = ((const GAS f32x4*)sbase)[tid + i * NTHR];
#pragma unroll
                    for (int i = 0; i < 8; ++i) { const int e = tid + i * NTHR, rr = e >> 11, e2 = e & 2047, p = e2 >> 5, n4 = (e2 & 31) * 4; const f32x4 v = sv8[i];
                        *(LAS unsigned*)(Sl + (rr * 64 + p) * LDN + n4) = pk2(v.x, v.y); *(LAS unsigned*)(Sl + (rr * 64 + p) * LDN + n4 + 2) = pk2(v.z, v.w); } }
                __syncthreads();
                if (ywave) {
#pragma unroll
                    for (int rr = 0; rr < 2; ++rr)
#pragma unroll
                        for (int j = 0; j < 2; ++j) { const int r = 2 * half + rr, hh = g * 4 + r, pj = (2 * wave + j) & 3;
                            f32x4 y1 = (f32x4){0.f, 0.f, 0.f, 0.f}, y2 = y1;
                            y1 = mma16(Wl + (r * T + ti * 16) * LDS_, LDS_, xT + (r * 64 + pj * 16) * LDS_, LDS_, SK, y1, lane);
#pragma unroll
                            for (int ks = 0; ks < 4; ++ks) y2 = __builtin_amdgcn_mfma_f32_16x16x32_bf16(ca[ks], *(const LAS bf16x8v*)(Sl + (rr * 64 + pj * 16 + (lane & 15)) * LDN + ks * 32 + 8 * (lane >> 4)), y2, 0, 0, 0);
                            const int p = pj * 16 + (lane & 15); const float dsk = dsk4[r];
#pragma unroll
                            for (int i = 0; i < 4; ++i) { const int t = ti * 16 + 4 * (lane >> 4) + i;
                                if (MODE != 2 || t < L) { const float xv = bf2f(xT[(r * 64 + p) * LDS_ + t]); const float z = zv[rr][j][i];
                                    const float yy = (y1[i] + __expf(cumL[t * 4 + r]) * y2[i] + dsk * xv) * z * sigm(z); ssum[i] += yy * yy; ytmp[t * 512 + hh * 64 + p] = yy; } } } }
            }
        }
        if (MODE == 1) UTE(2);
        if (MODE != 1) {
            const int r = wave >> 1, hh = g * 4 + r; const float dtot = __expf(cumL[(L - 1) * 4 + r]);
#pragma unroll 1
            for (int pi = 0; pi < 4; ++pi) { f32x4 d[4]; float sv[4][4];
                const size_t sb0 = ((size_t)(l * BS + b) * 8 + hh) * 8192; const GAS float* sin_ = (MODE == 2) ? INP(I_SSSM) + sb0 : nullptr;
                if (MODE == 2) {
#pragma unroll
                    for (int j = 0; j < 4; ++j)
#pragma unroll
                        for (int i = 0; i < 4; ++i) sv[j][i] = sin_[(pi * 16 + 4 * (lane >> 4) + i) * 128 + (4 * (wave & 1) + j) * 16 + (lane & 15)]; }
#pragma unroll
                for (int j = 0; j < 4; ++j) { const int nj = 4 * (wave & 1) + j; d[j] = (f32x4){0.f, 0.f, 0.f, 0.f}; d[j] = mma16(xwT + (r * 64 + pi * 16) * LDS_, LDS_, BgT + nj * 16 * LDS_, LDS_, SK, d[j], lane); }
#pragma unroll
                for (int j = 0; j < 4; ++j) { const int n = (4 * (wave & 1) + j) * 16 + (lane & 15);
#pragma unroll
                    for (int i = 0; i < 4; ++i) { const int p = pi * 16 + 4 * (lane >> 4) + i;
                        if (MODE == 0) ((GAS bf16*)SDDS)[((size_t)u * 8 + hh) * 8192 + p * 128 + n] = tobf(d[j][i]); else __builtin_nontemporal_store(dtot * sv[j][i] + d[j][i], F.out + O_SSSM + sb0 + p * 128 + n); } } }
            if (MODE == 0 && (lane & 63) == 0 && (wave & 1) == 0) SDDEC[u * 8 + hh] = dtot;
        }
    }
    const int tid = tid0, lane = lane0;
    if (MODE == 1) UTS(3);
    if (MODE != 0) {
#pragma unroll
        for (int i = 0; i < 4; ++i) { float s = ssum[i]; s += __shfl_xor(s, 1); s += __shfl_xor(s, 2); s += __shfl_xor(s, 4); s += __shfl_xor(s, 8);
            const int id = 2 * wave; if (id < NT_Y && (lane & 15) == 0) __hip_atomic_fetch_add(&rowss[(id >> 2) * 16 + 4 * (lane >> 4) + i], s, __ATOMIC_RELAXED, __HIP_MEMORY_SCOPE_WORKGROUP); }
        __syncthreads();
        const GAS float* ngp = INP(I_SNG) + l * 512;
        if (2 * wave < NT_Y) {
            float rinv[4];
#pragma unroll
            for (int i = 0; i < 4; ++i) { const int t = ((2 * wave) >> 2) * 16 + 4 * (lane >> 4) + i; rinv[i] = rsq(rowss[t] * (1.f / 512.f) + EPS); }
#pragma unroll 1
            for (int gh = 0; gh < 2; ++gh) { float yv[4][2][4], ngv[4][2];
#pragma unroll
                for (int g4 = 0; g4 < 4; ++g4)
#pragma unroll
                    for (int j = 0; j < 2; ++j) { const int id = 2 * wave + j, ti = id >> 2, pj = id & 3, chn = (gh * 4 + g4) * 64 + pj * 16 + (lane & 15); ngv[g4][j] = ngp[chn];
#pragma unroll
                        for (int i = 0; i < 4; ++i) { const int t = ti * 16 + 4 * (lane >> 4) + i; yv[g4][j][i] = ytmp[(t < L ? t : 0) * 512 + chn]; } }
#pragma unroll
                for (int g4 = 0; g4 < 4; ++g4)
#pragma unroll
                    for (int j = 0; j < 2; ++j) { const int id = 2 * wave + j, ti = id >> 2, pj = id & 3, chn = (gh * 4 + g4) * 64 + pj * 16 + (lane & 15);
#pragma unroll
                        for (int i = 0; i < 4; ++i) { const int t = ti * 16 + 4 * (lane >> 4) + i; if (MODE != 2 || t < L) MIX[(size_t)(m0 + t) * D + 1024 + chn] = tobf(yv[g4][j][i] * rinv[i] * ngv[g4][j]); } } }
        }
    }
    if (MODE == 1) { __syncthreads(); UTE(3); }
    if (MODE == 0 && (u & 63) == 63) for (int e = tid; e < 3 * 1024; e += NTHR) { const int j = e >> 10, c2 = e & 1023; F.out[O_PCONV + ((size_t)(l * BP + b) * 3 + j) * 1024 + c2] = bf2f(PROJ[(size_t)(m0 + 61 + j) * NPROJ + C_CX + c2]); }
    if (MODE == 2) for (int e = tid; e < 3 * 1024; e += NTHR) { const int j = e >> 10, c2 = e & 1023; F.out[O_SCONV + ((size_t)(l * BS + b) * 3 + j) * 1024 + c2] = bf2f(PROJ[(size_t)(m0 + 5 + j) * NPROJ + C_CX + c2]); }
}
template <int MODE> __device__ __forceinline__ void hgrn_unit(Frame& F, int l, int u) {
    WS_LOCALS
    constexpr int T = (MODE == 2) ? 16 : 64, SK = (MODE == 2) ? 32 : 64, L = (MODE == 2) ? 8 : 64, MID = (MODE == 2) ? 3 : 31, LDN = 136, LDS_ = SK + 8, NI = T / 4;
    constexpr int OFF_QT = T * 512, OFF_KT = OFF_QT + T * 272, OFF_KTT = OFF_KT + T * 272, OFF_VT = OFF_KTT + (MODE == 1 ? 0 : 128 * LDS_ * 2), OFF_S0T = OFF_VT + 128 * LDS_ * 2, OFF_AM = OFF_S0T + (MODE == 0 ? 0 : 128 * 272), OFF_END = OFF_AM + T * LDS_ * 2;
    static_assert(OFF_END <= RING_BYTES, "hgrn LDS map");
    const int tid = F.tid, lane = F.lane, wave = F.wave, d = tid & 127, tq = tid >> 7;
    int h, m0; size_t sidx;
    if (MODE == 2) { const int b = u >> 2; h = u & 3; m0 = MP + b * TS; sidx = ((size_t)(l * BS + b) * 4 + h) * 16384; }
    else { const int bh = u >> 6, c = u & 63, b = bh >> 2; h = bh & 3; m0 = b * TP + c * 64; sidx = (size_t)u * 16384; }
    LAS float* cum = (LAS float*)F.lds;
    LAS bf16* qt = (LAS bf16*)(F.lds + OFF_QT);
    LAS bf16* kt = (LAS bf16*)(F.lds + OFF_KT);
    LAS bf16* ktT = (LAS bf16*)(F.lds + OFF_KTT);
    LAS bf16* vT = (LAS bf16*)(F.lds + OFF_VT);
    LAS bf16* S0T = (LAS bf16*)(F.lds + OFF_S0T);
    LAS bf16* Am = (LAS bf16*)(F.lds + OFF_AM);
    LAS float* refv = (LAS float*)(F.lds + RING_BYTES + 2048);
    LAS float* efin = refv + 128; LAS float* decv = efin + 128; LAS float* erefv = decv + 128; LAS float* rowss = erefv + 128;
    const GAS float* S0g = INP(I_SHG) + sidx;
    GAS bf16* const HQb = (GAS bf16*)wsp(F, WS_HQ); GAS bf16* const HKb = (GAS bf16*)wsp(F, WS_HK); GAS bf16* const HVb = (GAS bf16*)wsp(F, WS_HV); GAS float* const HEREF = (GAS float*)wsp(F, WS_HEREF);
    if (MODE != 1) {
    __syncthreads();
    {   const int t = lane, tc = t < L ? t : L - 1, d0 = 16 * wave; const bool ok = t < L;
        const GAS bf16* row = PROJ + (size_t)(m0 + tc) * NPROJ + h * 128 + d0;
        const v4u fw0 = *(const GAS v4u*)(row + C_AF), fw1 = *(const GAS v4u*)(row + C_AF + 8), qw0 = *(const GAS v4u*)(row + C_AQ), qw1 = *(const GAS v4u*)(row + C_AQ + 8), iw0 = *(const GAS v4u*)(row + C_AI), iw1 = *(const GAS v4u*)(row + C_AI + 8);
        const GAS f32x4* lbp = (const GAS f32x4*)(LBv + l * 512 + h * 128 + d0); const f32x4 lb0 = lbp[0], lb1 = lbp[1], lb2 = lbp[2], lb3 = lbp[3];
        const float lbv[16] = {lb0.x, lb0.y, lb0.z, lb0.w, lb1.x, lb1.y, lb1.z, lb1.w, lb2.x, lb2.y, lb2.z, lb2.w, lb3.x, lb3.y, lb3.z, lb3.w};
        const unsigned fu[8] = {fw0.x, fw0.y, fw0.z, fw0.w, fw1.x, fw1.y, fw1.z, fw1.w}, qu[8] = {qw0.x, qw0.y, qw0.z, qw0.w, qw1.x, qw1.y, qw1.z, qw1.w}, iu[8] = {iw0.x, iw0.y, iw0.z, iw0.w, iw1.x, iw1.y, iw1.z, iw1.w};
        float a[16], q[16], k[16], v[16];
#pragma unroll
        for (int j = 0; j < 16; ++j) { const float fr = (j & 1) ? bfhi(fu[j >> 1]) : bflo(fu[j >> 1]), qr = (j & 1) ? bfhi(qu[j >> 1]) : bflo(qu[j >> 1]), v1 = (j & 1) ? bfhi(iu[j >> 1]) : bflo(iu[j >> 1]);
            const float e = __expf(-fr); const float ie = __builtin_amdgcn_rcpf(1.f + e); const float fg = lbv[j] + (1.f - lbv[j]) * ie;
            a[j] = ok ? __logf(fg) : 0.f; k[j] = ok ? (1.f - lbv[j]) * (e * ie) : 0.f; q[j] = ok ? qr * sigm(qr) : 0.f; v[j] = ok ? v1 : 0.f; }
#pragma unroll
        for (int o = 1; o < 64; o <<= 1) {
#pragma unroll
            for (int j = 0; j < 16; ++j) { const float y = __shfl_up(a[j], o); if (lane >= o) a[j] += y; } }
        unsigned qp[8], kp[8], vp[8];
#pragma unroll
        for (int j = 0; j < 16; ++j) { const float rf = __shfl(a[j], MID), cl = __shfl(a[j], L - 1);
            const float qs = q[j] * __expf(fminf(a[j] - rf, 80.f)), ks = k[j] * __expf(fminf(rf - a[j], 80.f));
            if (lane == j) { efin[d0 + j] = __expf(cl - rf); decv[d0 + j] = __expf(cl); erefv[d0 + j] = __expf(rf); if (MODE == 0) HEREF[u * 128 + d0 + j] = __expf(rf); }
            if (MODE != 1 && t < SK) ktT[(d0 + j) * LDS_ + t] = tobf(ks);
            if (t < SK) vT[(d0 + j) * LDS_ + t] = tobf(v[j]);
            if (j & 1) { qp[j >> 1] |= f2bf(qs) << 16; kp[j >> 1] |= f2bf(ks) << 16; vp[j >> 1] |= f2bf(v[j]) << 16; } else { qp[j >> 1] = f2bf(qs); kp[j >> 1] = f2bf(ks); vp[j >> 1] = f2bf(v[j]); } }
        const v4u q0 = {qp[0], qp[1], qp[2], qp[3]}, q1 = {qp[4], qp[5], qp[6], qp[7]}, k0 = {kp[0], kp[1], kp[2], kp[3]}, k1 = {kp[4], kp[5], kp[6], kp[7]}, v0 = {vp[0], vp[1], vp[2], vp[3]}, v1v = {vp[4], vp[5], vp[6], vp[7]};
        if (MODE != 0 && t < T) { *(LAS v4u*)(qt + t * LDN + d0) = q0; *(LAS v4u*)(qt + t * LDN + d0 + 8) = q1; *(LAS v4u*)(kt + t * LDN + d0) = k0; *(LAS v4u*)(kt + t * LDN + d0 + 8) = k1; }
        if (MODE == 0) { const size_t go = (size_t)u * 8192 + t * 128 + d0;
            *(GAS v4u*)(HQb + go) = q0; *(GAS v4u*)(HQb + go + 8) = q1; *(GAS v4u*)(HKb + go) = k0; *(GAS v4u*)(HKb + go + 8) = k1; *(GAS v4u*)(HVb + go) = v0; *(GAS v4u*)(HVb + go + 8) = v1v; }
        if (tid < 64) rowss[tid] = 0.f;
    }
    if (MODE == 2) __syncthreads();
    }
    if (MODE == 1) {
        __syncthreads();
        if (tid < 64) rowss[tid] = 0.f;
        v4u lq[2], lk[2], lv[2];
#pragma unroll
        for (int i = 0; i < 2; ++i) { const size_t go = (size_t)u * 8192 + (size_t)(tid + i * NTHR) * 8; lq[i] = *(const GAS v4u*)(HQb + go); lk[i] = *(const GAS v4u*)(HKb + go); lv[i] = *(const GAS v4u*)(HVb + go); }
#pragma unroll
        for (int i = 0; i < 2; ++i) { const int e = tid + i * NTHR, t = e >> 4, d8 = (e & 15) * 8;
            *(LAS v4u*)(qt + t * LDN + d8) = lq[i]; *(LAS v4u*)(kt + t * LDN + d8) = lk[i];
            const unsigned w[4] = {lv[i].x, lv[i].y, lv[i].z, lv[i].w};
#pragma unroll
            for (int k = 0; k < 4; ++k) { vT[(d8 + 2 * k) * LDS_ + t] = (bf16)(w[k] & 0xffffu); vT[(d8 + 2 * k + 1) * LDS_ + t] = (bf16)(w[k] >> 16); } }
    }
    if (MODE == 1) { v4u sb4[4]; const GAS v4u* sbp = (const GAS v4u*)((const GAS bf16*)HGSS + sidx);
#pragma unroll
        for (int i = 0; i < 4; ++i) sb4[i] = sbp[tid + i * NTHR];
#pragma unroll
        for (int i = 0; i < 4; ++i) { const int e = tid + i * NTHR, v = e >> 4, d8 = (e & 15) * 8; const f32x4 e0 = *(const GAS f32x4*)(HEREF + u * 128 + d8), e1 = *(const GAS f32x4*)(HEREF + u * 128 + d8 + 4); const v4u w = sb4[i]; v4u o;
            o.x = pk2(bflo(w.x) * e0.x, bfhi(w.x) * e0.y); o.y = pk2(bflo(w.y) * e0.z, bfhi(w.y) * e0.w); o.z = pk2(bflo(w.z) * e1.x, bfhi(w.z) * e1.y); o.w = pk2(bflo(w.w) * e1.z, bfhi(w.w) * e1.w);
            *(LAS v4u*)(S0T + v * LDN + d8) = o; } }
    if (MODE == 2) { f32x4 sv8[8];
#pragma unroll
        for (int i = 0; i < 8; ++i) sv8[i] = __builtin_nontemporal_load((const GAS f32x4*)S0g + tid + i * NTHR);
#pragma unroll
        for (int i = 0; i < 8; ++i) { const int e = tid + i * NTHR; const f32x4 s = sv8[i]; const int dd = e >> 5, v4 = (e & 31) * 4; const float er = erefv[dd];
            S0T[(v4) * LDN + dd] = tobf(s.x * er); S0T[(v4 + 1) * LDN + dd] = tobf(s.y * er); S0T[(v4 + 2) * LDN + dd] = tobf(s.z * er); S0T[(v4 + 3) * LDN + dd] = tobf(s.w * er); } }
    __syncthreads();
    if (MODE != 0) {
#pragma unroll
        for (int j = 0; j < 2; ++j) { const int id = 2 * wave + j; if (id < (T / 16) * (SK / 16)) { const int ti = id / (SK / 16), si = id % (SK / 16);
            f32x4 a = (f32x4){0.f, 0.f, 0.f, 0.f};
            if (si <= ti && si < T / 16) a = mma16(qt + ti * 16 * LDN, LDN, kt + si * 16 * LDN, LDN, 128, a, lane);
#pragma unroll
            for (int i = 0; i < 4; ++i) { const int t = ti * 16 + 4 * (lane >> 4) + i, s = si * 16 + (lane & 15); Am[t * LDS_ + s] = tobf((s <= t && si <= ti && si < T / 16) ? a[i] : 0.f); } } }
        __syncthreads();
        f32x4 o[4]; float ssum[4] = {0.f, 0.f, 0.f, 0.f};
#pragma unroll
        for (int j = 0; j < 4; ++j) { const int id = 4 * wave + j; o[j] = (f32x4){0.f, 0.f, 0.f, 0.f};
            if (id < (T / 16) * 8) { const int ti = id >> 3, vj = id & 7;
                o[j] = mma16(Am + ti * 16 * LDS_, LDS_, vT + vj * 16 * LDS_, LDS_, SK, o[j], lane);
                o[j] = mma16(qt + ti * 16 * LDN, LDN, S0T + vj * 16 * LDN, LDN, 128, o[j], lane);
#pragma unroll
                for (int i = 0; i < 4; ++i) ssum[i] += o[j][i] * o[j][i]; } }
        if (4 * wave < (T / 16) * 8) {
#pragma unroll
            for (int i = 0; i < 4; ++i) { float s = ssum[i]; s += __shfl_xor(s, 1); s += __shfl_xor(s, 2); s += __shfl_xor(s, 4); s += __shfl_xor(s, 8);
                if ((lane & 15) == 0) __hip_atomic_fetch_add(&rowss[((4 * wave) >> 3) * 16 + 4 * (lane >> 4) + i], s, __ATOMIC_RELAXED, __HIP_MEMORY_SCOPE_WORKGROUP); } }
        __syncthreads();
        const GAS float* ngp = INP(I_HNG) + l * 512 + h * 128;
        float grv[4][4], ngv[4];
#pragma unroll
        for (int j = 0; j < 4; ++j) { const int id = 4 * wave + j, ti = (id >> 3) & (T / 16 - 1), vj = id & 7, v = vj * 16 + (lane & 15); ngv[j] = ngp[v];
#pragma unroll
            for (int i = 0; i < 4; ++i) { const int t = ti * 16 + 4 * (lane >> 4) + i; const int tc = t < L ? t : L - 1; grv[j][i] = bf2f(PROJ[(size_t)(m0 + tc) * NPROJ + C_AG + h * 128 + v]); } }
#pragma unroll
        for (int j = 0; j < 4; ++j) { const int id = 4 * wave + j; if (id < (T / 16) * 8) { const int ti = id >> 3, vj = id & 7, v = vj * 16 + (lane & 15);
#pragma unroll
            for (int i = 0; i < 4; ++i) { const int t = ti * 16 + 4 * (lane >> 4) + i;
                if (MODE != 2 || t < L) MIX[(size_t)(m0 + t) * D + h * 128 + v] = tobf(o[j][i] * rsq(rowss[t] * (1.f / 128.f) + EPS) * ngv[j] * sigm(grv[j][i])); } } }
    }
    if (MODE != 1) {
        float sv[8][4];
        if (MODE == 2) {
#pragma unroll
            for (int j = 0; j < 8; ++j)
#pragma unroll
                for (int i = 0; i < 4; ++i) sv[j][i] = S0g[(wave * 16 + 4 * (lane >> 4) + i) * 128 + j * 16 + (lane & 15)]; }
#pragma unroll
        for (int j = 0; j < 8; ++j) { f32x4 a = (f32x4){0.f, 0.f, 0.f, 0.f}; a = mma16(ktT + wave * 16 * LDS_, LDS_, vT + j * 16 * LDS_, LDS_, SK, a, lane);
            const int v = j * 16 + (lane & 15);
            if (MODE == 0) { const int d0 = wave * 16 + 4 * (lane >> 4); const f32x4 ef = *(const LAS f32x4*)(efin + d0);
                *(GAS unsigned long long*)((GAS bf16*)HGDS + sidx + v * 128 + d0) = (unsigned long long)pk2(ef.x * a[0], ef.y * a[1]) | ((unsigned long long)pk2(ef.z * a[2], ef.w * a[3]) << 32); }
            else {
#pragma unroll
                for (int i = 0; i < 4; ++i) { const int dd = wave * 16 + 4 * (lane >> 4) + i; __builtin_nontemporal_store(decv[dd] * sv[j][i] + efin[dd] * a[i], F.out + O_SHG + sidx + dd * 128 + v); } } }
        if (MODE == 0 && tid < 128) HGDEC[u * 128 + tid] = decv[tid];
    }
}
__device__ __forceinline__ void scan_phase(Frame& F, int l) {
    WS_LOCALS
    const int gt = blockIdx.x * NTHR + F.tid, NT = F.G * NTHR;
    for (int e = gt; e < 131072; e += NT) {
        const bool isH = e < 65536; const int pe = isH ? e : e - 65536;
        const int bh = pe >> 13, vd = (pe & 8191) * 2, d = vd & 127, v = vd >> 7;
        const int bhh = pe >> 12, b = bhh >> 3, hh = bhh & 7, pn = (pe & 4095) * 2;
        const GAS unsigned* xin = (const GAS unsigned*)(isH ? (const GAS bf16*)HGDS + (size_t)bh * 64 * 16384 + vd : (const GAS bf16*)SDDS + ((size_t)(b * 64) * 8 + hh) * 8192 + pn);
        GAS unsigned* xout = (GAS unsigned*)(isH ? (GAS bf16*)HGSS + (size_t)bh * 64 * 16384 + vd : (GAS bf16*)SDSS + ((size_t)(b * 64) * 8 + hh) * 8192 + pn);
        const size_t cstep = isH ? 16384 / 2 : 8 * 8192 / 2;
        const GAS float* dcp = isH ? HGDEC + (size_t)bh * 64 * 128 + d : SDDEC + (size_t)(b * 64) * 8 + hh; const int dstep = isH ? 128 : 8, d1off = isH ? 1 : 0;
        float S0 = 0.f, S1 = 0.f;
#pragma unroll 1
        for (int c0 = 0; c0 < 64; c0 += 16) { unsigned xw[16]; float da[16], db[16];
#pragma unroll
            for (int k = 0; k < 16; ++k) { xw[k] = xin[(size_t)(c0 + k) * cstep]; da[k] = dcp[(size_t)(c0 + k) * dstep]; db[k] = dcp[(size_t)(c0 + k) * dstep + d1off]; }
#pragma unroll
            for (int k = 0; k < 16; ++k) { xout[(size_t)(c0 + k) * cstep] = pk2(S0, S1); S0 = da[k] * S0 + bflo(xw[k]); S1 = db[k] * S1 + bfhi(xw[k]); } }
        if (isH) { __builtin_nontemporal_store(S0, F.out + O_PHG + ((size_t)l * 8 + bh) * 16384 + d * 128 + v); __builtin_nontemporal_store(S1, F.out + O_PHG + ((size_t)l * 8 + bh) * 16384 + (d + 1) * 128 + v); }
        else { __builtin_nontemporal_store(S0, F.out + O_PSSM + ((size_t)(l * BP + b) * 8 + hh) * 8192 + pn); __builtin_nontemporal_store(S1, F.out + O_PSSM + ((size_t)(l * BP + b) * 8 + hh) * 8192 + pn + 1); } }
}
__device__ __forceinline__ float sq8(v4u w) { const float a0 = bflo(w.x), a1 = bfhi(w.x), a2 = bflo(w.y), a3 = bfhi(w.y), a4 = bflo(w.z), a5 = bfhi(w.z), a6 = bflo(w.w), a7 = bfhi(w.w);
    return ((a0 * a0 + a1 * a1) + (a2 * a2 + a3 * a3)) + ((a4 * a4 + a5 * a5) + (a6 * a6 + a7 * a7)); }
__device__ __forceinline__ float rope1(float x, float rn, float g, float c, float s, int dh) { const float xn = x * rn * g; const float other = __shfl_xor(xn, 1); return dh == 0 ? xn * c - other * s : xn * c + other * s; }
__device__ __forceinline__ v4u rope8(v4u w, float rn, const GAS float* g, const GAS float* rp, int dh) {
    const f32x4 g0 = *(const GAS f32x4*)g, g1 = *(const GAS f32x4*)(g + 4), c0 = *(const GAS f32x4*)rp, c1 = *(const GAS f32x4*)(rp + 4), s0 = *(const GAS f32x4*)(rp + 32), s1 = *(const GAS f32x4*)(rp + 36);
    v4u o;
    o.x = pk2(rope1(bflo(w.x), rn, g0.x, c0.x, s0.x, dh), rope1(bfhi(w.x), rn, g0.y, c0.y, s0.y, dh));
    o.y = pk2(rope1(bflo(w.y), rn, g0.z, c0.z, s0.z, dh), rope1(bfhi(w.y), rn, g0.w, c0.w, s0.w, dh));
    o.z = pk2(rope1(bflo(w.z), rn, g1.x, c1.x, s1.x, dh), rope1(bfhi(w.z), rn, g1.y, c1.y, s1.y, dh));
    o.w = pk2(rope1(bflo(w.w), rn, g1.z, c1.z, s1.z, dh), rope1(bfhi(w.w), rn, g1.w, c1.w, s1.w, dh));
    return o;
}
template <int SAMPLE> __device__ __forceinline__ void attn_unit(Frame& F, int l, int u) {
    WS_LOCALS
    constexpr int LDK = 72, LDV = 200, LDPW = 168;
    const int tid = F.tid, lane = F.lane, wave = F.wave;
    const GAS float* const ckp = INP(I_CK); const GAS float* const cvp = INP(I_CV);
    LAS bf16* Kb = (LAS bf16*)F.lds; LAS bf16* VT = Kb + 192 * LDK; LAS bf16* Qs = VT + 64 * LDV; LAS bf16* Pw = Qs + wave * 16 * LDPW;
    int b, g, q0, row_min; size_t mbase;
    if (SAMPLE) { b = u >> 1; g = u & 1; q0 = 0; row_min = 0; mbase = (size_t)MP + b * TS; }
    else { g = u & 1; const int qt = (u >> 1) & 63; b = u >> 7; q0 = qt * 64; row_min = q0 >= 127 ? 0 : 127 - q0; mbase = (size_t)b * TP; }
    __syncthreads();
    {   const int j8 = tid & 7; const GAS float* kg = INP(I_KNG) + l * 64 + 8 * j8;
        const f32x4 kg0 = *(const GAS f32x4*)kg, kg1 = *(const GAS f32x4*)(kg + 4);
        const float kgv[8] = {kg0.x, kg0.y, kg0.z, kg0.w, kg1.x, kg1.y, kg1.z, kg1.w};
        GAS float* const okp = F.out + (SAMPLE ? O_SK : O_PK); GAS float* const ovp = F.out + (SAMPLE ? O_SV : O_PV);
        const size_t ob = SAMPLE ? ((size_t)(l * BS + b) * 128) : ((size_t)(l * BP + b) * 128);
        const int roff = SAMPLE ? 8 : 63; const bool wr_cache = SAMPLE || q0 == TP - 64;
        for (int row = tid >> 3; row < 192; row += 64) {
            float ko[8], vo[8]; bool zero = false;
            if (SAMPLE && row < 128) { const GAS f32x4* kp = (const GAS f32x4*)(ckp + (((size_t)(l * BS + b) * 128 + row) * 2 + g) * 64 + 8 * j8); const GAS f32x4* vp = (const GAS f32x4*)(cvp + (((size_t)(l * BS + b) * 128 + row) * 2 + g) * 64 + 8 * j8);
                const f32x4 k0 = kp[0], k1 = kp[1], v0 = vp[0], v1 = vp[1];
                ko[0] = k0.x; ko[1] = k0.y; ko[2] = k0.z; ko[3] = k0.w; ko[4] = k1.x; ko[5] = k1.y; ko[6] = k1.z; ko[7] = k1.w; vo[0] = v0.x; vo[1] = v0.y; vo[2] = v0.z; vo[3] = v0.w; vo[4] = v1.x; vo[5] = v1.y; vo[6] = v1.z; vo[7] = v1.w; }
            else {
                int t, prow;
                if (SAMPLE) { t = row - 128; prow = 4096 + t; if (row >= 136) zero = true; } else { t = q0 - 127 + row; prow = t; if (t < 0 || row == 191) zero = true; }
                if (zero) {
#pragma unroll
                    for (int e = 0; e < 8; ++e) { ko[e] = 0.f; vo[e] = 0.f; } }
                else {
                    const GAS bf16* pr = PROJ + (mbase + t) * NPROJ;
                    const v4u kw = *(const GAS v4u*)(pr + C_DK + g * 64 + 8 * j8); const v4u vw = *(const GAS v4u*)(pr + C_DV + g * 64 + 8 * j8);
                    float kr[8] = {bflo(kw.x), bfhi(kw.x), bflo(kw.y), bfhi(kw.y), bflo(kw.z), bfhi(kw.z), bflo(kw.w), bfhi(kw.w)};
                    vo[0] = bflo(vw.x); vo[1] = bfhi(vw.x); vo[2] = bflo(vw.y); vo[3] = bfhi(vw.y); vo[4] = bflo(vw.z); vo[5] = bfhi(vw.z); vo[6] = bflo(vw.w); vo[7] = bfhi(vw.w);
                    float ss = 0.f;
#pragma unroll
                    for (int e = 0; e < 8; ++e) ss += kr[e] * kr[e];
                    ss += __shfl_xor(ss, 1); ss += __shfl_xor(ss, 2); ss += __shfl_xor(ss, 4);
                    const float rn = 1.f / sqrtf(ss * (1.f / 64.f) + EPS);
                    const GAS float* rp = ROPE + (size_t)prow * 64 + ((8 * j8) & 31);
                    const f32x4 rc0 = *(const GAS f32x4*)rp, rc1 = *(const GAS f32x4*)(rp + 4), rs0 = *(const GAS f32x4*)(rp + 32), rs1 = *(const GAS f32x4*)(rp + 36);
                    const float rcv[8] = {rc0.x, rc0.y, rc0.z, rc0.w, rc1.x, rc1.y, rc1.z, rc1.w}, rsv[8] = {rs0.x, rs0.y, rs0.z, rs0.w, rs1.x, rs1.y, rs1.z, rs1.w};
#pragma unroll
                    for (int e = 0; e < 8; ++e) { const float kn = kr[e] * rn * kgv[e]; const float other = __shfl_xor(kn, 4); const float c = rcv[e], s = rsv[e];
                        ko[e] = j8 < 4 ? kn * c - other * s : kn * c + other * s; }
                }
            }
            v4u kp4; kp4.x = pk2(ko[0], ko[1]); kp4.y = pk2(ko[2], ko[3]); kp4.z = pk2(ko[4], ko[5]); kp4.w = pk2(ko[6], ko[7]);
            *(LAS v4u*)(Kb + row * LDK + 8 * j8) = kp4;
#pragma unroll
            for (int e = 0; e < 8; ++e) VT[(8 * j8 + e) * LDV + row] = tobf(vo[e]);
            if (wr_cache && row >= roff && row < roff + 128) { const size_t o = ((ob + (row - roff)) * 2 + g) * 64 + 8 * j8;
                *(GAS f32x4*)(okp + o) = (f32x4){ko[0], ko[1], ko[2], ko[3]}; *(GAS f32x4*)(okp + o + 4) = (f32x4){ko[4], ko[5], ko[6], ko[7]};
                *(GAS f32x4*)(ovp + o) = (f32x4){vo[0], vo[1], vo[2], vo[3]}; *(GAS f32x4*)(ovp + o + 4) = (f32x4){vo[4], vo[5], vo[6], vo[7]}; }
        }
    }
    const bool qwave = !SAMPLE || wave == 0;
    if (qwave) {
        const int dh = lane & 1, qi = (lane >> 1) & 7, r = lane >> 4, head = g * 4 + r;
        const int t = SAMPLE ? qi : q0 + 8 * wave + qi; const int prow = SAMPLE ? 4096 + t : t;
        const GAS v4u* qp = (const GAS v4u*)(PROJ + (mbase + t) * NPROJ + C_DQ + head * 64 + 32 * dh);
        const v4u w0 = qp[0], w1 = qp[1], w2 = qp[2], w3 = qp[3];
        float ss = sq8(w0) + sq8(w1) + sq8(w2) + sq8(w3);
        ss += __shfl_xor(ss, 1);
        const float rn = 0.125f / sqrtf(ss * (1.f / 64.f) + EPS);
        const GAS float* qg = INP(I_QNG) + l * 64 + 32 * dh; const GAS float* rp = ROPE + (size_t)prow * 64;
        LAS v4u* qd = (LAS v4u*)(Qs + (32 * wave + 16 * (r >> 1) + 8 * (r & 1) + qi) * LDK + 32 * dh);
        qd[0] = rope8(w0, rn, qg, rp, dh); qd[1] = rope8(w1, rn, qg + 8, rp + 8, dh); qd[2] = rope8(w2, rn, qg + 16, rp + 16, dh); qd[3] = rope8(w3, rn, qg + 24, rp + 24, dh);
    }
    __syncthreads();
    bf16x8v qf[2][2];
    if (qwave) {
#pragma unroll
        for (int rt = 0; rt < 2; ++rt)
#pragma unroll
            for (int ks = 0; ks < 2; ++ks) qf[rt][ks] = *(const LAS bf16x8v*)(Qs + (32 * wave + 16 * rt + (lane & 15)) * LDK + 32 * ks + 8 * (lane >> 4));
    }
    __syncthreads();
    if (qwave) {
        const int ks0 = SAMPLE ? 0 : (8 * wave < 32 ? 8 * wave : 32);
        const GAS float* skp = INP(I_SINK) + l * 8 + g * 4;
#pragma unroll
        for (int rt = 0; rt < 2; ++rt) {
            f32x4 sc[10]; int kl = ks0 + (lane & 15); asm volatile("" : "+v"(kl));
#pragma unroll
            for (int c = 0; c < 10; ++c) { sc[c] = (f32x4){0.f, 0.f, 0.f, 0.f}; const LAS bf16* kp = Kb + (ks0 + 16 * c + (lane & 15)) * LDK + 8 * (lane >> 4);
                sc[c] = __builtin_amdgcn_mfma_f32_16x16x32_bf16(qf[rt][0], *(const LAS bf16x8v*)kp, sc[c], 0, 0, 0);
                sc[c] = __builtin_amdgcn_mfma_f32_16x16x32_bf16(qf[rt][1], *(const LAS bf16x8v*)(kp + 32), sc[c], 0, 0, 0); }
            float mx[4], sm[4], sinkv[4]; int klo[4]; unsigned span[4];
#pragma unroll
            for (int i = 0; i < 4; ++i) { const int row = 4 * (lane >> 4) + i, qi = row & 7; const int qrow = SAMPLE ? 128 + qi : 127 + 8 * wave + qi;
                sinkv[i] = skp[2 * rt + (row >> 3)]; mx[i] = sinkv[i]; sm[i] = 0.f;
                klo[i] = (qrow - 127) > row_min ? (qrow - 127) : row_min; span[i] = (unsigned)(qrow - klo[i]); }
#pragma unroll
            for (int c = 0; c < 10; ++c) { const int kr = kl + 16 * c;
#pragma unroll
                for (int i = 0; i < 4; ++i) { const float sv = ((unsigned)(kr - klo[i]) <= span[i]) ? sc[c][i] : -INFINITY; sc[c][i] = sv; mx[i] = fmaxf(mx[i], sv); } }
#pragma unroll
            for (int i = 0; i < 4; ++i) { float m = mx[i]; m = fmaxf(m, __shfl_xor(m, 1)); m = fmaxf(m, __shfl_xor(m, 2)); m = fmaxf(m, __shfl_xor(m, 4)); m = fmaxf(m, __shfl_xor(m, 8)); mx[i] = m; }
#pragma unroll
            for (int c = 0; c < 10; ++c) {
#pragma unroll
                for (int i = 0; i < 4; ++i) { const float p = __expf(sc[c][i] - mx[i]); sm[i] += p; Pw[(4 * (lane >> 4) + i) * LDPW + 16 * c + (lane & 15)] = tobf(p); } }
#pragma unroll
            for (int i = 0; i < 4; ++i) { float a = sm[i]; a += __shfl_xor(a, 1); a += __shfl_xor(a, 2); a += __shfl_xor(a, 4); a += __shfl_xor(a, 8); sm[i] = a + __expf(sinkv[i] - mx[i]); }
            asm volatile("s_waitcnt lgkmcnt(0)" ::: "memory");
#pragma unroll
            for (int dj = 0; dj < 4; ++dj) { f32x4 o = (f32x4){0.f, 0.f, 0.f, 0.f};
                o = mma16(Pw, LDPW, VT + dj * 16 * LDV + ks0, LDV, 160, o, lane);
#pragma unroll
                for (int i = 0; i < 4; ++i) { const int row = 4 * (lane >> 4) + i, qi = row & 7, head = g * 4 + 2 * rt + (row >> 3); const int t = SAMPLE ? qi : q0 + 8 * wave + qi;
                    MIX[(mbase + t) * D + 1536 + head * 64 + dj * 16 + (lane & 15)] = tobf(o[i] / sm[i]); } }
            asm volatile("s_waitcnt lgkmcnt(0)" ::: "memory");
        }
    }
}
template <int WIN> __device__ __forceinline__ void pool_rows_prompt(const GAS bf16* base, int ta, LAS bf16* pl, int LDP) {
    unsigned rw[47];
#pragma unroll
    for (int i = 0; i < 47; ++i) { const int t = ta - 15 + i; rw[i] = *(const GAS unsigned*)(base + (size_t)(t >= 0 ? t : 0) * NPROJ); if (t < 0) rw[i] = 0u; }
    float s0 = 0.f, s1 = 0.f;
#pragma unroll
    for (int j = 1; j < WIN; ++j) { s0 += bflo(rw[15 - j]); s1 += bfhi(rw[15 - j]); }
#pragma unroll
    for (int i = 0; i < 32; ++i) { const int t = ta + i; const float a0 = bflo(rw[15 + i]), a1 = bfhi(rw[15 + i]); s0 += a0; s1 += a1;
        const float ic = __builtin_amdgcn_rcpf((float)((t + 1) < WIN ? (t + 1) : WIN));
        *(LAS unsigned*)(pl + i * LDP) = pk2(s0 * ic - a0, s1 * ic - a1);
        s0 -= bflo(rw[15 + i - WIN + 1]); s1 -= bfhi(rw[15 + i - WIN + 1]); }
}
template <int WIN> __device__ __forceinline__ void pool_rows_sample(const GAS bf16* base, const GAS float* buf, LAS bf16* pl, int LDP) {
    float e0[23], e1[23];
#pragma unroll
    for (int i = 0; i < 15; ++i) { e0[i] = buf[(size_t)i * 512]; e1[i] = buf[(size_t)i * 512 + 1]; }
#pragma unroll
    for (int i = 0; i < 8; ++i) { const unsigned w = *(const GAS unsigned*)(base + (size_t)i * NPROJ); e0[15 + i] = bflo(w); e1[15 + i] = bfhi(w); }
    float s0 = 0.f, s1 = 0.f;
#pragma unroll
    for (int j = 1; j < WIN; ++j) { s0 += e0[15 - j]; s1 += e1[15 - j]; }
#pragma unroll
    for (int i = 0; i < 8; ++i) { s0 += e0[15 + i]; s1 += e1[15 + i];
        *(LAS unsigned*)(pl + i * LDP) = pk2(s0 * (1.f / WIN) - e0[15 + i], s1 * (1.f / WIN) - e1[15 + i]);
        s0 -= e0[15 + i - WIN + 1]; s1 -= e1[15 + i - WIN + 1]; }
}
__device__ __forceinline__ void pool_unit(Frame& F, int l, int u) {
    WS_LOCALS
    const int tid = F.tid, lane = F.lane, wave = F.wave;
    const GAS float* const spp = INP(I_SPOOL);
    LAS bf16* pl = (LAS bf16*)F.lds; constexpr int LDP = 520;
    const bool samp = u >= 128; const int b = samp ? 0 : (u >> 6), t0 = samp ? 0 : (u & 63) * 64; const int s8 = samp ? (u - 128) * 8 : 0;
    const size_t m0 = samp ? (size_t)MP + (size_t)s8 * TS : (size_t)b * TP + t0;
    __syncthreads();
    {   const int pr = tid & 255, half = tid >> 8, c0 = 2 * pr, gi = (wave & 3);
        if (!samp) { const GAS bf16* base = PROJ + ((size_t)b * TP) * NPROJ + C_PU + c0; LAS bf16* pp = pl + (half * 32) * LDP + c0; const int ta = t0 + half * 32;
            if (gi == 0) pool_rows_prompt<2>(base, ta, pp, LDP); else if (gi == 1) pool_rows_prompt<4>(base, ta, pp, LDP); else if (gi == 2) pool_rows_prompt<8>(base, ta, pp, LDP); else pool_rows_prompt<16>(base, ta, pp, LDP); }
        else {
#pragma unroll 1
            for (int q = 0; q < 4; ++q) { const int bq = half * 4 + q, bs = s8 + bq; const GAS bf16* base = PROJ + ((size_t)MP + (size_t)bs * TS) * NPROJ + C_PU + c0; const GAS float* buf = spp + ((size_t)(l * BS + bs) * 15) * 512 + c0; LAS bf16* pp = pl + (bq * 8) * LDP + c0;
                if (gi == 0) pool_rows_sample<2>(base, buf, pp, LDP); else if (gi == 1) pool_rows_sample<4>(base, buf, pp, LDP); else if (gi == 2) pool_rows_sample<8>(base, buf, pp, LDP); else pool_rows_sample<16>(base, buf, pp, LDP); } }
    }
    __syncthreads();
    {   const int g = wave >> 1; const GAS float* scp = INP(I_PSC) + l * 512 + g * 128;
        const GAS bf16* wpt = (const GAS bf16*)wsp(F, WS_WPT) + (size_t)(l * 4 + g) * 16384;
#pragma unroll 1
        for (int jj = 0; jj < 4; ++jj) { const int vj = 4 * (wave & 1) + jj;
            bf16x8v bfr[4];
#pragma unroll
            for (int k = 0; k < 4; ++k) bfr[k] = *(const GAS bf16x8v*)(wpt + (size_t)(vj * 16 + (lane & 15)) * 128 + k * 32 + 8 * (lane >> 4));
            const int dd = vj * 16 + (lane & 15); const float sc = scp[dd];
#pragma unroll
            for (int ti = 0; ti < 4; ++ti) { f32x4 acc = (f32x4){0.f, 0.f, 0.f, 0.f};
                const LAS bf16* ap = pl + (ti * 16 + (lane & 15)) * LDP + g * 128 + 8 * (lane >> 4);
#pragma unroll
                for (int k = 0; k < 4; ++k) acc = __builtin_amdgcn_mfma_f32_16x16x32_bf16(*(const LAS bf16x8v*)(ap + k * 32), bfr[k], acc, 0, 0, 0);
#pragma unroll
                for (int i = 0; i < 4; ++i) MIX[(m0 + ti * 16 + 4 * (lane >> 4) + i) * D + 512 + g * 128 + dd] = tobf(acc[i] * sc); } }
    }
    if (!samp && t0 == TP - 64) {
        float tv[15];
#pragma unroll
        for (int j = 0; j < 15; ++j) tv[j] = bf2f(PROJ[((size_t)b * TP + TP - 15 + j) * NPROJ + C_PU + tid]);
#pragma unroll
        for (int j = 0; j < 15; ++j) F.out[O_PPOOL + ((size_t)(l * BP + b) * 15 + j) * 512 + tid] = tv[j]; }
    if (samp) {
#pragma unroll 1
        for (int q = 0; q < 8; ++q) { const int bs = s8 + q; float tv[15];
#pragma unroll
            for (int j = 0; j < 15; ++j) tv[j] = j < 7 ? spp[((size_t)(l * BS + bs) * 15 + 8 + j) * 512 + tid] : bf2f(PROJ[((size_t)MP + (size_t)bs * TS + (j - 7)) * NPROJ + C_PU + tid]);
#pragma unroll
            for (int j = 0; j < 15; ++j) F.out[O_SPOOL + ((size_t)(l * BS + bs) * 15 + j) * 512 + tid] = tv[j]; } }
}
#ifndef TIME_MASK
#define TIME_MASK 0
#endif
#ifndef TIME_BLOCK
#define TIME_BLOCK 0
#endif
#define TSTART(bit) do { if ((TIME_MASK >> (bit)) & 1) tph = __builtin_amdgcn_s_memrealtime(); } while (0)
#define TSTOP(bit) do { if ((TIME_MASK >> (bit)) & 1) tacc += __builtin_amdgcn_s_memrealtime() - tph; } while (0)
#ifndef PROBE_MASK
#define PROBE_MASK 0
#endif
#ifndef PROBE_DUP
#define PROBE_DUP 0
#endif
#ifdef PH_SEL
#define PSEL(k, stmt) do { if ((k) == PH_SEL) { stmt; } } while (0)
#else
#define PSEL(k, stmt) do { stmt; } while (0)
#endif
struct Args { const float* in[N_IN]; float* out; unsigned char* ws; int ph_lo, ph_hi; };
static_assert(sizeof(Args) == (N_IN + 2) * 8 + 8, "Args has no padding");
__global__ void __launch_bounds__(NTHR, 2) hymba_fwd(Args args) {
    extern __shared__ __attribute__((aligned(16))) unsigned char lds[];
    Frame F;
    F.lds = (LAS unsigned char*)lds;
    F.MISC = (volatile LAS unsigned*)(F.lds + MISC_OFF);
    F.tid = threadIdx.x; F.lane = F.tid & 63; F.wave = __builtin_amdgcn_readfirstlane(F.tid >> 6);
    F.G = gridDim.x; F.gw = (int)blockIdx.x * NWAVES + F.wave; F.ngw = F.G * NWAVES;
    GAS unsigned char* ws = (GAS unsigned char*)args.ws; F.ws = ws; F.out = (GAS float*)args.out;
    F.ctl = (gu32*)(ws + WS_CTL);
    for (int u = F.tid; u < (LDS_BYTES - LDSCTL_OFF) / 4; u += NTHR) ((LAS unsigned*)(F.lds + LDSCTL_OFF))[u] = 0u;
    __syncthreads();
    if (F.tid < N_IN) ((LAS unsigned long long*)(F.lds + PTR_OFF))[F.tid] = (unsigned long long)args.in[F.tid];
    __syncthreads();
    const int lo = args.ph_lo, hi = args.ph_hi;
    XcdBarrier bar; bar.bar = (unsigned*)(F.ctl + CW_BAR); bar.x = 0; bar.st = nullptr;
    if (hi - lo > 1) bar = xcd_barrier_post((unsigned*)(F.ctl + CW_BAR), F.MISC + 8);
#define IN(k) (lo <= (k) && (k) < hi)
#define LAUNDER(P) asm volatile("" : "+v"(P.tid), "+v"(P.lane), "+s"(P.wave), "+s"(P.gw))
#define UL_DYN(bit, q, n, k, call) do { const int nrep_ = ((PROBE_MASK >> (bit)) & 1) ? 2 : 1; int nr_ = nrep_; asm volatile("" : "+s"(nr_)); for (int rr = 0; rr < nr_; ++rr) { Frame Q = F; LAUNDER(Q); while ((u = deq(Q, l * 32 + 16 * rr + (q))) < (n)) PSEL(k, call); } } while (0)
#define UL(bit, off, n, k, call) do { const int nrep_ = ((PROBE_MASK >> (bit)) & 1) ? 2 : 1; int nr_ = nrep_; asm volatile("" : "+s"(nr_)); for (int rr = 0; rr < nr_; ++rr) { Frame Q = F; LAUNDER(Q); for (u = ((int)blockIdx.x + F.G - ((off) % F.G)) % F.G; u < (n); u += F.G) { __syncthreads(); PSEL(k, call); } } } while (0)
#define PHASE_LOCALS Frame P = F; LAUNDER(P); WS_LOCALS
#define SEAM(k) do { if (IN(k) && IN((k) + 1)) xcd_barrier(bar); } while (0)
    unsigned long long tacc = 0, tph = 0; (void)tph;
    int rp_pro = (PROBE_DUP == 1) ? 2 : 1, rp_mix = (PROBE_DUP == 2) ? 2 : 1, rp_up = (PROBE_DUP == 3) ? 2 : 1, rp_in = (PROBE_DUP == 4) ? 2 : 1; asm volatile("" : "+s"(rp_pro), "+s"(rp_mix), "+s"(rp_up), "+s"(rp_in));
    TSTART(0); for (int rp = 0; rp < rp_pro; ++rp) { if (IN(0)) { PSEL(0, p0_prologue(F)); } SEAM(0); } TSTOP(0);
    for (int l = 0; l < DEPTH; ++l) {
        const int pb = 1 + l * PH_PER_LAYER;

        TSTART(1); if (IN(pb + 0)) { PHASE_LOCALS  PSEL(1, norm_phase(P, l, 0, l > 0 ? NSL_DN : 0)); } SEAM(pb + 0); TSTOP(1);
        for (int rq = 0; rq < rp_in; ++rq) {
        TSTART(2); if (IN(pb + 1)) { PHASE_LOCALS
            pg8::Gemm g{H, Wi + (size_t)l * NPROJ * D, M, NPROJ, D}; pg8::StaticOrder S; S.init(M, NPROJ, D, F.G, (int)blockIdx.x);
            pg8::EpiStoreBf16 E{PROJ, NPROJ, 0, 0};
            PSEL(2, (pg8::gemm_phase<pg8::EpiStoreBf16, pg8::StaticOrder, true, true>(P.lds, g, S, E)));
            if (F.G == 256) convert_multi(P, 115, 141, 1, l, 304, 864, 0, 0, 0, 0, 0, 0, 0, 0, 0);
            else convert_multi(P, 0, F.G, 1, l, 304, 864, 0, 0, 0, 0, 0, 0, 0, 0, 0);
        } SEAM(pb + 1); TSTOP(2);
        }
        for (int rp = 0; rp < rp_mix; ++rp) {
        TSTART(3); if (IN(pb + 2)) { PHASE_LOCALS
            int u;
            TSTART(23);
            TSTART(11); UL(3, 0, 128, 3, ssd_unit<0>(Q, l, u)); TSTOP(11);
            TSTART(12); UL(1, 0, 256, 4, attn_unit<0>(Q, l, u)); TSTOP(12);
            TSTART(13);
            {   Frame Q = F; LAUNDER(Q); const int bx = (int)blockIdx.x, G_ = F.G; const int nk = G_ == 256 ? 3 : (512 + G_ - 1) / G_;
                for (int k = 0; k < nk; ++k) { int uu;
                    if (G_ == 256) uu = k < 2 ? (bx < 224 ? bx + 224 * k : -1) : ((bx >= 160 && bx < 224) ? 448 + bx - 160 : -1); else uu = bx + k * G_ < 512 ? bx + k * G_ : -1;
                    if (uu >= 0) { __syncthreads(); hgrn_unit<0>(Q, l, uu); } } }
            TSTOP(13);
            TSTART(14);
            {   Frame Q = F; LAUNDER(Q); const int bx = (int)blockIdx.x, G_ = F.G; const int nk = G_ == 256 ? 1 : (132 + G_ - 1) / G_;
                for (int k = 0; k < nk; ++k) { int uu;
                    if (G_ == 256) uu = bx >= 128 ? bx - 128 : ((bx >= 64 && bx < 68) ? 128 + bx - 64 : -1); else uu = bx + k * G_ < 132 ? bx + k * G_ : -1;
                    if (uu >= 0) { __syncthreads(); pool_unit(Q, l, uu); } } }
            TSTOP(14);
            TSTART(15); UL(3, 224, 32, 7, ssd_unit<2>(Q, l, u)); TSTOP(15);
            TSTART(16); UL(1, 160, 64, 8, attn_unit<1>(Q, l, u)); TSTOP(16);
            TSTART(17);
            {   Frame Q = F; LAUNDER(Q); const int bx = (int)blockIdx.x, G_ = F.G; const int nk = G_ == 256 ? 2 : (128 + G_ - 1) / G_;
                for (int k = 0; k < nk; ++k) { int uu;
                    if (G_ == 256) uu = (bx >= 128 && bx < 160) ? bx - 128 + 32 * k : ((bx < 64 && k == 0) ? 64 + bx : -1); else uu = bx + k * G_ < 128 ? bx + k * G_ : -1;
                    if (uu >= 0) { __syncthreads(); hgrn_unit<2>(Q, l, uu); } } }
            TSTOP(17);
            TSTOP(23);
        } SEAM(pb + 2); TSTOP(3);
        TSTART(4); if (IN(pb + 3)) { PHASE_LOCALS  { int nr_ = ((PROBE_MASK >> 4) & 1) ? 2 : 1; asm volatile("" : "+s"(nr_)); for (int rr = 0; rr < nr_; ++rr) PSEL(10, scan_phase(P, l)); } } SEAM(pb + 3); TSTOP(4);
        TSTART(5); if (IN(pb + 4)) { PHASE_LOCALS
            int u;
            TSTART(18); UL(5, 0, 128, 11, ssd_unit<1>(Q, l, u)); TSTOP(18);
            TSTART(19); { Frame Q = F; LAUNDER(Q); const int bx = (int)blockIdx.x, G_ = F.G; const int nk = G_ == 256 ? 4 : (512 + G_ - 1) / G_;
                for (int k = 0; k < nk; ++k) { int uu;
                    if (G_ == 256) uu = bx < 128 ? (k == 0 ? 384 + bx : -1) : (bx < 192 ? (k < 2 ? (bx - 128) + 64 * k : -1) : 128 + (bx - 192) + 64 * k); else uu = bx + k * G_ < 512 ? bx + k * G_ : -1;
                    if (uu >= 0) { __syncthreads(); hgrn_unit<1>(Q, l, uu); } } } TSTOP(19);
            {
                __syncthreads();
                pg8::Gemm g{MIX, Wo + (size_t)l * D * D, M, D, D}; pg8::SliceOrder S; S.init(MP / 256, D, D, NSL_OUT, F.G < 64 ? F.G : 64, ((int)blockIdx.x + F.G - (128 % F.G)) % F.G);
                pg8::EpiGateRes E{F.out, D, MOD + (size_t)l * NBB * NMOD + 2 * D, NMOD, (GAS float*)wsp(F, WS_PART), (l == 0 ? INP(I_XP) : (const GAS float*)F.out)};
                pg8::gemm_phase<pg8::EpiGateRes, pg8::SliceOrder, true, true>(P.lds, g, S, E); }
        } SEAM(pb + 4); TSTOP(5);
        }
        TSTART(6); if (IN(pb + 5)) { PHASE_LOCALS
            pg8::Gemm g{MIX, Wo + (size_t)l * D * D, M, D, D}; pg8::StaticOrder S; S.init(MP, D, D, F.G, (int)blockIdx.x);
            pg8::EpiGateRes E{F.out, D, MOD + (size_t)l * NBB * NMOD + 2 * D, NMOD, (GAS float*)wsp(F, WS_PART), (l == 0 ? INP(I_XP) : (const GAS float*)F.out)};
            TSTART(22); PSEL(13, (pg8::gemm_phase<pg8::EpiGateRes, pg8::StaticOrder, true, true>(P.lds, g, S, E))); TSTOP(22);
        } SEAM(pb + 5); TSTOP(6);
        TSTART(7); if (IN(pb + 6)) { PHASE_LOCALS  PSEL(14, norm_phase(P, l, 1, NSL_OUT)); } SEAM(pb + 6); TSTOP(7);
        for (int rp = 0; rp < rp_up; ++rp) {
        TSTART(8); if (IN(pb + 7)) { PHASE_LOCALS
            pg8::Gemm g{H, Wu + (size_t)l * DFF * D, M, DFF, D}; pg8::StaticOrder S; S.init(M, DFF, D, F.G, (int)blockIdx.x);
            pg8::EpiStoreBf16 E{U, DFF, 1, 1};
            PSEL(15, (pg8::gemm_phase<pg8::EpiStoreBf16, pg8::StaticOrder, true, true>(P.lds, g, S, E)));
            convert_multi(P, 32, F.G - 32, (l + 1 < DEPTH ? 3 : 1), l, 944, 1456, 0, l + 1, 0, 304, (F.G == 256 ? 160 : 0), l + 1, 864, 944, (F.G == 256 ? 80 : 0));
        } SEAM(pb + 7); TSTOP(8);
        }
        TSTART(9); if (IN(pb + 8)) { PHASE_LOCALS
            pg8::Gemm g{U, Wd + (size_t)l * D * DFF, M, D, DFF}; pg8::SplitOrder S; S.init(MP, D, DFF, NSL_DN, F.G, (int)blockIdx.x);
            pg8::EpiGateRes E{F.out, D, MOD + (size_t)l * NBB * NMOD + 5 * D, NMOD, (GAS float*)wsp(F, WS_PART), (const GAS float*)F.out};
            TSTART(21); PSEL(16, (pg8::gemm_phase<pg8::EpiGateRes, pg8::SplitOrder, true, true, true>(P.lds, g, S, E))); TSTOP(21);
        } SEAM(pb + 8); TSTOP(9);
    }
    TSTART(10); if (IN(N_PHASES - 1)) { Frame P = F; LAUNDER(P); final_fix_phase(P, NSL_DN); } TSTOP(10);
    if (UT_MASK != 0 || GT_MASK != 0) tacc += ((unsigned long long)F.MISC[17] << 32) | F.MISC[16];
    if ((TIME_MASK != 0 || UT_MASK != 0 || GT_MASK != 0) && blockIdx.x == TIME_BLOCK) { const unsigned long long te = __builtin_amdgcn_s_memrealtime() + tacc; while (__builtin_amdgcn_s_memrealtime() < te) __builtin_amdgcn_s_sleep(8); }
#undef IN
#undef SEAM
}

extern "C" void kernel_launch(void* const* d_in, const int* in_sizes, int n_in, void* d_out, int out_size, void* d_ws, size_t ws_size, hipStream_t stream) {
    static int grid = 0;
    if (grid == 0) {
        if (n_in != N_IN || (size_t)out_size != O_END || ws_size < WS_END) { fprintf(stderr, "kernel_launch: unexpected shapes (n_in %d, out %d, ws %zu); nothing launched\n", n_in, out_size, ws_size); grid = -1; return; }
        int dev = 0, cus = 0, per_cu = 0;
        if (hipGetDevice(&dev) != hipSuccess || hipDeviceGetAttribute(&cus, hipDeviceAttributeMultiprocessorCount, dev) != hipSuccess) { grid = -1; return; }
        if (hipFuncSetAttribute((const void*)hymba_fwd, hipFuncAttributeMaxDynamicSharedMemorySize, LDS_BYTES) != hipSuccess) { fprintf(stderr, "kernel_launch: hipFuncSetAttribute failed\n"); grid = -1; return; }
        if (hipOccupancyMaxActiveBlocksPerMultiprocessor(&per_cu, (const void*)hymba_fwd, NTHR, LDS_BYTES) != hipSuccess || per_cu < 1) { fprintf(stderr, "kernel_launch: occupancy query says %d\n", per_cu); }
        (void)hipGetLastError();
        grid = cus < 256 ? cus : 256;
    }
    if (grid < 0) return;
    if (hipMemsetAsync((char*)d_ws + WS_CTL, 0, CTL_ZERO_BYTES, stream) != hipSuccess) return;
    Args a{};
    for (int i = 0; i < N_IN; ++i) a.in[i] = (const float*)d_in[i];
    a.out = (float*)d_out; a.ws = (unsigned char*)d_ws;
#if MK_ONE_LAUNCH
    a.ph_lo = 0; a.ph_hi = N_PHASES;
    hipLaunchKernelGGL(hymba_fwd, dim3(grid), dim3(NTHR), LDS_BYTES, stream, a);
#else
    for (int k = 0; k < N_PHASES; ++k) { a.ph_lo = k; a.ph_hi = k + 1; hipLaunchKernelGGL(hymba_fwd, dim3(grid), dim3(NTHR), LDS_BYTES, stream, a); }
#endif
}
```
